# Optimizing an MI355X kernel written in HIP

```python
import math
import jax, jax.numpy as jnp
from jax import lax
import numpy as np

D_MODEL = 1024
BATCH = 8
SEQ = 4096
DEPTH = 1

EPS = 1e-6
D_FF = 2816
CONV_CH = D_MODEL
CONV_WIDTH = 31
HEAD_DIM = 64
N_Q_HEADS = 16
N_KV_HEADS = 4
GROUP = N_Q_HEADS // N_KV_HEADS
WINDOW = 128
BLOCK = WINDOW
N_BUCKETS = 32
MAX_DISTANCE = 128
Q_W = N_Q_HEADS * HEAD_DIM
KV_W = N_KV_HEADS * HEAD_DIM
SPLITS = (2 * CONV_CH, Q_W, KV_W, KV_W, D_MODEL, D_MODEL)
IN_W = sum(SPLITS)

kernel_name = "hybrid_conformer_conv_swa_sink_macaron"


def rmsnorm(x, g):
    xf = x.astype(jnp.float32)
    y = xf * lax.rsqrt(jnp.mean(xf * xf, axis=-1, keepdims=True) + EPS)
    return (y * g.astype(jnp.float32)).astype(x.dtype)


def layernorm(x, g, b):
    xf = x.astype(jnp.float32)
    mu = jnp.mean(xf, axis=-1, keepdims=True)
    var = jnp.mean(jnp.square(xf - mu), axis=-1, keepdims=True)
    y = (xf - mu) * lax.rsqrt(var + EPS)
    return (y * g.astype(jnp.float32) + b.astype(jnp.float32)).astype(x.dtype)


def swiglu_ffn(x, w_in, w_out):
    a, b = jnp.split(x @ w_in, 2, axis=-1)
    return (jax.nn.silu(a) * b) @ w_out


def t5_causal_bucket(dist):
    max_exact = N_BUCKETS // 2
    d = jnp.maximum(dist, 1).astype(jnp.float32)
    large = max_exact + (jnp.log(d / max_exact) / math.log(MAX_DISTANCE / max_exact)
                         * (N_BUCKETS - max_exact)).astype(jnp.int32)
    large = jnp.minimum(large, N_BUCKETS - 1)
    return jnp.where(dist < max_exact, dist, large)


def conformer_conv(u, dw_kernel, dw_bias, ln_g, ln_b, w_proj):
    a, g = jnp.split(u, 2, axis=-1)
    z = a * jax.nn.sigmoid(g)
    z = lax.conv_general_dilated(
        z, dw_kernel[:, None, :].astype(z.dtype),
        window_strides=(1,), padding=((CONV_WIDTH - 1, 0),),
        dimension_numbers=("NWC", "WIO", "NWC"),
        feature_group_count=CONV_CH) + dw_bias
    z = jax.nn.silu(layernorm(z, ln_g, ln_b))
    return z @ w_proj


def sliding_window_gqa(q, k, v, q_norm_g, k_norm_g, sinks, rel_bias, w_o):
    B, S = q.shape[0], q.shape[1]
    nb = S // BLOCK
    q = rmsnorm(q, q_norm_g)
    k = rmsnorm(k, k_norm_g)
    qb = q.reshape(B, nb, BLOCK, N_KV_HEADS, GROUP, HEAD_DIM)
    kb = k.reshape(B, nb, BLOCK, N_KV_HEADS, HEAD_DIM)
    vb = v.reshape(B, nb, BLOCK, N_KV_HEADS, HEAD_DIM)
    kpad = jnp.zeros_like(kb[:, :1])
    vpad = jnp.zeros_like(vb[:, :1])
    kw = jnp.concatenate([jnp.concatenate([kpad, kb[:, :-1]], 1), kb], axis=2)
    vw = jnp.concatenate([jnp.concatenate([vpad, vb[:, :-1]], 1), vb], axis=2)

    s = jnp.einsum("bnqhgd,bnkhd->bnhgqk", qb, kw).astype(jnp.float32)
    s = s * (1.0 / math.sqrt(HEAD_DIM))

    qi = jnp.arange(BLOCK, dtype=jnp.int32)[:, None]
    kj = jnp.arange(2 * BLOCK, dtype=jnp.int32)[None, :]
    dist = qi + BLOCK - kj
    in_win = (dist >= 0) & (dist < WINDOW)
    bucket = t5_causal_bucket(jnp.maximum(dist, 0))
    bias = rel_bias.astype(jnp.float32)[bucket]
    bias = jnp.transpose(bias, (2, 0, 1)).reshape(N_KV_HEADS, GROUP, BLOCK, 2 * BLOCK)
    key_pos = jnp.arange(nb, dtype=jnp.int32)[:, None] * BLOCK - BLOCK + kj
    valid = in_win[None] & (key_pos >= 0)[:, None, :]

    s = s + bias[None, None]
    s = jnp.where(valid[None, :, None, None], s, jnp.finfo(jnp.float32).min)
    sink = sinks.astype(jnp.float32).reshape(N_KV_HEADS, GROUP)[None, None, :, :, None, None]
    m = jnp.maximum(jnp.max(s, axis=-1, keepdims=True), sink)
    p = jnp.exp(s - m)
    p = p / (jnp.sum(p, axis=-1, keepdims=True) + jnp.exp(sink - m))
    o = jnp.einsum("bnhgqk,bnkhd->bnqhgd", p.astype(vw.dtype), vw)
    return o.reshape(B, S, Q_W) @ w_o


def setup_inputs(seed: int = 0) -> dict:
    key = jax.random.key(seed)
    ks = jax.random.split(key, 24)
    f32 = jnp.float32

    def w(k, shape, fan_in):
        return jax.random.normal(k, shape, f32) * (fan_in ** -0.5)

    def gain(k, n):
        return jnp.ones((n,), f32) + 0.01 * jax.random.normal(k, (n,), f32)

    return {
        "x": jax.random.normal(ks[0], (BATCH, SEQ, D_MODEL), f32),
        "ffn1_norm": gain(ks[1], D_MODEL),
        "ffn1_w_in": w(ks[2], (D_MODEL, 2 * D_FF), D_MODEL),
        "ffn1_w_out": w(ks[3], (D_FF, D_MODEL), D_FF),
        "mix_norm": gain(ks[4], D_MODEL),
        "w_in": w(ks[5], (D_MODEL, IN_W), D_MODEL),
        "conv_dw_kernel": w(ks[6], (CONV_WIDTH, CONV_CH), CONV_WIDTH),
        "conv_dw_bias": 0.01 * jax.random.normal(ks[7], (CONV_CH,), f32),
        "conv_ln_g": gain(ks[8], CONV_CH),
        "conv_ln_b": 0.01 * jax.random.normal(ks[9], (CONV_CH,), f32),
        "conv_w_proj": w(ks[10], (CONV_CH, D_MODEL), CONV_CH),
        "q_norm": gain(ks[11], HEAD_DIM),
        "k_norm": gain(ks[12], HEAD_DIM),
        "attn_sinks": jax.random.normal(ks[13], (N_Q_HEADS,), f32),
        "rel_bias": 0.1 * jax.random.normal(ks[14], (N_BUCKETS, N_Q_HEADS), f32),
        "attn_w_o": w(ks[15], (Q_W, D_MODEL), Q_W),
        "w_out": w(ks[16], (D_MODEL, D_MODEL), D_MODEL),
        "ffn2_norm": gain(ks[17], D_MODEL),
        "ffn2_w_in": w(ks[18], (D_MODEL, 2 * D_FF), D_MODEL),
        "ffn2_w_out": w(ks[19], (D_FF, D_MODEL), D_FF),
    }


def reference(x, ffn1_norm, ffn1_w_in, ffn1_w_out, mix_norm, w_in,
              conv_dw_kernel, conv_dw_bias, conv_ln_g, conv_ln_b, conv_w_proj,
              q_norm, k_norm, attn_sinks, rel_bias, attn_w_o, w_out,
              ffn2_norm, ffn2_w_in, ffn2_w_out):
    B, S = x.shape[0], x.shape[1]
    for _ in range(DEPTH):
        x = x + 0.5 * swiglu_ffn(rmsnorm(x, ffn1_norm), ffn1_w_in, ffn1_w_out)

        h = rmsnorm(x, mix_norm)
        idx = np.cumsum(SPLITS)[:-1].tolist()
        u_conv, q, k, v, g_conv, g_attn = jnp.split(h @ w_in, idx, axis=-1)
        a = conformer_conv(u_conv, conv_dw_kernel, conv_dw_bias, conv_ln_g, conv_ln_b, conv_w_proj)
        b = sliding_window_gqa(q.reshape(B, S, N_Q_HEADS, HEAD_DIM),
                               k.reshape(B, S, N_KV_HEADS, HEAD_DIM),
                               v.reshape(B, S, N_KV_HEADS, HEAD_DIM),
                               q_norm, k_norm, attn_sinks, rel_bias, attn_w_o)
        merged = jax.nn.sigmoid(g_conv) * a + jax.nn.sigmoid(g_attn) * b
        x = x + merged @ w_out

        x = x + 0.5 * swiglu_ffn(rmsnorm(x, ffn2_norm), ffn2_w_in, ffn2_w_out)
    return x
```

```cpp
#include <hip/hip_runtime.h>
#include <cstdio>
#include <cstdint>

namespace nv {
constexpr int D = 1024, B = 8, S = 4096, FF = 2816, CW = 31, HD = 64, HQ = 16, HKV = 4, WIN = 128, INW = 5632;
constexpr float EPS = 1e-6f;

__device__ const unsigned char T5B[128] = {0, 1, 2, 3, 4, 5, 6, 7, 8, 9, 10, 11, 12, 13, 14, 15, 16, 16, 16, 17, 17, 18, 18, 18, 19, 19, 19, 20, 20, 20, 20, 21, 21, 21, 21, 22, 22, 22, 22, 22, 23, 23, 23, 23, 23, 23, 24, 24, 24, 24, 24, 24, 25, 25, 25, 25, 25, 25, 25, 26, 26, 26, 26, 26, 26, 26, 26, 27, 27, 27, 27, 27, 27, 27, 27, 27, 27, 28, 28, 28, 28, 28, 28, 28, 28, 28, 28, 29, 29, 29, 29, 29, 29, 29, 29, 29, 29, 29, 29, 30, 30, 30, 30, 30, 30, 30, 30, 30, 30, 30, 30, 30, 30, 31, 31, 31, 31, 31, 31, 31, 31, 31, 31, 31, 31, 31, 31, 31};

__device__ __forceinline__ float sigmoidf_(float v) { return 1.f / (1.f + expf(-v)); }
__device__ __forceinline__ float siluf_(float v) { return v / (1.f + expf(-v)); }

__device__ __forceinline__ float block_sum_256(float v, float* red) {
    for (int o = 32; o > 0; o >>= 1) v += __shfl_xor(v, o);
    const int w = threadIdx.x >> 6, l = threadIdx.x & 63;
    __syncthreads();
    if (l == 0) red[w] = v;
    __syncthreads();
    return red[0] + red[1] + red[2] + red[3];
}

__global__ void rms_rows(const float* x, const float* g, float* out) {
    __shared__ float red[4];
    const size_t r = blockIdx.x;
    const float4 v = ((const float4*)(x + r * D))[threadIdx.x];
    const float ss = block_sum_256(v.x * v.x + v.y * v.y + v.z * v.z + v.w * v.w, red);
    const float rs = rsqrtf(ss * (1.f / D) + EPS);
    const float4 gg = ((const float4*)g)[threadIdx.x];
    float4 o; o.x = v.x * rs * gg.x; o.y = v.y * rs * gg.y; o.z = v.z * rs * gg.z; o.w = v.w * rs * gg.w;
    ((float4*)(out + r * D))[threadIdx.x] = o;
}

__global__ void gemm_f32(const float* __restrict__ A, int lda, const float* __restrict__ Bm, int ldb, float* __restrict__ C, int ldc, int K) {
    __shared__ float As[16][68];
    __shared__ float Bs[16][68];
    const int tx = threadIdx.x & 15, ty = threadIdx.x >> 4;
    const int m0 = blockIdx.y * 64, n0 = blockIdx.x * 64;
    float acc[4][4] = {};
    for (int k0 = 0; k0 < K; k0 += 16) {
        {
            const int r = threadIdx.x >> 2, kq = (threadIdx.x & 3) * 4;
            const float4 a = *(const float4*)(A + (size_t)(m0 + r) * lda + k0 + kq);
            As[kq + 0][r] = a.x; As[kq + 1][r] = a.y; As[kq + 2][r] = a.z; As[kq + 3][r] = a.w;
            const int kr = threadIdx.x >> 4, c4 = (threadIdx.x & 15) * 4;
            const float4 b = *(const float4*)(Bm + (size_t)(k0 + kr) * ldb + n0 + c4);
            *(float4*)&Bs[kr][c4] = b;
        }
        __syncthreads();
#pragma unroll
        for (int k = 0; k < 16; ++k) {
            const float4 a = *(const float4*)&As[k][ty * 4];
            const float4 b = *(const float4*)&Bs[k][tx * 4];
            const float av[4] = {a.x, a.y, a.z, a.w}, bv[4] = {b.x, b.y, b.z, b.w};
#pragma unroll
            for (int i = 0; i < 4; ++i)
#pragma unroll
                for (int j = 0; j < 4; ++j) acc[i][j] = fmaf(av[i], bv[j], acc[i][j]);
        }
        __syncthreads();
    }
#pragma unroll
    for (int i = 0; i < 4; ++i) {
        float4 o; o.x = acc[i][0]; o.y = acc[i][1]; o.z = acc[i][2]; o.w = acc[i][3];
        *(float4*)(C + (size_t)(m0 + ty * 4 + i) * ldc + n0 + tx * 4) = o;
    }
}

__global__ void swiglu_k(const float* U, float* H, int rows) {
    const size_t i = (size_t)blockIdx.x * blockDim.x + threadIdx.x;
    if (i >= (size_t)rows * FF) return;
    const size_t t = i / FF; const int j = (int)(i % FF);
    const float a = U[t * (2 * FF) + j], b = U[t * (2 * FF) + FF + j];
    H[i] = siluf_(a) * b;
}
__global__ void resid_k(const float* xin, const float* y, float scale, float* out, size_t n) {
    const size_t i = (size_t)blockIdx.x * blockDim.x + threadIdx.x;
    if (i < n) out[i] = xin[i] + scale * y[i];
}
__global__ void glu_k(const float* P, float* z, int rows) {
    const size_t i = (size_t)blockIdx.x * blockDim.x + threadIdx.x;
    if (i >= (size_t)rows * D) return;
    const size_t t = i / D; const int c = (int)(i % D);
    z[i] = P[t * INW + c] * sigmoidf_(P[t * INW + D + c]);
}
__global__ void conv_k(const float* z, const float* w, const float* bias, float* y) {
    const size_t i = (size_t)blockIdx.x * blockDim.x + threadIdx.x;
    if (i >= (size_t)S * D) return;
    const int t = (int)(i / D), c = (int)(i % D);
    float acc = bias[c];
    for (int k = 0; k < CW; ++k) { const int tt = t - (CW - 1) + k; if (tt >= 0) acc = fmaf(w[k * D + c], z[(size_t)tt * D + c], acc); }
    y[i] = acc;
}
__global__ void ln_silu_k(const float* y, const float* g, const float* b, float* out) {
    __shared__ float red[4];
    const size_t r = blockIdx.x;
    const float4 v = ((const float4*)(y + r * D))[threadIdx.x];
    const float mu = block_sum_256(v.x + v.y + v.z + v.w, red) * (1.f / D);
    const float dx = v.x - mu, dy = v.y - mu, dz = v.z - mu, dw = v.w - mu;
    const float var = block_sum_256(dx * dx + dy * dy + dz * dz + dw * dw, red) * (1.f / D);
    const float rs = rsqrtf(var + EPS);
    const float4 gg = ((const float4*)g)[threadIdx.x], bb = ((const float4*)b)[threadIdx.x];
    float4 o; o.x = siluf_(dx * rs * gg.x + bb.x); o.y = siluf_(dy * rs * gg.y + bb.y); o.z = siluf_(dz * rs * gg.z + bb.z); o.w = siluf_(dw * rs * gg.w + bb.w);
    ((float4*)(out + r * D))[threadIdx.x] = o;
}
__global__ void qknorm_k(const float* P, const float* qg, const float* kg, float* qn, float* kn) {
    const int wv = (blockIdx.x * 4) + (threadIdx.x >> 6), lane = threadIdx.x & 63;
    const int t = wv / (HQ + HKV), hh = wv % (HQ + HKV);
    if (t >= S) return;
    const bool isq = hh < HQ;
    const int h = isq ? hh : hh - HQ;
    const float v = P[(size_t)t * INW + (isq ? 2 * D + h * HD : 3 * D + h * HD) + lane];
    float ss = v * v;
    for (int o = 32; o > 0; o >>= 1) ss += __shfl_xor(ss, o);
    const float rs = rsqrtf(ss * (1.f / HD) + EPS);
    if (isq) qn[(size_t)t * (HQ * HD) + h * HD + lane] = v * rs * qg[lane];
    else     kn[(size_t)t * (HKV * HD) + h * HD + lane] = v * rs * kg[lane];
}
__global__ void attn_k(const float* qn, const float* kn, const float* P, const float* sinks, const float* rel_bias, float* o) {
    const int wv = (blockIdx.x * 4) + (threadIdx.x >> 6), lane = threadIdx.x & 63;
    const int t = wv / HQ, h = wv % HQ, hk = h / (HQ / HKV);
    if (t >= S) return;
    const float* q = qn + (size_t)t * (HQ * HD) + h * HD;
    float s[2];
#pragma unroll
    for (int u = 0; u < 2; ++u) {
        const int dist = lane + 64 * u, key = t - dist;
        float acc = -3.0e38f;
        if (key >= 0) {
            const float* kr = kn + (size_t)key * (HKV * HD) + hk * HD;
            float d = 0.f;
            for (int e = 0; e < HD; ++e) d = fmaf(q[e], kr[e], d);
            acc = d * 0.125f + rel_bias[T5B[dist] * HQ + h];
        }
        s[u] = acc;
    }
    const float sink = sinks[h];
    float m = fmaxf(fmaxf(s[0], s[1]), sink);
    for (int of = 32; of > 0; of >>= 1) m = fmaxf(m, __shfl_xor(m, of));
    float p0 = (t - lane >= 0) ? expf(s[0] - m) : 0.f, p1 = (t - lane - 64 >= 0) ? expf(s[1] - m) : 0.f;
    float l = p0 + p1;
    for (int of = 32; of > 0; of >>= 1) l += __shfl_xor(l, of);
    l += expf(sink - m);
    const float inv = 1.f / l;
    float acc = 0.f;
    for (int j = 0; j < 64; ++j) {
        const float pj0 = __shfl(p0, j), pj1 = __shfl(p1, j);
        const int k0 = t - j, k1 = t - j - 64;
        if (k0 >= 0) acc = fmaf(pj0, P[(size_t)k0 * INW + 3 * D + HKV * HD + hk * HD + lane], acc);
        if (k1 >= 0) acc = fmaf(pj1, P[(size_t)k1 * INW + 3 * D + HKV * HD + hk * HD + lane], acc);
    }
    o[(size_t)t * (HQ * HD) + h * HD + lane] = acc * inv;
}
__global__ void merge_k(const float* P, const float* a, const float* b, float* mg, int rows) {
    const size_t i = (size_t)blockIdx.x * blockDim.x + threadIdx.x;
    if (i >= (size_t)rows * D) return;
    const size_t t = i / D; const int c = (int)(i % D);
    mg[i] = sigmoidf_(P[t * INW + 3584 + c]) * a[i] + sigmoidf_(P[t * INW + 4608 + c]) * b[i];
}

static void gemm(const float* A, int lda, const float* Bm, int ldb, float* C, int ldc, int M, int N, int K, hipStream_t st) {
    hipLaunchKernelGGL(gemm_f32, dim3(N / 64, M / 64), dim3(256), 0, st, A, lda, Bm, ldb, C, ldc, K);
}
}

extern "C" void kernel_launch(void* const* d_in, const int* in_sizes, int n_in, void* d_out, int out_size, void* d_ws, size_t ws_size, hipStream_t stream) {
    using namespace nv;
    const float* x = (const float*)d_in[0];
    const float* ffn1_norm = (const float*)d_in[1]; const float* ffn1_w_in = (const float*)d_in[2]; const float* ffn1_w_out = (const float*)d_in[3];
    const float* mix_norm = (const float*)d_in[4]; const float* w_in = (const float*)d_in[5];
    const float* conv_w = (const float*)d_in[6]; const float* conv_b = (const float*)d_in[7]; const float* ln_g = (const float*)d_in[8]; const float* ln_b = (const float*)d_in[9];
    const float* conv_proj = (const float*)d_in[10]; const float* q_norm = (const float*)d_in[11]; const float* k_norm = (const float*)d_in[12];
    const float* sinks = (const float*)d_in[13]; const float* rel_bias = (const float*)d_in[14]; const float* attn_wo = (const float*)d_in[15];
    const float* w_out = (const float*)d_in[16]; const float* ffn2_norm = (const float*)d_in[17]; const float* ffn2_w_in = (const float*)d_in[18]; const float* ffn2_w_out = (const float*)d_in[19];
    float* out = (float*)d_out;
    float* ws = (float*)d_ws;
    size_t off = 0;
    auto take = [&](size_t n) { float* p = ws + off; off += n; return p; };
    float* xn = take((size_t)S * D);
    float* U = take((size_t)S * INW);
    float* Hh = take((size_t)S * FF);
    float* Y = take((size_t)S * D);
    float* z = take((size_t)S * D);
    float* cy = take((size_t)S * D);
    float* cv = take((size_t)S * D);
    float* qn = take((size_t)S * D);
    float* kn = take((size_t)S * HKV * HD);
    float* ao = take((size_t)S * D);
    float* av = take((size_t)S * D);
    float* bv = take((size_t)S * D);
    float* mg = take((size_t)S * D);
    const int EB = 256;
    for (int b = 0; b < B; ++b) {
        const float* xb = x + (size_t)b * S * D;
        float* ob = out + (size_t)b * S * D;
        const size_t n1 = (size_t)S * D;
        hipLaunchKernelGGL(rms_rows, dim3(S), dim3(256), 0, stream, xb, ffn1_norm, xn);
        gemm(xn, D, ffn1_w_in, 2 * FF, U, 2 * FF, S, 2 * FF, D, stream);
        hipLaunchKernelGGL(swiglu_k, dim3((unsigned)(((size_t)S * FF + EB - 1) / EB)), dim3(EB), 0, stream, U, Hh, S);
        gemm(Hh, FF, ffn1_w_out, D, Y, D, S, D, FF, stream);
        hipLaunchKernelGGL(resid_k, dim3((unsigned)((n1 + EB - 1) / EB)), dim3(EB), 0, stream, xb, Y, 0.5f, ob, n1);
        hipLaunchKernelGGL(rms_rows, dim3(S), dim3(256), 0, stream, ob, mix_norm, xn);
        gemm(xn, D, w_in, INW, U, INW, S, INW, D, stream);
        hipLaunchKernelGGL(glu_k, dim3((unsigned)((n1 + EB - 1) / EB)), dim3(EB), 0, stream, U, z, S);
        hipLaunchKernelGGL(conv_k, dim3((unsigned)((n1 + EB - 1) / EB)), dim3(EB), 0, stream, z, conv_w, conv_b, cy);
        hipLaunchKernelGGL(ln_silu_k, dim3(S), dim3(256), 0, stream, cy, ln_g, ln_b, cv);
        gemm(cv, D, conv_proj, D, av, D, S, D, D, stream);
        hipLaunchKernelGGL(qknorm_k, dim3(S * (HQ + HKV) / 4), dim3(256), 0, stream, U, q_norm, k_norm, qn, kn);
        hipLaunchKernelGGL(attn_k, dim3(S * HQ / 4), dim3(256), 0, stream, qn, kn, U, sinks, rel_bias, ao);
        gemm(ao, D, attn_wo, D, bv, D, S, D, D, stream);
        hipLaunchKernelGGL(merge_k, dim3((unsigned)((n1 + EB - 1) / EB)), dim3(EB), 0, stream, U, av, bv, mg, S);
        gemm(mg, D, w_out, D, Y, D, S, D, D, stream);
        hipLaunchKernelGGL(resid_k, dim3((unsigned)((n1 + EB - 1) / EB)), dim3(EB), 0, stream, ob, Y, 1.0f, ob, n1);
        hipLaunchKernelGGL(rms_rows, dim3(S), dim3(256), 0, stream, ob, ffn2_norm, xn);
        gemm(xn, D, ffn2_w_in, 2 * FF, U, 2 * FF, S, 2 * FF, D, stream);
        hipLaunchKernelGGL(swiglu_k, dim3((unsigned)(((size_t)S * FF + EB - 1) / EB)), dim3(EB), 0, stream, U, Hh, S);
        gemm(Hh, FF, ffn2_w_out, D, Y, D, S, D, FF, stream);
        hipLaunchKernelGGL(resid_k, dim3((unsigned)((n1 + EB - 1) / EB)), dim3(EB), 0, stream, ob, Y, 0.5f, ob, n1);
    }
}
```

```cpp
#include <hip/hip_runtime.h>
#include <hip/hip_cooperative_groups.h>
#include <cstdio>
#include <cstdint>
#ifndef DEBUG_ORACLE
#define DEBUG_ORACLE 0
#endif
namespace pg8 {
#define PG8_LAS __attribute__((address_space(3)))
typedef unsigned short bf16_t;
typedef short bf16x8 __attribute__((ext_vector_type(8)));
typedef float f32x4 __attribute__((ext_vector_type(4)));
typedef unsigned u32x4 __attribute__((ext_vector_type(4)));
constexpr int BM = 256, BK = 64, HALF = 128, HTB = HALF * BK * 2  , STAGE_BYTES = 8 * HTB, NXCD = 8, WGM = 8;

__host__ __device__ __forceinline__ int lds_byte(int r, int c) { const int st = (r >> 4) * 2 + (c >> 5), rr = r & 15, cc = c & 31, ob = rr * 64 + cc * 2; return st * 1024 + (ob ^ (((ob >> 9) & 1) << 5)); }
__host__ __device__ __forceinline__ void stage_rc(int b, int& R, int& C) { const int st = b / 1024, sb = b % 1024, swz = sb ^ (((sb >> 9) & 1) << 5); R = (st >> 1) * 16 + swz / 64; C = (st & 1) * 32 + (swz % 64) / 2; }
__host__ __device__ __forceinline__ int perm32(int rho) { const int n = rho >> 4, i = rho & 15; return 8 * (i >> 2) + 4 * n + (i & 3); }

struct Unit { int pm, pn; };
struct Gemm { const bf16_t* A; const bf16_t* Bt; int M, N, K; };

struct StaticOrder {
    int nM, nN, nwg, G, c;
    __host__ __device__ void init(int M, int N, int G_, int c_) { nM = M / BM; nN = N / BM; nwg = nM * nN; G = G_; c = c_; }
    __host__ __device__ bool next(int i, Unit& u) const {
        const long L = (long)i * G + c; if (L >= nwg) return false;
        int wgid = (int)L; { const int q = nwg / NXCD, r = nwg % NXCD, xcd = wgid % NXCD, off = wgid / NXCD; wgid = (xcd < r ? xcd * (q + 1) : r * (q + 1) + (xcd - r) * q) + off; }
        const int nig = WGM * nN, gid = wgid / nig, fm = gid * WGM, gsz = (nM - fm) < WGM ? (nM - fm) : WGM;
        u.pm = fm + ((wgid % nig) % gsz); u.pn = (wgid % nig) / gsz; return true;
    }
    __device__ __forceinline__ void a_ready(const Unit&) const {}
    __device__ __forceinline__ void done(const Unit&) const {}
};

constexpr float RMS_EPS = 1e-6f;
constexpr float LOG2E = 1.4426950408889634f;
typedef float f32x2 __attribute__((ext_vector_type(2)));
typedef __bf16 bf16x2_t __attribute__((ext_vector_type(2)));
__device__ __forceinline__ unsigned cvt_pk_bf16(float lo, float hi) { f32x2 v = {lo, hi}; bf16x2_t b = __builtin_convertvector(v, bf16x2_t); return __builtin_bit_cast(unsigned, b); }
__device__ __forceinline__ u32x4 pack8(const f32x4 a, const f32x4 b) { u32x4 w; w.x = cvt_pk_bf16(a[0], a[1]); w.y = cvt_pk_bf16(a[2], a[3]); w.z = cvt_pk_bf16(b[0], b[1]); w.w = cvt_pk_bf16(b[2], b[3]); return w; }
__device__ __forceinline__ void unpack8(const u32x4 w, f32x4& a, f32x4& b) {
    a[0] = __uint_as_float(w.x << 16); a[1] = __uint_as_float(w.x & 0xffff0000u); a[2] = __uint_as_float(w.y << 16); a[3] = __uint_as_float(w.y & 0xffff0000u);
    b[0] = __uint_as_float(w.z << 16); b[1] = __uint_as_float(w.z & 0xffff0000u); b[2] = __uint_as_float(w.w << 16); b[3] = __uint_as_float(w.w & 0xffff0000u); }
__device__ __forceinline__ float fast_sigmoid(float v) { return __builtin_amdgcn_rcpf(1.0f + __builtin_amdgcn_exp2f(-LOG2E * v)); }
__device__ __forceinline__ f32x4 sigmoid4(const f32x4 v) { f32x4 o; o[0] = fast_sigmoid(v[0]); o[1] = fast_sigmoid(v[1]); o[2] = fast_sigmoid(v[2]); o[3] = fast_sigmoid(v[3]); return o; }
__device__ __forceinline__ float dot4(const f32x4 v) { return (v[0] * v[0] + v[1] * v[1]) + (v[2] * v[2] + v[3] * v[3]); }

struct EpiSwiglu {
    static constexpr bool PERM = true, AFTER_DRAIN = false;
    bf16_t* H; int ldh; const float* ssq;
    __device__ __forceinline__ void operator()(const f32x4 (&acc)[2][2][4][2], const Unit& u, int wr, int wc, int fr, int fq) const {
        const int row0 = u.pm * BM + wr * 64 + fr, col0 = u.pn * HALF + wc * 32 + 8 * fq;
        float rs[2][4];
#pragma unroll
        for (int ai = 0; ai < 2; ++ai)
#pragma unroll
            for (int m = 0; m < 4; ++m) rs[ai][m] = ssq[row0 + ai * HALF + m * 16];
#pragma unroll
        for (int ai = 0; ai < 2; ++ai)
#pragma unroll
            for (int m = 0; m < 4; ++m) {
                const float r = __builtin_amdgcn_rsqf(rs[ai][m] * (1.0f / 1024.0f) + RMS_EPS);
                f32x4 h[2];
#pragma unroll
                for (int n = 0; n < 2; ++n) { const f32x4 a = acc[ai][0][m][n] * r, b = acc[ai][1][m][n] * r; h[n] = a * sigmoid4(a) * b; }
                *(u32x4*)(H + (size_t)(row0 + ai * HALF + m * 16) * ldh + col0) = pack8(h[0], h[1]);
            }
    }
};

template <bool WANT_XB, bool HALF_SCALE> struct EpiResid {
    static constexpr bool PERM = true, AFTER_DRAIN = false;
    const float* res; float* out; int ld; bf16_t* xb; float* ssq_out;
    __device__ __forceinline__ void operator()(const f32x4 (&acc)[2][2][4][2], const Unit& u, int wr, int wc, int fr, int fq) const {
        const int row0 = u.pm * BM + wr * 64 + fr, col0 = u.pn * BM + wc * 32 + 8 * fq;
        constexpr float scale = HALF_SCALE ? 0.5f : 1.0f;
#pragma unroll
        for (int ai = 0; ai < 2; ++ai)
#pragma unroll
            for (int m = 0; m < 4; ++m) {
                const size_t off = (size_t)(row0 + ai * HALF + m * 16) * ld + col0;
                float ss = 0.f;
#pragma unroll
                for (int bj = 0; bj < 2; ++bj) {
                    const f32x4 r0 = *(const f32x4*)(res + off + bj * HALF), r1 = *(const f32x4*)(res + off + bj * HALF + 4);
                    const f32x4 v0 = r0 + acc[ai][bj][m][0] * scale, v1 = r1 + acc[ai][bj][m][1] * scale;
                    *(f32x4*)(out + off + bj * HALF) = v0; *(f32x4*)(out + off + bj * HALF + 4) = v1;
                    if (WANT_XB) { *(u32x4*)(xb + off + bj * HALF) = pack8(v0, v1); ss += dot4(v0) + dot4(v1); }
                }
                if (WANT_XB) { ss += __shfl_xor(ss, 16); ss += __shfl_xor(ss, 32); if (fq == 0) atomicAdd(ssq_out + row0 + ai * HALF + m * 16, ss); }
                if (m & 1) asm volatile("" ::: "memory");
            }
    }
};

struct EpiMix {
    static constexpr bool PERM = true, AFTER_DRAIN = false;
    const float* ssq; bf16_t *z, *q, *k, *v, *gc, *ga; const float *qg, *kg;
    __device__ __forceinline__ void operator()(const f32x4 (&acc)[2][2][4][2], const Unit& u, int wr, int wc, int fr, int fq) const {
        const int row0 = u.pm * BM + wr * 64 + fr, pn = u.pn;
        float rs[2][4];
#pragma unroll
        for (int ai = 0; ai < 2; ++ai)
#pragma unroll
            for (int m = 0; m < 4; ++m) rs[ai][m] = ssq[row0 + ai * HALF + m * 16];
#pragma unroll
        for (int ai = 0; ai < 2; ++ai)
#pragma unroll
            for (int m = 0; m < 4; ++m) rs[ai][m] = __builtin_amdgcn_rsqf(rs[ai][m] * (1.0f / 1024.0f) + RMS_EPS);
        if (pn < 8) {
            const int col0 = pn * HALF + wc * 32 + 8 * fq;
#pragma unroll
            for (int ai = 0; ai < 2; ++ai)
#pragma unroll
                for (int m = 0; m < 4; ++m) {
                    const float r = rs[ai][m]; f32x4 h[2];
#pragma unroll
                    for (int n = 0; n < 2; ++n) { const f32x4 a = acc[ai][0][m][n] * r, g = acc[ai][1][m][n] * r; h[n] = a * sigmoid4(g); }
                    *(u32x4*)(z + (size_t)(row0 + ai * HALF + m * 16) * 1024 + col0) = pack8(h[0], h[1]);
                }
        } else if (pn < 13) {
            const bool isq = pn < 12;
            const float* gp = isq ? qg : kg; const float gs = isq ? 0.125f * LOG2E : 1.0f;
            bf16_t* ob = isq ? q : k; const int ld = isq ? 1024 : 256, head = isq ? 4 * (pn - 8) + wc : wc;
            f32x4 gv[2][2];
#pragma unroll
            for (int bj = 0; bj < 2; ++bj)
#pragma unroll
                for (int n = 0; n < 2; ++n) gv[bj][n] = *(const f32x4*)(gp + 32 * bj + 8 * fq + 4 * n) * gs;
#pragma unroll
            for (int ai = 0; ai < 2; ++ai)
#pragma unroll
                for (int m = 0; m < 4; ++m) {
                    const float r = rs[ai][m]; f32x4 y[2][2]; float ss = 0.f;
#pragma unroll
                    for (int bj = 0; bj < 2; ++bj)
#pragma unroll
                        for (int n = 0; n < 2; ++n) { y[bj][n] = acc[ai][bj][m][n] * r; ss += dot4(y[bj][n]); }
                    ss += __shfl_xor(ss, 16); ss += __shfl_xor(ss, 32);
                    const float rh = __builtin_amdgcn_rsqf(ss * (1.0f / 64.0f) + RMS_EPS);
                    bf16_t* rowp = ob + (size_t)(row0 + ai * HALF + m * 16) * ld + 64 * head + 8 * fq;
#pragma unroll
                    for (int bj = 0; bj < 2; ++bj) *(u32x4*)(rowp + 32 * bj) = pack8(y[bj][0] * rh * gv[bj][0], y[bj][1] * rh * gv[bj][1]);
                }
        } else if (pn == 13) {
            const int col0 = wc * 32 + 8 * fq;
#pragma unroll
            for (int ai = 0; ai < 2; ++ai)
#pragma unroll
                for (int m = 0; m < 4; ++m) {
                    const float r = rs[ai][m]; bf16_t* rowp = v + (size_t)(row0 + ai * HALF + m * 16) * 256 + col0;
#pragma unroll
                    for (int bj = 0; bj < 2; ++bj) *(u32x4*)(rowp + bj * HALF) = pack8(acc[ai][bj][m][0] * r, acc[ai][bj][m][1] * r);
                }
        } else {
            bf16_t* ob = pn < 18 ? gc : ga; const int col0 = ((pn - 14) & 3) * BM + wc * 32 + 8 * fq;
#pragma unroll
            for (int ai = 0; ai < 2; ++ai)
#pragma unroll
                for (int m = 0; m < 4; ++m) {
                    const float r = rs[ai][m]; bf16_t* rowp = ob + (size_t)(row0 + ai * HALF + m * 16) * 1024 + col0;
#pragma unroll
                    for (int bj = 0; bj < 2; ++bj) *(u32x4*)(rowp + bj * HALF) = pack8(sigmoid4(acc[ai][bj][m][0] * r), sigmoid4(acc[ai][bj][m][1] * r));
                }
        }
    }
};

template <bool ADD> struct EpiGate {
    static constexpr bool PERM = true, AFTER_DRAIN = false;
    const bf16_t* gate; const bf16_t* prev; bf16_t* O;
    __device__ __forceinline__ void operator()(const f32x4 (&acc)[2][2][4][2], const Unit& u, int wr, int wc, int fr, int fq) const {
        const int row0 = u.pm * BM + wr * 64 + fr, col0 = u.pn * BM + wc * 32 + 8 * fq;
#pragma unroll
        for (int ai = 0; ai < 2; ++ai)
#pragma unroll
            for (int m = 0; m < 4; ++m) {
                const size_t off = (size_t)(row0 + ai * HALF + m * 16) * 1024 + col0;
#pragma unroll
                for (int bj = 0; bj < 2; ++bj) {
                    f32x4 g0, g1; unpack8(*(const u32x4*)(gate + off + bj * HALF), g0, g1);
                    f32x4 v0 = g0 * acc[ai][bj][m][0], v1 = g1 * acc[ai][bj][m][1];
                    if (ADD) { f32x4 p0, p1; unpack8(*(const u32x4*)(prev + off + bj * HALF), p0, p1); v0 += p0; v1 += p1; }
                    *(u32x4*)(O + off + bj * HALF) = pack8(v0, v1);
                }
                if (m & 1) asm volatile("" ::: "memory");
            }
    }
};

template <class Epi, class Sched, bool ALIGN_EPI = false, bool SP2 = false>
__device__ __forceinline__ void gemm_phase(PG8_LAS unsigned char* lds, const Gemm g, const Sched S, const Epi E) {
    int tid_ = threadIdx.x; asm volatile("" : "+v"(tid_));
    const int tid = tid_, wid = __builtin_amdgcn_readfirstlane(tid >> 6), lane = tid & 63, wr = wid >> 2, wc = wid & 3, fr = lane & 15, fq = lane >> 4;
    const int K = g.K, nt = K / BK;
    unsigned voffA[2], voffB[2];
#pragma unroll
    for (int i = 0; i < 2; ++i) { int R, C; stage_rc(tid * 16 + i * 8192, R, C); const int Rb = Epi::PERM ? ((R & ~31) + perm32(R & 31)) : R;
        voffA[i] = (unsigned)(R * K + C) * 2u; voffB[i] = (unsigned)(Rb * K + C) * 2u; }
    const size_t kstep = (size_t)(BK * 2);
    const size_t hstep = (size_t)HALF * K * 2;
    const size_t tstep = 2 * hstep;
    const unsigned ldsw = (unsigned)wid * 1024u;
    const int aoff = lds_byte(wr * 64 + fr, fq * 8), boff = lds_byte(wc * 32 + fr, fq * 8);
#define PG8_SA(b, h) (((b) * 2 + (h)) * HTB)
#define PG8_SB(b, h) ((4 + (b) * 2 + (h)) * HTB)
#define PG8_STAGE(bufoff, gbase, voff) do { _Pragma("unroll") for (int _i = 0; _i < 2; ++_i) \
        __builtin_amdgcn_global_load_lds((const unsigned*)((const char*)(gbase) + (voff)[_i]), (PG8_LAS unsigned*)(lds + (bufoff) + ldsw + _i * 8192), 16, 0, 0); } while (0)
#define PG8_LDA(dst, b, h) do { _Pragma("unroll") for (int m = 0; m < 4; ++m) _Pragma("unroll") for (int k = 0; k < 2; ++k) dst[m][k] = *(const PG8_LAS bf16x8*)(lds + PG8_SA(b, h) + aoff + m * 2048 + k * 1024); } while (0)
#define PG8_LDB(dst, b, h) do { _Pragma("unroll") for (int n = 0; n < 2; ++n) _Pragma("unroll") for (int k = 0; k < 2; ++k) dst[n][k] = *(const PG8_LAS bf16x8*)(lds + PG8_SB(b, h) + boff + n * 2048 + k * 1024); } while (0)
#define PG8_MMA(ai, bj, At, Bt) do { __builtin_amdgcn_s_setprio(1); _Pragma("unroll") for (int m = 0; m < 4; ++m) _Pragma("unroll") for (int n = 0; n < 2; ++n) _Pragma("unroll") for (int k = 0; k < 2; ++k) \
        acc[ai][bj][m][n] = __builtin_amdgcn_mfma_f32_16x16x32_bf16(Bt[n][k], At[m][k], acc[ai][bj][m][n], 0, 0, 0); __builtin_amdgcn_s_setprio(0); } while (0)
#define PG8_WAIT_V(n) asm volatile("s_waitcnt vmcnt(" #n ")" ::: "memory")
#define PG8_WAIT_L(n) asm volatile("s_waitcnt lgkmcnt(" #n ")" ::: "memory")
#define PG8_BAR __builtin_amdgcn_s_barrier()
#define PG8_SCHED __builtin_amdgcn_sched_barrier(0)
    Unit cur, nxt; int ui = 0;
    if (!S.next(0, cur)) return;
    f32x4 acc[2][2][4][2];
#pragma unroll
    for (int a = 0; a < 2; ++a)
#pragma unroll
        for (int b = 0; b < 2; ++b)
#pragma unroll
            for (int m = 0; m < 4; ++m)
#pragma unroll
                for (int n = 0; n < 2; ++n) acc[a][b][m][n] = (f32x4){0.f, 0.f, 0.f, 0.f};
    bf16x8 At[4][2], B0[2][2], B1[2][2];
    const char* cA = (const char*)g.A + (size_t)cur.pm * tstep; const char* cB = (const char*)g.Bt + (size_t)cur.pn * tstep;
    S.a_ready(cur);
    if constexpr (SP2) {
        PG8_STAGE(PG8_SB(0, 0), cB, voffB); PG8_STAGE(PG8_SB(0, 1), cB + hstep, voffB); PG8_STAGE(PG8_SA(0, 0), cA, voffA); PG8_STAGE(PG8_SA(0, 1), cA + hstep, voffA);
        if (wr == 1) PG8_BAR;
        PG8_WAIT_V(2); PG8_BAR;
        PG8_STAGE(PG8_SB(1, 0), cB + kstep, voffB); PG8_STAGE(PG8_SA(1, 0), cA + kstep, voffA); PG8_STAGE(PG8_SB(1, 1), cB + hstep + kstep, voffB);
        PG8_WAIT_V(6); PG8_BAR;
    } else {
        PG8_STAGE(PG8_SB(0, 0), cB, voffB); PG8_STAGE(PG8_SA(0, 0), cA, voffA); PG8_STAGE(PG8_SB(0, 1), cB + hstep, voffB); PG8_STAGE(PG8_SA(0, 1), cA + hstep, voffA);
        if (wr == 1) PG8_BAR;
        PG8_WAIT_V(4); PG8_BAR;
        PG8_STAGE(PG8_SB(1, 0), cB + kstep, voffB); PG8_STAGE(PG8_SA(1, 0), cA + kstep, voffA); PG8_STAGE(PG8_SB(1, 1), cB + hstep + kstep, voffB);
        PG8_WAIT_V(6); PG8_BAR;
    }
    for (;;) {
        const bool has_next = S.next(ui + 1, nxt);
        const char* nA = has_next ? (const char*)g.A + (size_t)nxt.pm * tstep : cA; const char* nB = has_next ? (const char*)g.Bt + (size_t)nxt.pn * tstep : cB;
        for (int t = 0; t < nt; t += 2) {
            const bool last = (t == nt - 2);
            const char* a1 = cA + (size_t)(t + 1) * kstep;
            const char* a2 = last ? nA : cA + (size_t)(t + 2) * kstep; const char* b2 = last ? nB : cB + (size_t)(t + 2) * kstep;
            const char* a3 = a2 + kstep; const char* b3 = b2 + kstep;
            if (last && has_next) S.a_ready(nxt);
            if constexpr (SP2) {
            PG8_LDB(B0, 0, 0); PG8_LDB(B1, 0, 1); PG8_SCHED; PG8_LDA(At, 0, 0); PG8_STAGE(PG8_SA(1, 1), a1 + hstep, voffA);
            PG8_WAIT_V(8); PG8_WAIT_L(0); PG8_BAR; PG8_MMA(0, 0, At, B0); PG8_MMA(0, 1, At, B1); PG8_BAR; PG8_SCHED;
            PG8_LDA(At, 0, 1); PG8_STAGE(PG8_SB(0, 0), b2, voffB); PG8_STAGE(PG8_SB(0, 1), b2 + hstep, voffB); PG8_STAGE(PG8_SA(0, 0), a2, voffA);
            PG8_WAIT_V(8); PG8_WAIT_L(0); PG8_BAR; PG8_MMA(1, 0, At, B0); PG8_MMA(1, 1, At, B1); PG8_BAR; PG8_SCHED;
            PG8_LDB(B0, 1, 0); PG8_LDB(B1, 1, 1); PG8_SCHED; PG8_LDA(At, 1, 0); PG8_STAGE(PG8_SA(0, 1), a2 + hstep, voffA);
            PG8_WAIT_V(8); PG8_WAIT_L(0); PG8_BAR; PG8_MMA(0, 0, At, B0); PG8_MMA(0, 1, At, B1); PG8_BAR; PG8_SCHED;
            PG8_LDA(At, 1, 1); PG8_STAGE(PG8_SB(1, 0), b3, voffB); PG8_STAGE(PG8_SB(1, 1), b3 + hstep, voffB); PG8_STAGE(PG8_SA(1, 0), a3, voffA);
            PG8_WAIT_V(8); PG8_WAIT_L(0); PG8_BAR; PG8_MMA(1, 0, At, B0); PG8_MMA(1, 1, At, B1); PG8_BAR; PG8_SCHED;
            } else {
            PG8_LDB(B0, 0, 0); PG8_SCHED; PG8_LDA(At, 0, 0); PG8_STAGE(PG8_SA(1, 1), a1 + hstep, voffA);
            PG8_WAIT_L(8); PG8_BAR; PG8_WAIT_L(0); PG8_MMA(0, 0, At, B0); PG8_BAR; PG8_SCHED;
            PG8_LDB(B1, 0, 1); PG8_STAGE(PG8_SB(0, 0), b2, voffB);
            PG8_BAR; PG8_WAIT_L(0); PG8_MMA(0, 1, At, B1); PG8_BAR;
            PG8_LDA(At, 0, 1); PG8_STAGE(PG8_SA(0, 0), a2, voffA);
            PG8_BAR; PG8_WAIT_L(0); PG8_MMA(1, 0, At, B0); PG8_BAR; PG8_SCHED;
            PG8_STAGE(PG8_SB(0, 1), b2 + hstep, voffB);
            PG8_WAIT_V(6); PG8_BAR; PG8_MMA(1, 1, At, B1); PG8_BAR;
            PG8_LDB(B0, 1, 0); PG8_SCHED; PG8_LDA(At, 1, 0); PG8_STAGE(PG8_SA(0, 1), a2 + hstep, voffA);
            PG8_WAIT_L(8); PG8_BAR; PG8_WAIT_L(0); PG8_MMA(0, 0, At, B0); PG8_BAR; PG8_SCHED;
            PG8_LDB(B1, 1, 1); PG8_STAGE(PG8_SB(1, 0), b3, voffB);
            PG8_BAR; PG8_WAIT_L(0); PG8_MMA(0, 1, At, B1); PG8_BAR;
            PG8_LDA(At, 1, 1); PG8_STAGE(PG8_SA(1, 0), a3, voffA);
            PG8_BAR; PG8_WAIT_L(0); PG8_MMA(1, 0, At, B0); PG8_BAR; PG8_SCHED;
            PG8_STAGE(PG8_SB(1, 1), b3 + hstep, voffB);
            PG8_WAIT_V(6); PG8_BAR; PG8_MMA(1, 1, At, B1); PG8_BAR;
            }
        }
        if constexpr (ALIGN_EPI) { if (wr == 0) PG8_BAR; }
        if constexpr (!Epi::AFTER_DRAIN) { E(acc, cur, wr, wc, fr, fq); S.done(cur); }
        if (!has_next) break;
#pragma unroll
        for (int a = 0; a < 2; ++a)
#pragma unroll
            for (int b = 0; b < 2; ++b)
#pragma unroll
                for (int m = 0; m < 4; ++m)
#pragma unroll
                    for (int n = 0; n < 2; ++n) acc[a][b][m][n] = (f32x4){0.f, 0.f, 0.f, 0.f};
        cur = nxt; cA = nA; cB = nB; ++ui;
        if constexpr (ALIGN_EPI) { if (wr == 1) PG8_BAR; }
    }
    PG8_WAIT_V(0);
    if constexpr (!ALIGN_EPI) { if (wr == 0) PG8_BAR; }
    PG8_BAR;
    if constexpr (Epi::AFTER_DRAIN) { E.fused(acc, cur, wr, wc, fr, fq, lds, wid, lane); S.done(cur); }
#undef PG8_SA
#undef PG8_SB
#undef PG8_STAGE
#undef PG8_LDA
#undef PG8_LDB
#undef PG8_MMA
#undef PG8_WAIT_V
#undef PG8_WAIT_L
#undef PG8_BAR
#undef PG8_SCHED
}
}
constexpr int D = 1024, NB = 8, SEQ = 4096, FF = 2816, CWID = 31, HD = 64, HQ = 16, HKV = 4, INW = 5632;
constexpr int M_FULL = NB * SEQ;
constexpr int NWAVES = 8, NTHREADS = 512;
constexpr int LDS_BYTES = 147456;
constexpr int RING_BYTES = 131072;

#define LAS __attribute__((address_space(3)))
typedef unsigned short bf16;
typedef unsigned v4u __attribute__((ext_vector_type(4)));
typedef unsigned v2u __attribute__((ext_vector_type(2)));
typedef float f32x4 __attribute__((ext_vector_type(4)));
typedef float f32x2 __attribute__((ext_vector_type(2)));
typedef float f32x16 __attribute__((ext_vector_type(16)));
typedef short bf16x8 __attribute__((ext_vector_type(8)));
typedef short s16x4 __attribute__((ext_vector_type(4)));

__device__ const unsigned char T5B[128] = {0, 1, 2, 3, 4, 5, 6, 7, 8, 9, 10, 11, 12, 13, 14, 15, 16, 16, 16, 17, 17, 18, 18, 18, 19, 19, 19, 20, 20, 20, 20, 21, 21, 21, 21, 22, 22, 22, 22, 22, 23, 23, 23, 23, 23, 23, 24, 24, 24, 24, 24, 24, 25, 25, 25, 25, 25, 25, 25, 26, 26, 26, 26, 26, 26, 26, 26, 27, 27, 27, 27, 27, 27, 27, 27, 27, 27, 28, 28, 28, 28, 28, 28, 28, 28, 28, 28, 29, 29, 29, 29, 29, 29, 29, 29, 29, 29, 29, 29, 30, 30, 30, 30, 30, 30, 30, 30, 30, 30, 30, 30, 30, 30, 31, 31, 31, 31, 31, 31, 31, 31, 31, 31, 31, 31, 31, 31, 31};

struct Args {
    const float *x, *ffn1_norm, *ffn1_w_in, *ffn1_w_out, *mix_norm, *w_in, *conv_w, *conv_b, *ln_g, *ln_b, *conv_proj, *q_norm, *k_norm, *sinks, *rel_bias, *attn_wo, *w_out, *ffn2_norm, *ffn2_w_in, *ffn2_w_out;
    float *x1, *x2, *out;
    unsigned* ctl;
    float* biasC;
    float *ssq0, *ssq1, *ssq2;
    bf16 *W1i, *W1o, *Wmx, *Wcp, *Wao, *Wot, *W2i, *W2o;
    bf16 *xb, *H, *H2, *z, *q, *k, *v, *gc, *ga, *c, *o, *m1, *mg;
    int M; int pad;
};

__device__ __forceinline__ unsigned f2bf(float f) { unsigned u = __builtin_bit_cast(unsigned, f); return (u + 0x7fffu + ((u >> 16) & 1u)) >> 16; }
__device__ __forceinline__ unsigned pk2(float lo, float hi) { return f2bf(lo) | (f2bf(hi) << 16); }
#define LDS_WAIT() asm volatile("s_waitcnt lgkmcnt(0)" ::: "memory")

__device__ __forceinline__ int src_col(int kind, int n0) {
    if (kind == 0) return n0;
    const int u = n0 >> 8, r = n0 & 255, bj = r >> 7, j = r & 127;
    if (kind == 1) return bj * FF + 128 * u + j;
    if (u < 8) return bj * 1024 + 128 * u + j;
    if (u < 12) return 2048 + 64 * (4 * (u - 8) + (j >> 5)) + 32 * bj;
    if (u == 12) return 3072 + 64 * (j >> 5) + 32 * bj;
    return n0;
}
__device__ __forceinline__ void p0_transpose_item(const float* W, int K, int Nsrc, int N, bf16* WT, const float* gain, int kind, LAS float* scr, int item, int lane) {
    const int nblk = N / 32, kb = item / nblk, nb = item % nblk, k0 = 64 * kb, n0 = 32 * nb, s0 = src_col(kind, n0);
#pragma unroll 8
    for (int i = 0; i < 32; ++i) { const int kk = 2 * i + (lane >> 5); const float g = gain ? gain[k0 + kk] : 1.0f; scr[kk * 33 + (lane & 31)] = g * W[(size_t)(k0 + kk) * Nsrc + s0 + (lane & 31)]; }
    LDS_WAIT(); asm volatile("" ::: "memory");
    const int c = lane & 7;
#pragma unroll
    for (int j = 0; j < 4; ++j) { const int n = (lane >> 3) + 8 * j; const LAS float* s = scr + (8 * c) * 33 + n;
        v4u o; o.x = pk2(s[0 * 33], s[1 * 33]); o.y = pk2(s[2 * 33], s[3 * 33]); o.z = pk2(s[4 * 33], s[5 * 33]); o.w = pk2(s[6 * 33], s[7 * 33]);
        *(v4u*)(WT + (size_t)(n0 + n) * K + k0 + 8 * c) = o; }
    LDS_WAIT(); asm volatile("" ::: "memory");
}
__device__ __forceinline__ float wave_sum(float v) {
#pragma unroll
    for (int o = 1; o < 64; o <<= 1) v += __shfl_xor(v, o);
    return v;
}
__device__ __forceinline__ void p0_prologue(const Args& A, LAS unsigned char* lds, int gw, int NGW, int lane) {
    LAS float* scr = (LAS float*)(lds + (threadIdx.x >> 6) * 16384);
    constexpr int I_IN = (D / 64) * (INW / 32), I_OUT = (FF / 64) * (D / 32), I_SQ = (D / 64) * (D / 32);
    constexpr int NITEMS = 3 * I_IN + 2 * I_OUT + 3 * I_SQ;
    for (int it = gw; it < NITEMS; it += NGW) {
        int r = it;
        if (r < I_IN) { p0_transpose_item(A.ffn1_w_in, D, 2 * FF, 2 * FF, A.W1i, A.ffn1_norm, 1, scr, r, lane); continue; } r -= I_IN;
        if (r < I_IN) { p0_transpose_item(A.w_in, D, INW, INW, A.Wmx, A.mix_norm, 2, scr, r, lane); continue; } r -= I_IN;
        if (r < I_IN) { p0_transpose_item(A.ffn2_w_in, D, 2 * FF, 2 * FF, A.W2i, A.ffn2_norm, 1, scr, r, lane); continue; } r -= I_IN;
        if (r < I_OUT) { p0_transpose_item(A.ffn1_w_out, FF, D, D, A.W1o, nullptr, 0, scr, r, lane); continue; } r -= I_OUT;
        if (r < I_OUT) { p0_transpose_item(A.ffn2_w_out, FF, D, D, A.W2o, nullptr, 0, scr, r, lane); continue; } r -= I_OUT;
        if (r < I_SQ) { p0_transpose_item(A.conv_proj, D, D, D, A.Wcp, nullptr, 0, scr, r, lane); continue; } r -= I_SQ;
        if (r < I_SQ) { p0_transpose_item(A.attn_wo, D, D, D, A.Wao, nullptr, 0, scr, r, lane); continue; } r -= I_SQ;
        p0_transpose_item(A.w_out, D, D, D, A.Wot, nullptr, 0, scr, r, lane);
    }
    for (int m = gw; m < A.M; m += NGW) {
        const f32x4* xr = (const f32x4*)(A.x + (size_t)m * D) + lane;
        f32x4 v[4]; float s = 0.f;
#pragma unroll
        for (int j = 0; j < 4; ++j) { v[j] = xr[64 * j]; s += (v[j][0] * v[j][0] + v[j][1] * v[j][1]) + (v[j][2] * v[j][2] + v[j][3] * v[j][3]); }
        s = wave_sum(s);
        v2u* o8 = (v2u*)(A.xb + (size_t)m * D) + lane;
#pragma unroll
        for (int j = 0; j < 4; ++j) { v2u w; w.x = pk2(v[j][0], v[j][1]); w.y = pk2(v[j][2], v[j][3]); o8[64 * j] = w; }
        if (lane == 0) { A.ssq0[m] = s; A.ssq1[m] = 0.f; A.ssq2[m] = 0.f; }
    }
    for (int e = gw * 64 + lane; e < HQ * 5 * 64 * 16; e += NGW * 64) {
        const int r = e & 15, ln = (e >> 4) & 63, di = (e >> 10) % 5, h = e / (5 * 1024);
        const int kk = (r & 3) + 8 * (r >> 2) + 4 * (ln >> 5), qq = ln & 31, dist = 32 * di + qq - kk;
        A.biasC[e] = (dist >= 0 && dist < 128) ? A.rel_bias[T5B[dist] * HQ + h] * pg8::LOG2E : -3.0e38f;
    }
}

__device__ __forceinline__ void conv_phase(const Args& A, LAS unsigned char* lds) {
    int tid_ = threadIdx.x; asm volatile("" : "+v"(tid_));
    const int tid = tid_, lane = tid & 63, wid = tid >> 6, c0 = 2 * tid;
    LAS float* Y = (LAS float*)lds;
    float w0[CWID], w1[CWID];
#pragma unroll
    for (int k = 0; k < CWID; ++k) { const f32x2 wv = *(const f32x2*)(A.conv_w + k * D + c0); w0[k] = wv[0]; w1[k] = wv[1]; }
    const f32x2 bias = *(const f32x2*)(A.conv_b + c0);
    const int nchunks = A.M / 128;
    for (int ch = blockIdx.x; ch < nchunks; ch += gridDim.x) {
        const int t0 = ch * 128; const bool first = (t0 % SEQ) == 0;
        float h0[32], h1[32];
#pragma unroll
        for (int i = 2; i < 32; ++i) {
            unsigned zz = 0u; if (!first) zz = *(const unsigned*)(A.z + (size_t)(t0 - 32 + i) * D + c0);
            h0[i] = __uint_as_float(zz << 16); h1[i] = __uint_as_float(zz & 0xffff0000u);
        }
        for (int tb = 0; tb < 128; tb += 32) {
            unsigned zin[32];
#pragma unroll
            for (int s = 0; s < 32; ++s) zin[s] = *(const unsigned*)(A.z + (size_t)(t0 + tb + s) * D + c0);
#pragma unroll
            for (int s = 0; s < 32; ++s) {
                h0[s] = __uint_as_float(zin[s] << 16); h1[s] = __uint_as_float(zin[s] & 0xffff0000u);
                float a0 = bias[0], a1 = bias[1];
#pragma unroll
                for (int k = 0; k < CWID; ++k) { a0 = fmaf(w0[k], h0[(s + 2 + k) & 31], a0); a1 = fmaf(w1[k], h1[(s + 2 + k) & 31], a1); }
                *(LAS f32x2*)(Y + s * D + c0) = (f32x2){a0, a1};
            }
            __syncthreads();
#pragma unroll 1
            for (int i = 0; i < 4; ++i) {
                const int s = wid * 4 + i; f32x4 y[4]; float sm = 0.f;
#pragma unroll
                for (int j = 0; j < 4; ++j) { y[j] = *(const LAS f32x4*)(Y + s * D + 4 * lane + 256 * j); sm += (y[j][0] + y[j][1]) + (y[j][2] + y[j][3]); }
                const float mu = wave_sum(sm) * (1.0f / D); float sq = 0.f;
#pragma unroll
                for (int j = 0; j < 4; ++j) { y[j] = y[j] - mu; sq += (y[j][0] * y[j][0] + y[j][1] * y[j][1]) + (y[j][2] * y[j][2] + y[j][3] * y[j][3]); }
                const float rs = __builtin_amdgcn_rsqf(wave_sum(sq) * (1.0f / D) + 1e-6f);
                bf16* orow = A.c + (size_t)(t0 + tb + s) * D;
#pragma unroll
                for (int j = 0; j < 4; ++j) {
                    const f32x4 g = *(const f32x4*)(A.ln_g + 4 * lane + 256 * j), b = *(const f32x4*)(A.ln_b + 4 * lane + 256 * j);
                    f32x4 v = y[j] * rs * g + b; v = v * pg8::sigmoid4(v);
                    v2u w; w.x = pg8::cvt_pk_bf16(v[0], v[1]); w.y = pg8::cvt_pk_bf16(v[2], v[3]);
                    *(v2u*)(orow + 4 * lane + 256 * j) = w;
                }
            }
            __syncthreads();
        }
    }
}

constexpr int ATT_K_OFF = 0, ATT_V_OFF = 32768;
__device__ __forceinline__ s16x4 vtr(const LAS unsigned char* p) { typedef short v4i16_t __attribute__((ext_vector_type(4))); return __builtin_bit_cast(s16x4, __builtin_amdgcn_ds_read_tr16_b64_v4i16((LAS v4i16_t*)p)); }
__device__ __forceinline__ void attn_phase(const Args& A, LAS unsigned char* lds) {
    int tid_ = threadIdx.x; asm volatile("" : "+v"(tid_));
    const int tid = tid_, lane = tid & 63, r32 = lane & 31, hi = lane >> 5; const int wid = __builtin_amdgcn_readfirstlane(tid >> 6);
    const int nunits = (A.M / 128) * HKV;
    for (int u = blockIdx.x; u < nunits; u += gridDim.x) {
        const int blk = u >> 2, hk = u & 3, t0 = blk * 128; const bool first = (t0 % SEQ) == 0;
#pragma unroll
        for (int i = 0; i < 4; ++i) {
            const int idx = tid + 512 * i, key = idx >> 3, cc = idx & 7;
            if (!(first && key < 128)) {
                const size_t g = (size_t)(t0 - 128 + key) * 256 + hk * 64 + cc * 8;
                const v4u kv = *(const v4u*)(A.k + g), vv = *(const v4u*)(A.v + g);
                *(LAS v4u*)(lds + ATT_K_OFF + (((key >> 5) * 4 + (cc >> 1)) * 2 + (cc & 1)) * 512 + (key & 31) * 16) = kv;
                *(LAS v4u*)(lds + ATT_V_OFF + ((key >> 2) * 2 + (cc >> 2)) * 256 + (key & 3) * 64 + (cc & 3) * 16) = vv;
            }
        }
        __syncthreads();
#pragma unroll 1
        for (int ti = 0; ti < 2; ++ti) {
            const int task = wid + 8 * ti, g = task >> 2, sub = task & 3, h = hk * 4 + g;
            const size_t qrow = (size_t)(t0 + 32 * sub + r32) * D + h * HD;
            bf16x8 qf[4];
#pragma unroll
            for (int d0 = 0; d0 < 4; ++d0) qf[d0] = *(const bf16x8*)(A.q + qrow + 16 * d0 + 8 * hi);
            f32x16 s[5];
            const float* bc = A.biasC + ((size_t)h * 5 * 64 + lane) * 16;
#pragma unroll
            for (int di = 0; di < 5; ++di) {
                const f32x4* bp = (const f32x4*)(bc + di * 1024);
#pragma unroll
                for (int j = 0; j < 4; ++j) { const f32x4 t = bp[j]; s[di][4 * j] = t[0]; s[di][4 * j + 1] = t[1]; s[di][4 * j + 2] = t[2]; s[di][4 * j + 3] = t[3]; }
            }
            const float sink2 = A.sinks[h] * pg8::LOG2E;
            float mx = sink2;
#pragma unroll
            for (int di = 0; di < 5; ++di) {
                const int kt = sub + 4 - di;
                if (!(first && kt < 4)) {
#pragma unroll
                    for (int d0 = 0; d0 < 4; ++d0) {
                        const bf16x8 kf = *(const LAS bf16x8*)(lds + ATT_K_OFF + ((kt * 4 + d0) * 2 + hi) * 512 + r32 * 16);
                        s[di] = __builtin_amdgcn_mfma_f32_32x32x16_bf16(kf, qf[d0], s[di], 0, 0, 0);
                    }
#pragma unroll
                    for (int r = 0; r < 16; ++r) mx = fmaxf(mx, s[di][r]);
                }
            }
            mx = fmaxf(mx, __shfl_xor(mx, 32));
            float l = 0.f;
            f32x16 o0, o1;
#pragma unroll
            for (int r = 0; r < 16; ++r) { o0[r] = 0.f; o1[r] = 0.f; }
#pragma unroll
            for (int di = 0; di < 5; ++di) {
                const int kt = sub + 4 - di;
                if (!(first && kt < 4)) {
#pragma unroll
                    for (int r = 0; r < 16; ++r) { s[di][r] = __builtin_amdgcn_exp2f(s[di][r] - mx); l += s[di][r]; }
#pragma unroll
                    for (int s2 = 0; s2 < 2; ++s2) {
                        v4u pw; pw.x = pg8::cvt_pk_bf16(s[di][8 * s2 + 0], s[di][8 * s2 + 1]); pw.y = pg8::cvt_pk_bf16(s[di][8 * s2 + 2], s[di][8 * s2 + 3]);
                        pw.z = pg8::cvt_pk_bf16(s[di][8 * s2 + 4], s[di][8 * s2 + 5]); pw.w = pg8::cvt_pk_bf16(s[di][8 * s2 + 6], s[di][8 * s2 + 7]);
                        const bf16x8 pa = __builtin_bit_cast(bf16x8, pw);
                        const LAS unsigned char* vp = lds + ATT_V_OFF + ((8 * kt + 4 * s2 + hi) * 2) * 256 + ((lane & 15) >> 2) * 64 + (((lane >> 4) & 1) * 16 + (lane & 3) * 4) * 2;
                        const s16x4 a0 = vtr(vp), a1 = vtr(vp + 2 * 512), b0 = vtr(vp + 256), b1 = vtr(vp + 256 + 2 * 512);
                        const bf16x8 v0 = (bf16x8){a0[0], a0[1], a0[2], a0[3], a1[0], a1[1], a1[2], a1[3]};
                        const bf16x8 v1 = (bf16x8){b0[0], b0[1], b0[2], b0[3], b1[0], b1[1], b1[2], b1[3]};
                        o0 = __builtin_amdgcn_mfma_f32_32x32x16_bf16(pa, v0, o0, 0, 0, 0);
                        o1 = __builtin_amdgcn_mfma_f32_32x32x16_bf16(pa, v1, o1, 0, 0, 0);
                    }
                }
            }
            l += __shfl_xor(l, 32);
            l += __builtin_amdgcn_exp2f(sink2 - mx);
            const float linv = __builtin_amdgcn_rcpf(l);
            bf16* ob = A.o + (size_t)(t0 + 32 * sub) * D + h * HD + r32;
#pragma unroll
            for (int r = 0; r < 16; ++r) {
                const int qq = (r & 3) + 8 * (r >> 2) + 4 * hi;
                const float li = __shfl(linv, qq);
                ob[(size_t)qq * D] = (bf16)f2bf(o0[r] * li);
                ob[(size_t)qq * D + 32] = (bf16)f2bf(o1[r] * li);
            }
        }
        __syncthreads();
    }
}
namespace cg = cooperative_groups;
typedef pg8::EpiResid<true, true> EpiResTH; typedef pg8::EpiResid<true, false> EpiResTF; typedef pg8::EpiResid<false, true> EpiResFH;
#ifndef STOP_AFTER
#define STOP_AFTER 99
#endif
__global__ void __launch_bounds__(NTHREADS, 2) mega_fwd(Args A) {
    extern __shared__ __attribute__((aligned(16))) unsigned char lds_raw[];
    LAS unsigned char* lds = (LAS unsigned char*)lds_raw;
    cg::grid_group grid = cg::this_grid();
    const int tid = threadIdx.x, lane = tid & 63, wave = tid >> 6, G = gridDim.x;
    const int vcu = (G % 8 == 0) ? ((int)blockIdx.x % 8) * (G / 8) + (int)blockIdx.x / 8 : (int)blockIdx.x;
    const int M = A.M;
#define GEMM_PHASE(EPI_T, AP, BP, NN, KK, ...) do { pg8::Gemm g_{AP, BP, M, NN, KK}; pg8::StaticOrder S_; S_.init(M, NN, G, (int)blockIdx.x); EPI_T E_{__VA_ARGS__}; \
        pg8::gemm_phase<EPI_T, pg8::StaticOrder, true, true>(lds, g_, S_, E_); } while (0)

    p0_prologue(A, lds, vcu * NWAVES + wave, G * NWAVES, lane);
    grid.sync();
    GEMM_PHASE(pg8::EpiSwiglu, A.xb, A.W1i, 2 * FF, D, A.H, FF, A.ssq0);
    grid.sync();
    if (STOP_AFTER <= 1) return;
    GEMM_PHASE(EpiResTH, A.H, A.W1o, D, FF, A.x, A.x1, D, A.xb, A.ssq1);
    grid.sync();
    if (STOP_AFTER <= 2) return;
    GEMM_PHASE(pg8::EpiMix, A.xb, A.Wmx, INW, D, A.ssq1, A.z, A.q, A.k, A.v, A.gc, A.ga, A.q_norm, A.k_norm);
    grid.sync();
    if (STOP_AFTER <= 3) return;
    conv_phase(A, lds);
    attn_phase(A, lds);
    grid.sync();
    if (STOP_AFTER <= 4) return;
    GEMM_PHASE(pg8::EpiGate<false>, A.c, A.Wcp, D, D, A.gc, nullptr, A.m1);
    grid.sync();
    GEMM_PHASE(pg8::EpiGate<true>, A.o, A.Wao, D, D, A.ga, A.m1, A.mg);
    grid.sync();
    if (STOP_AFTER <= 6) return;
    GEMM_PHASE(EpiResTF, A.mg, A.Wot, D, D, A.x1, A.x2, D, A.xb, A.ssq2);
    grid.sync();
    if (STOP_AFTER <= 7) return;
    GEMM_PHASE(pg8::EpiSwiglu, A.xb, A.W2i, 2 * FF, D, A.H2, FF, A.ssq2);
    grid.sync();
    GEMM_PHASE(EpiResFH, A.H2, A.W2o, D, FF, A.x2, A.out, D, nullptr, nullptr);
#undef GEMM_PHASE
}

static size_t ws_map(Args& a, unsigned char* ws, int M, bool alias) {
    size_t off = 0;
    auto take = [&](size_t bytes) { unsigned char* p = ws + off; off += (bytes + 255) & ~(size_t)255; return p; };
    a.ctl = (unsigned*)take(1u << 20);
    a.biasC = (float*)take((size_t)HQ * 5 * 64 * 16 * 4);
    a.ssq0 = (float*)take((size_t)M * 4); a.ssq1 = (float*)take((size_t)M * 4); a.ssq2 = (float*)take((size_t)M * 4);
    a.W1i = (bf16*)take((size_t)2 * FF * D * 2); a.W1o = (bf16*)take((size_t)D * FF * 2); a.Wmx = (bf16*)take((size_t)INW * D * 2);
    a.Wcp = (bf16*)take((size_t)D * D * 2); a.Wao = (bf16*)take((size_t)D * D * 2); a.Wot = (bf16*)take((size_t)D * D * 2);
    a.W2i = (bf16*)take((size_t)2 * FF * D * 2); a.W2o = (bf16*)take((size_t)D * FF * 2);
    const size_t act = (size_t)M * D * 2;
    a.xb = (bf16*)take(act);
    a.H = (bf16*)take((size_t)M * FF * 2); a.H2 = a.H;
    if (alias) {
        a.z = a.H; a.q = a.z + (size_t)M * D; a.k = a.q + (size_t)M * D; a.v = a.k + (size_t)M * 256;
        a.gc = (bf16*)take(act); a.ga = (bf16*)take(act); a.c = (bf16*)take(act);
        a.o = a.q; a.m1 = a.z; a.mg = a.c;
    } else {
        a.z = (bf16*)take(act); a.q = (bf16*)take(act); a.k = (bf16*)take((size_t)M * 256 * 2); a.v = (bf16*)take((size_t)M * 256 * 2);
        a.gc = (bf16*)take(act); a.ga = (bf16*)take(act); a.c = (bf16*)take(act);
        a.o = (bf16*)take(act); a.m1 = (bf16*)take(act); a.mg = (bf16*)take(act);
    }
    return off;
}
static void set_inputs(Args& a, void* const* d_in) {
    a.x = (const float*)d_in[0]; a.ffn1_norm = (const float*)d_in[1]; a.ffn1_w_in = (const float*)d_in[2]; a.ffn1_w_out = (const float*)d_in[3];
    a.mix_norm = (const float*)d_in[4]; a.w_in = (const float*)d_in[5]; a.conv_w = (const float*)d_in[6]; a.conv_b = (const float*)d_in[7];
    a.ln_g = (const float*)d_in[8]; a.ln_b = (const float*)d_in[9]; a.conv_proj = (const float*)d_in[10]; a.q_norm = (const float*)d_in[11];
    a.k_norm = (const float*)d_in[12]; a.sinks = (const float*)d_in[13]; a.rel_bias = (const float*)d_in[14]; a.attn_wo = (const float*)d_in[15];
    a.w_out = (const float*)d_in[16]; a.ffn2_norm = (const float*)d_in[17]; a.ffn2_w_in = (const float*)d_in[18]; a.ffn2_w_out = (const float*)d_in[19];
}
static int g_grid = 0;
static bool launch_mega(Args& a, hipStream_t stream) {
    if (g_grid == 0) {
        int dev = 0, cus = 0, per_cu = 0;
        if (hipGetDevice(&dev) != hipSuccess || hipDeviceGetAttribute(&cus, hipDeviceAttributeMultiprocessorCount, dev) != hipSuccess) { g_grid = -1; return false; }
        if (hipFuncSetAttribute((const void*)mega_fwd, hipFuncAttributeMaxDynamicSharedMemorySize, LDS_BYTES) != hipSuccess) { fprintf(stderr, "hipFuncSetAttribute failed\n"); g_grid = -1; return false; }
        if (hipOccupancyMaxActiveBlocksPerMultiprocessor(&per_cu, (const void*)mega_fwd, NTHREADS, LDS_BYTES) != hipSuccess || per_cu < 1) { fprintf(stderr, "occupancy query: %d blocks per CU\n", per_cu); g_grid = -1; (void)hipGetLastError(); return false; }
        g_grid = cus;
    }
    if (g_grid < 0) return false;
    void* args[] = {&a};
    const hipError_t e = hipLaunchCooperativeKernel((const void*)mega_fwd, dim3(g_grid), dim3(NTHREADS), args, LDS_BYTES, stream);
    if (e != hipSuccess) { fprintf(stderr, "cooperative launch failed: %s (grid %d)\n", hipGetErrorString(e), g_grid); return false; }
    return true;
}
#if DEBUG_ORACLE
namespace nv {
constexpr int S = SEQ, B = NB;
constexpr float EPS = 1e-6f;
__device__ __forceinline__ float sigmoidf_(float v) { return 1.f / (1.f + expf(-v)); }
__device__ __forceinline__ float siluf_(float v) { return v / (1.f + expf(-v)); }
__device__ __forceinline__ float block_sum_256(float v, float* red) {
    for (int o = 32; o > 0; o >>= 1) v += __shfl_xor(v, o);
    const int w = threadIdx.x >> 6, l = threadIdx.x & 63;
    __syncthreads(); if (l == 0) red[w] = v; __syncthreads();
    return red[0] + red[1] + red[2] + red[3];
}
__global__ void rms_rows(const float* x, const float* g, float* out) {
    __shared__ float red[4];
    const size_t r = blockIdx.x;
    const float4 v = ((const float4*)(x + r * D))[threadIdx.x];
    const float ss = block_sum_256(v.x * v.x + v.y * v.y + v.z * v.z + v.w * v.w, red);
    const float rs = rsqrtf(ss * (1.f / D) + EPS);
    const float4 gg = ((const float4*)g)[threadIdx.x];
    float4 o; o.x = v.x * rs * gg.x; o.y = v.y * rs * gg.y; o.z = v.z * rs * gg.z; o.w = v.w * rs * gg.w;
    ((float4*)(out + r * D))[threadIdx.x] = o;
}
__global__ void gemm_f32(const float* __restrict__ A, int lda, const float* __restrict__ Bm, int ldb, float* __restrict__ C, int ldc, int K) {
    __shared__ float As[16][68];
    __shared__ float Bs[16][68];
    const int tx = threadIdx.x & 15, ty = threadIdx.x >> 4;
    const int m0 = blockIdx.y * 64, n0 = blockIdx.x * 64;
    float acc[4][4] = {};
    for (int k0 = 0; k0 < K; k0 += 16) {
        {
            const int r = threadIdx.x >> 2, kq = (threadIdx.x & 3) * 4;
            const float4 a = *(const float4*)(A + (size_t)(m0 + r) * lda + k0 + kq);
            As[kq + 0][r] = a.x; As[kq + 1][r] = a.y; As[kq + 2][r] = a.z; As[kq + 3][r] = a.w;
            const int kr = threadIdx.x >> 4, c4 = (threadIdx.x & 15) * 4;
            *(float4*)&Bs[kr][c4] = *(const float4*)(Bm + (size_t)(k0 + kr) * ldb + n0 + c4);
        }
        __syncthreads();
#pragma unroll
        for (int k = 0; k < 16; ++k) {
            const float4 a = *(const float4*)&As[k][ty * 4];
            const float4 b = *(const float4*)&Bs[k][tx * 4];
            const float av[4] = {a.x, a.y, a.z, a.w}, bv[4] = {b.x, b.y, b.z, b.w};
#pragma unroll
            for (int i = 0; i < 4; ++i)
#pragma unroll
                for (int j = 0; j < 4; ++j) acc[i][j] = fmaf(av[i], bv[j], acc[i][j]);
        }
        __syncthreads();
    }
#pragma unroll
    for (int i = 0; i < 4; ++i) { float4 o; o.x = acc[i][0]; o.y = acc[i][1]; o.z = acc[i][2]; o.w = acc[i][3]; *(float4*)(C + (size_t)(m0 + ty * 4 + i) * ldc + n0 + tx * 4) = o; }
}
__global__ void swiglu_k(const float* U, float* H, int rows) {
    const size_t i = (size_t)blockIdx.x * blockDim.x + threadIdx.x;
    if (i >= (size_t)rows * FF) return;
    const size_t t = i / FF; const int j = (int)(i % FF);
    H[i] = siluf_(U[t * (2 * FF) + j]) * U[t * (2 * FF) + FF + j];
}
__global__ void resid_k(const float* xin, const float* y, float scale, float* out, size_t n) {
    const size_t i = (size_t)blockIdx.x * blockDim.x + threadIdx.x;
    if (i < n) out[i] = xin[i] + scale * y[i];
}
__global__ void glu_k(const float* P, float* z, int rows) {
    const size_t i = (size_t)blockIdx.x * blockDim.x + threadIdx.x;
    if (i >= (size_t)rows * D) return;
    const size_t t = i / D; const int c = (int)(i % D);
    z[i] = P[t * INW + c] * sigmoidf_(P[t * INW + D + c]);
}
__global__ void conv_k(const float* z, const float* w, const float* bias, float* y) {
    const size_t i = (size_t)blockIdx.x * blockDim.x + threadIdx.x;
    if (i >= (size_t)S * D) return;
    const int t = (int)(i / D), c = (int)(i % D);
    float acc = bias[c];
    for (int k = 0; k < CWID; ++k) { const int tt = t - (CWID - 1) + k; if (tt >= 0) acc = fmaf(w[k * D + c], z[(size_t)tt * D + c], acc); }
    y[i] = acc;
}
__global__ void ln_silu_k(const float* y, const float* g, const float* b, float* out) {
    __shared__ float red[4];
    const size_t r = blockIdx.x;
    const float4 v = ((const float4*)(y + r * D))[threadIdx.x];
    const float mu = block_sum_256(v.x + v.y + v.z + v.w, red) * (1.f / D);
    const float dx = v.x - mu, dy = v.y - mu, dz = v.z - mu, dw = v.w - mu;
    const float var = block_sum_256(dx * dx + dy * dy + dz * dz + dw * dw, red) * (1.f / D);
    const float rs = rsqrtf(var + EPS);
    const float4 gg = ((const float4*)g)[threadIdx.x], bb = ((const float4*)b)[threadIdx.x];
    float4 o; o.x = siluf_(dx * rs * gg.x + bb.x); o.y = siluf_(dy * rs * gg.y + bb.y); o.z = siluf_(dz * rs * gg.z + bb.z); o.w = siluf_(dw * rs * gg.w + bb.w);
    ((float4*)(out + r * D))[threadIdx.x] = o;
}
__global__ void qknorm_k(const float* P, const float* qg, const float* kg, float* qn, float* kn) {
    const int wv = (blockIdx.x * 4) + (threadIdx.x >> 6), lane = threadIdx.x & 63;
    const int t = wv / (HQ + HKV), hh = wv % (HQ + HKV);
    if (t >= S) return;
    const bool isq = hh < HQ;
    const int h = isq ? hh : hh - HQ;
    const float v = P[(size_t)t * INW + (isq ? 2 * D + h * HD : 3 * D + h * HD) + lane];
    float ss = v * v;
    for (int o = 32; o > 0; o >>= 1) ss += __shfl_xor(ss, o);
    const float rs = rsqrtf(ss * (1.f / HD) + EPS);
    if (isq) qn[(size_t)t * (HQ * HD) + h * HD + lane] = v * rs * qg[lane];
    else     kn[(size_t)t * (HKV * HD) + h * HD + lane] = v * rs * kg[lane];
}
__global__ void attn_k(const float* qn, const float* kn, const float* P, const float* sinks, const float* rel_bias, float* o) {
    const int wv = (blockIdx.x * 4) + (threadIdx.x >> 6), lane = threadIdx.x & 63;
    const int t = wv / HQ, h = wv % HQ, hk = h / (HQ / HKV);
    if (t >= S) return;
    const float* q = qn + (size_t)t * (HQ * HD) + h * HD;
    float s[2];
#pragma unroll
    for (int u = 0; u < 2; ++u) {
        const int dist = lane + 64 * u, key = t - dist;
        float acc = -3.0e38f;
        if (key >= 0) {
            const float* kr = kn + (size_t)key * (HKV * HD) + hk * HD;
            float d = 0.f;
            for (int e = 0; e < HD; ++e) d = fmaf(q[e], kr[e], d);
            acc = d * 0.125f + rel_bias[T5B[dist] * HQ + h];
        }
        s[u] = acc;
    }
    const float sink = sinks[h];
    float m = fmaxf(fmaxf(s[0], s[1]), sink);
    for (int of = 32; of > 0; of >>= 1) m = fmaxf(m, __shfl_xor(m, of));
    float p0 = (t - lane >= 0) ? expf(s[0] - m) : 0.f, p1 = (t - lane - 64 >= 0) ? expf(s[1] - m) : 0.f;
    float l = p0 + p1;
    for (int of = 32; of > 0; of >>= 1) l += __shfl_xor(l, of);
    l += expf(sink - m);
    const float inv = 1.f / l;
    float acc = 0.f;
    for (int j = 0; j < 64; ++j) {
        const float pj0 = __shfl(p0, j), pj1 = __shfl(p1, j);
        const int k0 = t - j, k1 = t - j - 64;
        if (k0 >= 0) acc = fmaf(pj0, P[(size_t)k0 * INW + 3 * D + HKV * HD + hk * HD + lane], acc);
        if (k1 >= 0) acc = fmaf(pj1, P[(size_t)k1 * INW + 3 * D + HKV * HD + hk * HD + lane], acc);
    }
    o[(size_t)t * (HQ * HD) + h * HD + lane] = acc * inv;
}
__global__ void merge_k(const float* P, const float* a, const float* b, float* mg, int rows) {
    const size_t i = (size_t)blockIdx.x * blockDim.x + threadIdx.x;
    if (i >= (size_t)rows * D) return;
    const size_t t = i / D; const int c = (int)(i % D);
    mg[i] = sigmoidf_(P[t * INW + 3584 + c]) * a[i] + sigmoidf_(P[t * INW + 4608 + c]) * b[i];
}
static void gemm(const float* A, int lda, const float* Bm, int ldb, float* C, int ldc, int M, int N, int K, hipStream_t st) {
    hipLaunchKernelGGL(gemm_f32, dim3(N / 64, M / 64), dim3(256), 0, st, A, lda, Bm, ldb, C, ldc, K);
}
__global__ void cmp_k(const void* a, int a_is_bf16, int lda, float ascale, const float* ref, int ldr, int sig, int rows, int cols, unsigned* slot) {
    const size_t i = (size_t)blockIdx.x * blockDim.x + threadIdx.x;
    float d = 0.f, r2 = 0.f;
    if (i < (size_t)rows * cols) {
        const size_t t = i / cols; const int c = (int)(i % cols);
        float av = a_is_bf16 ? __uint_as_float((unsigned)((const unsigned short*)a)[t * lda + c] << 16) : ((const float*)a)[t * lda + c];
        float rv = ref[t * ldr + c]; if (sig) rv = sigmoidf_(rv);
        d = fabsf(av * ascale - rv); if (!(d == d)) d = 1e30f; r2 = rv * rv;
    }
    float d2 = d * d;
    for (int o = 32; o > 0; o >>= 1) { d = fmaxf(d, __shfl_xor(d, o)); r2 += __shfl_xor(r2, o); d2 += __shfl_xor(d2, o); }
    if ((threadIdx.x & 63) == 0) { atomicMax(slot, __float_as_uint(d)); atomicAdd((float*)(slot + 1), r2); atomicAdd((float*)(slot + 2), d2); }
}
constexpr int NCHK = 16;
struct Counts { float c[NCHK]; };
__global__ void decide_k(unsigned* slots, Counts cnt, float tol, float* code_out) {
    if (threadIdx.x != 0 || blockIdx.x != 0) return;
    float code = 0.f;
    for (int k = 0; k < NCHK; ++k) {
        if (cnt.c[k] <= 0.f) continue;
        const float md = __uint_as_float(slots[4 * k]), rr = __uint_as_float(slots[4 * k + 1]), dd = __uint_as_float(slots[4 * k + 2]);
        const float rms = sqrtf(rr / cnt.c[k]), rmsr = sqrtf(dd / fmaxf(rr, 1e-30f));
        if (!(rmsr <= tol) || !(md <= 0.5f * rms)) { code = (float)(k + 1) + (rmsr < 0.03f ? 0.f : rmsr < 0.3f ? 0.3f : 0.6f); break; }
    }
    *code_out = code;
}
__global__ void finish_k(float* out, const float* mega_out, size_t dbg_off, size_t dbg_n, size_t n, const float* code) {
    const size_t i = (size_t)blockIdx.x * blockDim.x + threadIdx.x;
    if (i >= n) return;
    const float c = *code;
    float v = out[i];
    if (c == 0.f && i >= dbg_off && i < dbg_off + dbg_n) v = mega_out[i - dbg_off];
    out[i] = v * (1.f + c);
}
}
#ifndef DBG_B
#define DBG_B 5
#endif
#ifndef DBG_TOL
#define DBG_TOL 0.01f
#endif
#endif

extern "C" void kernel_launch(void* const* d_in, const int* in_sizes, int n_in, void* d_out, int out_size, void* d_ws, size_t ws_size, hipStream_t stream) {
    (void)in_sizes; (void)n_in; (void)out_size; (void)ws_size;
#if !DEBUG_ORACLE
    Args a{};
    set_inputs(a, d_in);
    a.out = (float*)d_out; a.x1 = a.out; a.x2 = a.out;
    ws_map(a, (unsigned char*)d_ws, M_FULL, true);
    a.M = M_FULL;
    launch_mega(a, stream);
#else
    using namespace nv;
    unsigned char* wsb = (unsigned char*)d_ws;
    Args a{};
    set_inputs(a, d_in);
    a.x += (size_t)DBG_B * S * D;
    size_t used = ws_map(a, wsb, S, false);
    auto takeb = [&](size_t bytes) { unsigned char* p = wsb + used; used += (bytes + 255) & ~(size_t)255; return p; };
    a.x1 = (float*)takeb((size_t)S * D * 4); a.x2 = (float*)takeb((size_t)S * D * 4); a.out = (float*)takeb((size_t)S * D * 4);
    a.H2 = (bf16*)takeb((size_t)S * FF * 2);
    a.M = S;
    unsigned* slots = (unsigned*)takeb(256); float* code = (float*)takeb(256);
    Counts hc{};
    const float* x = (const float*)d_in[0];
    float* out = (float*)d_out;
    float* xn = (float*)takeb((size_t)S * D * 4); float* U = (float*)takeb((size_t)S * INW * 4); float* Hh = (float*)takeb((size_t)S * FF * 4); float* Y = (float*)takeb((size_t)S * D * 4);
    float* z = (float*)takeb((size_t)S * D * 4); float* cy = xn; float* cv = (float*)takeb((size_t)S * D * 4); float* qn = (float*)takeb((size_t)S * D * 4);
    float* kn = (float*)takeb((size_t)S * 256 * 4); float* ao = (float*)takeb((size_t)S * D * 4); float* av = (float*)takeb((size_t)S * D * 4); float* bv = (float*)takeb((size_t)S * D * 4);
    float* mg = (float*)takeb((size_t)S * D * 4);
    if (used > ws_size) { fprintf(stderr, "debug build needs %zu bytes of workspace, have %zu\n", used, ws_size); return; }
    hipMemsetAsync(slots, 0, 256, stream);
    launch_mega(a, stream);
    const int EB = 256; const size_t n1 = (size_t)S * D;
    int nchk = 0;
    auto chk = [&](const void* ap, int isbf, int lda, float asc, const float* ref, int ldr, int sig, int rows, int cols) {
        const size_t n = (size_t)rows * cols;
        hipLaunchKernelGGL(cmp_k, dim3((unsigned)((n + 255) / 256)), dim3(256), 0, stream, ap, isbf, lda, asc, ref, ldr, sig, rows, cols, slots + 4 * nchk);
        hc.c[nchk] = (float)n; ++nchk;
    };
    for (int bi = 0; bi < B; ++bi) {
        const int b = (bi == B - 1) ? DBG_B : (bi >= DBG_B ? bi + 1 : bi);
        const bool dbg = (b == DBG_B);
        const float* xbp = x + (size_t)b * S * D; float* ob = out + (size_t)b * S * D;
        hipLaunchKernelGGL(rms_rows, dim3(S), dim3(256), 0, stream, xbp, a.ffn1_norm, xn);
        gemm(xn, D, a.ffn1_w_in, 2 * FF, U, 2 * FF, S, 2 * FF, D, stream);
        hipLaunchKernelGGL(swiglu_k, dim3((unsigned)(((size_t)S * FF + EB - 1) / EB)), dim3(EB), 0, stream, U, Hh, S);
        if (dbg) chk(a.H, 1, FF, 1.f, Hh, FF, 0, S, FF);
        gemm(Hh, FF, a.ffn1_w_out, D, Y, D, S, D, FF, stream);
        hipLaunchKernelGGL(resid_k, dim3((unsigned)((n1 + EB - 1) / EB)), dim3(EB), 0, stream, xbp, Y, 0.5f, ob, n1);
        if (dbg) chk(a.x1, 0, D, 1.f, ob, D, 0, S, D);
        hipLaunchKernelGGL(rms_rows, dim3(S), dim3(256), 0, stream, ob, a.mix_norm, xn);
        gemm(xn, D, a.w_in, INW, U, INW, S, INW, D, stream);
        hipLaunchKernelGGL(glu_k, dim3((unsigned)((n1 + EB - 1) / EB)), dim3(EB), 0, stream, U, z, S);
        if (dbg) chk(a.z, 1, D, 1.f, z, D, 0, S, D);
        hipLaunchKernelGGL(qknorm_k, dim3(S * (HQ + HKV) / 4), dim3(256), 0, stream, U, a.q_norm, a.k_norm, qn, kn);
        if (dbg) { chk(a.q, 1, D, 1.f / (0.125f * 1.4426950408889634f), qn, D, 0, S, D);
                   chk(a.k, 1, 256, 1.f, kn, 256, 0, S, 256);
                   chk(a.v, 1, 256, 1.f, U + 3328, INW, 0, S, 256);
                   chk(a.gc, 1, D, 1.f, U + 3584, INW, 1, S, D);
                   chk(a.ga, 1, D, 1.f, U + 4608, INW, 1, S, D); }
        hipLaunchKernelGGL(conv_k, dim3((unsigned)((n1 + EB - 1) / EB)), dim3(EB), 0, stream, z, a.conv_w, a.conv_b, cy);
        hipLaunchKernelGGL(ln_silu_k, dim3(S), dim3(256), 0, stream, cy, a.ln_g, a.ln_b, cv);
        if (dbg) chk(a.c, 1, D, 1.f, cv, D, 0, S, D);
        gemm(cv, D, a.conv_proj, D, av, D, S, D, D, stream);
        hipLaunchKernelGGL(attn_k, dim3(S * HQ / 4), dim3(256), 0, stream, qn, kn, U, a.sinks, a.rel_bias, ao);
        if (dbg) chk(a.o, 1, D, 1.f, ao, D, 0, S, D);
        gemm(ao, D, a.attn_wo, D, bv, D, S, D, D, stream);
        hipLaunchKernelGGL(merge_k, dim3((unsigned)((n1 + EB - 1) / EB)), dim3(EB), 0, stream, U, av, bv, mg, S);
        if (dbg) chk(a.mg, 1, D, 1.f, mg, D, 0, S, D);
        gemm(mg, D, a.w_out, D, Y, D, S, D, D, stream);
        hipLaunchKernelGGL(resid_k, dim3((unsigned)((n1 + EB - 1) / EB)), dim3(EB), 0, stream, ob, Y, 1.0f, ob, n1);
        if (dbg) chk(a.x2, 0, D, 1.f, ob, D, 0, S, D);
        hipLaunchKernelGGL(rms_rows, dim3(S), dim3(256), 0, stream, ob, a.ffn2_norm, xn);
        gemm(xn, D, a.ffn2_w_in, 2 * FF, U, 2 * FF, S, 2 * FF, D, stream);
        hipLaunchKernelGGL(swiglu_k, dim3((unsigned)(((size_t)S * FF + EB - 1) / EB)), dim3(EB), 0, stream, U, Hh, S);
        if (dbg) chk(a.H2, 1, FF, 1.f, Hh, FF, 0, S, FF);
        gemm(Hh, FF, a.ffn2_w_out, D, Y, D, S, D, FF, stream);
        hipLaunchKernelGGL(resid_k, dim3((unsigned)((n1 + EB - 1) / EB)), dim3(EB), 0, stream, ob, Y, 0.5f, ob, n1);
        if (dbg) chk(a.out, 0, D, 1.f, ob, D, 0, S, D);
    }
    hipLaunchKernelGGL(decide_k, dim3(1), dim3(64), 0, stream, slots, hc, DBG_TOL, code);
    const size_t nall = (size_t)B * S * D;
    hipLaunchKernelGGL(finish_k, dim3((unsigned)((nall + 255) / 256)), dim3(256), 0, stream, out, a.out, (size_t)DBG_B * S * D, (size_t)S * D, nall, code);
#endif
}
```

```cpp
#include <hip/hip_runtime.h>
#include <cstdio>
#include <cstdint>
#ifndef DEBUG_ORACLE
#define DEBUG_ORACLE 0
#endif
namespace pg8 {
#define PG8_LAS __attribute__((address_space(3)))
typedef unsigned short bf16_t;
typedef short bf16x8 __attribute__((ext_vector_type(8)));
typedef float f32x4 __attribute__((ext_vector_type(4)));
typedef unsigned u32x4 __attribute__((ext_vector_type(4)));
constexpr int BM = 256, BK = 64, HALF = 128, HTB = HALF * BK * 2  , STAGE_BYTES = 8 * HTB, NXCD = 8, WGM = 8;

__host__ __device__ __forceinline__ int lds_byte(int r, int c) { const int st = (r >> 4) * 2 + (c >> 5), rr = r & 15, cc = c & 31, ob = rr * 64 + cc * 2; return st * 1024 + (ob ^ (((ob >> 9) & 1) << 5)); }
__host__ __device__ __forceinline__ void stage_rc(int b, int& R, int& C) { const int st = b / 1024, sb = b % 1024, swz = sb ^ (((sb >> 9) & 1) << 5); R = (st >> 1) * 16 + swz / 64; C = (st & 1) * 32 + (swz % 64) / 2; }
__host__ __device__ __forceinline__ int perm32(int rho) { const int n = rho >> 4, i = rho & 15; return 8 * (i >> 2) + 4 * n + (i & 3); }

struct Unit { int pm, pn; };
struct Gemm { const bf16_t* A; const bf16_t* Bt; int M, N, K; };

struct StaticOrder {
    int nM, nN, nwg, G, c;
    __host__ __device__ void init(int M, int N, int G_, int c_) { nM = M / BM; nN = N / BM; nwg = nM * nN; G = G_; c = c_; }
    __host__ __device__ bool next(int i, Unit& u) const {
        const long L = (long)i * G + c; if (L >= nwg) return false;
        int wgid = (int)L; { const int q = nwg / NXCD, r = nwg % NXCD, xcd = wgid % NXCD, off = wgid / NXCD; wgid = (xcd < r ? xcd * (q + 1) : r * (q + 1) + (xcd - r) * q) + off; }
        const int nig = WGM * nN, gid = wgid / nig, fm = gid * WGM, gsz = (nM - fm) < WGM ? (nM - fm) : WGM;
        u.pm = fm + ((wgid % nig) % gsz); u.pn = (wgid % nig) / gsz; return true;
    }
    __device__ __forceinline__ void a_ready(const Unit&) const {}
    __device__ __forceinline__ void done(const Unit&) const {}
};

constexpr float RMS_EPS = 1e-6f;
constexpr float LOG2E = 1.4426950408889634f;
typedef float f32x2 __attribute__((ext_vector_type(2)));
typedef __bf16 bf16x2_t __attribute__((ext_vector_type(2)));
__device__ __forceinline__ unsigned cvt_pk_bf16(float lo, float hi) { f32x2 v = {lo, hi}; bf16x2_t b = __builtin_convertvector(v, bf16x2_t); return __builtin_bit_cast(unsigned, b); }
__device__ __forceinline__ u32x4 pack8(const f32x4 a, const f32x4 b) { u32x4 w; w.x = cvt_pk_bf16(a[0], a[1]); w.y = cvt_pk_bf16(a[2], a[3]); w.z = cvt_pk_bf16(b[0], b[1]); w.w = cvt_pk_bf16(b[2], b[3]); return w; }
__device__ __forceinline__ void unpack8(const u32x4 w, f32x4& a, f32x4& b) {
    a[0] = __uint_as_float(w.x << 16); a[1] = __uint_as_float(w.x & 0xffff0000u); a[2] = __uint_as_float(w.y << 16); a[3] = __uint_as_float(w.y & 0xffff0000u);
    b[0] = __uint_as_float(w.z << 16); b[1] = __uint_as_float(w.z & 0xffff0000u); b[2] = __uint_as_float(w.w << 16); b[3] = __uint_as_float(w.w & 0xffff0000u); }
__device__ __forceinline__ float fast_sigmoid(float v) { return __builtin_amdgcn_rcpf(1.0f + __builtin_amdgcn_exp2f(-LOG2E * v)); }
__device__ __forceinline__ f32x4 sigmoid4(const f32x4 v) { f32x4 o; o[0] = fast_sigmoid(v[0]); o[1] = fast_sigmoid(v[1]); o[2] = fast_sigmoid(v[2]); o[3] = fast_sigmoid(v[3]); return o; }
__device__ __forceinline__ float dot4(const f32x4 v) { return (v[0] * v[0] + v[1] * v[1]) + (v[2] * v[2] + v[3] * v[3]); }

struct EpiSwiglu {
    static constexpr bool PERM = true, AFTER_DRAIN = false;
    bf16_t* H; int ldh; const float* ssq;
    __device__ __forceinline__ void operator()(const f32x4 (&acc)[2][2][4][2], const Unit& u, int wr, int wc, int fr, int fq) const {
        const int row0 = u.pm * BM + wr * 64 + fr, col0 = u.pn * HALF + wc * 32 + 8 * fq;
        float rs[2][4];
#pragma unroll
        for (int ai = 0; ai < 2; ++ai)
#pragma unroll
            for (int m = 0; m < 4; ++m) rs[ai][m] = ssq[row0 + ai * HALF + m * 16];
#pragma unroll
        for (int ai = 0; ai < 2; ++ai)
#pragma unroll
            for (int m = 0; m < 4; ++m) {
                const float r = __builtin_amdgcn_rsqf(rs[ai][m] * (1.0f / 1024.0f) + RMS_EPS);
                f32x4 h[2];
#pragma unroll
                for (int n = 0; n < 2; ++n) { const f32x4 a = acc[ai][0][m][n] * r, b = acc[ai][1][m][n] * r; h[n] = a * sigmoid4(a) * b; }
                *(u32x4*)(H + (size_t)(row0 + ai * HALF + m * 16) * ldh + col0) = pack8(h[0], h[1]);
            }
    }
};

template <bool WANT_XB, bool HALF_SCALE> struct EpiResid {
    static constexpr bool PERM = true, AFTER_DRAIN = false;
    const float* res; float* out; int ld; bf16_t* xb; float* ssq_out;
    __device__ __forceinline__ void operator()(const f32x4 (&acc)[2][2][4][2], const Unit& u, int wr, int wc, int fr, int fq) const {
        const int row0 = u.pm * BM + wr * 64 + fr, col0 = u.pn * BM + wc * 32 + 8 * fq;
        constexpr float scale = HALF_SCALE ? 0.5f : 1.0f;
#pragma unroll
        for (int ai = 0; ai < 2; ++ai)
#pragma unroll
            for (int m = 0; m < 4; ++m) {
                const size_t off = (size_t)(row0 + ai * HALF + m * 16) * ld + col0;
                float ss = 0.f;
#pragma unroll
                for (int bj = 0; bj < 2; ++bj) {
                    const f32x4 r0 = *(const f32x4*)(res + off + bj * HALF), r1 = *(const f32x4*)(res + off + bj * HALF + 4);
                    const f32x4 v0 = r0 + acc[ai][bj][m][0] * scale, v1 = r1 + acc[ai][bj][m][1] * scale;
                    *(f32x4*)(out + off + bj * HALF) = v0; *(f32x4*)(out + off + bj * HALF + 4) = v1;
                    if (WANT_XB) { *(u32x4*)(xb + off + bj * HALF) = pack8(v0, v1); ss += dot4(v0) + dot4(v1); }
                }
                if (WANT_XB) { ss += __shfl_xor(ss, 16); ss += __shfl_xor(ss, 32); if (fq == 0) atomicAdd(ssq_out + row0 + ai * HALF + m * 16, ss); }
                if (m & 1) asm volatile("" ::: "memory");
            }
    }
};

struct EpiMix {
    static constexpr bool PERM = true, AFTER_DRAIN = false;
    const float* ssq; bf16_t *z, *q, *k, *v, *gc, *ga; const float *qg, *kg;
    __device__ __forceinline__ void operator()(const f32x4 (&acc)[2][2][4][2], const Unit& u, int wr, int wc, int fr, int fq) const {
        const int row0 = u.pm * BM + wr * 64 + fr, pn = u.pn;
        float rs[2][4];
#pragma unroll
        for (int ai = 0; ai < 2; ++ai)
#pragma unroll
            for (int m = 0; m < 4; ++m) rs[ai][m] = ssq[row0 + ai * HALF + m * 16];
#pragma unroll
        for (int ai = 0; ai < 2; ++ai)
#pragma unroll
            for (int m = 0; m < 4; ++m) rs[ai][m] = __builtin_amdgcn_rsqf(rs[ai][m] * (1.0f / 1024.0f) + RMS_EPS);
        if (pn < 8) {
            const int col0 = pn * HALF + wc * 32 + 8 * fq;
#pragma unroll
            for (int ai = 0; ai < 2; ++ai)
#pragma unroll
                for (int m = 0; m < 4; ++m) {
                    const float r = rs[ai][m]; f32x4 h[2];
#pragma unroll
                    for (int n = 0; n < 2; ++n) { const f32x4 a = acc[ai][0][m][n] * r, g = acc[ai][1][m][n] * r; h[n] = a * sigmoid4(g); }
                    *(u32x4*)(z + (size_t)(row0 + ai * HALF + m * 16) * 1024 + col0) = pack8(h[0], h[1]);
                }
        } else if (pn < 13) {
            const bool isq = pn < 12;
            const float* gp = isq ? qg : kg; const float gs = isq ? 0.125f * LOG2E : 1.0f;
            bf16_t* ob = isq ? q : k; const int ld = isq ? 1024 : 256, head = isq ? 4 * (pn - 8) + wc : wc;
            f32x4 gv[2][2];
#pragma unroll
            for (int bj = 0; bj < 2; ++bj)
#pragma unroll
                for (int n = 0; n < 2; ++n) gv[bj][n] = *(const f32x4*)(gp + 32 * bj + 8 * fq + 4 * n) * gs;
#pragma unroll
            for (int ai = 0; ai < 2; ++ai)
#pragma unroll
                for (int m = 0; m < 4; ++m) {
                    const float r = rs[ai][m]; f32x4 y[2][2]; float ss = 0.f;
#pragma unroll
                    for (int bj = 0; bj < 2; ++bj)
#pragma unroll
                        for (int n = 0; n < 2; ++n) { y[bj][n] = acc[ai][bj][m][n] * r; ss += dot4(y[bj][n]); }
                    ss += __shfl_xor(ss, 16); ss += __shfl_xor(ss, 32);
                    const float rh = __builtin_amdgcn_rsqf(ss * (1.0f / 64.0f) + RMS_EPS);
                    bf16_t* rowp = ob + (size_t)(row0 + ai * HALF + m * 16) * ld + 64 * head + 8 * fq;
#pragma unroll
                    for (int bj = 0; bj < 2; ++bj) *(u32x4*)(rowp + 32 * bj) = pack8(y[bj][0] * rh * gv[bj][0], y[bj][1] * rh * gv[bj][1]);
                }
        } else if (pn == 13) {
            const int col0 = wc * 32 + 8 * fq;
#pragma unroll
            for (int ai = 0; ai < 2; ++ai)
#pragma unroll
                for (int m = 0; m < 4; ++m) {
                    const float r = rs[ai][m]; bf16_t* rowp = v + (size_t)(row0 + ai * HALF + m * 16) * 256 + col0;
#pragma unroll
                    for (int bj = 0; bj < 2; ++bj) *(u32x4*)(rowp + bj * HALF) = pack8(acc[ai][bj][m][0] * r, acc[ai][bj][m][1] * r);
                }
        } else {
            bf16_t* ob = pn < 18 ? gc : ga; const int col0 = ((pn - 14) & 3) * BM + wc * 32 + 8 * fq;
#pragma unroll
            for (int ai = 0; ai < 2; ++ai)
#pragma unroll
                for (int m = 0; m < 4; ++m) {
                    const float r = rs[ai][m]; bf16_t* rowp = ob + (size_t)(row0 + ai * HALF + m * 16) * 1024 + col0;
#pragma unroll
                    for (int bj = 0; bj < 2; ++bj) *(u32x4*)(rowp + bj * HALF) = pack8(sigmoid4(acc[ai][bj][m][0] * r), sigmoid4(acc[ai][bj][m][1] * r));
                }
        }
    }
};

template <bool ADD> struct EpiGate {
    static constexpr bool PERM = true, AFTER_DRAIN = false;
    const bf16_t* gate; const bf16_t* prev; bf16_t* O;
    __device__ __forceinline__ void operator()(const f32x4 (&acc)[2][2][4][2], const Unit& u, int wr, int wc, int fr, int fq) const {
        const int row0 = u.pm * BM + wr * 64 + fr, col0 = u.pn * BM + wc * 32 + 8 * fq;
#pragma unroll
        for (int ai = 0; ai < 2; ++ai)
#pragma unroll
            for (int m = 0; m < 4; ++m) {
                const size_t off = (size_t)(row0 + ai * HALF + m * 16) * 1024 + col0;
#pragma unroll
                for (int bj = 0; bj < 2; ++bj) {
                    f32x4 g0, g1; unpack8(*(const u32x4*)(gate + off + bj * HALF), g0, g1);
                    f32x4 v0 = g0 * acc[ai][bj][m][0], v1 = g1 * acc[ai][bj][m][1];
                    if (ADD) { f32x4 p0, p1; unpack8(*(const u32x4*)(prev + off + bj * HALF), p0, p1); v0 += p0; v1 += p1; }
                    *(u32x4*)(O + off + bj * HALF) = pack8(v0, v1);
                }
                if (m & 1) asm volatile("" ::: "memory");
            }
    }
};

template <class Epi, class Sched, bool ALIGN_EPI = false, bool SP2 = false>
__device__ __forceinline__ void gemm_phase(PG8_LAS unsigned char* lds, const Gemm g, const Sched S, const Epi E) {
    int tid_ = threadIdx.x; asm volatile("" : "+v"(tid_));
    const int tid = tid_, wid = __builtin_amdgcn_readfirstlane(tid >> 6), lane = tid & 63, wr = wid >> 2, wc = wid & 3, fr = lane & 15, fq = lane >> 4;
    const int K = g.K, nt = K / BK;
    unsigned voffA[2], voffB[2];
#pragma unroll
    for (int i = 0; i < 2; ++i) { int R, C; stage_rc(tid * 16 + i * 8192, R, C); const int Rb = Epi::PERM ? ((R & ~31) + perm32(R & 31)) : R;
        voffA[i] = (unsigned)(R * K + C) * 2u; voffB[i] = (unsigned)(Rb * K + C) * 2u; }
    const size_t kstep = (size_t)(BK * 2);
    const size_t hstep = (size_t)HALF * K * 2;
    const size_t tstep = 2 * hstep;
    const unsigned ldsw = (unsigned)wid * 1024u;
    const int aoff = lds_byte(wr * 64 + fr, fq * 8), boff = lds_byte(wc * 32 + fr, fq * 8);
#define PG8_SA(b, h) (((b) * 2 + (h)) * HTB)
#define PG8_SB(b, h) ((4 + (b) * 2 + (h)) * HTB)
#define PG8_STAGE(bufoff, gbase, voff) do { _Pragma("unroll") for (int _i = 0; _i < 2; ++_i) \
        __builtin_amdgcn_global_load_lds((const unsigned*)((const char*)(gbase) + (voff)[_i]), (PG8_LAS unsigned*)(lds + (bufoff) + ldsw + _i * 8192), 16, 0, 0); } while (0)
#define PG8_LDA(dst, b, h) do { _Pragma("unroll") for (int m = 0; m < 4; ++m) _Pragma("unroll") for (int k = 0; k < 2; ++k) dst[m][k] = *(const PG8_LAS bf16x8*)(lds + PG8_SA(b, h) + aoff + m * 2048 + k * 1024); } while (0)
#define PG8_LDB(dst, b, h) do { _Pragma("unroll") for (int n = 0; n < 2; ++n) _Pragma("unroll") for (int k = 0; k < 2; ++k) dst[n][k] = *(const PG8_LAS bf16x8*)(lds + PG8_SB(b, h) + boff + n * 2048 + k * 1024); } while (0)
#define PG8_MMA(ai, bj, At, Bt) do { __builtin_amdgcn_s_setprio(1); _Pragma("unroll") for (int m = 0; m < 4; ++m) _Pragma("unroll") for (int n = 0; n < 2; ++n) _Pragma("unroll") for (int k = 0; k < 2; ++k) \
        acc[ai][bj][m][n] = __builtin_amdgcn_mfma_f32_16x16x32_bf16(Bt[n][k], At[m][k], acc[ai][bj][m][n], 0, 0, 0); __builtin_amdgcn_s_setprio(0); } while (0)
#define PG8_WAIT_V(n) asm volatile("s_waitcnt vmcnt(" #n ")" ::: "memory")
#define PG8_WAIT_L(n) asm volatile("s_waitcnt lgkmcnt(" #n ")" ::: "memory")
#define PG8_BAR __builtin_amdgcn_s_barrier()
#define PG8_SCHED __builtin_amdgcn_sched_barrier(0)
    Unit cur, nxt; int ui = 0;
    if (!S.next(0, cur)) return;
    f32x4 acc[2][2][4][2];
#pragma unroll
    for (int a = 0; a < 2; ++a)
#pragma unroll
        for (int b = 0; b < 2; ++b)
#pragma unroll
            for (int m = 0; m < 4; ++m)
#pragma unroll
                for (int n = 0; n < 2; ++n) acc[a][b][m][n] = (f32x4){0.f, 0.f, 0.f, 0.f};
    bf16x8 At[4][2], B0[2][2], B1[2][2];
    const char* cA = (const char*)g.A + (size_t)cur.pm * tstep; const char* cB = (const char*)g.Bt + (size_t)cur.pn * tstep;
    S.a_ready(cur);
    if constexpr (SP2) {
        PG8_STAGE(PG8_SB(0, 0), cB, voffB); PG8_STAGE(PG8_SB(0, 1), cB + hstep, voffB); PG8_STAGE(PG8_SA(0, 0), cA, voffA); PG8_STAGE(PG8_SA(0, 1), cA + hstep, voffA);
        if (wr == 1) PG8_BAR;
        PG8_WAIT_V(2); PG8_BAR;
        PG8_STAGE(PG8_SB(1, 0), cB + kstep, voffB); PG8_STAGE(PG8_SA(1, 0), cA + kstep, voffA); PG8_STAGE(PG8_SB(1, 1), cB + hstep + kstep, voffB);
        PG8_WAIT_V(6); PG8_BAR;
    } else {
        PG8_STAGE(PG8_SB(0, 0), cB, voffB); PG8_STAGE(PG8_SA(0, 0), cA, voffA); PG8_STAGE(PG8_SB(0, 1), cB + hstep, voffB); PG8_STAGE(PG8_SA(0, 1), cA + hstep, voffA);
        if (wr == 1) PG8_BAR;
        PG8_WAIT_V(4); PG8_BAR;
        PG8_STAGE(PG8_SB(1, 0), cB + kstep, voffB); PG8_STAGE(PG8_SA(1, 0), cA + kstep, voffA); PG8_STAGE(PG8_SB(1, 1), cB + hstep + kstep, voffB);
        PG8_WAIT_V(6); PG8_BAR;
    }
    for (;;) {
        const bool has_next = S.next(ui + 1, nxt);
        const char* nA = has_next ? (const char*)g.A + (size_t)nxt.pm * tstep : cA; const char* nB = has_next ? (const char*)g.Bt + (size_t)nxt.pn * tstep : cB;
        for (int t = 0; t < nt; t += 2) {
            const bool last = (t == nt - 2);
            const char* a1 = cA + (size_t)(t + 1) * kstep;
            const char* a2 = last ? nA : cA + (size_t)(t + 2) * kstep; const char* b2 = last ? nB : cB + (size_t)(t + 2) * kstep;
            const char* a3 = a2 + kstep; const char* b3 = b2 + kstep;
            if (last && has_next) S.a_ready(nxt);
            if constexpr (SP2) {
            PG8_LDB(B0, 0, 0); PG8_LDB(B1, 0, 1); PG8_SCHED; PG8_LDA(At, 0, 0); PG8_STAGE(PG8_SA(1, 1), a1 + hstep, voffA);
            PG8_WAIT_V(8); PG8_WAIT_L(0); PG8_BAR; PG8_MMA(0, 0, At, B0); PG8_MMA(0, 1, At, B1); PG8_BAR; PG8_SCHED;
            PG8_LDA(At, 0, 1); PG8_STAGE(PG8_SB(0, 0), b2, voffB); PG8_STAGE(PG8_SB(0, 1), b2 + hstep, voffB); PG8_STAGE(PG8_SA(0, 0), a2, voffA);
            PG8_WAIT_V(8); PG8_WAIT_L(0); PG8_BAR; PG8_MMA(1, 0, At, B0); PG8_MMA(1, 1, At, B1); PG8_BAR; PG8_SCHED;
            PG8_LDB(B0, 1, 0); PG8_LDB(B1, 1, 1); PG8_SCHED; PG8_LDA(At, 1, 0); PG8_STAGE(PG8_SA(0, 1), a2 + hstep, voffA);
            PG8_WAIT_V(8); PG8_WAIT_L(0); PG8_BAR; PG8_MMA(0, 0, At, B0); PG8_MMA(0, 1, At, B1); PG8_BAR; PG8_SCHED;
            PG8_LDA(At, 1, 1); PG8_STAGE(PG8_SB(1, 0), b3, voffB); PG8_STAGE(PG8_SB(1, 1), b3 + hstep, voffB); PG8_STAGE(PG8_SA(1, 0), a3, voffA);
            PG8_WAIT_V(8); PG8_WAIT_L(0); PG8_BAR; PG8_MMA(1, 0, At, B0); PG8_MMA(1, 1, At, B1); PG8_BAR; PG8_SCHED;
            } else {
            PG8_LDB(B0, 0, 0); PG8_SCHED; PG8_LDA(At, 0, 0); PG8_STAGE(PG8_SA(1, 1), a1 + hstep, voffA);
            PG8_WAIT_L(8); PG8_BAR; PG8_WAIT_L(0); PG8_MMA(0, 0, At, B0); PG8_BAR; PG8_SCHED;
            PG8_LDB(B1, 0, 1); PG8_STAGE(PG8_SB(0, 0), b2, voffB);
            PG8_BAR; PG8_WAIT_L(0); PG8_MMA(0, 1, At, B1); PG8_BAR;
            PG8_LDA(At, 0, 1); PG8_STAGE(PG8_SA(0, 0), a2, voffA);
            PG8_BAR; PG8_WAIT_L(0); PG8_MMA(1, 0, At, B0); PG8_BAR; PG8_SCHED;
            PG8_STAGE(PG8_SB(0, 1), b2 + hstep, voffB);
            PG8_WAIT_V(6); PG8_BAR; PG8_MMA(1, 1, At, B1); PG8_BAR;
            PG8_LDB(B0, 1, 0); PG8_SCHED; PG8_LDA(At, 1, 0); PG8_STAGE(PG8_SA(0, 1), a2 + hstep, voffA);
            PG8_WAIT_L(8); PG8_BAR; PG8_WAIT_L(0); PG8_MMA(0, 0, At, B0); PG8_BAR; PG8_SCHED;
            PG8_LDB(B1, 1, 1); PG8_STAGE(PG8_SB(1, 0), b3, voffB);
            PG8_BAR; PG8_WAIT_L(0); PG8_MMA(0, 1, At, B1); PG8_BAR;
            PG8_LDA(At, 1, 1); PG8_STAGE(PG8_SA(1, 0), a3, voffA);
            PG8_BAR; PG8_WAIT_L(0); PG8_MMA(1, 0, At, B0); PG8_BAR; PG8_SCHED;
            PG8_STAGE(PG8_SB(1, 1), b3 + hstep, voffB);
            PG8_WAIT_V(6); PG8_BAR; PG8_MMA(1, 1, At, B1); PG8_BAR;
            }
        }
        if constexpr (ALIGN_EPI) { if (wr == 0) PG8_BAR; }
        if constexpr (!Epi::AFTER_DRAIN) { E(acc, cur, wr, wc, fr, fq); S.done(cur); }
        if (!has_next) break;
#pragma unroll
        for (int a = 0; a < 2; ++a)
#pragma unroll
            for (int b = 0; b < 2; ++b)
#pragma unroll
                for (int m = 0; m < 4; ++m)
#pragma unroll
                    for (int n = 0; n < 2; ++n) acc[a][b][m][n] = (f32x4){0.f, 0.f, 0.f, 0.f};
        cur = nxt; cA = nA; cB = nB; ++ui;
        if constexpr (ALIGN_EPI) { if (wr == 1) PG8_BAR; }
    }
    PG8_WAIT_V(0);
    if constexpr (!ALIGN_EPI) { if (wr == 0) PG8_BAR; }
    PG8_BAR;
    if constexpr (Epi::AFTER_DRAIN) { E.fused(acc, cur, wr, wc, fr, fq, lds, wid, lane); S.done(cur); }
#undef PG8_SA
#undef PG8_SB
#undef PG8_STAGE
#undef PG8_LDA
#undef PG8_LDB
#undef PG8_MMA
#undef PG8_WAIT_V
#undef PG8_WAIT_L
#undef PG8_BAR
#undef PG8_SCHED
}
}
constexpr int D = 1024, NB = 8, SEQ = 4096, FF = 2816, CWID = 31, HD = 64, HQ = 16, HKV = 4, INW = 5632;
constexpr int M_FULL = NB * SEQ;
constexpr int NWAVES = 8, NTHREADS = 512;
constexpr int LDS_BYTES = 147456;
constexpr int RING_BYTES = 131072;
constexpr size_t CTL_ZERO_BYTES = 16384;

#define LAS __attribute__((address_space(3)))
typedef unsigned short bf16;
typedef unsigned v4u __attribute__((ext_vector_type(4)));
typedef unsigned v2u __attribute__((ext_vector_type(2)));
typedef float f32x4 __attribute__((ext_vector_type(4)));
typedef float f32x2 __attribute__((ext_vector_type(2)));
typedef float f32x16 __attribute__((ext_vector_type(16)));
typedef short bf16x8 __attribute__((ext_vector_type(8)));
typedef short s16x4 __attribute__((ext_vector_type(4)));

__device__ const unsigned char T5B[128] = {0, 1, 2, 3, 4, 5, 6, 7, 8, 9, 10, 11, 12, 13, 14, 15, 16, 16, 16, 17, 17, 18, 18, 18, 19, 19, 19, 20, 20, 20, 20, 21, 21, 21, 21, 22, 22, 22, 22, 22, 23, 23, 23, 23, 23, 23, 24, 24, 24, 24, 24, 24, 25, 25, 25, 25, 25, 25, 25, 26, 26, 26, 26, 26, 26, 26, 26, 27, 27, 27, 27, 27, 27, 27, 27, 27, 27, 28, 28, 28, 28, 28, 28, 28, 28, 28, 28, 29, 29, 29, 29, 29, 29, 29, 29, 29, 29, 29, 29, 30, 30, 30, 30, 30, 30, 30, 30, 30, 30, 30, 30, 30, 30, 31, 31, 31, 31, 31, 31, 31, 31, 31, 31, 31, 31, 31, 31, 31};

struct Args {
    const float *x, *ffn1_norm, *ffn1_w_in, *ffn1_w_out, *mix_norm, *w_in, *conv_w, *conv_b, *ln_g, *ln_b, *conv_proj, *q_norm, *k_norm, *sinks, *rel_bias, *attn_wo, *w_out, *ffn2_norm, *ffn2_w_in, *ffn2_w_out;
    float *x1, *x2, *out;
    unsigned* ctl;
    float* biasC;
    float *ssq0, *ssq1, *ssq2;
    bf16 *W1i, *W1o, *Wmx, *Wcp, *Wao, *Wot, *W2i, *W2o;
    bf16 *xb, *H, *H2, *z, *q, *k, *v, *gc, *ga, *c, *o, *m1, *mg;
    int M; int pad;
};

__device__ __forceinline__ unsigned f2bf(float f) { unsigned u = __builtin_bit_cast(unsigned, f); return (u + 0x7fffu + ((u >> 16) & 1u)) >> 16; }
__device__ __forceinline__ unsigned pk2(float lo, float hi) { return f2bf(lo) | (f2bf(hi) << 16); }
#define LDS_WAIT() asm volatile("s_waitcnt lgkmcnt(0)" ::: "memory")

__device__ __forceinline__ int src_col(int kind, int n0) {
    if (kind == 0) return n0;
    const int u = n0 >> 8, r = n0 & 255, bj = r >> 7, j = r & 127;
    if (kind == 1) return bj * FF + 128 * u + j;
    if (u < 8) return bj * 1024 + 128 * u + j;
    if (u < 12) return 2048 + 64 * (4 * (u - 8) + (j >> 5)) + 32 * bj;
    if (u == 12) return 3072 + 64 * (j >> 5) + 32 * bj;
    return n0;
}
__device__ __forceinline__ void p0_transpose_item(const float* W, int K, int Nsrc, int N, bf16* WT, const float* gain, int kind, LAS float* scr, int item, int lane) {
    const int nblk = N / 32, kb = item / nblk, nb = item % nblk, k0 = 64 * kb, n0 = 32 * nb, s0 = src_col(kind, n0);
#pragma unroll 8
    for (int i = 0; i < 32; ++i) { const int kk = 2 * i + (lane >> 5); const float g = gain ? gain[k0 + kk] : 1.0f; scr[kk * 33 + (lane & 31)] = g * W[(size_t)(k0 + kk) * Nsrc + s0 + (lane & 31)]; }
    LDS_WAIT(); asm volatile("" ::: "memory");
    const int c = lane & 7;
#pragma unroll
    for (int j = 0; j < 4; ++j) { const int n = (lane >> 3) + 8 * j; const LAS float* s = scr + (8 * c) * 33 + n;
        v4u o; o.x = pk2(s[0 * 33], s[1 * 33]); o.y = pk2(s[2 * 33], s[3 * 33]); o.z = pk2(s[4 * 33], s[5 * 33]); o.w = pk2(s[6 * 33], s[7 * 33]);
        *(v4u*)(WT + (size_t)(n0 + n) * K + k0 + 8 * c) = o; }
    LDS_WAIT(); asm volatile("" ::: "memory");
}
__device__ __forceinline__ float wave_sum(float v) {
#pragma unroll
    for (int o = 1; o < 64; o <<= 1) v += __shfl_xor(v, o);
    return v;
}
__device__ __forceinline__ void p0_prologue(const Args& A, LAS unsigned char* lds, int gw, int NGW, int lane) {
    LAS float* scr = (LAS float*)(lds + (threadIdx.x >> 6) * 16384);
    constexpr int I_IN = (D / 64) * (INW / 32), I_OUT = (FF / 64) * (D / 32), I_SQ = (D / 64) * (D / 32);
    constexpr int NITEMS = 3 * I_IN + 2 * I_OUT + 3 * I_SQ;
    for (int it = gw; it < NITEMS; it += NGW) {
        int r = it;
        if (r < I_IN) { p0_transpose_item(A.ffn1_w_in, D, 2 * FF, 2 * FF, A.W1i, A.ffn1_norm, 1, scr, r, lane); continue; } r -= I_IN;
        if (r < I_IN) { p0_transpose_item(A.w_in, D, INW, INW, A.Wmx, A.mix_norm, 2, scr, r, lane); continue; } r -= I_IN;
        if (r < I_IN) { p0_transpose_item(A.ffn2_w_in, D, 2 * FF, 2 * FF, A.W2i, A.ffn2_norm, 1, scr, r, lane); continue; } r -= I_IN;
        if (r < I_OUT) { p0_transpose_item(A.ffn1_w_out, FF, D, D, A.W1o, nullptr, 0, scr, r, lane); continue; } r -= I_OUT;
        if (r < I_OUT) { p0_transpose_item(A.ffn2_w_out, FF, D, D, A.W2o, nullptr, 0, scr, r, lane); continue; } r -= I_OUT;
        if (r < I_SQ) { p0_transpose_item(A.conv_proj, D, D, D, A.Wcp, nullptr, 0, scr, r, lane); continue; } r -= I_SQ;
        if (r < I_SQ) { p0_transpose_item(A.attn_wo, D, D, D, A.Wao, nullptr, 0, scr, r, lane); continue; } r -= I_SQ;
        p0_transpose_item(A.w_out, D, D, D, A.Wot, nullptr, 0, scr, r, lane);
    }
    for (int m = gw; m < A.M; m += NGW) {
        const f32x4* xr = (const f32x4*)(A.x + (size_t)m * D) + lane;
        f32x4 v[4]; float s = 0.f;
#pragma unroll
        for (int j = 0; j < 4; ++j) { v[j] = xr[64 * j]; s += (v[j][0] * v[j][0] + v[j][1] * v[j][1]) + (v[j][2] * v[j][2] + v[j][3] * v[j][3]); }
        s = wave_sum(s);
        v2u* o8 = (v2u*)(A.xb + (size_t)m * D) + lane;
#pragma unroll
        for (int j = 0; j < 4; ++j) { v2u w; w.x = pk2(v[j][0], v[j][1]); w.y = pk2(v[j][2], v[j][3]); o8[64 * j] = w; }
        if (lane == 0) { A.ssq0[m] = s; A.ssq1[m] = 0.f; A.ssq2[m] = 0.f; }
    }
    for (int e = gw * 64 + lane; e < HQ * 5 * 64 * 16; e += NGW * 64) {
        const int r = e & 15, ln = (e >> 4) & 63, di = (e >> 10) % 5, h = e / (5 * 1024);
        const int kk = (r & 3) + 8 * (r >> 2) + 4 * (ln >> 5), qq = ln & 31, dist = 32 * di + qq - kk;
        A.biasC[e] = (dist >= 0 && dist < 128) ? A.rel_bias[T5B[dist] * HQ + h] * pg8::LOG2E : -3.0e38f;
    }
}

__device__ __forceinline__ void conv_phase(const Args& A, LAS unsigned char* lds) {
    int tid_ = threadIdx.x; asm volatile("" : "+v"(tid_));
    const int tid = tid_, lane = tid & 63, wid = tid >> 6, c0 = 2 * tid;
    LAS float* Y = (LAS float*)lds;
    float w0[CWID], w1[CWID];
#pragma unroll
    for (int k = 0; k < CWID; ++k) { const f32x2 wv = *(const f32x2*)(A.conv_w + k * D + c0); w0[k] = wv[0]; w1[k] = wv[1]; }
    const f32x2 bias = *(const f32x2*)(A.conv_b + c0);
    const int nchunks = A.M / 128;
    for (int ch = blockIdx.x; ch < nchunks; ch += gridDim.x) {
        const int t0 = ch * 128; const bool first = (t0 % SEQ) == 0;
        float h0[32], h1[32];
#pragma unroll
        for (int i = 2; i < 32; ++i) {
            unsigned zz = 0u; if (!first) zz = *(const unsigned*)(A.z + (size_t)(t0 - 32 + i) * D + c0);
            h0[i] = __uint_as_float(zz << 16); h1[i] = __uint_as_float(zz & 0xffff0000u);
        }
        for (int tb = 0; tb < 128; tb += 32) {
            unsigned zin[32];
#pragma unroll
            for (int s = 0; s < 32; ++s) zin[s] = *(const unsigned*)(A.z + (size_t)(t0 + tb + s) * D + c0);
#pragma unroll
            for (int s = 0; s < 32; ++s) {
                h0[s] = __uint_as_float(zin[s] << 16); h1[s] = __uint_as_float(zin[s] & 0xffff0000u);
                float a0 = bias[0], a1 = bias[1];
#pragma unroll
                for (int k = 0; k < CWID; ++k) { a0 = fmaf(w0[k], h0[(s + 2 + k) & 31], a0); a1 = fmaf(w1[k], h1[(s + 2 + k) & 31], a1); }
                *(LAS f32x2*)(Y + s * D + c0) = (f32x2){a0, a1};
            }
            __syncthreads();
#pragma unroll 1
            for (int i = 0; i < 4; ++i) {
                const int s = wid * 4 + i; f32x4 y[4]; float sm = 0.f;
#pragma unroll
                for (int j = 0; j < 4; ++j) { y[j] = *(const LAS f32x4*)(Y + s * D + 4 * lane + 256 * j); sm += (y[j][0] + y[j][1]) + (y[j][2] + y[j][3]); }
                const float mu = wave_sum(sm) * (1.0f / D); float sq = 0.f;
#pragma unroll
                for (int j = 0; j < 4; ++j) { y[j] = y[j] - mu; sq += (y[j][0] * y[j][0] + y[j][1] * y[j][1]) + (y[j][2] * y[j][2] + y[j][3] * y[j][3]); }
                const float rs = __builtin_amdgcn_rsqf(wave_sum(sq) * (1.0f / D) + 1e-6f);
                bf16* orow = A.c + (size_t)(t0 + tb + s) * D;
#pragma unroll
                for (int j = 0; j < 4; ++j) {
                    const f32x4 g = *(const f32x4*)(A.ln_g + 4 * lane + 256 * j), b = *(const f32x4*)(A.ln_b + 4 * lane + 256 * j);
                    f32x4 v = y[j] * rs * g + b; v = v * pg8::sigmoid4(v);
                    v2u w; w.x = pg8::cvt_pk_bf16(v[0], v[1]); w.y = pg8::cvt_pk_bf16(v[2], v[3]);
                    *(v2u*)(orow + 4 * lane + 256 * j) = w;
                }
            }
            __syncthreads();
        }
    }
}

constexpr int ATT_K_OFF = 0, ATT_V_OFF = 32768;
__device__ __forceinline__ s16x4 vtr(const LAS unsigned char* p) { typedef short v4i16_t __attribute__((ext_vector_type(4))); return __builtin_bit_cast(s16x4, __builtin_amdgcn_ds_read_tr16_b64_v4i16((LAS v4i16_t*)p)); }
__device__ __forceinline__ void attn_phase(const Args& A, LAS unsigned char* lds) {
    int tid_ = threadIdx.x; asm volatile("" : "+v"(tid_));
    const int tid = tid_, lane = tid & 63, r32 = lane & 31, hi = lane >> 5; const int wid = __builtin_amdgcn_readfirstlane(tid >> 6);
    const int nunits = (A.M / 128) * HKV;
    for (int u = blockIdx.x; u < nunits; u += gridDim.x) {
        const int blk = u >> 2, hk = u & 3, t0 = blk * 128; const bool first = (t0 % SEQ) == 0;
#pragma unroll
        for (int i = 0; i < 4; ++i) {
            const int idx = tid + 512 * i, key = idx >> 3, cc = idx & 7;
            if (!(first && key < 128)) {
                const size_t g = (size_t)(t0 - 128 + key) * 256 + hk * 64 + cc * 8;
                const v4u kv = *(const v4u*)(A.k + g), vv = *(const v4u*)(A.v + g);
                *(LAS v4u*)(lds + ATT_K_OFF + (((key >> 5) * 4 + (cc >> 1)) * 2 + (cc & 1)) * 512 + (key & 31) * 16) = kv;
                *(LAS v4u*)(lds + ATT_V_OFF + ((key >> 2) * 2 + (cc >> 2)) * 256 + (key & 3) * 64 + (cc & 3) * 16) = vv;
            }
        }
        __syncthreads();
#pragma unroll 1
        for (int ti = 0; ti < 2; ++ti) {
            const int task = wid + 8 * ti, g = task >> 2, sub = task & 3, h = hk * 4 + g;
            const size_t qrow = (size_t)(t0 + 32 * sub + r32) * D + h * HD;
            bf16x8 qf[4];
#pragma unroll
            for (int d0 = 0; d0 < 4; ++d0) qf[d0] = *(const bf16x8*)(A.q + qrow + 16 * d0 + 8 * hi);
            f32x16 s[5];
            const float* bc = A.biasC + ((size_t)h * 5 * 64 + lane) * 16;
#pragma unroll
            for (int di = 0; di < 5; ++di) {
                const f32x4* bp = (const f32x4*)(bc + di * 1024);
#pragma unroll
                for (int j = 0; j < 4; ++j) { const f32x4 t = bp[j]; s[di][4 * j] = t[0]; s[di][4 * j + 1] = t[1]; s[di][4 * j + 2] = t[2]; s[di][4 * j + 3] = t[3]; }
            }
            const float sink2 = A.sinks[h] * pg8::LOG2E;
            float mx = sink2;
#pragma unroll
            for (int di = 0; di < 5; ++di) {
                const int kt = sub + 4 - di;
                if (!(first && kt < 4)) {
#pragma unroll
                    for (int d0 = 0; d0 < 4; ++d0) {
                        const bf16x8 kf = *(const LAS bf16x8*)(lds + ATT_K_OFF + ((kt * 4 + d0) * 2 + hi) * 512 + r32 * 16);
                        s[di] = __builtin_amdgcn_mfma_f32_32x32x16_bf16(kf, qf[d0], s[di], 0, 0, 0);
                    }
#pragma unroll
                    for (int r = 0; r < 16; ++r) mx = fmaxf(mx, s[di][r]);
                }
            }
            mx = fmaxf(mx, __shfl_xor(mx, 32));
            float l = 0.f;
            f32x16 o0, o1;
#pragma unroll
            for (int r = 0; r < 16; ++r) { o0[r] = 0.f; o1[r] = 0.f; }
#pragma unroll
            for (int di = 0; di < 5; ++di) {
                const int kt = sub + 4 - di;
                if (!(first && kt < 4)) {
#pragma unroll
                    for (int r = 0; r < 16; ++r) { s[di][r] = __builtin_amdgcn_exp2f(s[di][r] - mx); l += s[di][r]; }
#pragma unroll
                    for (int s2 = 0; s2 < 2; ++s2) {
                        v4u pw; pw.x = pg8::cvt_pk_bf16(s[di][8 * s2 + 0], s[di][8 * s2 + 1]); pw.y = pg8::cvt_pk_bf16(s[di][8 * s2 + 2], s[di][8 * s2 + 3]);
                        pw.z = pg8::cvt_pk_bf16(s[di][8 * s2 + 4], s[di][8 * s2 + 5]); pw.w = pg8::cvt_pk_bf16(s[di][8 * s2 + 6], s[di][8 * s2 + 7]);
                        const bf16x8 pa = __builtin_bit_cast(bf16x8, pw);
                        const LAS unsigned char* vp = lds + ATT_V_OFF + ((8 * kt + 4 * s2 + hi) * 2) * 256 + ((lane & 15) >> 2) * 64 + (((lane >> 4) & 1) * 16 + (lane & 3) * 4) * 2;
                        const s16x4 a0 = vtr(vp), a1 = vtr(vp + 2 * 512), b0 = vtr(vp + 256), b1 = vtr(vp + 256 + 2 * 512);
                        const bf16x8 v0 = (bf16x8){a0[0], a0[1], a0[2], a0[3], a1[0], a1[1], a1[2], a1[3]};
                        const bf16x8 v1 = (bf16x8){b0[0], b0[1], b0[2], b0[3], b1[0], b1[1], b1[2], b1[3]};
                        o0 = __builtin_amdgcn_mfma_f32_32x32x16_bf16(pa, v0, o0, 0, 0, 0);
                        o1 = __builtin_amdgcn_mfma_f32_32x32x16_bf16(pa, v1, o1, 0, 0, 0);
                    }
                }
            }
            l += __shfl_xor(l, 32);
            l += __builtin_amdgcn_exp2f(sink2 - mx);
            const float linv = __builtin_amdgcn_rcpf(l);
            bf16* ob = A.o + (size_t)(t0 + 32 * sub) * D + h * HD + r32;
#pragma unroll
            for (int r = 0; r < 16; ++r) {
                const int qq = (r & 3) + 8 * (r >> 2) + 4 * hi;
                const float li = __shfl(linv, qq);
                ob[(size_t)qq * D] = (bf16)f2bf(o0[r] * li);
                ob[(size_t)qq * D + 32] = (bf16)f2bf(o1[r] * li);
            }
        }
        __syncthreads();
    }
}
typedef unsigned gu32_t;
#define XB_TMO      128
#define XB_XCNT(j)  (256  + 64 * (j))
#define XB_XSUB(j)  (1280 + 64 * (j))
#define XB_XGEN(j)  (2304 + 64 * (j))
#define XB_TOP      3328
#define XB_TOPGEN   3392
#define XCD_BAR_WORDS 3456
#define XB_SPIN_CAP (1u << 18)

__device__ __forceinline__ unsigned xb_ld(unsigned* p)              { return __hip_atomic_load(p, __ATOMIC_RELAXED, __HIP_MEMORY_SCOPE_AGENT); }
__device__ __forceinline__ unsigned xb_add(unsigned* p, unsigned v) { return __hip_atomic_fetch_add(p, v, __ATOMIC_RELAXED, __HIP_MEMORY_SCOPE_AGENT); }
__device__ __forceinline__ unsigned xb_xcc_id() { return (unsigned)__builtin_amdgcn_s_getreg((3 << 11) | 20) & 0xFu; }
#define XB_SPIN(cond, bar) do { unsigned _sp = 0; while (cond) { __builtin_amdgcn_s_sleep(1); \
    if ((++_sp & 255u) == 0u) { if (xb_ld(&(bar)[XB_TMO])) break; if (_sp > XB_SPIN_CAP) { atomicAdd(&(bar)[XB_TMO], 1u); break; } } } } while (0)

struct XcdBarrier {
    unsigned* bar; unsigned x;
    volatile LAS unsigned* st;
};

__device__ __forceinline__ XcdBarrier xcd_barrier_post(unsigned* bar, volatile LAS unsigned* st) {
    XcdBarrier b; b.bar = bar; b.x = xb_xcc_id(); b.st = st;
    if (threadIdx.x == 0) (void)xb_add(&bar[XB_XCNT(b.x)], 1u);
    return b;
}
__device__ __forceinline__ void xcd_barrier_complete(unsigned* bar, unsigned x, unsigned& nloc, unsigned& nx) {
    const unsigned G = gridDim.x * gridDim.y * gridDim.z;
    unsigned sum, cnt, mine, sp = 0u;
    for (;;) {
        sum = 0u; cnt = 0u; mine = 0u;
#pragma unroll
        for (unsigned j = 0; j < 16; ++j) { const unsigned c = xb_ld(&bar[XB_XCNT(j)]); sum += c; cnt += (c > 0u) ? 1u : 0u; mine = (j == x) ? c : mine; }
        if (sum == G) break;
        __builtin_amdgcn_s_sleep(1);
        if ((++sp & 255u) == 0u) { if (xb_ld(&bar[XB_TMO])) break; if (sp > XB_SPIN_CAP) { atomicAdd(&bar[XB_TMO], 1u); break; } }
    }
    nloc = mine > 0u ? mine : 1u; nx = cnt > 0u ? cnt : 1u;
}

__device__ __forceinline__ void xcd_barrier(const XcdBarrier& b) {
    asm volatile("s_waitcnt vmcnt(0)" ::: "memory");
    __syncthreads();
    if (threadIdx.x == 0) {
        unsigned* bar = b.bar;
        __builtin_amdgcn_s_waitcnt(0);
        unsigned nloc = b.st[0], nx = b.st[1];
        if (nloc == 0u) { xcd_barrier_complete(bar, b.x, nloc, nx); b.st[0] = nloc; b.st[1] = nx; }
        const unsigned old = xb_add(&bar[XB_XSUB(b.x)], 1u);
        const unsigned gen = old / nloc;
        if (old + 1u == (gen + 1u) * nloc) {
            __builtin_amdgcn_fence(__ATOMIC_RELEASE, "agent");
            asm volatile("s_waitcnt vmcnt(0)" ::: "memory");
            const unsigned og = xb_add(&bar[XB_TOP], 1u);
            const unsigned tg = og / nx;
            if (og + 1u == (tg + 1u) * nx) xb_add(&bar[XB_TOPGEN], 1u);
            else XB_SPIN(xb_ld(&bar[XB_TOPGEN]) == tg, bar);
            __builtin_amdgcn_fence(__ATOMIC_ACQUIRE, "agent");
            xb_add(&bar[XB_XGEN(b.x)], 1u);
            asm volatile("s_waitcnt vmcnt(0)" ::: "memory");
        } else {
            XB_SPIN(xb_ld(&bar[XB_XGEN(b.x)]) == gen, bar);
            __builtin_amdgcn_fence(__ATOMIC_ACQUIRE, "agent");
            asm volatile("s_waitcnt vmcnt(0)" ::: "memory");
        }
    }
    __syncthreads();
}

typedef pg8::EpiResid<true, true> EpiResTH; typedef pg8::EpiResid<true, false> EpiResTF; typedef pg8::EpiResid<false, true> EpiResFH;
#ifndef STOP_AFTER
#define STOP_AFTER 99
#endif
__global__ void __launch_bounds__(NTHREADS, 2) mega_fwd(Args A) {
    extern __shared__ __attribute__((aligned(16))) unsigned char lds_raw[];
    LAS unsigned char* lds = (LAS unsigned char*)lds_raw;
    const int tid = threadIdx.x, lane = tid & 63, wave = tid >> 6, G = gridDim.x;
    const int vcu = (G % 8 == 0) ? ((int)blockIdx.x % 8) * (G / 8) + (int)blockIdx.x / 8 : (int)blockIdx.x;
    const int M = A.M;
    volatile LAS unsigned* MISC = (volatile LAS unsigned*)(lds + RING_BYTES);
    if (tid < 16) MISC[tid] = 0u;
    __syncthreads();
    const XcdBarrier bar = xcd_barrier_post(A.ctl, MISC);
#define GRID_SYNC() xcd_barrier(bar)
#define GEMM_PHASE(EPI_T, AP, BP, NN, KK, ...) do { pg8::Gemm g_{AP, BP, M, NN, KK}; pg8::StaticOrder S_; S_.init(M, NN, G, (int)blockIdx.x); EPI_T E_{__VA_ARGS__}; \
        pg8::gemm_phase<EPI_T, pg8::StaticOrder, true, true>(lds, g_, S_, E_); } while (0)

    p0_prologue(A, lds, vcu * NWAVES + wave, G * NWAVES, lane);
    GRID_SYNC();
    GEMM_PHASE(pg8::EpiSwiglu, A.xb, A.W1i, 2 * FF, D, A.H, FF, A.ssq0);
    GRID_SYNC();
    if (STOP_AFTER <= 1) return;
    GEMM_PHASE(EpiResTH, A.H, A.W1o, D, FF, A.x, A.x1, D, A.xb, A.ssq1);
    GRID_SYNC();
    if (STOP_AFTER <= 2) return;
    GEMM_PHASE(pg8::EpiMix, A.xb, A.Wmx, INW, D, A.ssq1, A.z, A.q, A.k, A.v, A.gc, A.ga, A.q_norm, A.k_norm);
    GRID_SYNC();
    if (STOP_AFTER <= 3) return;
    conv_phase(A, lds);
    attn_phase(A, lds);
    GRID_SYNC();
    if (STOP_AFTER <= 4) return;
    GEMM_PHASE(pg8::EpiGate<false>, A.c, A.Wcp, D, D, A.gc, nullptr, A.m1);
    GRID_SYNC();
    GEMM_PHASE(pg8::EpiGate<true>, A.o, A.Wao, D, D, A.ga, A.m1, A.mg);
    GRID_SYNC();
    if (STOP_AFTER <= 6) return;
    GEMM_PHASE(EpiResTF, A.mg, A.Wot, D, D, A.x1, A.x2, D, A.xb, A.ssq2);
    GRID_SYNC();
    if (STOP_AFTER <= 7) return;
    GEMM_PHASE(pg8::EpiSwiglu, A.xb, A.W2i, 2 * FF, D, A.H2, FF, A.ssq2);
    GRID_SYNC();
    GEMM_PHASE(EpiResFH, A.H2, A.W2o, D, FF, A.x2, A.out, D, nullptr, nullptr);
#undef GEMM_PHASE
#undef GRID_SYNC
}

static size_t ws_map(Args& a, unsigned char* ws, int M, bool alias) {
    size_t off = 0;
    auto take = [&](size_t bytes) { unsigned char* p = ws + off; off += (bytes + 255) & ~(size_t)255; return p; };
    a.ctl = (unsigned*)take(1u << 20);
    a.biasC = (float*)take((size_t)HQ * 5 * 64 * 16 * 4);
    a.ssq0 = (float*)take((size_t)M * 4); a.ssq1 = (float*)take((size_t)M * 4); a.ssq2 = (float*)take((size_t)M * 4);
    a.W1i = (bf16*)take((size_t)2 * FF * D * 2); a.W1o = (bf16*)take((size_t)D * FF * 2); a.Wmx = (bf16*)take((size_t)INW * D * 2);
    a.Wcp = (bf16*)take((size_t)D * D * 2); a.Wao = (bf16*)take((size_t)D * D * 2); a.Wot = (bf16*)take((size_t)D * D * 2);
    a.W2i = (bf16*)take((size_t)2 * FF * D * 2); a.W2o = (bf16*)take((size_t)D * FF * 2);
    const size_t act = (size_t)M * D * 2;
    a.xb = (bf16*)take(act);
    a.H = (bf16*)take((size_t)M * FF * 2); a.H2 = a.H;
    if (alias) {
        a.z = a.H; a.q = a.z + (size_t)M * D; a.k = a.q + (size_t)M * D; a.v = a.k + (size_t)M * 256;
        a.gc = (bf16*)take(act); a.ga = (bf16*)take(act); a.c = (bf16*)take(act);
        a.o = a.q; a.m1 = a.z; a.mg = a.c;
    } else {
        a.z = (bf16*)take(act); a.q = (bf16*)take(act); a.k = (bf16*)take((size_t)M * 256 * 2); a.v = (bf16*)take((size_t)M * 256 * 2);
        a.gc = (bf16*)take(act); a.ga = (bf16*)take(act); a.c = (bf16*)take(act);
        a.o = (bf16*)take(act); a.m1 = (bf16*)take(act); a.mg = (bf16*)take(act);
    }
    return off;
}
static void set_inputs(Args& a, void* const* d_in) {
    a.x = (const float*)d_in[0]; a.ffn1_norm = (const float*)d_in[1]; a.ffn1_w_in = (const float*)d_in[2]; a.ffn1_w_out = (const float*)d_in[3];
    a.mix_norm = (const float*)d_in[4]; a.w_in = (const float*)d_in[5]; a.conv_w = (const float*)d_in[6]; a.conv_b = (const float*)d_in[7];
    a.ln_g = (const float*)d_in[8]; a.ln_b = (const float*)d_in[9]; a.conv_proj = (const float*)d_in[10]; a.q_norm = (const float*)d_in[11];
    a.k_norm = (const float*)d_in[12]; a.sinks = (const float*)d_in[13]; a.rel_bias = (const float*)d_in[14]; a.attn_wo = (const float*)d_in[15];
    a.w_out = (const float*)d_in[16]; a.ffn2_norm = (const float*)d_in[17]; a.ffn2_w_in = (const float*)d_in[18]; a.ffn2_w_out = (const float*)d_in[19];
}
static int g_grid = 0;
static bool launch_mega(Args& a, hipStream_t stream) {
    if (g_grid == 0) {
        int dev = 0, cus = 0, per_cu = 0;
        if (hipGetDevice(&dev) != hipSuccess || hipDeviceGetAttribute(&cus, hipDeviceAttributeMultiprocessorCount, dev) != hipSuccess) { g_grid = -1; return false; }
        if (hipFuncSetAttribute((const void*)mega_fwd, hipFuncAttributeMaxDynamicSharedMemorySize, LDS_BYTES) != hipSuccess) { fprintf(stderr, "hipFuncSetAttribute failed\n"); g_grid = -1; return false; }
        if (hipOccupancyMaxActiveBlocksPerMultiprocessor(&per_cu, (const void*)mega_fwd, NTHREADS, LDS_BYTES) != hipSuccess || per_cu < 1) { fprintf(stderr, "occupancy query: %d blocks per CU\n", per_cu); g_grid = -1; (void)hipGetLastError(); return false; }
        g_grid = cus;
    }
    if (g_grid < 0) return false;
    void* args[] = {&a};
    const hipError_t e = hipLaunchCooperativeKernel((const void*)mega_fwd, dim3(g_grid), dim3(NTHREADS), args, LDS_BYTES, stream);
    if (e != hipSuccess) { fprintf(stderr, "cooperative launch failed: %s (grid %d)\n", hipGetErrorString(e), g_grid); return false; }
    return true;
}
#if DEBUG_ORACLE
namespace nv {
constexpr int S = SEQ, B = NB;
constexpr float EPS = 1e-6f;
__device__ __forceinline__ float sigmoidf_(float v) { return 1.f / (1.f + expf(-v)); }
__device__ __forceinline__ float siluf_(float v) { return v / (1.f + expf(-v)); }
__device__ __forceinline__ float block_sum_256(float v, float* red) {
    for (int o = 32; o > 0; o >>= 1) v += __shfl_xor(v, o);
    const int w = threadIdx.x >> 6, l = threadIdx.x & 63;
    __syncthreads(); if (l == 0) red[w] = v; __syncthreads();
    return red[0] + red[1] + red[2] + red[3];
}
__global__ void rms_rows(const float* x, const float* g, float* out) {
    __shared__ float red[4];
    const size_t r = blockIdx.x;
    const float4 v = ((const float4*)(x + r * D))[threadIdx.x];
    const float ss = block_sum_256(v.x * v.x + v.y * v.y + v.z * v.z + v.w * v.w, red);
    const float rs = rsqrtf(ss * (1.f / D) + EPS);
    const float4 gg = ((const float4*)g)[threadIdx.x];
    float4 o; o.x = v.x * rs * gg.x; o.y = v.y * rs * gg.y; o.z = v.z * rs * gg.z; o.w = v.w * rs * gg.w;
    ((float4*)(out + r * D))[threadIdx.x] = o;
}
__global__ void gemm_f32(const float* __restrict__ A, int lda, const float* __restrict__ Bm, int ldb, float* __restrict__ C, int ldc, int K) {
    __shared__ float As[16][68];
    __shared__ float Bs[16][68];
    const int tx = threadIdx.x & 15, ty = threadIdx.x >> 4;
    const int m0 = blockIdx.y * 64, n0 = blockIdx.x * 64;
    float acc[4][4] = {};
    for (int k0 = 0; k0 < K; k0 += 16) {
        {
            const int r = threadIdx.x >> 2, kq = (threadIdx.x & 3) * 4;
            const float4 a = *(const float4*)(A + (size_t)(m0 + r) * lda + k0 + kq);
            As[kq + 0][r] = a.x; As[kq + 1][r] = a.y; As[kq + 2][r] = a.z; As[kq + 3][r] = a.w;
            const int kr = threadIdx.x >> 4, c4 = (threadIdx.x & 15) * 4;
            *(float4*)&Bs[kr][c4] = *(const float4*)(Bm + (size_t)(k0 + kr) * ldb + n0 + c4);
        }
        __syncthreads();
#pragma unroll
        for (int k = 0; k < 16; ++k) {
            const float4 a = *(const float4*)&As[k][ty * 4];
            const float4 b = *(const float4*)&Bs[k][tx * 4];
            const float av[4] = {a.x, a.y, a.z, a.w}, bv[4] = {b.x, b.y, b.z, b.w};
#pragma unroll
            for (int i = 0; i < 4; ++i)
#pragma unroll
                for (int j = 0; j < 4; ++j) acc[i][j] = fmaf(av[i], bv[j], acc[i][j]);
        }
        __syncthreads();
    }
#pragma unroll
    for (int i = 0; i < 4; ++i) { float4 o; o.x = acc[i][0]; o.y = acc[i][1]; o.z = acc[i][2]; o.w = acc[i][3]; *(float4*)(C + (size_t)(m0 + ty * 4 + i) * ldc + n0 + tx * 4) = o; }
}
__global__ void swiglu_k(const float* U, float* H, int rows) {
    const size_t i = (size_t)blockIdx.x * blockDim.x + threadIdx.x;
    if (i >= (size_t)rows * FF) return;
    const size_t t = i / FF; const int j = (int)(i % FF);
    H[i] = siluf_(U[t * (2 * FF) + j]) * U[t * (2 * FF) + FF + j];
}
__global__ void resid_k(const float* xin, const float* y, float scale, float* out, size_t n) {
    const size_t i = (size_t)blockIdx.x * blockDim.x + threadIdx.x;
    if (i < n) out[i] = xin[i] + scale * y[i];
}
__global__ void glu_k(const float* P, float* z, int rows) {
    const size_t i = (size_t)blockIdx.x * blockDim.x + threadIdx.x;
    if (i >= (size_t)rows * D) return;
    const size_t t = i / D; const int c = (int)(i % D);
    z[i] = P[t * INW + c] * sigmoidf_(P[t * INW + D + c]);
}
__global__ void conv_k(const float* z, const float* w, const float* bias, float* y) {
    const size_t i = (size_t)blockIdx.x * blockDim.x + threadIdx.x;
    if (i >= (size_t)S * D) return;
    const int t = (int)(i / D), c = (int)(i % D);
    float acc = bias[c];
    for (int k = 0; k < CWID; ++k) { const int tt = t - (CWID - 1) + k; if (tt >= 0) acc = fmaf(w[k * D + c], z[(size_t)tt * D + c], acc); }
    y[i] = acc;
}
__global__ void ln_silu_k(const float* y, const float* g, const float* b, float* out) {
    __shared__ float red[4];
    const size_t r = blockIdx.x;
    const float4 v = ((const float4*)(y + r * D))[threadIdx.x];
    const float mu = block_sum_256(v.x + v.y + v.z + v.w, red) * (1.f / D);
    const float dx = v.x - mu, dy = v.y - mu, dz = v.z - mu, dw = v.w - mu;
    const float var = block_sum_256(dx * dx + dy * dy + dz * dz + dw * dw, red) * (1.f / D);
    const float rs = rsqrtf(var + EPS);
    const float4 gg = ((const float4*)g)[threadIdx.x], bb = ((const float4*)b)[threadIdx.x];
    float4 o; o.x = siluf_(dx * rs * gg.x + bb.x); o.y = siluf_(dy * rs * gg.y + bb.y); o.z = siluf_(dz * rs * gg.z + bb.z); o.w = siluf_(dw * rs * gg.w + bb.w);
    ((float4*)(out + r * D))[threadIdx.x] = o;
}
__global__ void qknorm_k(const float* P, const float* qg, const float* kg, float* qn, float* kn) {
    const int wv = (blockIdx.x * 4) + (threadIdx.x >> 6), lane = threadIdx.x & 63;
    const int t = wv / (HQ + HKV), hh = wv % (HQ + HKV);
    if (t >= S) return;
    const bool isq = hh < HQ;
    const int h = isq ? hh : hh - HQ;
    const float v = P[(size_t)t * INW + (isq ? 2 * D + h * HD : 3 * D + h * HD) + lane];
    float ss = v * v;
    for (int o = 32; o > 0; o >>= 1) ss += __shfl_xor(ss, o);
    const float rs = rsqrtf(ss * (1.f / HD) + EPS);
    if (isq) qn[(size_t)t * (HQ * HD) + h * HD + lane] = v * rs * qg[lane];
    else     kn[(size_t)t * (HKV * HD) + h * HD + lane] = v * rs * kg[lane];
}
__global__ void attn_k(const float* qn, const float* kn, const float* P, const float* sinks, const float* rel_bias, float* o) {
    const int wv = (blockIdx.x * 4) + (threadIdx.x >> 6), lane = threadIdx.x & 63;
    const int t = wv / HQ, h = wv % HQ, hk = h / (HQ / HKV);
    if (t >= S) return;
    const float* q = qn + (size_t)t * (HQ * HD) + h * HD;
    float s[2];
#pragma unroll
    for (int u = 0; u < 2; ++u) {
        const int dist = lane + 64 * u, key = t - dist;
        float acc = -3.0e38f;
        if (key >= 0) {
            const float* kr = kn + (size_t)key * (HKV * HD) + hk * HD;
            float d = 0.f;
            for (int e = 0; e < HD; ++e) d = fmaf(q[e], kr[e], d);
            acc = d * 0.125f + rel_bias[T5B[dist] * HQ + h];
        }
        s[u] = acc;
    }
    const float sink = sinks[h];
    float m = fmaxf(fmaxf(s[0], s[1]), sink);
    for (int of = 32; of > 0; of >>= 1) m = fmaxf(m, __shfl_xor(m, of));
    float p0 = (t - lane >= 0) ? expf(s[0] - m) : 0.f, p1 = (t - lane - 64 >= 0) ? expf(s[1] - m) : 0.f;
    float l = p0 + p1;
    for (int of = 32; of > 0; of >>= 1) l += __shfl_xor(l, of);
    l += expf(sink - m);
    const float inv = 1.f / l;
    float acc = 0.f;
    for (int j = 0; j < 64; ++j) {
        const float pj0 = __shfl(p0, j), pj1 = __shfl(p1, j);
        const int k0 = t - j, k1 = t - j - 64;
        if (k0 >= 0) acc = fmaf(pj0, P[(size_t)k0 * INW + 3 * D + HKV * HD + hk * HD + lane], acc);
        if (k1 >= 0) acc = fmaf(pj1, P[(size_t)k1 * INW + 3 * D + HKV * HD + hk * HD + lane], acc);
    }
    o[(size_t)t * (HQ * HD) + h * HD + lane] = acc * inv;
}
__global__ void merge_k(const float* P, const float* a, const float* b, float* mg, int rows) {
    const size_t i = (size_t)blockIdx.x * blockDim.x + threadIdx.x;
    if (i >= (size_t)rows * D) return;
    const size_t t = i / D; const int c = (int)(i % D);
    mg[i] = sigmoidf_(P[t * INW + 3584 + c]) * a[i] + sigmoidf_(P[t * INW + 4608 + c]) * b[i];
}
static void gemm(const float* A, int lda, const float* Bm, int ldb, float* C, int ldc, int M, int N, int K, hipStream_t st) {
    hipLaunchKernelGGL(gemm_f32, dim3(N / 64, M / 64), dim3(256), 0, st, A, lda, Bm, ldb, C, ldc, K);
}
__global__ void cmp_k(const void* a, int a_is_bf16, int lda, float ascale, const float* ref, int ldr, int sig, int rows, int cols, unsigned* slot) {
    const size_t i = (size_t)blockIdx.x * blockDim.x + threadIdx.x;
    float d = 0.f, r2 = 0.f;
    if (i < (size_t)rows * cols) {
        const size_t t = i / cols; const int c = (int)(i % cols);
        float av = a_is_bf16 ? __uint_as_float((unsigned)((const unsigned short*)a)[t * lda + c] << 16) : ((const float*)a)[t * lda + c];
        float rv = ref[t * ldr + c]; if (sig) rv = sigmoidf_(rv);
        d = fabsf(av * ascale - rv); if (!(d == d)) d = 1e30f; r2 = rv * rv;
    }
    float d2 = d * d;
    for (int o = 32; o > 0; o >>= 1) { d = fmaxf(d, __shfl_xor(d, o)); r2 += __shfl_xor(r2, o); d2 += __shfl_xor(d2, o); }
    if ((threadIdx.x & 63) == 0) { atomicMax(slot, __float_as_uint(d)); atomicAdd((float*)(slot + 1), r2); atomicAdd((float*)(slot + 2), d2); }
}
constexpr int NCHK = 16;
struct Counts { float c[NCHK]; };
__global__ void decide_k(unsigned* slots, Counts cnt, float tol, float* code_out) {
    if (threadIdx.x != 0 || blockIdx.x != 0) return;
    float code = 0.f;
    for (int k = 0; k < NCHK; ++k) {
        if (cnt.c[k] <= 0.f) continue;
        const float md = __uint_as_float(slots[4 * k]), rr = __uint_as_float(slots[4 * k + 1]), dd = __uint_as_float(slots[4 * k + 2]);
        const float rms = sqrtf(rr / cnt.c[k]), rmsr = sqrtf(dd / fmaxf(rr, 1e-30f));
        if (!(rmsr <= tol) || !(md <= 0.5f * rms)) { code = (float)(k + 1) + (rmsr < 0.03f ? 0.f : rmsr < 0.3f ? 0.3f : 0.6f); break; }
    }
    *code_out = code;
}
__global__ void finish_k(float* out, const float* mega_out, size_t dbg_off, size_t dbg_n, size_t n, const float* code) {
    const size_t i = (size_t)blockIdx.x * blockDim.x + threadIdx.x;
    if (i >= n) return;
    const float c = *code;
    float v = out[i];
    if (c == 0.f && i >= dbg_off && i < dbg_off + dbg_n) v = mega_out[i - dbg_off];
    out[i] = v * (1.f + c);
}
}
#ifndef DBG_B
#define DBG_B 5
#endif
#ifndef DBG_TOL
#define DBG_TOL 0.01f
#endif
#endif

extern "C" void kernel_launch(void* const* d_in, const int* in_sizes, int n_in, void* d_out, int out_size, void* d_ws, size_t ws_size, hipStream_t stream) {
    (void)in_sizes; (void)n_in; (void)out_size; (void)ws_size;
#if !DEBUG_ORACLE
    Args a{};
    set_inputs(a, d_in);
    a.out = (float*)d_out; a.x1 = a.out; a.x2 = a.out;
    ws_map(a, (unsigned char*)d_ws, M_FULL, true);
    a.M = M_FULL;
    if (hipMemsetAsync(a.ctl, 0, CTL_ZERO_BYTES, stream) != hipSuccess) return;
    launch_mega(a, stream);
#else
    using namespace nv;
    unsigned char* wsb = (unsigned char*)d_ws;
    Args a{};
    set_inputs(a, d_in);
    a.x += (size_t)DBG_B * S * D;
    size_t used = ws_map(a, wsb, S, false);
    auto takeb = [&](size_t bytes) { unsigned char* p = wsb + used; used += (bytes + 255) & ~(size_t)255; return p; };
    a.x1 = (float*)takeb((size_t)S * D * 4); a.x2 = (float*)takeb((size_t)S * D * 4); a.out = (float*)takeb((size_t)S * D * 4);
    a.H2 = (bf16*)takeb((size_t)S * FF * 2);
    a.M = S;
    unsigned* slots = (unsigned*)takeb(256); float* code = (float*)takeb(256);
    Counts hc{};
    const float* x = (const float*)d_in[0];
    float* out = (float*)d_out;
    float* xn = (float*)takeb((size_t)S * D * 4); float* U = (float*)takeb((size_t)S * INW * 4); float* Hh = (float*)takeb((size_t)S * FF * 4); float* Y = (float*)takeb((size_t)S * D * 4);
    float* z = (float*)takeb((size_t)S * D * 4); float* cy = xn; float* cv = (float*)takeb((size_t)S * D * 4); float* qn = (float*)takeb((size_t)S * D * 4);
    float* kn = (float*)takeb((size_t)S * 256 * 4); float* ao = (float*)takeb((size_t)S * D * 4); float* av = (float*)takeb((size_t)S * D * 4); float* bv = (float*)takeb((size_t)S * D * 4);
    float* mg = (float*)takeb((size_t)S * D * 4);
    if (used > ws_size) { fprintf(stderr, "debug build needs %zu bytes of workspace, have %zu\n", used, ws_size); return; }
    hipMemsetAsync(slots, 0, 256, stream);
    hipMemsetAsync(a.ctl, 0, CTL_ZERO_BYTES, stream);
    launch_mega(a, stream);
    const int EB = 256; const size_t n1 = (size_t)S * D;
    int nchk = 0;
    auto chk = [&](const void* ap, int isbf, int lda, float asc, const float* ref, int ldr, int sig, int rows, int cols) {
        const size_t n = (size_t)rows * cols;
        hipLaunchKernelGGL(cmp_k, dim3((unsigned)((n + 255) / 256)), dim3(256), 0, stream, ap, isbf, lda, asc, ref, ldr, sig, rows, cols, slots + 4 * nchk);
        hc.c[nchk] = (float)n; ++nchk;
    };
    for (int bi = 0; bi < B; ++bi) {
        const int b = (bi == B - 1) ? DBG_B : (bi >= DBG_B ? bi + 1 : bi);
        const bool dbg = (b == DBG_B);
        const float* xbp = x + (size_t)b * S * D; float* ob = out + (size_t)b * S * D;
        hipLaunchKernelGGL(rms_rows, dim3(S), dim3(256), 0, stream, xbp, a.ffn1_norm, xn);
        gemm(xn, D, a.ffn1_w_in, 2 * FF, U, 2 * FF, S, 2 * FF, D, stream);
        hipLaunchKernelGGL(swiglu_k, dim3((unsigned)(((size_t)S * FF + EB - 1) / EB)), dim3(EB), 0, stream, U, Hh, S);
        if (dbg) chk(a.H, 1, FF, 1.f, Hh, FF, 0, S, FF);
        gemm(Hh, FF, a.ffn1_w_out, D, Y, D, S, D, FF, stream);
        hipLaunchKernelGGL(resid_k, dim3((unsigned)((n1 + EB - 1) / EB)), dim3(EB), 0, stream, xbp, Y, 0.5f, ob, n1);
        if (dbg) chk(a.x1, 0, D, 1.f, ob, D, 0, S, D);
        hipLaunchKernelGGL(rms_rows, dim3(S), dim3(256), 0, stream, ob, a.mix_norm, xn);
        gemm(xn, D, a.w_in, INW, U, INW, S, INW, D, stream);
        hipLaunchKernelGGL(glu_k, dim3((unsigned)((n1 + EB - 1) / EB)), dim3(EB), 0, stream, U, z, S);
        if (dbg) chk(a.z, 1, D, 1.f, z, D, 0, S, D);
        hipLaunchKernelGGL(qknorm_k, dim3(S * (HQ + HKV) / 4), dim3(256), 0, stream, U, a.q_norm, a.k_norm, qn, kn);
        if (dbg) { chk(a.q, 1, D, 1.f / (0.125f * 1.4426950408889634f), qn, D, 0, S, D);
                   chk(a.k, 1, 256, 1.f, kn, 256, 0, S, 256);
                   chk(a.v, 1, 256, 1.f, U + 3328, INW, 0, S, 256);
                   chk(a.gc, 1, D, 1.f, U + 3584, INW, 1, S, D);
                   chk(a.ga, 1, D, 1.f, U + 4608, INW, 1, S, D); }
        hipLaunchKernelGGL(conv_k, dim3((unsigned)((n1 + EB - 1) / EB)), dim3(EB), 0, stream, z, a.conv_w, a.conv_b, cy);
        hipLaunchKernelGGL(ln_silu_k, dim3(S), dim3(256), 0, stream, cy, a.ln_g, a.ln_b, cv);
        if (dbg) chk(a.c, 1, D, 1.f, cv, D, 0, S, D);
        gemm(cv, D, a.conv_proj, D, av, D, S, D, D, stream);
        hipLaunchKernelGGL(attn_k, dim3(S * HQ / 4), dim3(256), 0, stream, qn, kn, U, a.sinks, a.rel_bias, ao);
        if (dbg) chk(a.o, 1, D, 1.f, ao, D, 0, S, D);
        gemm(ao, D, a.attn_wo, D, bv, D, S, D, D, stream);
        hipLaunchKernelGGL(merge_k, dim3((unsigned)((n1 + EB - 1) / EB)), dim3(EB), 0, stream, U, av, bv, mg, S);
        if (dbg) chk(a.mg, 1, D, 1.f, mg, D, 0, S, D);
        gemm(mg, D, a.w_out, D, Y, D, S, D, D, stream);
        hipLaunchKernelGGL(resid_k, dim3((unsigned)((n1 + EB - 1) / EB)), dim3(EB), 0, stream, ob, Y, 1.0f, ob, n1);
        if (dbg) chk(a.x2, 0, D, 1.f, ob, D, 0, S, D);
        hipLaunchKernelGGL(rms_rows, dim3(S), dim3(256), 0, stream, ob, a.ffn2_norm, xn);
        gemm(xn, D, a.ffn2_w_in, 2 * FF, U, 2 * FF, S, 2 * FF, D, stream);
        hipLaunchKernelGGL(swiglu_k, dim3((unsigned)(((size_t)S * FF + EB - 1) / EB)), dim3(EB), 0, stream, U, Hh, S);
        if (dbg) chk(a.H2, 1, FF, 1.f, Hh, FF, 0, S, FF);
        gemm(Hh, FF, a.ffn2_w_out, D, Y, D, S, D, FF, stream);
        hipLaunchKernelGGL(resid_k, dim3((unsigned)((n1 + EB - 1) / EB)), dim3(EB), 0, stream, ob, Y, 0.5f, ob, n1);
        if (dbg) chk(a.out, 0, D, 1.f, ob, D, 0, S, D);
    }
    hipLaunchKernelGGL(decide_k, dim3(1), dim3(64), 0, stream, slots, hc, DBG_TOL, code);
    const size_t nall = (size_t)B * S * D;
    hipLaunchKernelGGL(finish_k, dim3((unsigned)((nall + 255) / 256)), dim3(256), 0, stream, out, a.out, (size_t)DBG_B * S * D, (size_t)S * D, nall, code);
#endif
}
```

```cpp
#include <hip/hip_runtime.h>
#include <cstdio>
#include <cstdint>
#ifndef DEBUG_ORACLE
#define DEBUG_ORACLE 0
#endif
namespace pg8 {
#define PG8_LAS __attribute__((address_space(3)))
typedef unsigned short bf16_t;
typedef short bf16x8 __attribute__((ext_vector_type(8)));
typedef float f32x4 __attribute__((ext_vector_type(4)));
typedef unsigned u32x4 __attribute__((ext_vector_type(4)));
constexpr int BM = 256, BK = 64, HALF = 128, HTB = HALF * BK * 2  , STAGE_BYTES = 8 * HTB, NXCD = 8, WGM = 8;

__host__ __device__ __forceinline__ int lds_byte(int r, int c) { const int st = (r >> 4) * 2 + (c >> 5), rr = r & 15, cc = c & 31, ob = rr * 64 + cc * 2; return st * 1024 + (ob ^ (((ob >> 9) & 1) << 5)); }
__host__ __device__ __forceinline__ void stage_rc(int b, int& R, int& C) { const int st = b / 1024, sb = b % 1024, swz = sb ^ (((sb >> 9) & 1) << 5); R = (st >> 1) * 16 + swz / 64; C = (st & 1) * 32 + (swz % 64) / 2; }
__host__ __device__ __forceinline__ int perm32(int rho) { const int n = rho >> 4, i = rho & 15; return 8 * (i >> 2) + 4 * n + (i & 3); }

struct Unit { int pm, pn; };
struct Gemm { const bf16_t* A; const bf16_t* Bt; int M, N, K; const bf16_t* A2; const bf16_t* Bt2; };

struct StaticOrder {
    int nM, nN, nwg, G, c;
    __host__ __device__ void init(int M, int N, int G_, int c_) { nM = M / BM; nN = N / BM; nwg = nM * nN; G = G_; c = c_; }
    __host__ __device__ bool next(int i, Unit& u) const {
        const long L = (long)i * G + c; if (L >= nwg) return false;
        int wgid = (int)L; { const int q = nwg / NXCD, r = nwg % NXCD, xcd = wgid % NXCD, off = wgid / NXCD; wgid = (xcd < r ? xcd * (q + 1) : r * (q + 1) + (xcd - r) * q) + off; }
        const int nig = WGM * nN, gid = wgid / nig, fm = gid * WGM, gsz = (nM - fm) < WGM ? (nM - fm) : WGM;
        u.pm = fm + ((wgid % nig) % gsz); u.pn = (wgid % nig) / gsz; return true;
    }
    __device__ __forceinline__ void a_ready(const Unit&) const {}
    __device__ __forceinline__ void done(const Unit&) const {}
};

constexpr float RMS_EPS = 1e-6f;
constexpr float LOG2E = 1.4426950408889634f;
typedef float f32x2 __attribute__((ext_vector_type(2)));
typedef __bf16 bf16x2_t __attribute__((ext_vector_type(2)));
__device__ __forceinline__ unsigned cvt_pk_bf16(float lo, float hi) { f32x2 v = {lo, hi}; bf16x2_t b = __builtin_convertvector(v, bf16x2_t); return __builtin_bit_cast(unsigned, b); }
__device__ __forceinline__ u32x4 pack8(const f32x4 a, const f32x4 b) { u32x4 w; w.x = cvt_pk_bf16(a[0], a[1]); w.y = cvt_pk_bf16(a[2], a[3]); w.z = cvt_pk_bf16(b[0], b[1]); w.w = cvt_pk_bf16(b[2], b[3]); return w; }
__device__ __forceinline__ void unpack8(const u32x4 w, f32x4& a, f32x4& b) {
    a[0] = __uint_as_float(w.x << 16); a[1] = __uint_as_float(w.x & 0xffff0000u); a[2] = __uint_as_float(w.y << 16); a[3] = __uint_as_float(w.y & 0xffff0000u);
    b[0] = __uint_as_float(w.z << 16); b[1] = __uint_as_float(w.z & 0xffff0000u); b[2] = __uint_as_float(w.w << 16); b[3] = __uint_as_float(w.w & 0xffff0000u); }
__device__ __forceinline__ float fast_sigmoid(float v) { return __builtin_amdgcn_rcpf(1.0f + __builtin_amdgcn_exp2f(-LOG2E * v)); }
__device__ __forceinline__ f32x4 sigmoid4(const f32x4 v) { f32x4 o; o[0] = fast_sigmoid(v[0]); o[1] = fast_sigmoid(v[1]); o[2] = fast_sigmoid(v[2]); o[3] = fast_sigmoid(v[3]); return o; }
__device__ __forceinline__ float dot4(const f32x4 v) { return (v[0] * v[0] + v[1] * v[1]) + (v[2] * v[2] + v[3] * v[3]); }

struct EpiSwiglu {
    static constexpr bool PERM = true, AFTER_DRAIN = false;
    bf16_t* H; int ldh; const float* ssq;
    __device__ __forceinline__ void operator()(const f32x4 (&acc)[2][2][4][2], const Unit& u, int wr, int wc, int fr, int fq) const {
        const int row0 = u.pm * BM + wr * 64 + fr, col0 = u.pn * HALF + wc * 32 + 8 * fq;
        float rs[2][4];
#pragma unroll
        for (int ai = 0; ai < 2; ++ai)
#pragma unroll
            for (int m = 0; m < 4; ++m) rs[ai][m] = ssq[row0 + ai * HALF + m * 16];
#pragma unroll
        for (int ai = 0; ai < 2; ++ai)
#pragma unroll
            for (int m = 0; m < 4; ++m) {
                const float r = __builtin_amdgcn_rsqf(rs[ai][m] * (1.0f / 1024.0f) + RMS_EPS);
                f32x4 h[2];
#pragma unroll
                for (int n = 0; n < 2; ++n) { const f32x4 a = acc[ai][0][m][n] * r, b = acc[ai][1][m][n] * r; h[n] = a * sigmoid4(a) * b; }
                *(u32x4*)(H + (size_t)(row0 + ai * HALF + m * 16) * ldh + col0) = pack8(h[0], h[1]);
            }
    }
};

template <int MODE> struct EpiProbe {
    static constexpr bool PERM = true, AFTER_DRAIN = false;
    bf16_t* H; int ldh; const float* ssq;
    __device__ __forceinline__ void operator()(const f32x4 (&acc)[2][2][4][2], const Unit& u, int wr, int wc, int fr, int fq) const {
        const int row0 = u.pm * BM + wr * 64 + fr, col0 = u.pn * HALF + wc * 32 + 8 * fq;
#pragma unroll
        for (int ai = 0; ai < 2; ++ai)
#pragma unroll
            for (int m = 0; m < 4; ++m) {
                if (MODE == 0) { asm volatile("" :: "v"(acc[ai][0][m][0]), "v"(acc[ai][0][m][1]), "v"(acc[ai][1][m][0]), "v"(acc[ai][1][m][1])); }
                else { *(u32x4*)(H + (size_t)(row0 + ai * HALF + m * 16) * ldh + col0) = pack8(acc[ai][0][m][0] + acc[ai][1][m][0], acc[ai][0][m][1] + acc[ai][1][m][1]); }
            }
    }
};

template <bool WANT_XB, bool HALF_SCALE> struct EpiResid {
    static constexpr bool PERM = true, AFTER_DRAIN = false;
    const float* res; float* out; int ld; bf16_t* xb; float* ssq_out;
    __device__ __forceinline__ void operator()(const f32x4 (&acc)[2][2][4][2], const Unit& u, int wr, int wc, int fr, int fq) const {
        const int row0 = u.pm * BM + wr * 64 + fr, col0 = u.pn * BM + wc * 32 + 8 * fq;
        constexpr float scale = HALF_SCALE ? 0.5f : 1.0f;
#pragma unroll
        for (int ai = 0; ai < 2; ++ai)
#pragma unroll
            for (int m = 0; m < 4; ++m) {
                const size_t off = (size_t)(row0 + ai * HALF + m * 16) * ld + col0;
                float ss = 0.f;
#pragma unroll
                for (int bj = 0; bj < 2; ++bj) {
                    const f32x4 r0 = *(const f32x4*)(res + off + bj * HALF), r1 = *(const f32x4*)(res + off + bj * HALF + 4);
                    const f32x4 v0 = r0 + acc[ai][bj][m][0] * scale, v1 = r1 + acc[ai][bj][m][1] * scale;
                    *(f32x4*)(out + off + bj * HALF) = v0; *(f32x4*)(out + off + bj * HALF + 4) = v1;
                    if (WANT_XB) { *(u32x4*)(xb + off + bj * HALF) = pack8(v0, v1); ss += dot4(v0) + dot4(v1); }
                }
                if (WANT_XB) { ss += __shfl_xor(ss, 16); ss += __shfl_xor(ss, 32); if (fq == 0) atomicAdd(ssq_out + row0 + ai * HALF + m * 16, ss); }
                if (m & 1) asm volatile("" ::: "memory");
            }
    }
};

struct EpiMix {
    static constexpr bool PERM = true, AFTER_DRAIN = false;
    const float* ssq; bf16_t *z, *q, *k, *v, *gc, *ga; const float *qg, *kg;
    __device__ __forceinline__ void operator()(const f32x4 (&acc)[2][2][4][2], const Unit& u, int wr, int wc, int fr, int fq) const {
        const int row0 = u.pm * BM + wr * 64 + fr, pn = u.pn;
        float rs[2][4];
#pragma unroll
        for (int ai = 0; ai < 2; ++ai)
#pragma unroll
            for (int m = 0; m < 4; ++m) rs[ai][m] = ssq[row0 + ai * HALF + m * 16];
#pragma unroll
        for (int ai = 0; ai < 2; ++ai)
#pragma unroll
            for (int m = 0; m < 4; ++m) rs[ai][m] = __builtin_amdgcn_rsqf(rs[ai][m] * (1.0f / 1024.0f) + RMS_EPS);
        if (pn < 8) {
            const int col0 = pn * HALF + wc * 32 + 8 * fq;
#pragma unroll
            for (int ai = 0; ai < 2; ++ai)
#pragma unroll
                for (int m = 0; m < 4; ++m) {
                    const float r = rs[ai][m]; f32x4 h[2];
#pragma unroll
                    for (int n = 0; n < 2; ++n) { const f32x4 a = acc[ai][0][m][n] * r, g = acc[ai][1][m][n] * r; h[n] = a * sigmoid4(g); }
                    *(u32x4*)(z + (size_t)(row0 + ai * HALF + m * 16) * 1024 + col0) = pack8(h[0], h[1]);
                }
        } else if (pn < 13) {
            const bool isq = pn < 12;
            const float* gp = isq ? qg : kg; const float gs = isq ? 0.125f * LOG2E : 1.0f;
            bf16_t* ob = isq ? q : k; const int ld = isq ? 1024 : 256, head = isq ? 4 * (pn - 8) + wc : wc;
            f32x4 gv[2][2];
#pragma unroll
            for (int bj = 0; bj < 2; ++bj)
#pragma unroll
                for (int n = 0; n < 2; ++n) gv[bj][n] = *(const f32x4*)(gp + 32 * bj + 8 * fq + 4 * n) * gs;
#pragma unroll
            for (int ai = 0; ai < 2; ++ai)
#pragma unroll
                for (int m = 0; m < 4; ++m) {
                    const float r = rs[ai][m]; f32x4 y[2][2]; float ss = 0.f;
#pragma unroll
                    for (int bj = 0; bj < 2; ++bj)
#pragma unroll
                        for (int n = 0; n < 2; ++n) { y[bj][n] = acc[ai][bj][m][n] * r; ss += dot4(y[bj][n]); }
                    ss += __shfl_xor(ss, 16); ss += __shfl_xor(ss, 32);
                    const float rh = __builtin_amdgcn_rsqf(ss * (1.0f / 64.0f) + RMS_EPS);
                    bf16_t* rowp = ob + (size_t)(row0 + ai * HALF + m * 16) * ld + 64 * head + 8 * fq;
#pragma unroll
                    for (int bj = 0; bj < 2; ++bj) *(u32x4*)(rowp + 32 * bj) = pack8(y[bj][0] * rh * gv[bj][0], y[bj][1] * rh * gv[bj][1]);
                }
        } else if (pn == 13) {
            const int col0 = wc * 32 + 8 * fq;
#pragma unroll
            for (int ai = 0; ai < 2; ++ai)
#pragma unroll
                for (int m = 0; m < 4; ++m) {
                    const float r = rs[ai][m]; bf16_t* rowp = v + (size_t)(row0 + ai * HALF + m * 16) * 256 + col0;
#pragma unroll
                    for (int bj = 0; bj < 2; ++bj) *(u32x4*)(rowp + bj * HALF) = pack8(acc[ai][bj][m][0] * r, acc[ai][bj][m][1] * r);
                }
        } else {
            const int col0 = (pn - 14) * HALF + wc * 32 + 8 * fq;
#pragma unroll
            for (int ai = 0; ai < 2; ++ai)
#pragma unroll
                for (int m = 0; m < 4; ++m) {
                    const float r = rs[ai][m]; f32x4 rtv[2], sav[2];
#pragma unroll
                    for (int n = 0; n < 2; ++n) {
                        const f32x4 gc_ = acc[ai][0][m][n] * r, ga_ = acc[ai][1][m][n] * r;
#pragma unroll
                        for (int j = 0; j < 4; ++j) {
                            const float ec = __builtin_amdgcn_exp2f(-LOG2E * gc_[j]), ea = __builtin_amdgcn_exp2f(-LOG2E * ga_[j]);
                            sav[n][j] = __builtin_amdgcn_rcpf(1.0f + ea); rtv[n][j] = (1.0f + ea) * __builtin_amdgcn_rcpf(1.0f + ec);
                        }
                    }
                    const size_t off = (size_t)(row0 + ai * HALF + m * 16) * 1024 + col0;
                    *(u32x4*)(gc + off) = pack8(rtv[0], rtv[1]); *(u32x4*)(ga + off) = pack8(sav[0], sav[1]);
                }
        }
    }
};

struct EpiMerge {
    static constexpr bool PERM = true, AFTER_DRAIN = false;
    const bf16_t* rt; const bf16_t* sa; bf16_t* O;
    __device__ __forceinline__ void mid(f32x4 (&acc)[2][2][4][2], const Unit& u, int wr, int wc, int fr, int fq) const {
        const int row0 = u.pm * BM + wr * 64 + fr, col0 = u.pn * BM + wc * 32 + 8 * fq;
#pragma unroll
        for (int ai = 0; ai < 2; ++ai)
#pragma unroll
            for (int m = 0; m < 4; ++m) {
                const size_t off = (size_t)(row0 + ai * HALF + m * 16) * 1024 + col0;
#pragma unroll
                for (int bj = 0; bj < 2; ++bj) { f32x4 g0, g1; unpack8(*(const u32x4*)(rt + off + bj * HALF), g0, g1); acc[ai][bj][m][0] *= g0; acc[ai][bj][m][1] *= g1; }
                if (m & 1) asm volatile("" ::: "memory");
            }
    }
    __device__ __forceinline__ void operator()(const f32x4 (&acc)[2][2][4][2], const Unit& u, int wr, int wc, int fr, int fq) const {
        const int row0 = u.pm * BM + wr * 64 + fr, col0 = u.pn * BM + wc * 32 + 8 * fq;
#pragma unroll
        for (int ai = 0; ai < 2; ++ai)
#pragma unroll
            for (int m = 0; m < 4; ++m) {
                const size_t off = (size_t)(row0 + ai * HALF + m * 16) * 1024 + col0;
#pragma unroll
                for (int bj = 0; bj < 2; ++bj) { f32x4 g0, g1; unpack8(*(const u32x4*)(sa + off + bj * HALF), g0, g1); *(u32x4*)(O + off + bj * HALF) = pack8(g0 * acc[ai][bj][m][0], g1 * acc[ai][bj][m][1]); }
                if (m & 1) asm volatile("" ::: "memory");
            }
    }
};

template <class Epi, class Sched, bool ALIGN_EPI = false, bool SP2 = false, int NSEG = 1>
__device__ __forceinline__ void gemm_phase(PG8_LAS unsigned char* lds, const Gemm g, const Sched S, const Epi E) {
    int tid_ = threadIdx.x; asm volatile("" : "+v"(tid_));
    const int tid = tid_, wid = __builtin_amdgcn_readfirstlane(tid >> 6), lane = tid & 63, wr = wid >> 2, wc = wid & 3, fr = lane & 15, fq = lane >> 4;
    const int K = g.K, mt = K / BK, nt = NSEG * mt;
    unsigned voffA[2], voffB[2];
#pragma unroll
    for (int i = 0; i < 2; ++i) { int R, C; stage_rc(tid * 16 + i * 8192, R, C); const int Rb = Epi::PERM ? ((R & ~31) + perm32(R & 31)) : R;
        voffA[i] = (unsigned)(R * K + C) * 2u; voffB[i] = (unsigned)(Rb * K + C) * 2u; }
    const size_t kstep = (size_t)(BK * 2);
    const size_t hstep = (size_t)HALF * K * 2;
    const size_t tstep = 2 * hstep;
    const unsigned ldsw = (unsigned)wid * 1024u;
    const int aoff = lds_byte(wr * 64 + fr, fq * 8), boff = lds_byte(wc * 32 + fr, fq * 8);
#define PG8_SA(b, h) (((b) * 2 + (h)) * HTB)
#define PG8_SB(b, h) ((4 + (b) * 2 + (h)) * HTB)
#define PG8_STAGE(bufoff, gbase, voff) do { _Pragma("unroll") for (int _i = 0; _i < 2; ++_i) \
        __builtin_amdgcn_global_load_lds((const unsigned*)((const char*)(gbase) + (voff)[_i]), (PG8_LAS unsigned*)(lds + (bufoff) + ldsw + _i * 8192), 16, 0, 0); } while (0)
#define PG8_LDA(dst, b, h) do { _Pragma("unroll") for (int m = 0; m < 4; ++m) _Pragma("unroll") for (int k = 0; k < 2; ++k) dst[m][k] = *(const PG8_LAS bf16x8*)(lds + PG8_SA(b, h) + aoff + m * 2048 + k * 1024); } while (0)
#define PG8_LDB(dst, b, h) do { _Pragma("unroll") for (int n = 0; n < 2; ++n) _Pragma("unroll") for (int k = 0; k < 2; ++k) dst[n][k] = *(const PG8_LAS bf16x8*)(lds + PG8_SB(b, h) + boff + n * 2048 + k * 1024); } while (0)
#define PG8_MMA(ai, bj, At, Bt) do { __builtin_amdgcn_s_setprio(1); _Pragma("unroll") for (int m = 0; m < 4; ++m) _Pragma("unroll") for (int n = 0; n < 2; ++n) _Pragma("unroll") for (int k = 0; k < 2; ++k) \
        acc[ai][bj][m][n] = __builtin_amdgcn_mfma_f32_16x16x32_bf16(Bt[n][k], At[m][k], acc[ai][bj][m][n], 0, 0, 0); __builtin_amdgcn_s_setprio(0); } while (0)
#define PG8_WAIT_V(n) asm volatile("s_waitcnt vmcnt(" #n ")" ::: "memory")
#define PG8_WAIT_L(n) asm volatile("s_waitcnt lgkmcnt(" #n ")" ::: "memory")
#define PG8_BAR __builtin_amdgcn_s_barrier()
#define PG8_SCHED __builtin_amdgcn_sched_barrier(0)
    Unit cur, nxt; int ui = 0;
    if (!S.next(0, cur)) return;
    f32x4 acc[2][2][4][2];
#pragma unroll
    for (int a = 0; a < 2; ++a)
#pragma unroll
        for (int b = 0; b < 2; ++b)
#pragma unroll
            for (int m = 0; m < 4; ++m)
#pragma unroll
                for (int n = 0; n < 2; ++n) acc[a][b][m][n] = (f32x4){0.f, 0.f, 0.f, 0.f};
    bf16x8 At[4][2], B0[2][2], B1[2][2];
    const char* cA = (const char*)g.A + (size_t)cur.pm * tstep; const char* cB = (const char*)g.Bt + (size_t)cur.pn * tstep;
    const char* cA2 = (NSEG == 2) ? (const char*)g.A2 + (size_t)cur.pm * tstep : cA; const char* cB2 = (NSEG == 2) ? (const char*)g.Bt2 + (size_t)cur.pn * tstep : cB;
    S.a_ready(cur);
    if constexpr (SP2) {
        PG8_STAGE(PG8_SB(0, 0), cB, voffB); PG8_STAGE(PG8_SB(0, 1), cB + hstep, voffB); PG8_STAGE(PG8_SA(0, 0), cA, voffA); PG8_STAGE(PG8_SA(0, 1), cA + hstep, voffA);
        if (wr == 1) PG8_BAR;
        PG8_WAIT_V(2); PG8_BAR;
        PG8_STAGE(PG8_SB(1, 0), cB + kstep, voffB); PG8_STAGE(PG8_SA(1, 0), cA + kstep, voffA); PG8_STAGE(PG8_SB(1, 1), cB + hstep + kstep, voffB);
        PG8_WAIT_V(6); PG8_BAR;
    } else {
        PG8_STAGE(PG8_SB(0, 0), cB, voffB); PG8_STAGE(PG8_SA(0, 0), cA, voffA); PG8_STAGE(PG8_SB(0, 1), cB + hstep, voffB); PG8_STAGE(PG8_SA(0, 1), cA + hstep, voffA);
        if (wr == 1) PG8_BAR;
        PG8_WAIT_V(4); PG8_BAR;
        PG8_STAGE(PG8_SB(1, 0), cB + kstep, voffB); PG8_STAGE(PG8_SA(1, 0), cA + kstep, voffA); PG8_STAGE(PG8_SB(1, 1), cB + hstep + kstep, voffB);
        PG8_WAIT_V(6); PG8_BAR;
    }
    for (;;) {
        const bool has_next = S.next(ui + 1, nxt);
        const char* nA = has_next ? (const char*)g.A + (size_t)nxt.pm * tstep : cA; const char* nB = has_next ? (const char*)g.Bt + (size_t)nxt.pn * tstep : cB;
        const char* nA2 = (NSEG == 2 && has_next) ? (const char*)g.A2 + (size_t)nxt.pm * tstep : cA2; const char* nB2 = (NSEG == 2 && has_next) ? (const char*)g.Bt2 + (size_t)nxt.pn * tstep : cB2;
        for (int t = 0; t < nt; t += 2) {
            const bool last = (t == nt - 2);
            if constexpr (NSEG == 2) { if (t == mt) E.mid(acc, cur, wr, wc, fr, fq); }
            const bool s1 = (NSEG == 2) && (t + 1 >= mt), s2 = (NSEG == 2) && (t + 2 >= mt);
            const char* a1 = s1 ? cA2 + (size_t)(t + 1 - mt) * kstep : cA + (size_t)(t + 1) * kstep;
            const char* a2 = last ? nA : (s2 ? cA2 + (size_t)(t + 2 - mt) * kstep : cA + (size_t)(t + 2) * kstep);
            const char* b2 = last ? nB : (s2 ? cB2 + (size_t)(t + 2 - mt) * kstep : cB + (size_t)(t + 2) * kstep);
            const char* a3 = a2 + kstep; const char* b3 = b2 + kstep;
            if (last && has_next) S.a_ready(nxt);
            if constexpr (SP2) {
            PG8_LDB(B0, 0, 0); PG8_LDB(B1, 0, 1); PG8_SCHED; PG8_LDA(At, 0, 0); PG8_STAGE(PG8_SA(1, 1), a1 + hstep, voffA);
            PG8_WAIT_V(8); PG8_WAIT_L(0); PG8_BAR; PG8_MMA(0, 0, At, B0); PG8_MMA(0, 1, At, B1); PG8_BAR; PG8_SCHED;
            PG8_LDA(At, 0, 1); PG8_STAGE(PG8_SB(0, 0), b2, voffB); PG8_STAGE(PG8_SB(0, 1), b2 + hstep, voffB); PG8_STAGE(PG8_SA(0, 0), a2, voffA);
            PG8_WAIT_V(8); PG8_WAIT_L(0); PG8_BAR; PG8_MMA(1, 0, At, B0); PG8_MMA(1, 1, At, B1); PG8_BAR; PG8_SCHED;
            PG8_LDB(B0, 1, 0); PG8_LDB(B1, 1, 1); PG8_SCHED; PG8_LDA(At, 1, 0); PG8_STAGE(PG8_SA(0, 1), a2 + hstep, voffA);
            PG8_WAIT_V(8); PG8_WAIT_L(0); PG8_BAR; PG8_MMA(0, 0, At, B0); PG8_MMA(0, 1, At, B1); PG8_BAR; PG8_SCHED;
            PG8_LDA(At, 1, 1); PG8_STAGE(PG8_SB(1, 0), b3, voffB); PG8_STAGE(PG8_SB(1, 1), b3 + hstep, voffB); PG8_STAGE(PG8_SA(1, 0), a3, voffA);
            PG8_WAIT_V(8); PG8_WAIT_L(0); PG8_BAR; PG8_MMA(1, 0, At, B0); PG8_MMA(1, 1, At, B1); PG8_BAR; PG8_SCHED;
            } else {
            PG8_LDB(B0, 0, 0); PG8_SCHED; PG8_LDA(At, 0, 0); PG8_STAGE(PG8_SA(1, 1), a1 + hstep, voffA);
            PG8_WAIT_L(8); PG8_BAR; PG8_WAIT_L(0); PG8_MMA(0, 0, At, B0); PG8_BAR; PG8_SCHED;
            PG8_LDB(B1, 0, 1); PG8_STAGE(PG8_SB(0, 0), b2, voffB);
            PG8_BAR; PG8_WAIT_L(0); PG8_MMA(0, 1, At, B1); PG8_BAR;
            PG8_LDA(At, 0, 1); PG8_STAGE(PG8_SA(0, 0), a2, voffA);
            PG8_BAR; PG8_WAIT_L(0); PG8_MMA(1, 0, At, B0); PG8_BAR; PG8_SCHED;
            PG8_STAGE(PG8_SB(0, 1), b2 + hstep, voffB);
            PG8_WAIT_V(6); PG8_BAR; PG8_MMA(1, 1, At, B1); PG8_BAR;
            PG8_LDB(B0, 1, 0); PG8_SCHED; PG8_LDA(At, 1, 0); PG8_STAGE(PG8_SA(0, 1), a2 + hstep, voffA);
            PG8_WAIT_L(8); PG8_BAR; PG8_WAIT_L(0); PG8_MMA(0, 0, At, B0); PG8_BAR; PG8_SCHED;
            PG8_LDB(B1, 1, 1); PG8_STAGE(PG8_SB(1, 0), b3, voffB);
            PG8_BAR; PG8_WAIT_L(0); PG8_MMA(0, 1, At, B1); PG8_BAR;
            PG8_LDA(At, 1, 1); PG8_STAGE(PG8_SA(1, 0), a3, voffA);
            PG8_BAR; PG8_WAIT_L(0); PG8_MMA(1, 0, At, B0); PG8_BAR; PG8_SCHED;
            PG8_STAGE(PG8_SB(1, 1), b3 + hstep, voffB);
            PG8_WAIT_V(6); PG8_BAR; PG8_MMA(1, 1, At, B1); PG8_BAR;
            }
        }
        if constexpr (ALIGN_EPI) { if (wr == 0) PG8_BAR; }
        if constexpr (!Epi::AFTER_DRAIN) { E(acc, cur, wr, wc, fr, fq); S.done(cur); }
        if (!has_next) break;
#pragma unroll
        for (int a = 0; a < 2; ++a)
#pragma unroll
            for (int b = 0; b < 2; ++b)
#pragma unroll
                for (int m = 0; m < 4; ++m)
#pragma unroll
                    for (int n = 0; n < 2; ++n) acc[a][b][m][n] = (f32x4){0.f, 0.f, 0.f, 0.f};
        cur = nxt; cA = nA; cB = nB; cA2 = nA2; cB2 = nB2; ++ui;
        if constexpr (ALIGN_EPI) { if (wr == 1) PG8_BAR; }
    }
    PG8_WAIT_V(0);
    if constexpr (!ALIGN_EPI) { if (wr == 0) PG8_BAR; }
    PG8_BAR;
    if constexpr (Epi::AFTER_DRAIN) { E.fused(acc, cur, wr, wc, fr, fq, lds, wid, lane); S.done(cur); }
#undef PG8_SA
#undef PG8_SB
#undef PG8_STAGE
#undef PG8_LDA
#undef PG8_LDB
#undef PG8_MMA
#undef PG8_WAIT_V
#undef PG8_WAIT_L
#undef PG8_BAR
#undef PG8_SCHED
}
}
constexpr int D = 1024, NB = 8, SEQ = 4096, FF = 2816, CWID = 31, HD = 64, HQ = 16, HKV = 4, INW = 5632;
constexpr int M_FULL = NB * SEQ;
constexpr int NWAVES = 8, NTHREADS = 512;
constexpr int LDS_BYTES = 147456;
constexpr int RING_BYTES = 131072;
constexpr size_t CTL_ZERO_BYTES = 16384;

#define LAS __attribute__((address_space(3)))
typedef unsigned short bf16;
typedef unsigned v4u __attribute__((ext_vector_type(4)));
typedef unsigned v2u __attribute__((ext_vector_type(2)));
typedef float f32x4 __attribute__((ext_vector_type(4)));
typedef float f32x2 __attribute__((ext_vector_type(2)));
typedef float f32x16 __attribute__((ext_vector_type(16)));
typedef short bf16x8 __attribute__((ext_vector_type(8)));
typedef short s16x4 __attribute__((ext_vector_type(4)));

__device__ const unsigned char T5B[128] = {0, 1, 2, 3, 4, 5, 6, 7, 8, 9, 10, 11, 12, 13, 14, 15, 16, 16, 16, 17, 17, 18, 18, 18, 19, 19, 19, 20, 20, 20, 20, 21, 21, 21, 21, 22, 22, 22, 22, 22, 23, 23, 23, 23, 23, 23, 24, 24, 24, 24, 24, 24, 25, 25, 25, 25, 25, 25, 25, 26, 26, 26, 26, 26, 26, 26, 26, 27, 27, 27, 27, 27, 27, 27, 27, 27, 27, 28, 28, 28, 28, 28, 28, 28, 28, 28, 28, 29, 29, 29, 29, 29, 29, 29, 29, 29, 29, 29, 29, 30, 30, 30, 30, 30, 30, 30, 30, 30, 30, 30, 30, 30, 30, 31, 31, 31, 31, 31, 31, 31, 31, 31, 31, 31, 31, 31, 31, 31};

struct Args {
    const float *x, *ffn1_norm, *ffn1_w_in, *ffn1_w_out, *mix_norm, *w_in, *conv_w, *conv_b, *ln_g, *ln_b, *conv_proj, *q_norm, *k_norm, *sinks, *rel_bias, *attn_wo, *w_out, *ffn2_norm, *ffn2_w_in, *ffn2_w_out;
    float *x1, *x2, *out;
    unsigned* ctl;
    float* biasC;
    float *ssq0, *ssq1, *ssq2;
    bf16 *W1i, *W1o, *Wmx, *Wcp, *Wao, *Wot, *W2i, *W2o;
    bf16 *xb, *H, *H2, *z, *q, *k, *v, *gc, *ga, *c, *o, *m1, *mg;
    int M; int pad;
};

__device__ __forceinline__ unsigned f2bf(float f) { unsigned u = __builtin_bit_cast(unsigned, f); return (u + 0x7fffu + ((u >> 16) & 1u)) >> 16; }
__device__ __forceinline__ unsigned pk2(float lo, float hi) { return f2bf(lo) | (f2bf(hi) << 16); }
#define LDS_WAIT() asm volatile("s_waitcnt lgkmcnt(0)" ::: "memory")

__device__ __forceinline__ int src_col(int kind, int n0) {
    if (kind == 0) return n0;
    const int u = n0 >> 8, r = n0 & 255, bj = r >> 7, j = r & 127;
    if (kind == 1) return bj * FF + 128 * u + j;
    if (u < 8) return bj * 1024 + 128 * u + j;
    if (u < 12) return 2048 + 64 * (4 * (u - 8) + (j >> 5)) + 32 * bj;
    if (u == 12) return 3072 + 64 * (j >> 5) + 32 * bj;
    if (u == 13) return n0;
    return 3584 + bj * 1024 + 128 * (u - 14) + j;
}
__device__ __forceinline__ void p0_transpose_item(const float* W, int K, int Nsrc, int N, bf16* WT, const float* gain, int kind, LAS float* scr, int item, int lane) {
    const int nblk = N / 32, kb = item / nblk, nb = item % nblk, k0 = 64 * kb, n0 = 32 * nb, s0 = src_col(kind, n0);
#pragma unroll 8
    for (int i = 0; i < 32; ++i) { const int kk = 2 * i + (lane >> 5); const float g = gain ? gain[k0 + kk] : 1.0f; scr[kk * 33 + (lane & 31)] = g * W[(size_t)(k0 + kk) * Nsrc + s0 + (lane & 31)]; }
    LDS_WAIT(); asm volatile("" ::: "memory");
    const int c = lane & 7;
#pragma unroll
    for (int j = 0; j < 4; ++j) { const int n = (lane >> 3) + 8 * j; const LAS float* s = scr + (8 * c) * 33 + n;
        v4u o; o.x = pk2(s[0 * 33], s[1 * 33]); o.y = pk2(s[2 * 33], s[3 * 33]); o.z = pk2(s[4 * 33], s[5 * 33]); o.w = pk2(s[6 * 33], s[7 * 33]);
        *(v4u*)(WT + (size_t)(n0 + n) * K + k0 + 8 * c) = o; }
    LDS_WAIT(); asm volatile("" ::: "memory");
}
__device__ __forceinline__ float wave_sum(float v) {
#pragma unroll
    for (int o = 1; o < 64; o <<= 1) v += __shfl_xor(v, o);
    return v;
}
__device__ __forceinline__ void p0_prologue(const Args& A, LAS unsigned char* lds, int gw, int NGW, int lane) {
    LAS float* scr = (LAS float*)(lds + (threadIdx.x >> 6) * 16384);
    constexpr int I_IN = (D / 64) * (INW / 32), I_OUT = (FF / 64) * (D / 32), I_SQ = (D / 64) * (D / 32);
    constexpr int NITEMS = 3 * I_IN + 2 * I_OUT + 3 * I_SQ;
    for (int it = gw; it < NITEMS; it += NGW) {
        int r = it;
        if (r < I_IN) { p0_transpose_item(A.ffn1_w_in, D, 2 * FF, 2 * FF, A.W1i, A.ffn1_norm, 1, scr, r, lane); continue; } r -= I_IN;
        if (r < I_IN) { p0_transpose_item(A.w_in, D, INW, INW, A.Wmx, A.mix_norm, 2, scr, r, lane); continue; } r -= I_IN;
        if (r < I_IN) { p0_transpose_item(A.ffn2_w_in, D, 2 * FF, 2 * FF, A.W2i, A.ffn2_norm, 1, scr, r, lane); continue; } r -= I_IN;
        if (r < I_OUT) { p0_transpose_item(A.ffn1_w_out, FF, D, D, A.W1o, nullptr, 0, scr, r, lane); continue; } r -= I_OUT;
        if (r < I_OUT) { p0_transpose_item(A.ffn2_w_out, FF, D, D, A.W2o, nullptr, 0, scr, r, lane); continue; } r -= I_OUT;
        if (r < I_SQ) { p0_transpose_item(A.conv_proj, D, D, D, A.Wcp, nullptr, 0, scr, r, lane); continue; } r -= I_SQ;
        if (r < I_SQ) { p0_transpose_item(A.attn_wo, D, D, D, A.Wao, nullptr, 0, scr, r, lane); continue; } r -= I_SQ;
        p0_transpose_item(A.w_out, D, D, D, A.Wot, nullptr, 0, scr, r, lane);
    }
    for (int m = gw; m < A.M; m += NGW) {
        const f32x4* xr = (const f32x4*)(A.x + (size_t)m * D) + lane;
        f32x4 v[4]; float s = 0.f;
#pragma unroll
        for (int j = 0; j < 4; ++j) { v[j] = xr[64 * j]; s += (v[j][0] * v[j][0] + v[j][1] * v[j][1]) + (v[j][2] * v[j][2] + v[j][3] * v[j][3]); }
        s = wave_sum(s);
        v2u* o8 = (v2u*)(A.xb + (size_t)m * D) + lane;
#pragma unroll
        for (int j = 0; j < 4; ++j) { v2u w; w.x = pk2(v[j][0], v[j][1]); w.y = pk2(v[j][2], v[j][3]); o8[64 * j] = w; }
        if (lane == 0) { A.ssq0[m] = s; A.ssq1[m] = 0.f; A.ssq2[m] = 0.f; }
    }
    for (int e = gw * 64 + lane; e < HQ * 5 * 64 * 16; e += NGW * 64) {
        const int r = e & 15, ln = (e >> 4) & 63, di = (e >> 10) % 5, h = e / (5 * 1024);
        const int kk = (r & 3) + 8 * (r >> 2) + 4 * (ln >> 5), qq = ln & 31, dist = 32 * di + qq - kk;
        A.biasC[e] = (dist >= 0 && dist < 128) ? A.rel_bias[T5B[dist] * HQ + h] * pg8::LOG2E : -3.0e38f;
    }
}

__device__ __forceinline__ void conv_phase(const Args& A, LAS unsigned char* lds) {
    int tid_ = threadIdx.x; asm volatile("" : "+v"(tid_));
    const int tid = tid_, lane = tid & 63, wid = tid >> 6, c0 = 2 * tid;
    LAS float* Y = (LAS float*)lds;
    float w0[CWID], w1[CWID];
#pragma unroll
    for (int k = 0; k < CWID; ++k) { const f32x2 wv = *(const f32x2*)(A.conv_w + k * D + c0); w0[k] = wv[0]; w1[k] = wv[1]; }
    const f32x2 bias = *(const f32x2*)(A.conv_b + c0);
    const int nchunks = A.M / 128;
    for (int ch = blockIdx.x; ch < nchunks; ch += gridDim.x) {
        const int t0 = ch * 128; const bool first = (t0 % SEQ) == 0;
        float h0[32], h1[32];
#pragma unroll
        for (int i = 2; i < 32; ++i) {
            unsigned zz = 0u; if (!first) zz = *(const unsigned*)(A.z + (size_t)(t0 - 32 + i) * D + c0);
            h0[i] = __uint_as_float(zz << 16); h1[i] = __uint_as_float(zz & 0xffff0000u);
        }
        for (int tb = 0; tb < 128; tb += 32) {
            unsigned zin[32];
#pragma unroll
            for (int s = 0; s < 32; ++s) zin[s] = *(const unsigned*)(A.z + (size_t)(t0 + tb + s) * D + c0);
#pragma unroll
            for (int s = 0; s < 32; ++s) {
                h0[s] = __uint_as_float(zin[s] << 16); h1[s] = __uint_as_float(zin[s] & 0xffff0000u);
                float a0 = bias[0], a1 = bias[1];
#pragma unroll
                for (int k = 0; k < CWID; ++k) { a0 = fmaf(w0[k], h0[(s + 2 + k) & 31], a0); a1 = fmaf(w1[k], h1[(s + 2 + k) & 31], a1); }
                *(LAS f32x2*)(Y + s * D + c0) = (f32x2){a0, a1};
            }
            __syncthreads();
#pragma unroll 1
            for (int i = 0; i < 4; ++i) {
                const int s = wid * 4 + i; f32x4 y[4]; float sm = 0.f;
#pragma unroll
                for (int j = 0; j < 4; ++j) { y[j] = *(const LAS f32x4*)(Y + s * D + 4 * lane + 256 * j); sm += (y[j][0] + y[j][1]) + (y[j][2] + y[j][3]); }
                const float mu = wave_sum(sm) * (1.0f / D); float sq = 0.f;
#pragma unroll
                for (int j = 0; j < 4; ++j) { y[j] = y[j] - mu; sq += (y[j][0] * y[j][0] + y[j][1] * y[j][1]) + (y[j][2] * y[j][2] + y[j][3] * y[j][3]); }
                const float rs = __builtin_amdgcn_rsqf(wave_sum(sq) * (1.0f / D) + 1e-6f);
                bf16* orow = A.c + (size_t)(t0 + tb + s) * D;
#pragma unroll
                for (int j = 0; j < 4; ++j) {
                    const f32x4 g = *(const f32x4*)(A.ln_g + 4 * lane + 256 * j), b = *(const f32x4*)(A.ln_b + 4 * lane + 256 * j);
                    f32x4 v = y[j] * rs * g + b; v = v * pg8::sigmoid4(v);
                    v2u w; w.x = pg8::cvt_pk_bf16(v[0], v[1]); w.y = pg8::cvt_pk_bf16(v[2], v[3]);
                    *(v2u*)(orow + 4 * lane + 256 * j) = w;
                }
            }
            __syncthreads();
        }
    }
}

constexpr int ATT_K_OFF = 0, ATT_V_OFF = 32768;
__device__ __forceinline__ s16x4 vtr(const LAS unsigned char* p) { typedef short v4i16_t __attribute__((ext_vector_type(4))); return __builtin_bit_cast(s16x4, __builtin_amdgcn_ds_read_tr16_b64_v4i16((LAS v4i16_t*)p)); }
__device__ __forceinline__ void attn_phase(const Args& A, LAS unsigned char* lds) {
    int tid_ = threadIdx.x; asm volatile("" : "+v"(tid_));
    const int tid = tid_, lane = tid & 63, r32 = lane & 31, hi = lane >> 5; const int wid = __builtin_amdgcn_readfirstlane(tid >> 6);
    const int nunits = (A.M / 128) * HKV;
    for (int u = blockIdx.x; u < nunits; u += gridDim.x) {
        const int blk = u >> 2, hk = u & 3, t0 = blk * 128; const bool first = (t0 % SEQ) == 0;
#pragma unroll
        for (int i = 0; i < 4; ++i) {
            const int idx = tid + 512 * i, key = idx >> 3, cc = idx & 7;
            if (!(first && key < 128)) {
                const size_t g = (size_t)(t0 - 128 + key) * 256 + hk * 64 + cc * 8;
                const v4u kv = *(const v4u*)(A.k + g), vv = *(const v4u*)(A.v + g);
                *(LAS v4u*)(lds + ATT_K_OFF + (((key >> 5) * 4 + (cc >> 1)) * 2 + (cc & 1)) * 512 + (key & 31) * 16) = kv;
                *(LAS v4u*)(lds + ATT_V_OFF + ((key >> 2) * 2 + (cc >> 2)) * 256 + (key & 3) * 64 + (cc & 3) * 16) = vv;
            }
        }
        __syncthreads();
#pragma unroll 1
        for (int ti = 0; ti < 2; ++ti) {
            const int task = wid + 8 * ti, g = task >> 2, sub = task & 3, h = hk * 4 + g;
            const size_t qrow = (size_t)(t0 + 32 * sub + r32) * D + h * HD;
            bf16x8 qf[4];
#pragma unroll
            for (int d0 = 0; d0 < 4; ++d0) qf[d0] = *(const bf16x8*)(A.q + qrow + 16 * d0 + 8 * hi);
            f32x16 s[5];
            const float* bc = A.biasC + ((size_t)h * 5 * 64 + lane) * 16;
#pragma unroll
            for (int di = 0; di < 5; ++di) {
                const f32x4* bp = (const f32x4*)(bc + di * 1024);
#pragma unroll
                for (int j = 0; j < 4; ++j) { const f32x4 t = bp[j]; s[di][4 * j] = t[0]; s[di][4 * j + 1] = t[1]; s[di][4 * j + 2] = t[2]; s[di][4 * j + 3] = t[3]; }
            }
            const float sink2 = A.sinks[h] * pg8::LOG2E;
            float mx = sink2;
#pragma unroll
            for (int di = 0; di < 5; ++di) {
                const int kt = sub + 4 - di;
                if (!(first && kt < 4)) {
#pragma unroll
                    for (int d0 = 0; d0 < 4; ++d0) {
                        const bf16x8 kf = *(const LAS bf16x8*)(lds + ATT_K_OFF + ((kt * 4 + d0) * 2 + hi) * 512 + r32 * 16);
                        s[di] = __builtin_amdgcn_mfma_f32_32x32x16_bf16(kf, qf[d0], s[di], 0, 0, 0);
                    }
#pragma unroll
                    for (int r = 0; r < 16; ++r) mx = fmaxf(mx, s[di][r]);
                }
            }
            mx = fmaxf(mx, __shfl_xor(mx, 32));
            float l = 0.f;
            f32x16 o0, o1;
#pragma unroll
            for (int r = 0; r < 16; ++r) { o0[r] = 0.f; o1[r] = 0.f; }
#pragma unroll
            for (int di = 0; di < 5; ++di) {
                const int kt = sub + 4 - di;
                if (!(first && kt < 4)) {
#pragma unroll
                    for (int r = 0; r < 16; ++r) { s[di][r] = __builtin_amdgcn_exp2f(s[di][r] - mx); l += s[di][r]; }
#pragma unroll
                    for (int s2 = 0; s2 < 2; ++s2) {
                        v4u pw; pw.x = pg8::cvt_pk_bf16(s[di][8 * s2 + 0], s[di][8 * s2 + 1]); pw.y = pg8::cvt_pk_bf16(s[di][8 * s2 + 2], s[di][8 * s2 + 3]);
                        pw.z = pg8::cvt_pk_bf16(s[di][8 * s2 + 4], s[di][8 * s2 + 5]); pw.w = pg8::cvt_pk_bf16(s[di][8 * s2 + 6], s[di][8 * s2 + 7]);
                        const bf16x8 pa = __builtin_bit_cast(bf16x8, pw);
                        const LAS unsigned char* vp = lds + ATT_V_OFF + ((8 * kt + 4 * s2 + hi) * 2) * 256 + ((lane & 15) >> 2) * 64 + (((lane >> 4) & 1) * 16 + (lane & 3) * 4) * 2;
                        const s16x4 a0 = vtr(vp), a1 = vtr(vp + 2 * 512), b0 = vtr(vp + 256), b1 = vtr(vp + 256 + 2 * 512);
                        const bf16x8 v0 = (bf16x8){a0[0], a0[1], a0[2], a0[3], a1[0], a1[1], a1[2], a1[3]};
                        const bf16x8 v1 = (bf16x8){b0[0], b0[1], b0[2], b0[3], b1[0], b1[1], b1[2], b1[3]};
                        o0 = __builtin_amdgcn_mfma_f32_32x32x16_bf16(pa, v0, o0, 0, 0, 0);
                        o1 = __builtin_amdgcn_mfma_f32_32x32x16_bf16(pa, v1, o1, 0, 0, 0);
                    }
                }
            }
            l += __shfl_xor(l, 32);
            l += __builtin_amdgcn_exp2f(sink2 - mx);
            const float linv = __builtin_amdgcn_rcpf(l);
            bf16* ob = A.o + (size_t)(t0 + 32 * sub) * D + h * HD + r32;
#pragma unroll
            for (int r = 0; r < 16; ++r) {
                const int qq = (r & 3) + 8 * (r >> 2) + 4 * hi;
                const float li = __shfl(linv, qq);
                ob[(size_t)qq * D] = (bf16)f2bf(o0[r] * li);
                ob[(size_t)qq * D + 32] = (bf16)f2bf(o1[r] * li);
            }
        }
        __syncthreads();
    }
}
typedef unsigned gu32_t;
#define XB_TMO      128
#define XB_XCNT(j)  (256  + 64 * (j))
#define XB_XSUB(j)  (1280 + 64 * (j))
#define XB_XGEN(j)  (2304 + 64 * (j))
#define XB_TOP      3328
#define XB_TOPGEN   3392
#define XCD_BAR_WORDS 3456
#define XB_SPIN_CAP (1u << 18)

__device__ __forceinline__ unsigned xb_ld(unsigned* p)              { return __hip_atomic_load(p, __ATOMIC_RELAXED, __HIP_MEMORY_SCOPE_AGENT); }
__device__ __forceinline__ unsigned xb_add(unsigned* p, unsigned v) { return __hip_atomic_fetch_add(p, v, __ATOMIC_RELAXED, __HIP_MEMORY_SCOPE_AGENT); }
__device__ __forceinline__ unsigned xb_xcc_id() { return (unsigned)__builtin_amdgcn_s_getreg((3 << 11) | 20) & 0xFu; }
#define XB_SPIN(cond, bar) do { unsigned _sp = 0; while (cond) { __builtin_amdgcn_s_sleep(1); \
    if ((++_sp & 255u) == 0u) { if (xb_ld(&(bar)[XB_TMO])) break; if (_sp > XB_SPIN_CAP) { atomicAdd(&(bar)[XB_TMO], 1u); break; } } } } while (0)

struct XcdBarrier {
    unsigned* bar; unsigned x;
    volatile LAS unsigned* st;
};

__device__ __forceinline__ XcdBarrier xcd_barrier_post(unsigned* bar, volatile LAS unsigned* st) {
    XcdBarrier b; b.bar = bar; b.x = xb_xcc_id(); b.st = st;
    if (threadIdx.x == 0) (void)xb_add(&bar[XB_XCNT(b.x)], 1u);
    return b;
}
__device__ __forceinline__ void xcd_barrier_complete(unsigned* bar, unsigned x, unsigned& nloc, unsigned& nx) {
    const unsigned G = gridDim.x * gridDim.y * gridDim.z;
    unsigned sum, cnt, mine, sp = 0u;
    for (;;) {
        sum = 0u; cnt = 0u; mine = 0u;
#pragma unroll
        for (unsigned j = 0; j < 16; ++j) { const unsigned c = xb_ld(&bar[XB_XCNT(j)]); sum += c; cnt += (c > 0u) ? 1u : 0u; mine = (j == x) ? c : mine; }
        if (sum == G) break;
        __builtin_amdgcn_s_sleep(1);
        if ((++sp & 255u) == 0u) { if (xb_ld(&bar[XB_TMO])) break; if (sp > XB_SPIN_CAP) { atomicAdd(&bar[XB_TMO], 1u); break; } }
    }
    nloc = mine > 0u ? mine : 1u; nx = cnt > 0u ? cnt : 1u;
}

__device__ __forceinline__ void xcd_barrier(const XcdBarrier& b) {
    asm volatile("s_waitcnt vmcnt(0)" ::: "memory");
    __syncthreads();
    if (threadIdx.x == 0) {
        unsigned* bar = b.bar;
        __builtin_amdgcn_s_waitcnt(0);
        unsigned nloc = b.st[0], nx = b.st[1];
        if (nloc == 0u) { xcd_barrier_complete(bar, b.x, nloc, nx); b.st[0] = nloc; b.st[1] = nx; }
        const unsigned old = xb_add(&bar[XB_XSUB(b.x)], 1u);
        const unsigned gen = old / nloc;
        if (old + 1u == (gen + 1u) * nloc) {
            __builtin_amdgcn_fence(__ATOMIC_RELEASE, "agent");
            asm volatile("s_waitcnt vmcnt(0)" ::: "memory");
            const unsigned og = xb_add(&bar[XB_TOP], 1u);
            const unsigned tg = og / nx;
            if (og + 1u == (tg + 1u) * nx) xb_add(&bar[XB_TOPGEN], 1u);
            else XB_SPIN(xb_ld(&bar[XB_TOPGEN]) == tg, bar);
            __builtin_amdgcn_fence(__ATOMIC_ACQUIRE, "agent");
            xb_add(&bar[XB_XGEN(b.x)], 1u);
            asm volatile("s_waitcnt vmcnt(0)" ::: "memory");
        } else {
            XB_SPIN(xb_ld(&bar[XB_XGEN(b.x)]) == gen, bar);
            __builtin_amdgcn_fence(__ATOMIC_ACQUIRE, "agent");
            asm volatile("s_waitcnt vmcnt(0)" ::: "memory");
        }
    }
    __syncthreads();
}

typedef pg8::EpiResid<true, true> EpiResTH; typedef pg8::EpiResid<true, false> EpiResTF; typedef pg8::EpiResid<false, true> EpiResFH;
#ifndef STOP_AFTER
#define STOP_AFTER 99
#endif
#ifndef DUP_MASK
#define DUP_MASK 0
#endif
__global__ void __launch_bounds__(NTHREADS, 2) mega_fwd(Args A) {
    extern __shared__ __attribute__((aligned(16))) unsigned char lds_raw[];
    LAS unsigned char* lds = (LAS unsigned char*)lds_raw;
    const int tid = threadIdx.x, lane = tid & 63, wave = tid >> 6, G = gridDim.x;
    const int vcu = (G % 8 == 0) ? ((int)blockIdx.x % 8) * (G / 8) + (int)blockIdx.x / 8 : (int)blockIdx.x;
    const int M = A.M;
    volatile LAS unsigned* MISC = (volatile LAS unsigned*)(lds + RING_BYTES);
    if (tid < 16) MISC[tid] = 0u;
    __syncthreads();
    const XcdBarrier bar = xcd_barrier_post(A.ctl, MISC);
#define GRID_SYNC() xcd_barrier(bar)
#define GEMM_PHASE(EPI_T, AP, BP, NN, KK, ...) do { pg8::Gemm g_{AP, BP, M, NN, KK}; pg8::StaticOrder S_; S_.init(M, NN, G, (int)blockIdx.x); EPI_T E_{__VA_ARGS__}; \
        pg8::gemm_phase<EPI_T, pg8::StaticOrder, true, true>(lds, g_, S_, E_); } while (0)

    p0_prologue(A, lds, vcu * NWAVES + wave, G * NWAVES, lane);
    if (DUP_MASK & 1) { __syncthreads(); p0_prologue(A, lds, vcu * NWAVES + wave, G * NWAVES, lane); }
    GRID_SYNC();
    if (DUP_MASK & 8) GEMM_PHASE(pg8::EpiSwiglu, A.xb, A.W1i, 2 * FF, D, A.H, FF, A.ssq0);
    if (DUP_MASK & 64) GEMM_PHASE(pg8::EpiProbe<0>, A.xb, A.W1i, 2 * FF, D, A.H, FF, A.ssq0);
    if (DUP_MASK & 128) GEMM_PHASE(pg8::EpiProbe<1>, A.xb, A.W1i, 2 * FF, D, A.H, FF, A.ssq0);
    GEMM_PHASE(pg8::EpiSwiglu, A.xb, A.W1i, 2 * FF, D, A.H, FF, A.ssq0);
    GRID_SYNC();
    if (STOP_AFTER <= 1) return;
    GEMM_PHASE(EpiResTH, A.H, A.W1o, D, FF, A.x, A.x1, D, A.xb, A.ssq1);
    GRID_SYNC();
    if (STOP_AFTER <= 2) return;
    GEMM_PHASE(pg8::EpiMix, A.xb, A.Wmx, INW, D, A.ssq1, A.z, A.q, A.k, A.v, A.gc, A.ga, A.q_norm, A.k_norm);
    if (DUP_MASK & 16) GEMM_PHASE(pg8::EpiMix, A.xb, A.Wmx, INW, D, A.ssq1, A.z, A.q, A.k, A.v, A.gc, A.ga, A.q_norm, A.k_norm);
    GRID_SYNC();
    if (STOP_AFTER <= 3) return;
    conv_phase(A, lds);
    if (DUP_MASK & 2) conv_phase(A, lds);
    attn_phase(A, lds);
    if (DUP_MASK & 4) attn_phase(A, lds);
    GRID_SYNC();
    if (STOP_AFTER <= 4) return;
    do { pg8::Gemm g_{A.c, A.Wcp, M, D, D, A.o, A.Wao}; pg8::StaticOrder S_; S_.init(M, D, G, (int)blockIdx.x); pg8::EpiMerge E_{A.gc, A.ga, A.mg};
         pg8::gemm_phase<pg8::EpiMerge, pg8::StaticOrder, true, true, 2>(lds, g_, S_, E_); } while (0);
    GRID_SYNC();
    if (STOP_AFTER <= 6) return;
    GEMM_PHASE(EpiResTF, A.mg, A.Wot, D, D, A.x1, A.x2, D, A.xb, A.ssq2);
    GRID_SYNC();
    if (STOP_AFTER <= 7) return;
    GEMM_PHASE(pg8::EpiSwiglu, A.xb, A.W2i, 2 * FF, D, A.H2, FF, A.ssq2);
    if (DUP_MASK & 32) GEMM_PHASE(pg8::EpiSwiglu, A.xb, A.W2i, 2 * FF, D, A.H2, FF, A.ssq2);
    GRID_SYNC();
    GEMM_PHASE(EpiResFH, A.H2, A.W2o, D, FF, A.x2, A.out, D, nullptr, nullptr);
#undef GEMM_PHASE
#undef GRID_SYNC
}

static size_t ws_map(Args& a, unsigned char* ws, int M, bool alias) {
    size_t off = 0;
    auto take = [&](size_t bytes) { unsigned char* p = ws + off; off += (bytes + 255) & ~(size_t)255; return p; };
    a.ctl = (unsigned*)take(1u << 20);
    a.biasC = (float*)take((size_t)HQ * 5 * 64 * 16 * 4);
    a.ssq0 = (float*)take((size_t)M * 4); a.ssq1 = (float*)take((size_t)M * 4); a.ssq2 = (float*)take((size_t)M * 4);
    a.W1i = (bf16*)take((size_t)2 * FF * D * 2); a.W1o = (bf16*)take((size_t)D * FF * 2); a.Wmx = (bf16*)take((size_t)INW * D * 2);
    a.Wcp = (bf16*)take((size_t)D * D * 2); a.Wao = (bf16*)take((size_t)D * D * 2); a.Wot = (bf16*)take((size_t)D * D * 2);
    a.W2i = (bf16*)take((size_t)2 * FF * D * 2); a.W2o = (bf16*)take((size_t)D * FF * 2);
    const size_t act = (size_t)M * D * 2;
    a.xb = (bf16*)take(act);
    a.H = (bf16*)take((size_t)M * FF * 2); a.H2 = a.H;
    if (alias) {
        a.z = a.H; a.q = a.z + (size_t)M * D; a.k = a.q + (size_t)M * D; a.v = a.k + (size_t)M * 256;
        a.gc = (bf16*)take(act); a.ga = (bf16*)take(act); a.c = (bf16*)take(act);
        a.o = a.xb; a.m1 = nullptr; a.mg = a.z;
    } else {
        a.z = (bf16*)take(act); a.q = (bf16*)take(act); a.k = (bf16*)take((size_t)M * 256 * 2); a.v = (bf16*)take((size_t)M * 256 * 2);
        a.gc = (bf16*)take(act); a.ga = (bf16*)take(act); a.c = (bf16*)take(act);
        a.o = (bf16*)take(act); a.m1 = nullptr; a.mg = (bf16*)take(act);
    }
    return off;
}
static void set_inputs(Args& a, void* const* d_in) {
    a.x = (const float*)d_in[0]; a.ffn1_norm = (const float*)d_in[1]; a.ffn1_w_in = (const float*)d_in[2]; a.ffn1_w_out = (const float*)d_in[3];
    a.mix_norm = (const float*)d_in[4]; a.w_in = (const float*)d_in[5]; a.conv_w = (const float*)d_in[6]; a.conv_b = (const float*)d_in[7];
    a.ln_g = (const float*)d_in[8]; a.ln_b = (const float*)d_in[9]; a.conv_proj = (const float*)d_in[10]; a.q_norm = (const float*)d_in[11];
    a.k_norm = (const float*)d_in[12]; a.sinks = (const float*)d_in[13]; a.rel_bias = (const float*)d_in[14]; a.attn_wo = (const float*)d_in[15];
    a.w_out = (const float*)d_in[16]; a.ffn2_norm = (const float*)d_in[17]; a.ffn2_w_in = (const float*)d_in[18]; a.ffn2_w_out = (const float*)d_in[19];
}
static int g_grid = 0;
static bool launch_mega(Args& a, hipStream_t stream) {
    if (g_grid == 0) {
        int dev = 0, cus = 0, per_cu = 0;
        if (hipGetDevice(&dev) != hipSuccess || hipDeviceGetAttribute(&cus, hipDeviceAttributeMultiprocessorCount, dev) != hipSuccess) { g_grid = -1; return false; }
        if (hipFuncSetAttribute((const void*)mega_fwd, hipFuncAttributeMaxDynamicSharedMemorySize, LDS_BYTES) != hipSuccess) { fprintf(stderr, "hipFuncSetAttribute failed\n"); g_grid = -1; return false; }
        if (hipOccupancyMaxActiveBlocksPerMultiprocessor(&per_cu, (const void*)mega_fwd, NTHREADS, LDS_BYTES) != hipSuccess || per_cu < 1) { fprintf(stderr, "occupancy query: %d blocks per CU\n", per_cu); g_grid = -1; (void)hipGetLastError(); return false; }
        g_grid = cus;
    }
    if (g_grid < 0) return false;
    void* args[] = {&a};
    const hipError_t e = hipLaunchCooperativeKernel((const void*)mega_fwd, dim3(g_grid), dim3(NTHREADS), args, LDS_BYTES, stream);
    if (e != hipSuccess) { fprintf(stderr, "cooperative launch failed: %s (grid %d)\n", hipGetErrorString(e), g_grid); return false; }
    return true;
}
#if DEBUG_ORACLE
namespace nv {
constexpr int S = SEQ, B = NB;
constexpr float EPS = 1e-6f;
__device__ __forceinline__ float sigmoidf_(float v) { return 1.f / (1.f + expf(-v)); }
__device__ __forceinline__ float siluf_(float v) { return v / (1.f + expf(-v)); }
__device__ __forceinline__ float block_sum_256(float v, float* red) {
    for (int o = 32; o > 0; o >>= 1) v += __shfl_xor(v, o);
    const int w = threadIdx.x >> 6, l = threadIdx.x & 63;
    __syncthreads(); if (l == 0) red[w] = v; __syncthreads();
    return red[0] + red[1] + red[2] + red[3];
}
__global__ void rms_rows(const float* x, const float* g, float* out) {
    __shared__ float red[4];
    const size_t r = blockIdx.x;
    const float4 v = ((const float4*)(x + r * D))[threadIdx.x];
    const float ss = block_sum_256(v.x * v.x + v.y * v.y + v.z * v.z + v.w * v.w, red);
    const float rs = rsqrtf(ss * (1.f / D) + EPS);
    const float4 gg = ((const float4*)g)[threadIdx.x];
    float4 o; o.x = v.x * rs * gg.x; o.y = v.y * rs * gg.y; o.z = v.z * rs * gg.z; o.w = v.w * rs * gg.w;
    ((float4*)(out + r * D))[threadIdx.x] = o;
}
__global__ void gemm_f32(const float* __restrict__ A, int lda, const float* __restrict__ Bm, int ldb, float* __restrict__ C, int ldc, int K) {
    __shared__ float As[16][68];
    __shared__ float Bs[16][68];
    const int tx = threadIdx.x & 15, ty = threadIdx.x >> 4;
    const int m0 = blockIdx.y * 64, n0 = blockIdx.x * 64;
    float acc[4][4] = {};
    for (int k0 = 0; k0 < K; k0 += 16) {
        {
            const int r = threadIdx.x >> 2, kq = (threadIdx.x & 3) * 4;
            const float4 a = *(const float4*)(A + (size_t)(m0 + r) * lda + k0 + kq);
            As[kq + 0][r] = a.x; As[kq + 1][r] = a.y; As[kq + 2][r] = a.z; As[kq + 3][r] = a.w;
            const int kr = threadIdx.x >> 4, c4 = (threadIdx.x & 15) * 4;
            *(float4*)&Bs[kr][c4] = *(const float4*)(Bm + (size_t)(k0 + kr) * ldb + n0 + c4);
        }
        __syncthreads();
#pragma unroll
        for (int k = 0; k < 16; ++k) {
            const float4 a = *(const float4*)&As[k][ty * 4];
            const float4 b = *(const float4*)&Bs[k][tx * 4];
            const float av[4] = {a.x, a.y, a.z, a.w}, bv[4] = {b.x, b.y, b.z, b.w};
#pragma unroll
            for (int i = 0; i < 4; ++i)
#pragma unroll
                for (int j = 0; j < 4; ++j) acc[i][j] = fmaf(av[i], bv[j], acc[i][j]);
        }
        __syncthreads();
    }
#pragma unroll
    for (int i = 0; i < 4; ++i) { float4 o; o.x = acc[i][0]; o.y = acc[i][1]; o.z = acc[i][2]; o.w = acc[i][3]; *(float4*)(C + (size_t)(m0 + ty * 4 + i) * ldc + n0 + tx * 4) = o; }
}
__global__ void swiglu_k(const float* U, float* H, int rows) {
    const size_t i = (size_t)blockIdx.x * blockDim.x + threadIdx.x;
    if (i >= (size_t)rows * FF) return;
    const size_t t = i / FF; const int j = (int)(i % FF);
    H[i] = siluf_(U[t * (2 * FF) + j]) * U[t * (2 * FF) + FF + j];
}
__global__ void resid_k(const float* xin, const float* y, float scale, float* out, size_t n) {
    const size_t i = (size_t)blockIdx.x * blockDim.x + threadIdx.x;
    if (i < n) out[i] = xin[i] + scale * y[i];
}
__global__ void glu_k(const float* P, float* z, int rows) {
    const size_t i = (size_t)blockIdx.x * blockDim.x + threadIdx.x;
    if (i >= (size_t)rows * D) return;
    const size_t t = i / D; const int c = (int)(i % D);
    z[i] = P[t * INW + c] * sigmoidf_(P[t * INW + D + c]);
}
__global__ void conv_k(const float* z, const float* w, const float* bias, float* y) {
    const size_t i = (size_t)blockIdx.x * blockDim.x + threadIdx.x;
    if (i >= (size_t)S * D) return;
    const int t = (int)(i / D), c = (int)(i % D);
    float acc = bias[c];
    for (int k = 0; k < CWID; ++k) { const int tt = t - (CWID - 1) + k; if (tt >= 0) acc = fmaf(w[k * D + c], z[(size_t)tt * D + c], acc); }
    y[i] = acc;
}
__global__ void ln_silu_k(const float* y, const float* g, const float* b, float* out) {
    __shared__ float red[4];
    const size_t r = blockIdx.x;
    const float4 v = ((const float4*)(y + r * D))[threadIdx.x];
    const float mu = block_sum_256(v.x + v.y + v.z + v.w, red) * (1.f / D);
    const float dx = v.x - mu, dy = v.y - mu, dz = v.z - mu, dw = v.w - mu;
    const float var = block_sum_256(dx * dx + dy * dy + dz * dz + dw * dw, red) * (1.f / D);
    const float rs = rsqrtf(var + EPS);
    const float4 gg = ((const float4*)g)[threadIdx.x], bb = ((const float4*)b)[threadIdx.x];
    float4 o; o.x = siluf_(dx * rs * gg.x + bb.x); o.y = siluf_(dy * rs * gg.y + bb.y); o.z = siluf_(dz * rs * gg.z + bb.z); o.w = siluf_(dw * rs * gg.w + bb.w);
    ((float4*)(out + r * D))[threadIdx.x] = o;
}
__global__ void qknorm_k(const float* P, const float* qg, const float* kg, float* qn, float* kn) {
    const int wv = (blockIdx.x * 4) + (threadIdx.x >> 6), lane = threadIdx.x & 63;
    const int t = wv / (HQ + HKV), hh = wv % (HQ + HKV);
    if (t >= S) return;
    const bool isq = hh < HQ;
    const int h = isq ? hh : hh - HQ;
    const float v = P[(size_t)t * INW + (isq ? 2 * D + h * HD : 3 * D + h * HD) + lane];
    float ss = v * v;
    for (int o = 32; o > 0; o >>= 1) ss += __shfl_xor(ss, o);
    const float rs = rsqrtf(ss * (1.f / HD) + EPS);
    if (isq) qn[(size_t)t * (HQ * HD) + h * HD + lane] = v * rs * qg[lane];
    else     kn[(size_t)t * (HKV * HD) + h * HD + lane] = v * rs * kg[lane];
}
__global__ void attn_k(const float* qn, const float* kn, const float* P, const float* sinks, const float* rel_bias, float* o) {
    const int wv = (blockIdx.x * 4) + (threadIdx.x >> 6), lane = threadIdx.x & 63;
    const int t = wv / HQ, h = wv % HQ, hk = h / (HQ / HKV);
    if (t >= S) return;
    const float* q = qn + (size_t)t * (HQ * HD) + h * HD;
    float s[2];
#pragma unroll
    for (int u = 0; u < 2; ++u) {
        const int dist = lane + 64 * u, key = t - dist;
        float acc = -3.0e38f;
        if (key >= 0) {
            const float* kr = kn + (size_t)key * (HKV * HD) + hk * HD;
            float d = 0.f;
            for (int e = 0; e < HD; ++e) d = fmaf(q[e], kr[e], d);
            acc = d * 0.125f + rel_bias[T5B[dist] * HQ + h];
        }
        s[u] = acc;
    }
    const float sink = sinks[h];
    float m = fmaxf(fmaxf(s[0], s[1]), sink);
    for (int of = 32; of > 0; of >>= 1) m = fmaxf(m, __shfl_xor(m, of));
    float p0 = (t - lane >= 0) ? expf(s[0] - m) : 0.f, p1 = (t - lane - 64 >= 0) ? expf(s[1] - m) : 0.f;
    float l = p0 + p1;
    for (int of = 32; of > 0; of >>= 1) l += __shfl_xor(l, of);
    l += expf(sink - m);
    const float inv = 1.f / l;
    float acc = 0.f;
    for (int j = 0; j < 64; ++j) {
        const float pj0 = __shfl(p0, j), pj1 = __shfl(p1, j);
        const int k0 = t - j, k1 = t - j - 64;
        if (k0 >= 0) acc = fmaf(pj0, P[(size_t)k0 * INW + 3 * D + HKV * HD + hk * HD + lane], acc);
        if (k1 >= 0) acc = fmaf(pj1, P[(size_t)k1 * INW + 3 * D + HKV * HD + hk * HD + lane], acc);
    }
    o[(size_t)t * (HQ * HD) + h * HD + lane] = acc * inv;
}
__global__ void merge_k(const float* P, const float* a, const float* b, float* mg, int rows) {
    const size_t i = (size_t)blockIdx.x * blockDim.x + threadIdx.x;
    if (i >= (size_t)rows * D) return;
    const size_t t = i / D; const int c = (int)(i % D);
    mg[i] = sigmoidf_(P[t * INW + 3584 + c]) * a[i] + sigmoidf_(P[t * INW + 4608 + c]) * b[i];
}
static void gemm(const float* A, int lda, const float* Bm, int ldb, float* C, int ldc, int M, int N, int K, hipStream_t st) {
    hipLaunchKernelGGL(gemm_f32, dim3(N / 64, M / 64), dim3(256), 0, st, A, lda, Bm, ldb, C, ldc, K);
}
__global__ void cmp_k(const void* a, int a_is_bf16, int lda, float ascale, const float* ref, int ldr, int sig, int rows, int cols, unsigned* slot) {
    const size_t i = (size_t)blockIdx.x * blockDim.x + threadIdx.x;
    float d = 0.f, r2 = 0.f;
    if (i < (size_t)rows * cols) {
        const size_t t = i / cols; const int c = (int)(i % cols);
        float av = a_is_bf16 ? __uint_as_float((unsigned)((const unsigned short*)a)[t * lda + c] << 16) : ((const float*)a)[t * lda + c];
        float rv = ref[t * ldr + c]; if (sig) rv = sigmoidf_(rv);
        d = fabsf(av * ascale - rv); if (!(d == d)) d = 1e30f; r2 = rv * rv;
    }
    float d2 = d * d;
    for (int o = 32; o > 0; o >>= 1) { d = fmaxf(d, __shfl_xor(d, o)); r2 += __shfl_xor(r2, o); d2 += __shfl_xor(d2, o); }
    if ((threadIdx.x & 63) == 0) { atomicMax(slot, __float_as_uint(d)); atomicAdd((float*)(slot + 1), r2); atomicAdd((float*)(slot + 2), d2); }
}
constexpr int NCHK = 16;
struct Counts { float c[NCHK]; };
__global__ void decide_k(unsigned* slots, Counts cnt, float tol, float* code_out) {
    if (threadIdx.x != 0 || blockIdx.x != 0) return;
    float code = 0.f;
    for (int k = 0; k < NCHK; ++k) {
        if (cnt.c[k] <= 0.f) continue;
        const float md = __uint_as_float(slots[4 * k]), rr = __uint_as_float(slots[4 * k + 1]), dd = __uint_as_float(slots[4 * k + 2]);
        const float rms = sqrtf(rr / cnt.c[k]), rmsr = sqrtf(dd / fmaxf(rr, 1e-30f));
        if (!(rmsr <= tol) || !(md <= 0.5f * rms)) { code = (float)(k + 1) + (rmsr < 0.03f ? 0.f : rmsr < 0.3f ? 0.3f : 0.6f); break; }
    }
    *code_out = code;
}
__global__ void finish_k(float* out, const float* mega_out, size_t dbg_off, size_t dbg_n, size_t n, const float* code) {
    const size_t i = (size_t)blockIdx.x * blockDim.x + threadIdx.x;
    if (i >= n) return;
    const float c = *code;
    float v = out[i];
    if (c == 0.f && i >= dbg_off && i < dbg_off + dbg_n) v = mega_out[i - dbg_off];
    out[i] = v * (1.f + c);
}
}
#ifndef DBG_B
#define DBG_B 5
#endif
#ifndef DBG_TOL
#define DBG_TOL 0.01f
#endif
#endif

extern "C" void kernel_launch(void* const* d_in, const int* in_sizes, int n_in, void* d_out, int out_size, void* d_ws, size_t ws_size, hipStream_t stream) {
    (void)in_sizes; (void)n_in; (void)out_size; (void)ws_size;
#if !DEBUG_ORACLE
    Args a{};
    set_inputs(a, d_in);
    a.out = (float*)d_out; a.x1 = a.out; a.x2 = a.out;
    ws_map(a, (unsigned char*)d_ws, M_FULL, true);
    a.M = M_FULL;
    if (hipMemsetAsync(a.ctl, 0, CTL_ZERO_BYTES, stream) != hipSuccess) return;
    launch_mega(a, stream);
#else
    using namespace nv;
    unsigned char* wsb = (unsigned char*)d_ws;
    Args a{};
    set_inputs(a, d_in);
    a.x += (size_t)DBG_B * S * D;
    size_t used = ws_map(a, wsb, S, false);
    auto takeb = [&](size_t bytes) { unsigned char* p = wsb + used; used += (bytes + 255) & ~(size_t)255; return p; };
    a.x1 = (float*)takeb((size_t)S * D * 4); a.x2 = (float*)takeb((size_t)S * D * 4); a.out = (float*)takeb((size_t)S * D * 4);
    a.H2 = (bf16*)takeb((size_t)S * FF * 2);
    a.M = S;
    unsigned* slots = (unsigned*)takeb(256); float* code = (float*)takeb(256);
    Counts hc{};
    const float* x = (const float*)d_in[0];
    float* out = (float*)d_out;
    float* xn = (float*)takeb((size_t)S * D * 4); float* U = (float*)takeb((size_t)S * INW * 4); float* Hh = (float*)takeb((size_t)S * FF * 4); float* Y = (float*)takeb((size_t)S * D * 4);
    float* z = (float*)takeb((size_t)S * D * 4); float* cy = xn; float* cv = (float*)takeb((size_t)S * D * 4); float* qn = (float*)takeb((size_t)S * D * 4);
    float* kn = (float*)takeb((size_t)S * 256 * 4); float* ao = (float*)takeb((size_t)S * D * 4); float* av = (float*)takeb((size_t)S * D * 4); float* bv = (float*)takeb((size_t)S * D * 4);
    float* mg = (float*)takeb((size_t)S * D * 4);
    if (used > ws_size) { fprintf(stderr, "debug build needs %zu bytes of workspace, have %zu\n", used, ws_size); return; }
    hipMemsetAsync(slots, 0, 256, stream);
    hipMemsetAsync(a.ctl, 0, CTL_ZERO_BYTES, stream);
    launch_mega(a, stream);
    const int EB = 256; const size_t n1 = (size_t)S * D;
    int nchk = 0;
    auto chk = [&](const void* ap, int isbf, int lda, float asc, const float* ref, int ldr, int sig, int rows, int cols) {
        const size_t n = (size_t)rows * cols;
        hipLaunchKernelGGL(cmp_k, dim3((unsigned)((n + 255) / 256)), dim3(256), 0, stream, ap, isbf, lda, asc, ref, ldr, sig, rows, cols, slots + 4 * nchk);
        hc.c[nchk] = (float)n; ++nchk;
    };
    for (int bi = 0; bi < B; ++bi) {
        const int b = (bi == B - 1) ? DBG_B : (bi >= DBG_B ? bi + 1 : bi);
        const bool dbg = (b == DBG_B);
        const float* xbp = x + (size_t)b * S * D; float* ob = out + (size_t)b * S * D;
        hipLaunchKernelGGL(rms_rows, dim3(S), dim3(256), 0, stream, xbp, a.ffn1_norm, xn);
        gemm(xn, D, a.ffn1_w_in, 2 * FF, U, 2 * FF, S, 2 * FF, D, stream);
        hipLaunchKernelGGL(swiglu_k, dim3((unsigned)(((size_t)S * FF + EB - 1) / EB)), dim3(EB), 0, stream, U, Hh, S);
        if (dbg) chk(a.H, 1, FF, 1.f, Hh, FF, 0, S, FF);
        gemm(Hh, FF, a.ffn1_w_out, D, Y, D, S, D, FF, stream);
        hipLaunchKernelGGL(resid_k, dim3((unsigned)((n1 + EB - 1) / EB)), dim3(EB), 0, stream, xbp, Y, 0.5f, ob, n1);
        if (dbg) chk(a.x1, 0, D, 1.f, ob, D, 0, S, D);
        hipLaunchKernelGGL(rms_rows, dim3(S), dim3(256), 0, stream, ob, a.mix_norm, xn);
        gemm(xn, D, a.w_in, INW, U, INW, S, INW, D, stream);
        hipLaunchKernelGGL(glu_k, dim3((unsigned)((n1 + EB - 1) / EB)), dim3(EB), 0, stream, U, z, S);
        if (dbg) chk(a.z, 1, D, 1.f, z, D, 0, S, D);
        hipLaunchKernelGGL(qknorm_k, dim3(S * (HQ + HKV) / 4), dim3(256), 0, stream, U, a.q_norm, a.k_norm, qn, kn);
        if (dbg) { chk(a.q, 1, D, 1.f / (0.125f * 1.4426950408889634f), qn, D, 0, S, D);
                   chk(a.k, 1, 256, 1.f, kn, 256, 0, S, 256);
                   chk(a.v, 1, 256, 1.f, U + 3328, INW, 0, S, 256);
                   chk(a.ga, 1, D, 1.f, U + 4608, INW, 1, S, D);
                   chk(a.ga, 1, D, 1.f, U + 4608, INW, 1, S, D); }
        hipLaunchKernelGGL(conv_k, dim3((unsigned)((n1 + EB - 1) / EB)), dim3(EB), 0, stream, z, a.conv_w, a.conv_b, cy);
        hipLaunchKernelGGL(ln_silu_k, dim3(S), dim3(256), 0, stream, cy, a.ln_g, a.ln_b, cv);
        if (dbg) chk(a.c, 1, D, 1.f, cv, D, 0, S, D);
        gemm(cv, D, a.conv_proj, D, av, D, S, D, D, stream);
        hipLaunchKernelGGL(attn_k, dim3(S * HQ / 4), dim3(256), 0, stream, qn, kn, U, a.sinks, a.rel_bias, ao);
        if (dbg) chk(a.o, 1, D, 1.f, ao, D, 0, S, D);
        gemm(ao, D, a.attn_wo, D, bv, D, S, D, D, stream);
        hipLaunchKernelGGL(merge_k, dim3((unsigned)((n1 + EB - 1) / EB)), dim3(EB), 0, stream, U, av, bv, mg, S);
        if (dbg) chk(a.mg, 1, D, 1.f, mg, D, 0, S, D);
        gemm(mg, D, a.w_out, D, Y, D, S, D, D, stream);
        hipLaunchKernelGGL(resid_k, dim3((unsigned)((n1 + EB - 1) / EB)), dim3(EB), 0, stream, ob, Y, 1.0f, ob, n1);
        if (dbg) chk(a.x2, 0, D, 1.f, ob, D, 0, S, D);
        hipLaunchKernelGGL(rms_rows, dim3(S), dim3(256), 0, stream, ob, a.ffn2_norm, xn);
        gemm(xn, D, a.ffn2_w_in, 2 * FF, U, 2 * FF, S, 2 * FF, D, stream);
        hipLaunchKernelGGL(swiglu_k, dim3((unsigned)(((size_t)S * FF + EB - 1) / EB)), dim3(EB), 0, stream, U, Hh, S);
        if (dbg) chk(a.H2, 1, FF, 1.f, Hh, FF, 0, S, FF);
        gemm(Hh, FF, a.ffn2_w_out, D, Y, D, S, D, FF, stream);
        hipLaunchKernelGGL(resid_k, dim3((unsigned)((n1 + EB - 1) / EB)), dim3(EB), 0, stream, ob, Y, 0.5f, ob, n1);
        if (dbg) chk(a.out, 0, D, 1.f, ob, D, 0, S, D);
    }
    hipLaunchKernelGGL(decide_k, dim3(1), dim3(64), 0, stream, slots, hc, DBG_TOL, code);
    const size_t nall = (size_t)B * S * D;
    hipLaunchKernelGGL(finish_k, dim3((unsigned)((nall + 255) / 256)), dim3(256), 0, stream, out, a.out, (size_t)DBG_B * S * D, (size_t)S * D, nall, code);
#endif
}
```

```cpp
#include <hip/hip_runtime.h>
#include <cstdio>
#include <cstdint>
#ifndef DEBUG_ORACLE
#define DEBUG_ORACLE 0
#endif
namespace pg8 {
#define PG8_LAS __attribute__((address_space(3)))
typedef unsigned short bf16_t;
typedef short bf16x8 __attribute__((ext_vector_type(8)));
typedef float f32x4 __attribute__((ext_vector_type(4)));
typedef unsigned u32x4 __attribute__((ext_vector_type(4)));
constexpr int BM = 256, BK = 64, HALF = 128, HTB = HALF * BK * 2  , STAGE_BYTES = 8 * HTB, NXCD = 8, WGM = 8;

__host__ __device__ __forceinline__ int lds_byte(int r, int c) { const int st = (r >> 4) * 2 + (c >> 5), rr = r & 15, cc = c & 31, ob = rr * 64 + cc * 2; return st * 1024 + (ob ^ (((ob >> 9) & 1) << 5)); }
__host__ __device__ __forceinline__ void stage_rc(int b, int& R, int& C) { const int st = b / 1024, sb = b % 1024, swz = sb ^ (((sb >> 9) & 1) << 5); R = (st >> 1) * 16 + swz / 64; C = (st & 1) * 32 + (swz % 64) / 2; }
__host__ __device__ __forceinline__ int perm32(int rho) { const int n = rho >> 4, i = rho & 15; return 8 * (i >> 2) + 4 * n + (i & 3); }

struct Unit { int pm, pn; };
struct Gemm { const bf16_t* A; const bf16_t* Bt; int M, N, K; const bf16_t* A2; const bf16_t* Bt2; };

struct StaticOrder {
    int nM, nN, nwg, G, c;
    __host__ __device__ void init(int M, int N, int G_, int c_) { nM = M / BM; nN = N / BM; nwg = nM * nN; G = G_; c = c_; }
    __host__ __device__ bool next(int i, Unit& u) const {
        const long L = (long)i * G + c; if (L >= nwg) return false;
        int wgid = (int)L; { const int q = nwg / NXCD, r = nwg % NXCD, xcd = wgid % NXCD, off = wgid / NXCD; wgid = (xcd < r ? xcd * (q + 1) : r * (q + 1) + (xcd - r) * q) + off; }
        const int nig = WGM * nN, gid = wgid / nig, fm = gid * WGM, gsz = (nM - fm) < WGM ? (nM - fm) : WGM;
        u.pm = fm + ((wgid % nig) % gsz); u.pn = (wgid % nig) / gsz; return true;
    }
    __device__ __forceinline__ void a_ready(const Unit&) const {}
    __device__ __forceinline__ void done(const Unit&) const {}
};

constexpr float RMS_EPS = 1e-6f;
constexpr float LOG2E = 1.4426950408889634f;
typedef float f32x2 __attribute__((ext_vector_type(2)));
typedef __bf16 bf16x2_t __attribute__((ext_vector_type(2)));
__device__ __forceinline__ unsigned cvt_pk_bf16(float lo, float hi) { f32x2 v = {lo, hi}; bf16x2_t b = __builtin_convertvector(v, bf16x2_t); return __builtin_bit_cast(unsigned, b); }
__device__ __forceinline__ u32x4 pack8(const f32x4 a, const f32x4 b) { u32x4 w; w.x = cvt_pk_bf16(a[0], a[1]); w.y = cvt_pk_bf16(a[2], a[3]); w.z = cvt_pk_bf16(b[0], b[1]); w.w = cvt_pk_bf16(b[2], b[3]); return w; }
__device__ __forceinline__ void unpack8(const u32x4 w, f32x4& a, f32x4& b) {
    a[0] = __uint_as_float(w.x << 16); a[1] = __uint_as_float(w.x & 0xffff0000u); a[2] = __uint_as_float(w.y << 16); a[3] = __uint_as_float(w.y & 0xffff0000u);
    b[0] = __uint_as_float(w.z << 16); b[1] = __uint_as_float(w.z & 0xffff0000u); b[2] = __uint_as_float(w.w << 16); b[3] = __uint_as_float(w.w & 0xffff0000u); }
__device__ __forceinline__ float fast_sigmoid(float v) { return __builtin_amdgcn_rcpf(1.0f + __builtin_amdgcn_exp2f(-LOG2E * v)); }
__device__ __forceinline__ f32x4 sigmoid4(const f32x4 v) { f32x4 o; o[0] = fast_sigmoid(v[0]); o[1] = fast_sigmoid(v[1]); o[2] = fast_sigmoid(v[2]); o[3] = fast_sigmoid(v[3]); return o; }
__device__ __forceinline__ float dot4(const f32x4 v) { return (v[0] * v[0] + v[1] * v[1]) + (v[2] * v[2] + v[3] * v[3]); }

struct EpiSwiglu {
    static constexpr bool PERM = true, AFTER_DRAIN = false;
    bf16_t* H; int ldh; const float* ssq;
    __device__ __forceinline__ void operator()(const f32x4 (&acc)[2][2][4][2], const Unit& u, int wr, int wc, int fr, int fq) const {
        const int row0 = u.pm * BM + wr * 64 + fr, col0 = u.pn * HALF + wc * 32 + 8 * fq;
        float rs[2][4];
#pragma unroll
        for (int ai = 0; ai < 2; ++ai)
#pragma unroll
            for (int m = 0; m < 4; ++m) rs[ai][m] = ssq[row0 + ai * HALF + m * 16];
#pragma unroll
        for (int ai = 0; ai < 2; ++ai)
#pragma unroll
            for (int m = 0; m < 4; ++m) {
                const float r = __builtin_amdgcn_rsqf(rs[ai][m] * (1.0f / 1024.0f) + RMS_EPS);
                f32x4 h[2];
#pragma unroll
                for (int n = 0; n < 2; ++n) { const f32x4 a = acc[ai][0][m][n] * r, b = acc[ai][1][m][n] * r; h[n] = a * sigmoid4(a) * b; }
                *(u32x4*)(H + (size_t)(row0 + ai * HALF + m * 16) * ldh + col0) = pack8(h[0], h[1]);
            }
    }
};

template <int MODE> struct EpiProbe {
    static constexpr bool PERM = true, AFTER_DRAIN = false;
    bf16_t* H; int ldh; const float* ssq;
    __device__ __forceinline__ void operator()(const f32x4 (&acc)[2][2][4][2], const Unit& u, int wr, int wc, int fr, int fq) const {
        const int row0 = u.pm * BM + wr * 64 + fr, col0 = u.pn * HALF + wc * 32 + 8 * fq;
#pragma unroll
        for (int ai = 0; ai < 2; ++ai)
#pragma unroll
            for (int m = 0; m < 4; ++m) {
                if (MODE == 0) { asm volatile("" :: "v"(acc[ai][0][m][0]), "v"(acc[ai][0][m][1]), "v"(acc[ai][1][m][0]), "v"(acc[ai][1][m][1])); }
                else { *(u32x4*)(H + (size_t)(row0 + ai * HALF + m * 16) * ldh + col0) = pack8(acc[ai][0][m][0] + acc[ai][1][m][0], acc[ai][0][m][1] + acc[ai][1][m][1]); }
            }
    }
};

template <bool WANT_XB, bool HALF_SCALE> struct EpiResid {
    static constexpr bool PERM = true, AFTER_DRAIN = false;
    const float* res; float* out; int ld; bf16_t* xb; float* ssq_out;
    __device__ __forceinline__ void operator()(const f32x4 (&acc)[2][2][4][2], const Unit& u, int wr, int wc, int fr, int fq) const {
        const int row0 = u.pm * BM + wr * 64 + fr, col0 = u.pn * BM + wc * 32 + 8 * fq;
        constexpr float scale = HALF_SCALE ? 0.5f : 1.0f;
#pragma unroll
        for (int ai = 0; ai < 2; ++ai)
#pragma unroll
            for (int m = 0; m < 4; ++m) {
                const size_t off = (size_t)(row0 + ai * HALF + m * 16) * ld + col0;
                float ss = 0.f;
#pragma unroll
                for (int bj = 0; bj < 2; ++bj) {
                    const f32x4 r0 = *(const f32x4*)(res + off + bj * HALF), r1 = *(const f32x4*)(res + off + bj * HALF + 4);
                    const f32x4 v0 = r0 + acc[ai][bj][m][0] * scale, v1 = r1 + acc[ai][bj][m][1] * scale;
                    *(f32x4*)(out + off + bj * HALF) = v0; *(f32x4*)(out + off + bj * HALF + 4) = v1;
                    if (WANT_XB) { *(u32x4*)(xb + off + bj * HALF) = pack8(v0, v1); ss += dot4(v0) + dot4(v1); }
                }
                if (WANT_XB) { ss += __shfl_xor(ss, 16); ss += __shfl_xor(ss, 32); if (fq == 0) atomicAdd(ssq_out + row0 + ai * HALF + m * 16, ss); }
                if (m & 1) asm volatile("" ::: "memory");
            }
    }
};

struct EpiMix {
    static constexpr bool PERM = true, AFTER_DRAIN = false;
    const float* ssq; bf16_t *z, *q, *k, *v, *gc, *ga; const float *qg, *kg;
    __device__ __forceinline__ void operator()(const f32x4 (&acc)[2][2][4][2], const Unit& u, int wr, int wc, int fr, int fq) const {
        const int row0 = u.pm * BM + wr * 64 + fr, pn = u.pn;
        float rs[2][4];
#pragma unroll
        for (int ai = 0; ai < 2; ++ai)
#pragma unroll
            for (int m = 0; m < 4; ++m) rs[ai][m] = ssq[row0 + ai * HALF + m * 16];
#pragma unroll
        for (int ai = 0; ai < 2; ++ai)
#pragma unroll
            for (int m = 0; m < 4; ++m) rs[ai][m] = __builtin_amdgcn_rsqf(rs[ai][m] * (1.0f / 1024.0f) + RMS_EPS);
        if (pn < 8) {
            const int col0 = pn * HALF + wc * 32 + 8 * fq;
#pragma unroll
            for (int ai = 0; ai < 2; ++ai)
#pragma unroll
                for (int m = 0; m < 4; ++m) {
                    const float r = rs[ai][m]; f32x4 h[2];
#pragma unroll
                    for (int n = 0; n < 2; ++n) { const f32x4 a = acc[ai][0][m][n] * r, g = acc[ai][1][m][n] * r; h[n] = a * sigmoid4(g); }
                    *(u32x4*)(z + (size_t)(row0 + ai * HALF + m * 16) * 1024 + col0) = pack8(h[0], h[1]);
                }
        } else if (pn < 13) {
            const bool isq = pn < 12;
            const float* gp = isq ? qg : kg; const float gs = isq ? 0.125f * LOG2E : 1.0f;
            bf16_t* ob = isq ? q : k; const int ld = isq ? 1024 : 256, head = isq ? 4 * (pn - 8) + wc : wc;
            f32x4 gv[2][2];
#pragma unroll
            for (int bj = 0; bj < 2; ++bj)
#pragma unroll
                for (int n = 0; n < 2; ++n) gv[bj][n] = *(const f32x4*)(gp + 32 * bj + 8 * fq + 4 * n) * gs;
#pragma unroll
            for (int ai = 0; ai < 2; ++ai)
#pragma unroll
                for (int m = 0; m < 4; ++m) {
                    const float r = rs[ai][m]; f32x4 y[2][2]; float ss = 0.f;
#pragma unroll
                    for (int bj = 0; bj < 2; ++bj)
#pragma unroll
                        for (int n = 0; n < 2; ++n) { y[bj][n] = acc[ai][bj][m][n] * r; ss += dot4(y[bj][n]); }
                    ss += __shfl_xor(ss, 16); ss += __shfl_xor(ss, 32);
                    const float rh = __builtin_amdgcn_rsqf(ss * (1.0f / 64.0f) + RMS_EPS);
                    bf16_t* rowp = ob + (size_t)(row0 + ai * HALF + m * 16) * ld + 64 * head + 8 * fq;
#pragma unroll
                    for (int bj = 0; bj < 2; ++bj) *(u32x4*)(rowp + 32 * bj) = pack8(y[bj][0] * rh * gv[bj][0], y[bj][1] * rh * gv[bj][1]);
                }
        } else if (pn == 13) {
            const int col0 = wc * 32 + 8 * fq;
#pragma unroll
            for (int ai = 0; ai < 2; ++ai)
#pragma unroll
                for (int m = 0; m < 4; ++m) {
                    const float r = rs[ai][m]; bf16_t* rowp = v + (size_t)(row0 + ai * HALF + m * 16) * 256 + col0;
#pragma unroll
                    for (int bj = 0; bj < 2; ++bj) *(u32x4*)(rowp + bj * HALF) = pack8(acc[ai][bj][m][0] * r, acc[ai][bj][m][1] * r);
                }
        } else {
            const int col0 = (pn - 14) * HALF + wc * 32 + 8 * fq;
#pragma unroll
            for (int ai = 0; ai < 2; ++ai)
#pragma unroll
                for (int m = 0; m < 4; ++m) {
                    const float r = rs[ai][m]; f32x4 rtv[2], sav[2];
#pragma unroll
                    for (int n = 0; n < 2; ++n) {
                        const f32x4 gc_ = acc[ai][0][m][n] * r, ga_ = acc[ai][1][m][n] * r;
#pragma unroll
                        for (int j = 0; j < 4; ++j) {
                            const float ec = __builtin_amdgcn_exp2f(-LOG2E * gc_[j]), ea = __builtin_amdgcn_exp2f(-LOG2E * ga_[j]);
                            sav[n][j] = __builtin_amdgcn_rcpf(1.0f + ea); rtv[n][j] = (1.0f + ea) * __builtin_amdgcn_rcpf(1.0f + ec);
                        }
                    }
                    const size_t off = (size_t)(row0 + ai * HALF + m * 16) * 1024 + col0;
                    *(u32x4*)(gc + off) = pack8(rtv[0], rtv[1]); *(u32x4*)(ga + off) = pack8(sav[0], sav[1]);
                }
        }
    }
};

struct EpiMerge {
    static constexpr bool PERM = true, AFTER_DRAIN = false;
    const bf16_t* rt; const bf16_t* sa; bf16_t* O;
    __device__ __forceinline__ void mid(f32x4 (&acc)[2][2][4][2], const Unit& u, int wr, int wc, int fr, int fq) const {
        const int row0 = u.pm * BM + wr * 64 + fr, col0 = u.pn * BM + wc * 32 + 8 * fq;
#pragma unroll
        for (int ai = 0; ai < 2; ++ai)
#pragma unroll
            for (int m = 0; m < 4; ++m) {
                const size_t off = (size_t)(row0 + ai * HALF + m * 16) * 1024 + col0;
#pragma unroll
                for (int bj = 0; bj < 2; ++bj) { f32x4 g0, g1; unpack8(*(const u32x4*)(rt + off + bj * HALF), g0, g1); acc[ai][bj][m][0] *= g0; acc[ai][bj][m][1] *= g1; }
                if (m & 1) asm volatile("" ::: "memory");
            }
    }
    __device__ __forceinline__ void operator()(const f32x4 (&acc)[2][2][4][2], const Unit& u, int wr, int wc, int fr, int fq) const {
        const int row0 = u.pm * BM + wr * 64 + fr, col0 = u.pn * BM + wc * 32 + 8 * fq;
#pragma unroll
        for (int ai = 0; ai < 2; ++ai)
#pragma unroll
            for (int m = 0; m < 4; ++m) {
                const size_t off = (size_t)(row0 + ai * HALF + m * 16) * 1024 + col0;
#pragma unroll
                for (int bj = 0; bj < 2; ++bj) { f32x4 g0, g1; unpack8(*(const u32x4*)(sa + off + bj * HALF), g0, g1); *(u32x4*)(O + off + bj * HALF) = pack8(g0 * acc[ai][bj][m][0], g1 * acc[ai][bj][m][1]); }
                if (m & 1) asm volatile("" ::: "memory");
            }
    }
};

template <class Epi, class Sched, bool ALIGN_EPI = false, bool SP2 = false, int NSEG = 1>
__device__ __forceinline__ void gemm_phase(PG8_LAS unsigned char* lds, const Gemm g, const Sched S, const Epi E) {
    int tid_ = threadIdx.x; asm volatile("" : "+v"(tid_));
    const int tid = tid_, wid = __builtin_amdgcn_readfirstlane(tid >> 6), lane = tid & 63, wr = wid >> 2, wc = wid & 3, fr = lane & 15, fq = lane >> 4;
    const int K = g.K, mt = K / BK, nt = NSEG * mt;
    unsigned voffA[2], voffB[2];
#pragma unroll
    for (int i = 0; i < 2; ++i) { int R, C; stage_rc(tid * 16 + i * 8192, R, C); const int Rb = Epi::PERM ? ((R & ~31) + perm32(R & 31)) : R;
        voffA[i] = (unsigned)(R * K + C) * 2u; voffB[i] = (unsigned)(Rb * K + C) * 2u; }
    const size_t kstep = (size_t)(BK * 2);
    const size_t hstep = (size_t)HALF * K * 2;
    const size_t tstep = 2 * hstep;
    const unsigned ldsw = (unsigned)wid * 1024u;
    const int aoff = lds_byte(wr * 64 + fr, fq * 8), boff = lds_byte(wc * 32 + fr, fq * 8);
#define PG8_SA(b, h) (((b) * 2 + (h)) * HTB)
#define PG8_SB(b, h) ((4 + (b) * 2 + (h)) * HTB)
#define PG8_STAGE(bufoff, gbase, voff) do { _Pragma("unroll") for (int _i = 0; _i < 2; ++_i) \
        __builtin_amdgcn_global_load_lds((const unsigned*)((const char*)(gbase) + (voff)[_i]), (PG8_LAS unsigned*)(lds + (bufoff) + ldsw + _i * 8192), 16, 0, 0); } while (0)
#define PG8_LDA(dst, b, h) do { _Pragma("unroll") for (int m = 0; m < 4; ++m) _Pragma("unroll") for (int k = 0; k < 2; ++k) dst[m][k] = *(const PG8_LAS bf16x8*)(lds + PG8_SA(b, h) + aoff + m * 2048 + k * 1024); } while (0)
#define PG8_LDB(dst, b, h) do { _Pragma("unroll") for (int n = 0; n < 2; ++n) _Pragma("unroll") for (int k = 0; k < 2; ++k) dst[n][k] = *(const PG8_LAS bf16x8*)(lds + PG8_SB(b, h) + boff + n * 2048 + k * 1024); } while (0)
#define PG8_MMA(ai, bj, At, Bt) do { __builtin_amdgcn_s_setprio(1); _Pragma("unroll") for (int m = 0; m < 4; ++m) _Pragma("unroll") for (int n = 0; n < 2; ++n) _Pragma("unroll") for (int k = 0; k < 2; ++k) \
        acc[ai][bj][m][n] = __builtin_amdgcn_mfma_f32_16x16x32_bf16(Bt[n][k], At[m][k], acc[ai][bj][m][n], 0, 0, 0); __builtin_amdgcn_s_setprio(0); } while (0)
#define PG8_WAIT_V(n) asm volatile("s_waitcnt vmcnt(" #n ")" ::: "memory")
#define PG8_WAIT_L(n) asm volatile("s_waitcnt lgkmcnt(" #n ")" ::: "memory")
#define PG8_BAR __builtin_amdgcn_s_barrier()
#define PG8_SCHED __builtin_amdgcn_sched_barrier(0)
    Unit cur, nxt; int ui = 0;
    if (!S.next(0, cur)) return;
    f32x4 acc[2][2][4][2];
#pragma unroll
    for (int a = 0; a < 2; ++a)
#pragma unroll
        for (int b = 0; b < 2; ++b)
#pragma unroll
            for (int m = 0; m < 4; ++m)
#pragma unroll
                for (int n = 0; n < 2; ++n) acc[a][b][m][n] = (f32x4){0.f, 0.f, 0.f, 0.f};
    bf16x8 At[4][2], B0[2][2], B1[2][2];
    const char* cA = (const char*)g.A + (size_t)cur.pm * tstep; const char* cB = (const char*)g.Bt + (size_t)cur.pn * tstep;
    const char* cA2 = (NSEG == 2) ? (const char*)g.A2 + (size_t)cur.pm * tstep : cA; const char* cB2 = (NSEG == 2) ? (const char*)g.Bt2 + (size_t)cur.pn * tstep : cB;
    S.a_ready(cur);
    if constexpr (SP2) {
        PG8_STAGE(PG8_SB(0, 0), cB, voffB); PG8_STAGE(PG8_SB(0, 1), cB + hstep, voffB); PG8_STAGE(PG8_SA(0, 0), cA, voffA); PG8_STAGE(PG8_SA(0, 1), cA + hstep, voffA);
        if (wr == 1) PG8_BAR;
        PG8_WAIT_V(2); PG8_BAR;
        PG8_STAGE(PG8_SB(1, 0), cB + kstep, voffB); PG8_STAGE(PG8_SA(1, 0), cA + kstep, voffA); PG8_STAGE(PG8_SB(1, 1), cB + hstep + kstep, voffB);
        PG8_WAIT_V(6); PG8_BAR;
    } else {
        PG8_STAGE(PG8_SB(0, 0), cB, voffB); PG8_STAGE(PG8_SA(0, 0), cA, voffA); PG8_STAGE(PG8_SB(0, 1), cB + hstep, voffB); PG8_STAGE(PG8_SA(0, 1), cA + hstep, voffA);
        if (wr == 1) PG8_BAR;
        PG8_WAIT_V(4); PG8_BAR;
        PG8_STAGE(PG8_SB(1, 0), cB + kstep, voffB); PG8_STAGE(PG8_SA(1, 0), cA + kstep, voffA); PG8_STAGE(PG8_SB(1, 1), cB + hstep + kstep, voffB);
        PG8_WAIT_V(6); PG8_BAR;
    }
    for (;;) {
        const bool has_next = S.next(ui + 1, nxt);
        const char* nA = has_next ? (const char*)g.A + (size_t)nxt.pm * tstep : cA; const char* nB = has_next ? (const char*)g.Bt + (size_t)nxt.pn * tstep : cB;
        const char* nA2 = (NSEG == 2 && has_next) ? (const char*)g.A2 + (size_t)nxt.pm * tstep : cA2; const char* nB2 = (NSEG == 2 && has_next) ? (const char*)g.Bt2 + (size_t)nxt.pn * tstep : cB2;
        for (int t = 0; t < nt; t += 2) {
            const bool last = (t == nt - 2);
            if constexpr (NSEG == 2) { if (t == mt) E.mid(acc, cur, wr, wc, fr, fq); }
            const bool s1 = (NSEG == 2) && (t + 1 >= mt), s2 = (NSEG == 2) && (t + 2 >= mt);
            const char* a1 = s1 ? cA2 + (size_t)(t + 1 - mt) * kstep : cA + (size_t)(t + 1) * kstep;
            const char* a2 = last ? nA : (s2 ? cA2 + (size_t)(t + 2 - mt) * kstep : cA + (size_t)(t + 2) * kstep);
            const char* b2 = last ? nB : (s2 ? cB2 + (size_t)(t + 2 - mt) * kstep : cB + (size_t)(t + 2) * kstep);
            const char* a3 = a2 + kstep; const char* b3 = b2 + kstep;
            if (last && has_next) S.a_ready(nxt);
            if constexpr (SP2) {
            PG8_LDB(B0, 0, 0); PG8_LDB(B1, 0, 1); PG8_SCHED; PG8_LDA(At, 0, 0); PG8_STAGE(PG8_SA(1, 1), a1 + hstep, voffA);
            PG8_WAIT_V(8); PG8_WAIT_L(0); PG8_BAR; PG8_MMA(0, 0, At, B0); PG8_MMA(0, 1, At, B1); PG8_BAR; PG8_SCHED;
            PG8_LDA(At, 0, 1); PG8_STAGE(PG8_SB(0, 0), b2, voffB); PG8_STAGE(PG8_SB(0, 1), b2 + hstep, voffB); PG8_STAGE(PG8_SA(0, 0), a2, voffA);
            PG8_WAIT_V(8); PG8_WAIT_L(0); PG8_BAR; PG8_MMA(1, 0, At, B0); PG8_MMA(1, 1, At, B1); PG8_BAR; PG8_SCHED;
            PG8_LDB(B0, 1, 0); PG8_LDB(B1, 1, 1); PG8_SCHED; PG8_LDA(At, 1, 0); PG8_STAGE(PG8_SA(0, 1), a2 + hstep, voffA);
            PG8_WAIT_V(8); PG8_WAIT_L(0); PG8_BAR; PG8_MMA(0, 0, At, B0); PG8_MMA(0, 1, At, B1); PG8_BAR; PG8_SCHED;
            PG8_LDA(At, 1, 1); PG8_STAGE(PG8_SB(1, 0), b3, voffB); PG8_STAGE(PG8_SB(1, 1), b3 + hstep, voffB); PG8_STAGE(PG8_SA(1, 0), a3, voffA);
            PG8_WAIT_V(8); PG8_WAIT_L(0); PG8_BAR; PG8_MMA(1, 0, At, B0); PG8_MMA(1, 1, At, B1); PG8_BAR; PG8_SCHED;
            } else {
            PG8_LDB(B0, 0, 0); PG8_SCHED; PG8_LDA(At, 0, 0); PG8_STAGE(PG8_SA(1, 1), a1 + hstep, voffA);
            PG8_WAIT_L(8); PG8_BAR; PG8_WAIT_L(0); PG8_MMA(0, 0, At, B0); PG8_BAR; PG8_SCHED;
            PG8_LDB(B1, 0, 1); PG8_STAGE(PG8_SB(0, 0), b2, voffB);
            PG8_BAR; PG8_WAIT_L(0); PG8_MMA(0, 1, At, B1); PG8_BAR;
            PG8_LDA(At, 0, 1); PG8_STAGE(PG8_SA(0, 0), a2, voffA);
            PG8_BAR; PG8_WAIT_L(0); PG8_MMA(1, 0, At, B0); PG8_BAR; PG8_SCHED;
            PG8_STAGE(PG8_SB(0, 1), b2 + hstep, voffB);
            PG8_WAIT_V(6); PG8_BAR; PG8_MMA(1, 1, At, B1); PG8_BAR;
            PG8_LDB(B0, 1, 0); PG8_SCHED; PG8_LDA(At, 1, 0); PG8_STAGE(PG8_SA(0, 1), a2 + hstep, voffA);
            PG8_WAIT_L(8); PG8_BAR; PG8_WAIT_L(0); PG8_MMA(0, 0, At, B0); PG8_BAR; PG8_SCHED;
            PG8_LDB(B1, 1, 1); PG8_STAGE(PG8_SB(1, 0), b3, voffB);
            PG8_BAR; PG8_WAIT_L(0); PG8_MMA(0, 1, At, B1); PG8_BAR;
            PG8_LDA(At, 1, 1); PG8_STAGE(PG8_SA(1, 0), a3, voffA);
            PG8_BAR; PG8_WAIT_L(0); PG8_MMA(1, 0, At, B0); PG8_BAR; PG8_SCHED;
            PG8_STAGE(PG8_SB(1, 1), b3 + hstep, voffB);
            PG8_WAIT_V(6); PG8_BAR; PG8_MMA(1, 1, At, B1); PG8_BAR;
            }
        }
        if constexpr (ALIGN_EPI) { if (wr == 0) PG8_BAR; }
        if constexpr (!Epi::AFTER_DRAIN) { E(acc, cur, wr, wc, fr, fq); S.done(cur); }
        if (!has_next) break;
#pragma unroll
        for (int a = 0; a < 2; ++a)
#pragma unroll
            for (int b = 0; b < 2; ++b)
#pragma unroll
                for (int m = 0; m < 4; ++m)
#pragma unroll
                    for (int n = 0; n < 2; ++n) acc[a][b][m][n] = (f32x4){0.f, 0.f, 0.f, 0.f};
        cur = nxt; cA = nA; cB = nB; cA2 = nA2; cB2 = nB2; ++ui;
        if constexpr (ALIGN_EPI) { if (wr == 1) PG8_BAR; }
    }
    PG8_WAIT_V(0);
    if constexpr (!ALIGN_EPI) { if (wr == 0) PG8_BAR; }
    PG8_BAR;
    if constexpr (Epi::AFTER_DRAIN) { E.fused(acc, cur, wr, wc, fr, fq, lds, wid, lane); S.done(cur); }
#undef PG8_SA
#undef PG8_SB
#undef PG8_STAGE
#undef PG8_LDA
#undef PG8_LDB
#undef PG8_MMA
#undef PG8_WAIT_V
#undef PG8_WAIT_L
#undef PG8_BAR
#undef PG8_SCHED
}
}
constexpr int D = 1024, NB = 8, SEQ = 4096, FF = 2816, CWID = 31, HD = 64, HQ = 16, HKV = 4, INW = 5632;
constexpr int M_FULL = NB * SEQ;
constexpr int NWAVES = 8, NTHREADS = 512;
constexpr int LDS_BYTES = 147456;
constexpr int RING_BYTES = 131072;
constexpr size_t CTL_ZERO_BYTES = 16384;

#define LAS __attribute__((address_space(3)))
typedef unsigned short bf16;
typedef unsigned v4u __attribute__((ext_vector_type(4)));
typedef unsigned v2u __attribute__((ext_vector_type(2)));
typedef float f32x4 __attribute__((ext_vector_type(4)));
typedef float f32x2 __attribute__((ext_vector_type(2)));
typedef float f32x16 __attribute__((ext_vector_type(16)));
typedef short bf16x8 __attribute__((ext_vector_type(8)));
typedef short s16x4 __attribute__((ext_vector_type(4)));

__device__ const unsigned char T5B[128] = {0, 1, 2, 3, 4, 5, 6, 7, 8, 9, 10, 11, 12, 13, 14, 15, 16, 16, 16, 17, 17, 18, 18, 18, 19, 19, 19, 20, 20, 20, 20, 21, 21, 21, 21, 22, 22, 22, 22, 22, 23, 23, 23, 23, 23, 23, 24, 24, 24, 24, 24, 24, 25, 25, 25, 25, 25, 25, 25, 26, 26, 26, 26, 26, 26, 26, 26, 27, 27, 27, 27, 27, 27, 27, 27, 27, 27, 28, 28, 28, 28, 28, 28, 28, 28, 28, 28, 29, 29, 29, 29, 29, 29, 29, 29, 29, 29, 29, 29, 30, 30, 30, 30, 30, 30, 30, 30, 30, 30, 30, 30, 30, 30, 31, 31, 31, 31, 31, 31, 31, 31, 31, 31, 31, 31, 31, 31, 31};

struct Args {
    const float *x, *ffn1_norm, *ffn1_w_in, *ffn1_w_out, *mix_norm, *w_in, *conv_w, *conv_b, *ln_g, *ln_b, *conv_proj, *q_norm, *k_norm, *sinks, *rel_bias, *attn_wo, *w_out, *ffn2_norm, *ffn2_w_in, *ffn2_w_out;
    float *x1, *x2, *out;
    unsigned* ctl;
    float *ssq0, *ssq1, *ssq2;
    bf16 *W1i, *W1o, *Wmx, *Wcp, *Wao, *Wot, *W2i, *W2o;
    bf16 *xb, *H, *H2, *z, *q, *k, *v, *gc, *ga, *c, *o, *m1, *mg;
    int M; int pad;
};

__device__ __forceinline__ unsigned f2bf(float f) { unsigned u = __builtin_bit_cast(unsigned, f); return (u + 0x7fffu + ((u >> 16) & 1u)) >> 16; }
__device__ __forceinline__ unsigned pk2(float lo, float hi) { return f2bf(lo) | (f2bf(hi) << 16); }
#define LDS_WAIT() asm volatile("s_waitcnt lgkmcnt(0)" ::: "memory")

__device__ __forceinline__ int src_col(int kind, int n0) {
    if (kind == 0) return n0;
    const int u = n0 >> 8, r = n0 & 255, bj = r >> 7, j = r & 127;
    if (kind == 1) return bj * FF + 128 * u + j;
    if (u < 8) return bj * 1024 + 128 * u + j;
    if (u < 12) return 2048 + 64 * (4 * (u - 8) + (j >> 5)) + 32 * bj;
    if (u == 12) return 3072 + 64 * (j >> 5) + 32 * bj;
    if (u == 13) return n0;
    return 3584 + bj * 1024 + 128 * (u - 14) + j;
}
__device__ __forceinline__ void p0_transpose_item(const float* W, int K, int Nsrc, int N, bf16* WT, const float* gain, int kind, LAS float* scr, int item, int lane) {
    const int nblk = N / 32, kb = item / nblk, nb = item % nblk, k0 = 64 * kb, n0 = 32 * nb, s0 = src_col(kind, n0);
    const int kr = lane >> 3, c4 = (lane & 7) * 4;
    f32x4 v[8]; float g[8];
#pragma unroll
    for (int i = 0; i < 8; ++i) v[i] = *(const f32x4*)(W + (size_t)(k0 + kr + 8 * i) * Nsrc + s0 + c4);
#pragma unroll
    for (int i = 0; i < 8; ++i) g[i] = gain ? gain[k0 + kr + 8 * i] : 1.0f;
#pragma unroll
    for (int i = 0; i < 8; ++i) { LAS float* d = scr + (kr + 8 * i) * 33 + c4; d[0] = g[i] * v[i][0]; d[1] = g[i] * v[i][1]; d[2] = g[i] * v[i][2]; d[3] = g[i] * v[i][3]; }
    LDS_WAIT(); asm volatile("" ::: "memory");
    const int c = lane & 7;
#pragma unroll
    for (int j = 0; j < 4; ++j) { const int n = (lane >> 3) + 8 * j; const LAS float* s = scr + (8 * c) * 33 + n;
        v4u o; o.x = pg8::cvt_pk_bf16(s[0 * 33], s[1 * 33]); o.y = pg8::cvt_pk_bf16(s[2 * 33], s[3 * 33]); o.z = pg8::cvt_pk_bf16(s[4 * 33], s[5 * 33]); o.w = pg8::cvt_pk_bf16(s[6 * 33], s[7 * 33]);
        *(v4u*)(WT + (size_t)(n0 + n) * K + k0 + 8 * c) = o; }
    LDS_WAIT(); asm volatile("" ::: "memory");
}
__device__ __forceinline__ float wave_sum(float v) {
#pragma unroll
    for (int o = 1; o < 64; o <<= 1) v += __shfl_xor(v, o);
    return v;
}
__device__ __forceinline__ void p0_prologue(const Args& A, LAS unsigned char* lds, int gw, int NGW, int lane) {
    LAS float* scr = (LAS float*)(lds + (threadIdx.x >> 6) * 16384);
    constexpr int I_IN = (D / 64) * (INW / 32), I_OUT = (FF / 64) * (D / 32), I_SQ = (D / 64) * (D / 32);
    constexpr int NITEMS = 3 * I_IN + 2 * I_OUT + 3 * I_SQ;
    for (int it = gw; it < NITEMS; it += NGW) {
        int r = it;
        if (r < I_IN) { p0_transpose_item(A.ffn1_w_in, D, 2 * FF, 2 * FF, A.W1i, A.ffn1_norm, 1, scr, r, lane); continue; } r -= I_IN;
        if (r < I_IN) { p0_transpose_item(A.w_in, D, INW, INW, A.Wmx, A.mix_norm, 2, scr, r, lane); continue; } r -= I_IN;
        if (r < I_IN) { p0_transpose_item(A.ffn2_w_in, D, 2 * FF, 2 * FF, A.W2i, A.ffn2_norm, 1, scr, r, lane); continue; } r -= I_IN;
        if (r < I_OUT) { p0_transpose_item(A.ffn1_w_out, FF, D, D, A.W1o, nullptr, 0, scr, r, lane); continue; } r -= I_OUT;
        if (r < I_OUT) { p0_transpose_item(A.ffn2_w_out, FF, D, D, A.W2o, nullptr, 0, scr, r, lane); continue; } r -= I_OUT;
        if (r < I_SQ) { p0_transpose_item(A.conv_proj, D, D, D, A.Wcp, nullptr, 0, scr, r, lane); continue; } r -= I_SQ;
        if (r < I_SQ) { p0_transpose_item(A.attn_wo, D, D, D, A.Wao, nullptr, 0, scr, r, lane); continue; } r -= I_SQ;
        p0_transpose_item(A.w_out, D, D, D, A.Wot, nullptr, 0, scr, r, lane);
    }
    for (int m = 2 * gw; m < A.M; m += 2 * NGW) {
        const f32x4* xr = (const f32x4*)(A.x + (size_t)m * D) + lane;
        f32x4 v[8];
#pragma unroll
        for (int j = 0; j < 8; ++j) v[j] = xr[64 * j];
        float s0 = 0.f, s1 = 0.f;
#pragma unroll
        for (int j = 0; j < 4; ++j) { s0 += (v[j][0] * v[j][0] + v[j][1] * v[j][1]) + (v[j][2] * v[j][2] + v[j][3] * v[j][3]); s1 += (v[j + 4][0] * v[j + 4][0] + v[j + 4][1] * v[j + 4][1]) + (v[j + 4][2] * v[j + 4][2] + v[j + 4][3] * v[j + 4][3]); }
        s0 = wave_sum(s0); s1 = wave_sum(s1);
        v2u* o8 = (v2u*)(A.xb + (size_t)m * D) + lane;
#pragma unroll
        for (int j = 0; j < 8; ++j) { v2u w; w.x = pg8::cvt_pk_bf16(v[j][0], v[j][1]); w.y = pg8::cvt_pk_bf16(v[j][2], v[j][3]); o8[64 * j] = w; }
        if (lane < 2) { const float s = lane ? s1 : s0; A.ssq0[m + lane] = s; A.ssq1[m + lane] = 0.f; A.ssq2[m + lane] = 0.f; }
    }
}

__device__ __forceinline__ f32x2 bf2_to_f2(unsigned z) { return (f32x2){__uint_as_float(z << 16), __uint_as_float(z & 0xffff0000u)}; }
__device__ __forceinline__ void conv_phase(const Args& A, LAS unsigned char* lds) {
    int tid_ = threadIdx.x; asm volatile("" : "+v"(tid_));
    const int tid = tid_, lane = tid & 63, wid = tid >> 6, c0 = 2 * tid;
    LAS float* Y = (LAS float*)lds;
    f32x2 w[CWID];
#pragma unroll
    for (int k = 0; k < CWID; ++k) w[k] = *(const f32x2*)(A.conv_w + k * D + c0);
    const f32x2 bias = *(const f32x2*)(A.conv_b + c0);
    const int nchunks = A.M / 128;
    for (int ch = blockIdx.x; ch < nchunks; ch += gridDim.x) {
        const int t0 = ch * 128; const bool first = (t0 % SEQ) == 0;
        const bf16* zp = A.z + (size_t)t0 * D + c0;
        f32x2 h[32];
        unsigned zin[32];
#pragma unroll
        for (int s = 0; s < 32; ++s) zin[s] = *(const unsigned*)(zp + (size_t)s * D);
#pragma unroll
        for (int i = 2; i < 32; ++i) { unsigned zz = 0u; if (!first) zz = *(const unsigned*)(zp - (size_t)(32 - i) * D); h[i] = bf2_to_f2(zz); }
#pragma unroll 1
        for (int tb = 0; tb < 128; tb += 32) {
            unsigned zn[32];
            const bf16* zq = zp + (size_t)(tb + 32 < 128 ? tb + 32 : tb) * D;
#pragma unroll
            for (int s = 0; s < 32; ++s) zn[s] = *(const unsigned*)(zq + (size_t)s * D);
#pragma unroll
            for (int s = 0; s < 32; ++s) {
                h[s] = bf2_to_f2(zin[s]);
                f32x2 a = bias;
#pragma unroll
                for (int k = 0; k < CWID; ++k) a = __builtin_elementwise_fma(w[k], h[(s + 2 + k) & 31], a);
                *(LAS f32x2*)(Y + s * D + c0) = a;
            }
#pragma unroll
            for (int s = 0; s < 32; ++s) zin[s] = zn[s];
            __syncthreads();
#pragma unroll 1
            for (int i = 0; i < 4; ++i) {
                const int s = wid * 4 + i; f32x4 y[4]; float sm = 0.f;
#pragma unroll
                for (int j = 0; j < 4; ++j) { y[j] = *(const LAS f32x4*)(Y + s * D + 4 * lane + 256 * j); sm += (y[j][0] + y[j][1]) + (y[j][2] + y[j][3]); }
                const float mu = wave_sum(sm) * (1.0f / D); float sq = 0.f;
#pragma unroll
                for (int j = 0; j < 4; ++j) { y[j] = y[j] - mu; sq += (y[j][0] * y[j][0] + y[j][1] * y[j][1]) + (y[j][2] * y[j][2] + y[j][3] * y[j][3]); }
                const float rs = __builtin_amdgcn_rsqf(wave_sum(sq) * (1.0f / D) + 1e-6f);
                bf16* orow = A.c + (size_t)(t0 + tb + s) * D;
#pragma unroll
                for (int j = 0; j < 4; ++j) {
                    const f32x4 g = *(const f32x4*)(A.ln_g + 4 * lane + 256 * j), b = *(const f32x4*)(A.ln_b + 4 * lane + 256 * j);
                    f32x4 v = y[j] * rs * g + b; v = v * pg8::sigmoid4(v);
                    v2u wv; wv.x = pg8::cvt_pk_bf16(v[0], v[1]); wv.y = pg8::cvt_pk_bf16(v[2], v[3]);
                    *(v2u*)(orow + 4 * lane + 256 * j) = wv;
                }
            }
            __syncthreads();
        }
    }
}

constexpr int ATT_K_OFF = 0, ATT_V_OFF = 32768, ATT_TB_OFF = 65536, ATT_LS_OFF = 69632, ATT_OST_OFF = 73728;
__device__ __forceinline__ s16x4 vtr(const LAS unsigned char* p) { typedef short v4i16_t __attribute__((ext_vector_type(4))); return __builtin_bit_cast(s16x4, __builtin_amdgcn_ds_read_tr16_b64_v4i16((LAS v4i16_t*)p)); }
__device__ __forceinline__ void attn_phase(const Args& A, LAS unsigned char* lds) {
    int tid_ = threadIdx.x; asm volatile("" : "+v"(tid_));
    const int tid = tid_, lane = tid & 63, r32 = lane & 31, hi = lane >> 5; const int wid = __builtin_amdgcn_readfirstlane(tid >> 6);
    const int nunits = (A.M / 128) * HKV;
    LAS float* TB = (LAS float*)(lds + ATT_TB_OFF);
    LAS float* LS = (LAS float*)(lds + ATT_LS_OFF) + wid * 64;
    LAS bf16* OST = (LAS bf16*)(lds + ATT_OST_OFF) + wid * 2048;
    for (int u = blockIdx.x; u < nunits; u += gridDim.x) {
        const int blk = u >> 2, hk = u & 3, t0 = blk * 128; const bool first = (t0 % SEQ) == 0;
#pragma unroll
        for (int i = 0; i < 4; ++i) {
            const int idx = tid + 512 * i, key = idx >> 3, cc = idx & 7;
            if (!(first && key < 128)) {
                const size_t g = (size_t)(t0 - 128 + key) * 256 + hk * 64 + cc * 8;
                const v4u kv = *(const v4u*)(A.k + g), vv = *(const v4u*)(A.v + g);
                *(LAS v4u*)(lds + ATT_K_OFF + (((key >> 5) * 4 + (cc >> 1)) * 2 + (cc & 1)) * 512 + (key & 31) * 16) = kv;
                *(LAS v4u*)(lds + ATT_V_OFF + ((key >> 2) * 2 + (cc >> 2)) * 256 + (key & 3) * 64 + (cc & 3) * 16) = vv;
            }
        }
        for (int e = tid; e < 4 * 192; e += NTHREADS) {
            const int g = e / 192, dist = e % 192 - 32;
            TB[e] = (dist >= 0 && dist < 128) ? A.rel_bias[T5B[dist] * HQ + hk * 4 + g] * pg8::LOG2E : -3.0e38f;
        }
        __syncthreads();
#pragma unroll 1
        for (int ti = 0; ti < 2; ++ti) {
            const int task = wid + 8 * ti, g = task >> 2, sub = task & 3, h = hk * 4 + g;
            const size_t qrow = (size_t)(t0 + 32 * sub + r32) * D + h * HD;
            bf16x8 qf[4];
#pragma unroll
            for (int d0 = 0; d0 < 4; ++d0) qf[d0] = *(const bf16x8*)(A.q + qrow + 16 * d0 + 8 * hi);
            f32x16 s[5];
            const LAS float* tb = TB + g * 192 + 32 + r32 - 4 * hi;
#pragma unroll
            for (int di = 0; di < 5; ++di)
#pragma unroll
                for (int r = 0; r < 16; ++r) s[di][r] = tb[32 * di - ((r & 3) + 8 * (r >> 2))];
            const float sink2 = A.sinks[h] * pg8::LOG2E;
            float mx = sink2;
#pragma unroll
            for (int di = 0; di < 5; ++di) {
                const int kt = sub + 4 - di;
                if (!(first && kt < 4)) {
#pragma unroll
                    for (int d0 = 0; d0 < 4; ++d0) {
                        const bf16x8 kf = *(const LAS bf16x8*)(lds + ATT_K_OFF + ((kt * 4 + d0) * 2 + hi) * 512 + r32 * 16);
                        s[di] = __builtin_amdgcn_mfma_f32_32x32x16_bf16(kf, qf[d0], s[di], 0, 0, 0);
                    }
#pragma unroll
                    for (int r = 0; r < 16; ++r) mx = fmaxf(mx, s[di][r]);
                }
            }
            mx = fmaxf(mx, __shfl_xor(mx, 32));
            float l = 0.f;
            f32x16 o0, o1;
#pragma unroll
            for (int r = 0; r < 16; ++r) { o0[r] = 0.f; o1[r] = 0.f; }
#pragma unroll
            for (int di = 0; di < 5; ++di) {
                const int kt = sub + 4 - di;
                if (!(first && kt < 4)) {
#pragma unroll
                    for (int r = 0; r < 16; ++r) { s[di][r] = __builtin_amdgcn_exp2f(s[di][r] - mx); l += s[di][r]; }
#pragma unroll
                    for (int s2 = 0; s2 < 2; ++s2) {
                        v4u pw; pw.x = pg8::cvt_pk_bf16(s[di][8 * s2 + 0], s[di][8 * s2 + 1]); pw.y = pg8::cvt_pk_bf16(s[di][8 * s2 + 2], s[di][8 * s2 + 3]);
                        pw.z = pg8::cvt_pk_bf16(s[di][8 * s2 + 4], s[di][8 * s2 + 5]); pw.w = pg8::cvt_pk_bf16(s[di][8 * s2 + 6], s[di][8 * s2 + 7]);
                        const bf16x8 pa = __builtin_bit_cast(bf16x8, pw);
                        const LAS unsigned char* vp = lds + ATT_V_OFF + ((8 * kt + 4 * s2 + hi) * 2) * 256 + ((lane & 15) >> 2) * 64 + (((lane >> 4) & 1) * 16 + (lane & 3) * 4) * 2;
                        const s16x4 a0 = vtr(vp), a1 = vtr(vp + 2 * 512), b0 = vtr(vp + 256), b1 = vtr(vp + 256 + 2 * 512);
                        const bf16x8 v0 = (bf16x8){a0[0], a0[1], a0[2], a0[3], a1[0], a1[1], a1[2], a1[3]};
                        const bf16x8 v1 = (bf16x8){b0[0], b0[1], b0[2], b0[3], b1[0], b1[1], b1[2], b1[3]};
                        o0 = __builtin_amdgcn_mfma_f32_32x32x16_bf16(pa, v0, o0, 0, 0, 0);
                        o1 = __builtin_amdgcn_mfma_f32_32x32x16_bf16(pa, v1, o1, 0, 0, 0);
                    }
                }
            }
            l += __shfl_xor(l, 32);
            l += __builtin_amdgcn_exp2f(sink2 - mx);
            if (hi == 0) LS[r32] = __builtin_amdgcn_rcpf(l);
#pragma unroll
            for (int r = 0; r < 16; ++r) {
                const int qq = (r & 3) + 8 * (r >> 2) + 4 * hi;
                const float li = LS[qq];
                OST[qq * 64 + r32] = (bf16)(pg8::cvt_pk_bf16(o0[r] * li, 0.f) & 0xffffu);
                OST[qq * 64 + 32 + r32] = (bf16)(pg8::cvt_pk_bf16(o1[r] * li, 0.f) & 0xffffu);
            }
            bf16* ob = A.o + (size_t)(t0 + 32 * sub) * D + h * HD;
#pragma unroll
            for (int i = 0; i < 4; ++i) { const int row = i * 8 + (lane >> 3), chn = lane & 7; *(v4u*)(ob + (size_t)row * D + chn * 8) = *(const LAS v4u*)(OST + row * 64 + chn * 8); }
        }
        __syncthreads();
    }
}
typedef unsigned gu32_t;
#define XB_TMO      128
#define XB_XCNT(j)  (256  + 64 * (j))
#define XB_XSUB(j)  (1280 + 64 * (j))
#define XB_XGEN(j)  (2304 + 64 * (j))
#define XB_TOP      3328
#define XB_TOPGEN   3392
#define XCD_BAR_WORDS 3456
#define XB_SPIN_CAP (1u << 18)

__device__ __forceinline__ unsigned xb_ld(unsigned* p)              { return __hip_atomic_load(p, __ATOMIC_RELAXED, __HIP_MEMORY_SCOPE_AGENT); }
__device__ __forceinline__ unsigned xb_add(unsigned* p, unsigned v) { return __hip_atomic_fetch_add(p, v, __ATOMIC_RELAXED, __HIP_MEMORY_SCOPE_AGENT); }
__device__ __forceinline__ unsigned xb_xcc_id() { return (unsigned)__builtin_amdgcn_s_getreg((3 << 11) | 20) & 0xFu; }
#define XB_SPIN(cond, bar) do { unsigned _sp = 0; while (cond) { __builtin_amdgcn_s_sleep(1); \
    if ((++_sp & 255u) == 0u) { if (xb_ld(&(bar)[XB_TMO])) break; if (_sp > XB_SPIN_CAP) { atomicAdd(&(bar)[XB_TMO], 1u); break; } } } } while (0)

struct XcdBarrier {
    unsigned* bar; unsigned x;
    volatile LAS unsigned* st;
};

__device__ __forceinline__ XcdBarrier xcd_barrier_post(unsigned* bar, volatile LAS unsigned* st) {
    XcdBarrier b; b.bar = bar; b.x = xb_xcc_id(); b.st = st;
    if (threadIdx.x == 0) (void)xb_add(&bar[XB_XCNT(b.x)], 1u);
    return b;
}
__device__ __forceinline__ void xcd_barrier_complete(unsigned* bar, unsigned x, unsigned& nloc, unsigned& nx) {
    const unsigned G = gridDim.x * gridDim.y * gridDim.z;
    unsigned sum, cnt, mine, sp = 0u;
    for (;;) {
        sum = 0u; cnt = 0u; mine = 0u;
#pragma unroll
        for (unsigned j = 0; j < 16; ++j) { const unsigned c = xb_ld(&bar[XB_XCNT(j)]); sum += c; cnt += (c > 0u) ? 1u : 0u; mine = (j == x) ? c : mine; }
        if (sum == G) break;
        __builtin_amdgcn_s_sleep(1);
        if ((++sp & 255u) == 0u) { if (xb_ld(&bar[XB_TMO])) break; if (sp > XB_SPIN_CAP) { atomicAdd(&bar[XB_TMO], 1u); break; } }
    }
    nloc = mine > 0u ? mine : 1u; nx = cnt > 0u ? cnt : 1u;
}

__device__ __forceinline__ void xcd_barrier(const XcdBarrier& b) {
    asm volatile("s_waitcnt vmcnt(0)" ::: "memory");
    __syncthreads();
    if (threadIdx.x == 0) {
        unsigned* bar = b.bar;
        __builtin_amdgcn_s_waitcnt(0);
        unsigned nloc = b.st[0], nx = b.st[1];
        if (nloc == 0u) { xcd_barrier_complete(bar, b.x, nloc, nx); b.st[0] = nloc; b.st[1] = nx; }
        const unsigned old = xb_add(&bar[XB_XSUB(b.x)], 1u);
        const unsigned gen = old / nloc;
        if (old + 1u == (gen + 1u) * nloc) {
            __builtin_amdgcn_fence(__ATOMIC_RELEASE, "agent");
            asm volatile("s_waitcnt vmcnt(0)" ::: "memory");
            const unsigned og = xb_add(&bar[XB_TOP], 1u);
            const unsigned tg = og / nx;
            if (og + 1u == (tg + 1u) * nx) xb_add(&bar[XB_TOPGEN], 1u);
            else XB_SPIN(xb_ld(&bar[XB_TOPGEN]) == tg, bar);
            __builtin_amdgcn_fence(__ATOMIC_ACQUIRE, "agent");
            xb_add(&bar[XB_XGEN(b.x)], 1u);
            asm volatile("s_waitcnt vmcnt(0)" ::: "memory");
        } else {
            XB_SPIN(xb_ld(&bar[XB_XGEN(b.x)]) == gen, bar);
            __builtin_amdgcn_fence(__ATOMIC_ACQUIRE, "agent");
            asm volatile("s_waitcnt vmcnt(0)" ::: "memory");
        }
    }
    __syncthreads();
}

typedef pg8::EpiResid<true, true> EpiResTH; typedef pg8::EpiResid<true, false> EpiResTF; typedef pg8::EpiResid<false, true> EpiResFH;
#ifndef STOP_AFTER
#define STOP_AFTER 99
#endif
#ifndef DUP_MASK
#define DUP_MASK 0
#endif
__global__ void __launch_bounds__(NTHREADS, 2) mega_fwd(Args A) {
    extern __shared__ __attribute__((aligned(16))) unsigned char lds_raw[];
    LAS unsigned char* lds = (LAS unsigned char*)lds_raw;
    const int tid = threadIdx.x, lane = tid & 63, wave = tid >> 6, G = gridDim.x;
    const int vcu = (G % 8 == 0) ? ((int)blockIdx.x % 8) * (G / 8) + (int)blockIdx.x / 8 : (int)blockIdx.x;
    const int M = A.M;
    volatile LAS unsigned* MISC = (volatile LAS unsigned*)(lds + RING_BYTES);
    if (tid < 16) MISC[tid] = 0u;
    __syncthreads();
    const XcdBarrier bar = xcd_barrier_post(A.ctl, MISC);
#define GRID_SYNC() xcd_barrier(bar)
#define GEMM_PHASE(EPI_T, AP, BP, NN, KK, ...) do { pg8::Gemm g_{AP, BP, M, NN, KK}; pg8::StaticOrder S_; S_.init(M, NN, G, (int)blockIdx.x); EPI_T E_{__VA_ARGS__}; \
        pg8::gemm_phase<EPI_T, pg8::StaticOrder, true, true>(lds, g_, S_, E_); } while (0)

    p0_prologue(A, lds, vcu * NWAVES + wave, G * NWAVES, lane);
    if (DUP_MASK & 1) { __syncthreads(); p0_prologue(A, lds, vcu * NWAVES + wave, G * NWAVES, lane); }
    GRID_SYNC();
    if (DUP_MASK & 8) GEMM_PHASE(pg8::EpiSwiglu, A.xb, A.W1i, 2 * FF, D, A.H, FF, A.ssq0);
    if (DUP_MASK & 64) GEMM_PHASE(pg8::EpiProbe<0>, A.xb, A.W1i, 2 * FF, D, A.H, FF, A.ssq0);
    if (DUP_MASK & 128) GEMM_PHASE(pg8::EpiProbe<1>, A.xb, A.W1i, 2 * FF, D, A.H, FF, A.ssq0);
    GEMM_PHASE(pg8::EpiSwiglu, A.xb, A.W1i, 2 * FF, D, A.H, FF, A.ssq0);
    GRID_SYNC();
    if (STOP_AFTER <= 1) return;
    GEMM_PHASE(EpiResTH, A.H, A.W1o, D, FF, A.x, A.x1, D, A.xb, A.ssq1);
    GRID_SYNC();
    if (STOP_AFTER <= 2) return;
    GEMM_PHASE(pg8::EpiMix, A.xb, A.Wmx, INW, D, A.ssq1, A.z, A.q, A.k, A.v, A.gc, A.ga, A.q_norm, A.k_norm);
    if (DUP_MASK & 16) GEMM_PHASE(pg8::EpiMix, A.xb, A.Wmx, INW, D, A.ssq1, A.z, A.q, A.k, A.v, A.gc, A.ga, A.q_norm, A.k_norm);
    GRID_SYNC();
    if (STOP_AFTER <= 3) return;
    conv_phase(A, lds);
    if (DUP_MASK & 2) conv_phase(A, lds);
    attn_phase(A, lds);
    if (DUP_MASK & 4) attn_phase(A, lds);
    GRID_SYNC();
    if (STOP_AFTER <= 4) return;
    do { pg8::Gemm g_{A.c, A.Wcp, M, D, D, A.o, A.Wao}; pg8::StaticOrder S_; S_.init(M, D, G, (int)blockIdx.x); pg8::EpiMerge E_{A.gc, A.ga, A.mg};
         pg8::gemm_phase<pg8::EpiMerge, pg8::StaticOrder, true, true, 2>(lds, g_, S_, E_); } while (0);
    GRID_SYNC();
    if (STOP_AFTER <= 6) return;
    GEMM_PHASE(EpiResTF, A.mg, A.Wot, D, D, A.x1, A.x2, D, A.xb, A.ssq2);
    GRID_SYNC();
    if (STOP_AFTER <= 7) return;
    GEMM_PHASE(pg8::EpiSwiglu, A.xb, A.W2i, 2 * FF, D, A.H2, FF, A.ssq2);
    if (DUP_MASK & 32) GEMM_PHASE(pg8::EpiSwiglu, A.xb, A.W2i, 2 * FF, D, A.H2, FF, A.ssq2);
    GRID_SYNC();
    GEMM_PHASE(EpiResFH, A.H2, A.W2o, D, FF, A.x2, A.out, D, nullptr, nullptr);
#undef GEMM_PHASE
#undef GRID_SYNC
}

static size_t ws_map(Args& a, unsigned char* ws, int M, bool alias) {
    size_t off = 0;
    auto take = [&](size_t bytes) { unsigned char* p = ws + off; off += (bytes + 255) & ~(size_t)255; return p; };
    a.ctl = (unsigned*)take(1u << 20);
    a.ssq0 = (float*)take((size_t)M * 4); a.ssq1 = (float*)take((size_t)M * 4); a.ssq2 = (float*)take((size_t)M * 4);
    a.W1i = (bf16*)take((size_t)2 * FF * D * 2); a.W1o = (bf16*)take((size_t)D * FF * 2); a.Wmx = (bf16*)take((size_t)INW * D * 2);
    a.Wcp = (bf16*)take((size_t)D * D * 2); a.Wao = (bf16*)take((size_t)D * D * 2); a.Wot = (bf16*)take((size_t)D * D * 2);
    a.W2i = (bf16*)take((size_t)2 * FF * D * 2); a.W2o = (bf16*)take((size_t)D * FF * 2);
    const size_t act = (size_t)M * D * 2;
    a.xb = (bf16*)take(act);
    a.H = (bf16*)take((size_t)M * FF * 2); a.H2 = a.H;
    if (alias) {
        a.z = a.H; a.q = a.z + (size_t)M * D; a.k = a.q + (size_t)M * D; a.v = a.k + (size_t)M * 256;
        a.gc = (bf16*)take(act); a.ga = (bf16*)take(act); a.c = (bf16*)take(act);
        a.o = a.xb; a.m1 = nullptr; a.mg = a.z;
    } else {
        a.z = (bf16*)take(act); a.q = (bf16*)take(act); a.k = (bf16*)take((size_t)M * 256 * 2); a.v = (bf16*)take((size_t)M * 256 * 2);
        a.gc = (bf16*)take(act); a.ga = (bf16*)take(act); a.c = (bf16*)take(act);
        a.o = (bf16*)take(act); a.m1 = nullptr; a.mg = (bf16*)take(act);
    }
    return off;
}
static void set_inputs(Args& a, void* const* d_in) {
    a.x = (const float*)d_in[0]; a.ffn1_norm = (const float*)d_in[1]; a.ffn1_w_in = (const float*)d_in[2]; a.ffn1_w_out = (const float*)d_in[3];
    a.mix_norm = (const float*)d_in[4]; a.w_in = (const float*)d_in[5]; a.conv_w = (const float*)d_in[6]; a.conv_b = (const float*)d_in[7];
    a.ln_g = (const float*)d_in[8]; a.ln_b = (const float*)d_in[9]; a.conv_proj = (const float*)d_in[10]; a.q_norm = (const float*)d_in[11];
    a.k_norm = (const float*)d_in[12]; a.sinks = (const float*)d_in[13]; a.rel_bias = (const float*)d_in[14]; a.attn_wo = (const float*)d_in[15];
    a.w_out = (const float*)d_in[16]; a.ffn2_norm = (const float*)d_in[17]; a.ffn2_w_in = (const float*)d_in[18]; a.ffn2_w_out = (const float*)d_in[19];
}
static int g_grid = 0;
static bool launch_mega(Args& a, hipStream_t stream) {
    if (g_grid == 0) {
        int dev = 0, cus = 0, per_cu = 0;
        if (hipGetDevice(&dev) != hipSuccess || hipDeviceGetAttribute(&cus, hipDeviceAttributeMultiprocessorCount, dev) != hipSuccess) { g_grid = -1; return false; }
        if (hipFuncSetAttribute((const void*)mega_fwd, hipFuncAttributeMaxDynamicSharedMemorySize, LDS_BYTES) != hipSuccess) { fprintf(stderr, "hipFuncSetAttribute failed\n"); g_grid = -1; return false; }
        if (hipOccupancyMaxActiveBlocksPerMultiprocessor(&per_cu, (const void*)mega_fwd, NTHREADS, LDS_BYTES) != hipSuccess || per_cu < 1) { fprintf(stderr, "occupancy query: %d blocks per CU\n", per_cu); g_grid = -1; (void)hipGetLastError(); return false; }
        g_grid = cus;
    }
    if (g_grid < 0) return false;
    void* args[] = {&a};
    const hipError_t e = hipLaunchCooperativeKernel((const void*)mega_fwd, dim3(g_grid), dim3(NTHREADS), args, LDS_BYTES, stream);
    if (e != hipSuccess) { fprintf(stderr, "cooperative launch failed: %s (grid %d)\n", hipGetErrorString(e), g_grid); return false; }
    return true;
}
#if DEBUG_ORACLE
namespace nv {
constexpr int S = SEQ, B = NB;
constexpr float EPS = 1e-6f;
__device__ __forceinline__ float sigmoidf_(float v) { return 1.f / (1.f + expf(-v)); }
__device__ __forceinline__ float siluf_(float v) { return v / (1.f + expf(-v)); }
__device__ __forceinline__ float block_sum_256(float v, float* red) {
    for (int o = 32; o > 0; o >>= 1) v += __shfl_xor(v, o);
    const int w = threadIdx.x >> 6, l = threadIdx.x & 63;
    __syncthreads(); if (l == 0) red[w] = v; __syncthreads();
    return red[0] + red[1] + red[2] + red[3];
}
__global__ void rms_rows(const float* x, const float* g, float* out) {
    __shared__ float red[4];
    const size_t r = blockIdx.x;
    const float4 v = ((const float4*)(x + r * D))[threadIdx.x];
    const float ss = block_sum_256(v.x * v.x + v.y * v.y + v.z * v.z + v.w * v.w, red);
    const float rs = rsqrtf(ss * (1.f / D) + EPS);
    const float4 gg = ((const float4*)g)[threadIdx.x];
    float4 o; o.x = v.x * rs * gg.x; o.y = v.y * rs * gg.y; o.z = v.z * rs * gg.z; o.w = v.w * rs * gg.w;
    ((float4*)(out + r * D))[threadIdx.x] = o;
}
__global__ void gemm_f32(const float* __restrict__ A, int lda, const float* __restrict__ Bm, int ldb, float* __restrict__ C, int ldc, int K) {
    __shared__ float As[16][68];
    __shared__ float Bs[16][68];
    const int tx = threadIdx.x & 15, ty = threadIdx.x >> 4;
    const int m0 = blockIdx.y * 64, n0 = blockIdx.x * 64;
    float acc[4][4] = {};
    for (int k0 = 0; k0 < K; k0 += 16) {
        {
            const int r = threadIdx.x >> 2, kq = (threadIdx.x & 3) * 4;
            const float4 a = *(const float4*)(A + (size_t)(m0 + r) * lda + k0 + kq);
            As[kq + 0][r] = a.x; As[kq + 1][r] = a.y; As[kq + 2][r] = a.z; As[kq + 3][r] = a.w;
            const int kr = threadIdx.x >> 4, c4 = (threadIdx.x & 15) * 4;
            *(float4*)&Bs[kr][c4] = *(const float4*)(Bm + (size_t)(k0 + kr) * ldb + n0 + c4);
        }
        __syncthreads();
#pragma unroll
        for (int k = 0; k < 16; ++k) {
            const float4 a = *(const float4*)&As[k][ty * 4];
            const float4 b = *(const float4*)&Bs[k][tx * 4];
            const float av[4] = {a.x, a.y, a.z, a.w}, bv[4] = {b.x, b.y, b.z, b.w};
#pragma unroll
            for (int i = 0; i < 4; ++i)
#pragma unroll
                for (int j = 0; j < 4; ++j) acc[i][j] = fmaf(av[i], bv[j], acc[i][j]);
        }
        __syncthreads();
    }
#pragma unroll
    for (int i = 0; i < 4; ++i) { float4 o; o.x = acc[i][0]; o.y = acc[i][1]; o.z = acc[i][2]; o.w = acc[i][3]; *(float4*)(C + (size_t)(m0 + ty * 4 + i) * ldc + n0 + tx * 4) = o; }
}
__global__ void swiglu_k(const float* U, float* H, int rows) {
    const size_t i = (size_t)blockIdx.x * blockDim.x + threadIdx.x;
    if (i >= (size_t)rows * FF) return;
    const size_t t = i / FF; const int j = (int)(i % FF);
    H[i] = siluf_(U[t * (2 * FF) + j]) * U[t * (2 * FF) + FF + j];
}
__global__ void resid_k(const float* xin, const float* y, float scale, float* out, size_t n) {
    const size_t i = (size_t)blockIdx.x * blockDim.x + threadIdx.x;
    if (i < n) out[i] = xin[i] + scale * y[i];
}
__global__ void glu_k(const float* P, float* z, int rows) {
    const size_t i = (size_t)blockIdx.x * blockDim.x + threadIdx.x;
    if (i >= (size_t)rows * D) return;
    const size_t t = i / D; const int c = (int)(i % D);
    z[i] = P[t * INW + c] * sigmoidf_(P[t * INW + D + c]);
}
__global__ void conv_k(const float* z, const float* w, const float* bias, float* y) {
    const size_t i = (size_t)blockIdx.x * blockDim.x + threadIdx.x;
    if (i >= (size_t)S * D) return;
    const int t = (int)(i / D), c = (int)(i % D);
    float acc = bias[c];
    for (int k = 0; k < CWID; ++k) { const int tt = t - (CWID - 1) + k; if (tt >= 0) acc = fmaf(w[k * D + c], z[(size_t)tt * D + c], acc); }
    y[i] = acc;
}
__global__ void ln_silu_k(const float* y, const float* g, const float* b, float* out) {
    __shared__ float red[4];
    const size_t r = blockIdx.x;
    const float4 v = ((const float4*)(y + r * D))[threadIdx.x];
    const float mu = block_sum_256(v.x + v.y + v.z + v.w, red) * (1.f / D);
    const float dx = v.x - mu, dy = v.y - mu, dz = v.z - mu, dw = v.w - mu;
    const float var = block_sum_256(dx * dx + dy * dy + dz * dz + dw * dw, red) * (1.f / D);
    const float rs = rsqrtf(var + EPS);
    const float4 gg = ((const float4*)g)[threadIdx.x], bb = ((const float4*)b)[threadIdx.x];
    float4 o; o.x = siluf_(dx * rs * gg.x + bb.x); o.y = siluf_(dy * rs * gg.y + bb.y); o.z = siluf_(dz * rs * gg.z + bb.z); o.w = siluf_(dw * rs * gg.w + bb.w);
    ((float4*)(out + r * D))[threadIdx.x] = o;
}
__global__ void qknorm_k(const float* P, const float* qg, const float* kg, float* qn, float* kn) {
    const int wv = (blockIdx.x * 4) + (threadIdx.x >> 6), lane = threadIdx.x & 63;
    const int t = wv / (HQ + HKV), hh = wv % (HQ + HKV);
    if (t >= S) return;
    const bool isq = hh < HQ;
    const int h = isq ? hh : hh - HQ;
    const float v = P[(size_t)t * INW + (isq ? 2 * D + h * HD : 3 * D + h * HD) + lane];
    float ss = v * v;
    for (int o = 32; o > 0; o >>= 1) ss += __shfl_xor(ss, o);
    const float rs = rsqrtf(ss * (1.f / HD) + EPS);
    if (isq) qn[(size_t)t * (HQ * HD) + h * HD + lane] = v * rs * qg[lane];
    else     kn[(size_t)t * (HKV * HD) + h * HD + lane] = v * rs * kg[lane];
}
__global__ void attn_k(const float* qn, const float* kn, const float* P, const float* sinks, const float* rel_bias, float* o) {
    const int wv = (blockIdx.x * 4) + (threadIdx.x >> 6), lane = threadIdx.x & 63;
    const int t = wv / HQ, h = wv % HQ, hk = h / (HQ / HKV);
    if (t >= S) return;
    const float* q = qn + (size_t)t * (HQ * HD) + h * HD;
    float s[2];
#pragma unroll
    for (int u = 0; u < 2; ++u) {
        const int dist = lane + 64 * u, key = t - dist;
        float acc = -3.0e38f;
        if (key >= 0) {
            const float* kr = kn + (size_t)key * (HKV * HD) + hk * HD;
            float d = 0.f;
            for (int e = 0; e < HD; ++e) d = fmaf(q[e], kr[e], d);
            acc = d * 0.125f + rel_bias[T5B[dist] * HQ + h];
        }
        s[u] = acc;
    }
    const float sink = sinks[h];
    float m = fmaxf(fmaxf(s[0], s[1]), sink);
    for (int of = 32; of > 0; of >>= 1) m = fmaxf(m, __shfl_xor(m, of));
    float p0 = (t - lane >= 0) ? expf(s[0] - m) : 0.f, p1 = (t - lane - 64 >= 0) ? expf(s[1] - m) : 0.f;
    float l = p0 + p1;
    for (int of = 32; of > 0; of >>= 1) l += __shfl_xor(l, of);
    l += expf(sink - m);
    const float inv = 1.f / l;
    float acc = 0.f;
    for (int j = 0; j < 64; ++j) {
        const float pj0 = __shfl(p0, j), pj1 = __shfl(p1, j);
        const int k0 = t - j, k1 = t - j - 64;
        if (k0 >= 0) acc = fmaf(pj0, P[(size_t)k0 * INW + 3 * D + HKV * HD + hk * HD + lane], acc);
        if (k1 >= 0) acc = fmaf(pj1, P[(size_t)k1 * INW + 3 * D + HKV * HD + hk * HD + lane], acc);
    }
    o[(size_t)t * (HQ * HD) + h * HD + lane] = acc * inv;
}
__global__ void merge_k(const float* P, const float* a, const float* b, float* mg, int rows) {
    const size_t i = (size_t)blockIdx.x * blockDim.x + threadIdx.x;
    if (i >= (size_t)rows * D) return;
    const size_t t = i / D; const int c = (int)(i % D);
    mg[i] = sigmoidf_(P[t * INW + 3584 + c]) * a[i] + sigmoidf_(P[t * INW + 4608 + c]) * b[i];
}
static void gemm(const float* A, int lda, const float* Bm, int ldb, float* C, int ldc, int M, int N, int K, hipStream_t st) {
    hipLaunchKernelGGL(gemm_f32, dim3(N / 64, M / 64), dim3(256), 0, st, A, lda, Bm, ldb, C, ldc, K);
}
__global__ void cmp_k(const void* a, int a_is_bf16, int lda, float ascale, const float* ref, int ldr, int sig, int rows, int cols, unsigned* slot) {
    const size_t i = (size_t)blockIdx.x * blockDim.x + threadIdx.x;
    float d = 0.f, r2 = 0.f;
    if (i < (size_t)rows * cols) {
        const size_t t = i / cols; const int c = (int)(i % cols);
        float av = a_is_bf16 ? __uint_as_float((unsigned)((const unsigned short*)a)[t * lda + c] << 16) : ((const float*)a)[t * lda + c];
        float rv = ref[t * ldr + c]; if (sig) rv = sigmoidf_(rv);
        d = fabsf(av * ascale - rv); if (!(d == d)) d = 1e30f; r2 = rv * rv;
    }
    float d2 = d * d;
    for (int o = 32; o > 0; o >>= 1) { d = fmaxf(d, __shfl_xor(d, o)); r2 += __shfl_xor(r2, o); d2 += __shfl_xor(d2, o); }
    if ((threadIdx.x & 63) == 0) { atomicMax(slot, __float_as_uint(d)); atomicAdd((float*)(slot + 1), r2); atomicAdd((float*)(slot + 2), d2); }
}
constexpr int NCHK = 16;
struct Counts { float c[NCHK]; };
__global__ void decide_k(unsigned* slots, Counts cnt, float tol, float* code_out) {
    if (threadIdx.x != 0 || blockIdx.x != 0) return;
    float code = 0.f;
    for (int k = 0; k < NCHK; ++k) {
        if (cnt.c[k] <= 0.f) continue;
        const float md = __uint_as_float(slots[4 * k]), rr = __uint_as_float(slots[4 * k + 1]), dd = __uint_as_float(slots[4 * k + 2]);
        const float rms = sqrtf(rr / cnt.c[k]), rmsr = sqrtf(dd / fmaxf(rr, 1e-30f));
        if (!(rmsr <= tol) || !(md <= 0.5f * rms)) { code = (float)(k + 1) + (rmsr < 0.03f ? 0.f : rmsr < 0.3f ? 0.3f : 0.6f); break; }
    }
    *code_out = code;
}
__global__ void finish_k(float* out, const float* mega_out, size_t dbg_off, size_t dbg_n, size_t n, const float* code) {
    const size_t i = (size_t)blockIdx.x * blockDim.x + threadIdx.x;
    if (i >= n) return;
    const float c = *code;
    float v = out[i];
    if (c == 0.f && i >= dbg_off && i < dbg_off + dbg_n) v = mega_out[i - dbg_off];
    out[i] = v * (1.f + c);
}
}
#ifndef DBG_B
#define DBG_B 5
#endif
#ifndef DBG_TOL
#define DBG_TOL 0.01f
#endif
#endif

extern "C" void kernel_launch(void* const* d_in, const int* in_sizes, int n_in, void* d_out, int out_size, void* d_ws, size_t ws_size, hipStream_t stream) {
    (void)in_sizes; (void)n_in; (void)out_size; (void)ws_size;
#if !DEBUG_ORACLE
    Args a{};
    set_inputs(a, d_in);
    a.out = (float*)d_out; a.x1 = a.out; a.x2 = a.out;
    ws_map(a, (unsigned char*)d_ws, M_FULL, true);
    a.M = M_FULL;
    if (hipMemsetAsync(a.ctl, 0, CTL_ZERO_BYTES, stream) != hipSuccess) return;
    launch_mega(a, stream);
#else
    using namespace nv;
    unsigned char* wsb = (unsigned char*)d_ws;
    Args a{};
    set_inputs(a, d_in);
    a.x += (size_t)DBG_B * S * D;
    size_t used = ws_map(a, wsb, S, false);
    auto takeb = [&](size_t bytes) { unsigned char* p = wsb + used; used += (bytes + 255) & ~(size_t)255; return p; };
    a.x1 = (float*)takeb((size_t)S * D * 4); a.x2 = (float*)takeb((size_t)S * D * 4); a.out = (float*)takeb((size_t)S * D * 4);
    a.H2 = (bf16*)takeb((size_t)S * FF * 2);
    a.M = S;
    unsigned* slots = (unsigned*)takeb(256); float* code = (float*)takeb(256);
    Counts hc{};
    const float* x = (const float*)d_in[0];
    float* out = (float*)d_out;
    float* xn = (float*)takeb((size_t)S * D * 4); float* U = (float*)takeb((size_t)S * INW * 4); float* Hh = (float*)takeb((size_t)S * FF * 4); float* Y = (float*)takeb((size_t)S * D * 4);
    float* z = (float*)takeb((size_t)S * D * 4); float* cy = xn; float* cv = (float*)takeb((size_t)S * D * 4); float* qn = (float*)takeb((size_t)S * D * 4);
    float* kn = (float*)takeb((size_t)S * 256 * 4); float* ao = (float*)takeb((size_t)S * D * 4); float* av = (float*)takeb((size_t)S * D * 4); float* bv = (float*)takeb((size_t)S * D * 4);
    float* mg = (float*)takeb((size_t)S * D * 4);
    if (used > ws_size) { fprintf(stderr, "debug build needs %zu bytes of workspace, have %zu\n", used, ws_size); return; }
    hipMemsetAsync(slots, 0, 256, stream);
    hipMemsetAsync(a.ctl, 0, CTL_ZERO_BYTES, stream);
    launch_mega(a, stream);
    const int EB = 256; const size_t n1 = (size_t)S * D;
    int nchk = 0;
    auto chk = [&](const void* ap, int isbf, int lda, float asc, const float* ref, int ldr, int sig, int rows, int cols) {
        const size_t n = (size_t)rows * cols;
        hipLaunchKernelGGL(cmp_k, dim3((unsigned)((n + 255) / 256)), dim3(256), 0, stream, ap, isbf, lda, asc, ref, ldr, sig, rows, cols, slots + 4 * nchk);
        hc.c[nchk] = (float)n; ++nchk;
    };
    for (int bi = 0; bi < B; ++bi) {
        const int b = (bi == B - 1) ? DBG_B : (bi >= DBG_B ? bi + 1 : bi);
        const bool dbg = (b == DBG_B);
        const float* xbp = x + (size_t)b * S * D; float* ob = out + (size_t)b * S * D;
        hipLaunchKernelGGL(rms_rows, dim3(S), dim3(256), 0, stream, xbp, a.ffn1_norm, xn);
        gemm(xn, D, a.ffn1_w_in, 2 * FF, U, 2 * FF, S, 2 * FF, D, stream);
        hipLaunchKernelGGL(swiglu_k, dim3((unsigned)(((size_t)S * FF + EB - 1) / EB)), dim3(EB), 0, stream, U, Hh, S);
        if (dbg) chk(a.H, 1, FF, 1.f, Hh, FF, 0, S, FF);
        gemm(Hh, FF, a.ffn1_w_out, D, Y, D, S, D, FF, stream);
        hipLaunchKernelGGL(resid_k, dim3((unsigned)((n1 + EB - 1) / EB)), dim3(EB), 0, stream, xbp, Y, 0.5f, ob, n1);
        if (dbg) chk(a.x1, 0, D, 1.f, ob, D, 0, S, D);
        hipLaunchKernelGGL(rms_rows, dim3(S), dim3(256), 0, stream, ob, a.mix_norm, xn);
        gemm(xn, D, a.w_in, INW, U, INW, S, INW, D, stream);
        hipLaunchKernelGGL(glu_k, dim3((unsigned)((n1 + EB - 1) / EB)), dim3(EB), 0, stream, U, z, S);
        if (dbg) chk(a.z, 1, D, 1.f, z, D, 0, S, D);
        hipLaunchKernelGGL(qknorm_k, dim3(S * (HQ + HKV) / 4), dim3(256), 0, stream, U, a.q_norm, a.k_norm, qn, kn);
        if (dbg) { chk(a.q, 1, D, 1.f / (0.125f * 1.4426950408889634f), qn, D, 0, S, D);
                   chk(a.k, 1, 256, 1.f, kn, 256, 0, S, 256);
                   chk(a.v, 1, 256, 1.f, U + 3328, INW, 0, S, 256);
                   chk(a.ga, 1, D, 1.f, U + 4608, INW, 1, S, D);
                   chk(a.ga, 1, D, 1.f, U + 4608, INW, 1, S, D); }
        hipLaunchKernelGGL(conv_k, dim3((unsigned)((n1 + EB - 1) / EB)), dim3(EB), 0, stream, z, a.conv_w, a.conv_b, cy);
        hipLaunchKernelGGL(ln_silu_k, dim3(S), dim3(256), 0, stream, cy, a.ln_g, a.ln_b, cv);
        if (dbg) chk(a.c, 1, D, 1.f, cv, D, 0, S, D);
        gemm(cv, D, a.conv_proj, D, av, D, S, D, D, stream);
        hipLaunchKernelGGL(attn_k, dim3(S * HQ / 4), dim3(256), 0, stream, qn, kn, U, a.sinks, a.rel_bias, ao);
        if (dbg) chk(a.o, 1, D, 1.f, ao, D, 0, S, D);
        gemm(ao, D, a.attn_wo, D, bv, D, S, D, D, stream);
        hipLaunchKernelGGL(merge_k, dim3((unsigned)((n1 + EB - 1) / EB)), dim3(EB), 0, stream, U, av, bv, mg, S);
        if (dbg) chk(a.mg, 1, D, 1.f, mg, D, 0, S, D);
        gemm(mg, D, a.w_out, D, Y, D, S, D, D, stream);
        hipLaunchKernelGGL(resid_k, dim3((unsigned)((n1 + EB - 1) / EB)), dim3(EB), 0, stream, ob, Y, 1.0f, ob, n1);
        if (dbg) chk(a.x2, 0, D, 1.f, ob, D, 0, S, D);
        hipLaunchKernelGGL(rms_rows, dim3(S), dim3(256), 0, stream, ob, a.ffn2_norm, xn);
        gemm(xn, D, a.ffn2_w_in, 2 * FF, U, 2 * FF, S, 2 * FF, D, stream);
        hipLaunchKernelGGL(swiglu_k, dim3((unsigned)(((size_t)S * FF + EB - 1) / EB)), dim3(EB), 0, stream, U, Hh, S);
        if (dbg) chk(a.H2, 1, FF, 1.f, Hh, FF, 0, S, FF);
        gemm(Hh, FF, a.ffn2_w_out, D, Y, D, S, D, FF, stream);
        hipLaunchKernelGGL(resid_k, dim3((unsigned)((n1 + EB - 1) / EB)), dim3(EB), 0, stream, ob, Y, 0.5f, ob, n1);
        if (dbg) chk(a.out, 0, D, 1.f, ob, D, 0, S, D);
    }
    hipLaunchKernelGGL(decide_k, dim3(1), dim3(64), 0, stream, slots, hc, DBG_TOL, code);
    const size_t nall = (size_t)B * S * D;
    hipLaunchKernelGGL(finish_k, dim3((unsigned)((nall + 255) / 256)), dim3(256), 0, stream, out, a.out, (size_t)DBG_B * S * D, (size_t)S * D, nall, code);
#endif
}
```

```cpp
#include <hip/hip_runtime.h>
#include <cstdio>
#include <cstdint>
#ifndef DEBUG_ORACLE
#define DEBUG_ORACLE 0
#endif
namespace pg8 {
#define PG8_LAS __attribute__((address_space(3)))
typedef unsigned short bf16_t;
typedef short bf16x8 __attribute__((ext_vector_type(8)));
typedef float f32x4 __attribute__((ext_vector_type(4)));
typedef unsigned u32x4 __attribute__((ext_vector_type(4)));
constexpr int BM = 256, BK = 64, HALF = 128, HTB = HALF * BK * 2  , STAGE_BYTES = 8 * HTB, NXCD = 8, WGM = 8;

__host__ __device__ __forceinline__ int lds_byte(int r, int c) { const int st = (r >> 4) * 2 + (c >> 5), rr = r & 15, cc = c & 31, ob = rr * 64 + cc * 2; return st * 1024 + (ob ^ (((ob >> 9) & 1) << 5)); }
__host__ __device__ __forceinline__ void stage_rc(int b, int& R, int& C) { const int st = b / 1024, sb = b % 1024, swz = sb ^ (((sb >> 9) & 1) << 5); R = (st >> 1) * 16 + swz / 64; C = (st & 1) * 32 + (swz % 64) / 2; }
__host__ __device__ __forceinline__ int perm32(int rho) { const int n = rho >> 4, i = rho & 15; return 8 * (i >> 2) + 4 * n + (i & 3); }

struct Unit { int pm, pn; };
struct Gemm { const bf16_t* A; const bf16_t* Bt; int M, N, K; const bf16_t* A2; const bf16_t* Bt2; };

struct StaticOrder {
    int nM, nN, nwg, G, c;
    __host__ __device__ void init(int M, int N, int G_, int c_) { nM = M / BM; nN = N / BM; nwg = nM * nN; G = G_; c = c_; }
    __host__ __device__ bool next(int i, Unit& u) const {
        const long L = (long)i * G + c; if (L >= nwg) return false;
        int wgid = (int)L; { const int q = nwg / NXCD, r = nwg % NXCD, xcd = wgid % NXCD, off = wgid / NXCD; wgid = (xcd < r ? xcd * (q + 1) : r * (q + 1) + (xcd - r) * q) + off; }
        const int nig = WGM * nN, gid = wgid / nig, fm = gid * WGM, gsz = (nM - fm) < WGM ? (nM - fm) : WGM;
        u.pm = fm + ((wgid % nig) % gsz); u.pn = (wgid % nig) / gsz; return true;
    }
    __device__ __forceinline__ void a_ready(const Unit&) const {}
    __device__ __forceinline__ void done(const Unit&) const {}
};

constexpr float RMS_EPS = 1e-6f;
constexpr float LOG2E = 1.4426950408889634f;
typedef float f32x2 __attribute__((ext_vector_type(2)));
typedef __bf16 bf16x2_t __attribute__((ext_vector_type(2)));
__device__ __forceinline__ unsigned cvt_pk_bf16(float lo, float hi) { f32x2 v = {lo, hi}; bf16x2_t b = __builtin_convertvector(v, bf16x2_t); return __builtin_bit_cast(unsigned, b); }
__device__ __forceinline__ u32x4 pack8(const f32x4 a, const f32x4 b) { u32x4 w; w.x = cvt_pk_bf16(a[0], a[1]); w.y = cvt_pk_bf16(a[2], a[3]); w.z = cvt_pk_bf16(b[0], b[1]); w.w = cvt_pk_bf16(b[2], b[3]); return w; }
__device__ __forceinline__ void unpack8(const u32x4 w, f32x4& a, f32x4& b) {
    a[0] = __uint_as_float(w.x << 16); a[1] = __uint_as_float(w.x & 0xffff0000u); a[2] = __uint_as_float(w.y << 16); a[3] = __uint_as_float(w.y & 0xffff0000u);
    b[0] = __uint_as_float(w.z << 16); b[1] = __uint_as_float(w.z & 0xffff0000u); b[2] = __uint_as_float(w.w << 16); b[3] = __uint_as_float(w.w & 0xffff0000u); }
__device__ __forceinline__ float fast_sigmoid(float v) { return __builtin_amdgcn_rcpf(1.0f + __builtin_amdgcn_exp2f(-LOG2E * v)); }
__device__ __forceinline__ f32x4 sigmoid4(const f32x4 v) { f32x4 o; o[0] = fast_sigmoid(v[0]); o[1] = fast_sigmoid(v[1]); o[2] = fast_sigmoid(v[2]); o[3] = fast_sigmoid(v[3]); return o; }
__device__ __forceinline__ float dot4(const f32x4 v) { return (v[0] * v[0] + v[1] * v[1]) + (v[2] * v[2] + v[3] * v[3]); }

struct EpiSwiglu {
    static constexpr bool PERM = true, AFTER_DRAIN = false;
    bf16_t* H; int ldh; const float* ssq;
    __device__ __forceinline__ void operator()(const f32x4 (&acc)[2][2][4][2], const Unit& u, int wr, int wc, int fr, int fq) const {
        const int row0 = u.pm * BM + wr * 64 + fr, col0 = u.pn * HALF + wc * 32 + 8 * fq;
        float rs[2][4];
#pragma unroll
        for (int ai = 0; ai < 2; ++ai)
#pragma unroll
            for (int m = 0; m < 4; ++m) rs[ai][m] = ssq[row0 + ai * HALF + m * 16];
#pragma unroll
        for (int ai = 0; ai < 2; ++ai)
#pragma unroll
            for (int m = 0; m < 4; ++m) {
                const float r = __builtin_amdgcn_rsqf(rs[ai][m] * (1.0f / 1024.0f) + RMS_EPS);
                f32x4 h[2];
#pragma unroll
                for (int n = 0; n < 2; ++n) { const f32x4 a = acc[ai][0][m][n] * r, b = acc[ai][1][m][n] * r; h[n] = a * sigmoid4(a) * b; }
                *(u32x4*)(H + (size_t)(row0 + ai * HALF + m * 16) * ldh + col0) = pack8(h[0], h[1]);
            }
    }
};

template <int MODE> struct EpiProbe {
    static constexpr bool PERM = true, AFTER_DRAIN = false;
    bf16_t* H; int ldh; const float* ssq;
    __device__ __forceinline__ void operator()(const f32x4 (&acc)[2][2][4][2], const Unit& u, int wr, int wc, int fr, int fq) const {
        const int row0 = u.pm * BM + wr * 64 + fr, col0 = u.pn * HALF + wc * 32 + 8 * fq;
#pragma unroll
        for (int ai = 0; ai < 2; ++ai)
#pragma unroll
            for (int m = 0; m < 4; ++m) {
                if (MODE == 0) { asm volatile("" :: "v"(acc[ai][0][m][0]), "v"(acc[ai][0][m][1]), "v"(acc[ai][1][m][0]), "v"(acc[ai][1][m][1])); }
                else { *(u32x4*)(H + (size_t)(row0 + ai * HALF + m * 16) * ldh + col0) = pack8(acc[ai][0][m][0] + acc[ai][1][m][0], acc[ai][0][m][1] + acc[ai][1][m][1]); }
            }
    }
};

template <bool RES_F32, bool WANT_XB, bool HALF_SCALE> struct EpiResid {
    static constexpr bool PERM = true, AFTER_DRAIN = false;
    const float* res32; const bf16_t* res16; float* out32; bf16_t* xb; float* ssq_out;
    __device__ __forceinline__ void operator()(const f32x4 (&acc)[2][2][4][2], const Unit& u, int wr, int wc, int fr, int fq) const {
        const int row0 = u.pm * BM + wr * 64 + fr, col0 = u.pn * BM + wc * 32 + 8 * fq;
        constexpr float scale = HALF_SCALE ? 0.5f : 1.0f;
#pragma unroll
        for (int ai = 0; ai < 2; ++ai)
#pragma unroll
            for (int m = 0; m < 4; ++m) {
                const size_t off = (size_t)(row0 + ai * HALF + m * 16) * 1024 + col0;
                float ss = 0.f;
#pragma unroll
                for (int bj = 0; bj < 2; ++bj) {
                    f32x4 r0, r1;
                    if (RES_F32) { r0 = *(const f32x4*)(res32 + off + bj * HALF); r1 = *(const f32x4*)(res32 + off + bj * HALF + 4); }
                    else unpack8(*(const u32x4*)(res16 + off + bj * HALF), r0, r1);
                    const f32x4 v0 = r0 + acc[ai][bj][m][0] * scale, v1 = r1 + acc[ai][bj][m][1] * scale;
                    if (out32) { *(f32x4*)(out32 + off + bj * HALF) = v0; *(f32x4*)(out32 + off + bj * HALF + 4) = v1; }
                    if (WANT_XB) { *(u32x4*)(xb + off + bj * HALF) = pack8(v0, v1); ss += dot4(v0) + dot4(v1); }
                }
                if (WANT_XB) { ss += __shfl_xor(ss, 16); ss += __shfl_xor(ss, 32); if (fq == 0) atomicAdd(ssq_out + row0 + ai * HALF + m * 16, ss); }
                if (m & 1) asm volatile("" ::: "memory");
            }
    }
};

struct EpiMix {
    static constexpr bool PERM = true, AFTER_DRAIN = false;
    const float* ssq; bf16_t *z, *q, *k, *v, *gc, *ga; const float *qg, *kg;
    __device__ __forceinline__ void operator()(const f32x4 (&acc)[2][2][4][2], const Unit& u, int wr, int wc, int fr, int fq) const {
        const int row0 = u.pm * BM + wr * 64 + fr, pn = u.pn;
        float rs[2][4];
#pragma unroll
        for (int ai = 0; ai < 2; ++ai)
#pragma unroll
            for (int m = 0; m < 4; ++m) rs[ai][m] = ssq[row0 + ai * HALF + m * 16];
#pragma unroll
        for (int ai = 0; ai < 2; ++ai)
#pragma unroll
            for (int m = 0; m < 4; ++m) rs[ai][m] = __builtin_amdgcn_rsqf(rs[ai][m] * (1.0f / 1024.0f) + RMS_EPS);
        if (pn < 8) {
            const int col0 = pn * HALF + wc * 32 + 8 * fq;
#pragma unroll
            for (int ai = 0; ai < 2; ++ai)
#pragma unroll
                for (int m = 0; m < 4; ++m) {
                    const float r = rs[ai][m]; f32x4 h[2];
#pragma unroll
                    for (int n = 0; n < 2; ++n) { const f32x4 a = acc[ai][0][m][n] * r, g = acc[ai][1][m][n] * r; h[n] = a * sigmoid4(g); }
                    *(u32x4*)(z + (size_t)(row0 + ai * HALF + m * 16) * 1024 + col0) = pack8(h[0], h[1]);
                }
        } else if (pn < 13) {
            const bool isq = pn < 12;
            const float* gp = isq ? qg : kg; const float gs = isq ? 0.125f * LOG2E : 1.0f;
            bf16_t* ob = isq ? q : k; const int ld = isq ? 1024 : 256, head = isq ? 4 * (pn - 8) + wc : wc;
            f32x4 gv[2][2];
#pragma unroll
            for (int bj = 0; bj < 2; ++bj)
#pragma unroll
                for (int n = 0; n < 2; ++n) gv[bj][n] = *(const f32x4*)(gp + 32 * bj + 8 * fq + 4 * n) * gs;
#pragma unroll
            for (int ai = 0; ai < 2; ++ai)
#pragma unroll
                for (int m = 0; m < 4; ++m) {
                    const float r = rs[ai][m]; f32x4 y[2][2]; float ss = 0.f;
#pragma unroll
                    for (int bj = 0; bj < 2; ++bj)
#pragma unroll
                        for (int n = 0; n < 2; ++n) { y[bj][n] = acc[ai][bj][m][n] * r; ss += dot4(y[bj][n]); }
                    ss += __shfl_xor(ss, 16); ss += __shfl_xor(ss, 32);
                    const float rh = __builtin_amdgcn_rsqf(ss * (1.0f / 64.0f) + RMS_EPS);
                    bf16_t* rowp = ob + (size_t)(row0 + ai * HALF + m * 16) * ld + 64 * head + 8 * fq;
#pragma unroll
                    for (int bj = 0; bj < 2; ++bj) *(u32x4*)(rowp + 32 * bj) = pack8(y[bj][0] * rh * gv[bj][0], y[bj][1] * rh * gv[bj][1]);
                }
        } else if (pn == 13) {
            const int col0 = wc * 32 + 8 * fq;
#pragma unroll
            for (int ai = 0; ai < 2; ++ai)
#pragma unroll
                for (int m = 0; m < 4; ++m) {
                    const float r = rs[ai][m]; bf16_t* rowp = v + (size_t)(row0 + ai * HALF + m * 16) * 256 + col0;
#pragma unroll
                    for (int bj = 0; bj < 2; ++bj) *(u32x4*)(rowp + bj * HALF) = pack8(acc[ai][bj][m][0] * r, acc[ai][bj][m][1] * r);
                }
        } else {
            const int col0 = (pn - 14) * HALF + wc * 32 + 8 * fq;
#pragma unroll
            for (int ai = 0; ai < 2; ++ai)
#pragma unroll
                for (int m = 0; m < 4; ++m) {
                    const float r = rs[ai][m]; f32x4 rtv[2], sav[2];
#pragma unroll
                    for (int n = 0; n < 2; ++n) {
                        const f32x4 gc_ = acc[ai][0][m][n] * r, ga_ = acc[ai][1][m][n] * r;
#pragma unroll
                        for (int j = 0; j < 4; ++j) {
                            const float ec = __builtin_amdgcn_exp2f(-LOG2E * gc_[j]), ea = __builtin_amdgcn_exp2f(-LOG2E * ga_[j]);
                            sav[n][j] = __builtin_amdgcn_rcpf(1.0f + ea); rtv[n][j] = (1.0f + ea) * __builtin_amdgcn_rcpf(1.0f + ec);
                        }
                    }
                    const size_t off = (size_t)(row0 + ai * HALF + m * 16) * 1024 + col0;
                    *(u32x4*)(gc + off) = pack8(rtv[0], rtv[1]); *(u32x4*)(ga + off) = pack8(sav[0], sav[1]);
                }
        }
    }
};

struct EpiMerge {
    static constexpr bool PERM = true, AFTER_DRAIN = false;
    const bf16_t* rt; const bf16_t* sa; bf16_t* O;
    __device__ __forceinline__ void mid(f32x4 (&acc)[2][2][4][2], const Unit& u, int wr, int wc, int fr, int fq) const {
        const int row0 = u.pm * BM + wr * 64 + fr, col0 = u.pn * BM + wc * 32 + 8 * fq;
#pragma unroll
        for (int ai = 0; ai < 2; ++ai)
#pragma unroll
            for (int m = 0; m < 4; ++m) {
                const size_t off = (size_t)(row0 + ai * HALF + m * 16) * 1024 + col0;
#pragma unroll
                for (int bj = 0; bj < 2; ++bj) { f32x4 g0, g1; unpack8(*(const u32x4*)(rt + off + bj * HALF), g0, g1); acc[ai][bj][m][0] *= g0; acc[ai][bj][m][1] *= g1; }
                if (m & 1) asm volatile("" ::: "memory");
            }
    }
    __device__ __forceinline__ void operator()(const f32x4 (&acc)[2][2][4][2], const Unit& u, int wr, int wc, int fr, int fq) const {
        const int row0 = u.pm * BM + wr * 64 + fr, col0 = u.pn * BM + wc * 32 + 8 * fq;
#pragma unroll
        for (int ai = 0; ai < 2; ++ai)
#pragma unroll
            for (int m = 0; m < 4; ++m) {
                const size_t off = (size_t)(row0 + ai * HALF + m * 16) * 1024 + col0;
#pragma unroll
                for (int bj = 0; bj < 2; ++bj) { f32x4 g0, g1; unpack8(*(const u32x4*)(sa + off + bj * HALF), g0, g1); *(u32x4*)(O + off + bj * HALF) = pack8(g0 * acc[ai][bj][m][0], g1 * acc[ai][bj][m][1]); }
                if (m & 1) asm volatile("" ::: "memory");
            }
    }
};

template <class Epi, class Sched, bool ALIGN_EPI = false, bool SP2 = false, int NSEG = 1>
__device__ __forceinline__ void gemm_phase(PG8_LAS unsigned char* lds, const Gemm g, const Sched S, const Epi E) {
    int tid_ = threadIdx.x; asm volatile("" : "+v"(tid_));
    const int tid = tid_, wid = __builtin_amdgcn_readfirstlane(tid >> 6), lane = tid & 63, wr = wid >> 2, wc = wid & 3, fr = lane & 15, fq = lane >> 4;
    const int K = g.K, mt = K / BK, nt = NSEG * mt;
    unsigned voffA[2], voffB[2];
#pragma unroll
    for (int i = 0; i < 2; ++i) { int R, C; stage_rc(tid * 16 + i * 8192, R, C); const int Rb = Epi::PERM ? ((R & ~31) + perm32(R & 31)) : R;
        voffA[i] = (unsigned)(R * K + C) * 2u; voffB[i] = (unsigned)(Rb * K + C) * 2u; }
    const size_t kstep = (size_t)(BK * 2);
    const size_t hstep = (size_t)HALF * K * 2;
    const size_t tstep = 2 * hstep;
    const unsigned ldsw = (unsigned)wid * 1024u;
    const int aoff = lds_byte(wr * 64 + fr, fq * 8), boff = lds_byte(wc * 32 + fr, fq * 8);
#define PG8_SA(b, h) (((b) * 2 + (h)) * HTB)
#define PG8_SB(b, h) ((4 + (b) * 2 + (h)) * HTB)
#define PG8_STAGE(bufoff, gbase, voff) do { _Pragma("unroll") for (int _i = 0; _i < 2; ++_i) \
        __builtin_amdgcn_global_load_lds((const unsigned*)((const char*)(gbase) + (voff)[_i]), (PG8_LAS unsigned*)(lds + (bufoff) + ldsw + _i * 8192), 16, 0, 0); } while (0)
#define PG8_LDA(dst, b, h) do { _Pragma("unroll") for (int m = 0; m < 4; ++m) _Pragma("unroll") for (int k = 0; k < 2; ++k) dst[m][k] = *(const PG8_LAS bf16x8*)(lds + PG8_SA(b, h) + aoff + m * 2048 + k * 1024); } while (0)
#define PG8_LDB(dst, b, h) do { _Pragma("unroll") for (int n = 0; n < 2; ++n) _Pragma("unroll") for (int k = 0; k < 2; ++k) dst[n][k] = *(const PG8_LAS bf16x8*)(lds + PG8_SB(b, h) + boff + n * 2048 + k * 1024); } while (0)
#define PG8_MMA(ai, bj, At, Bt) do { __builtin_amdgcn_s_setprio(1); _Pragma("unroll") for (int m = 0; m < 4; ++m) _Pragma("unroll") for (int n = 0; n < 2; ++n) _Pragma("unroll") for (int k = 0; k < 2; ++k) \
        acc[ai][bj][m][n] = __builtin_amdgcn_mfma_f32_16x16x32_bf16(Bt[n][k], At[m][k], acc[ai][bj][m][n], 0, 0, 0); __builtin_amdgcn_s_setprio(0); } while (0)
#define PG8_WAIT_V(n) asm volatile("s_waitcnt vmcnt(" #n ")" ::: "memory")
#define PG8_WAIT_L(n) asm volatile("s_waitcnt lgkmcnt(" #n ")" ::: "memory")
#define PG8_BAR __builtin_amdgcn_s_barrier()
#define PG8_SCHED __builtin_amdgcn_sched_barrier(0)
    Unit cur, nxt; int ui = 0;
    if (!S.next(0, cur)) return;
    f32x4 acc[2][2][4][2];
#pragma unroll
    for (int a = 0; a < 2; ++a)
#pragma unroll
        for (int b = 0; b < 2; ++b)
#pragma unroll
            for (int m = 0; m < 4; ++m)
#pragma unroll
                for (int n = 0; n < 2; ++n) acc[a][b][m][n] = (f32x4){0.f, 0.f, 0.f, 0.f};
    bf16x8 At[4][2], B0[2][2], B1[2][2];
    const char* cA = (const char*)g.A + (size_t)cur.pm * tstep; const char* cB = (const char*)g.Bt + (size_t)cur.pn * tstep;
    const char* cA2 = (NSEG == 2) ? (const char*)g.A2 + (size_t)cur.pm * tstep : cA; const char* cB2 = (NSEG == 2) ? (const char*)g.Bt2 + (size_t)cur.pn * tstep : cB;
    S.a_ready(cur);
    if constexpr (SP2) {
        PG8_STAGE(PG8_SB(0, 0), cB, voffB); PG8_STAGE(PG8_SB(0, 1), cB + hstep, voffB); PG8_STAGE(PG8_SA(0, 0), cA, voffA); PG8_STAGE(PG8_SA(0, 1), cA + hstep, voffA);
        if (wr == 1) PG8_BAR;
        PG8_WAIT_V(2); PG8_BAR;
        PG8_STAGE(PG8_SB(1, 0), cB + kstep, voffB); PG8_STAGE(PG8_SA(1, 0), cA + kstep, voffA); PG8_STAGE(PG8_SB(1, 1), cB + hstep + kstep, voffB);
        PG8_WAIT_V(6); PG8_BAR;
    } else {
        PG8_STAGE(PG8_SB(0, 0), cB, voffB); PG8_STAGE(PG8_SA(0, 0), cA, voffA); PG8_STAGE(PG8_SB(0, 1), cB + hstep, voffB); PG8_STAGE(PG8_SA(0, 1), cA + hstep, voffA);
        if (wr == 1) PG8_BAR;
        PG8_WAIT_V(4); PG8_BAR;
        PG8_STAGE(PG8_SB(1, 0), cB + kstep, voffB); PG8_STAGE(PG8_SA(1, 0), cA + kstep, voffA); PG8_STAGE(PG8_SB(1, 1), cB + hstep + kstep, voffB);
        PG8_WAIT_V(6); PG8_BAR;
    }
    for (;;) {
        const bool has_next = S.next(ui + 1, nxt);
        const char* nA = has_next ? (const char*)g.A + (size_t)nxt.pm * tstep : cA; const char* nB = has_next ? (const char*)g.Bt + (size_t)nxt.pn * tstep : cB;
        const char* nA2 = (NSEG == 2 && has_next) ? (const char*)g.A2 + (size_t)nxt.pm * tstep : cA2; const char* nB2 = (NSEG == 2 && has_next) ? (const char*)g.Bt2 + (size_t)nxt.pn * tstep : cB2;
        for (int t = 0; t < nt; t += 2) {
            const bool last = (t == nt - 2);
            if constexpr (NSEG == 2) { if (t == mt) E.mid(acc, cur, wr, wc, fr, fq); }
            const bool s1 = (NSEG == 2) && (t + 1 >= mt), s2 = (NSEG == 2) && (t + 2 >= mt);
            const char* a1 = s1 ? cA2 + (size_t)(t + 1 - mt) * kstep : cA + (size_t)(t + 1) * kstep;
            const char* a2 = last ? nA : (s2 ? cA2 + (size_t)(t + 2 - mt) * kstep : cA + (size_t)(t + 2) * kstep);
            const char* b2 = last ? nB : (s2 ? cB2 + (size_t)(t + 2 - mt) * kstep : cB + (size_t)(t + 2) * kstep);
            const char* a3 = a2 + kstep; const char* b3 = b2 + kstep;
            if (last && has_next) S.a_ready(nxt);
            if constexpr (SP2) {
            PG8_LDB(B0, 0, 0); PG8_LDB(B1, 0, 1); PG8_SCHED; PG8_LDA(At, 0, 0); PG8_STAGE(PG8_SA(1, 1), a1 + hstep, voffA);
            PG8_WAIT_V(8); PG8_WAIT_L(0); PG8_BAR; PG8_MMA(0, 0, At, B0); PG8_MMA(0, 1, At, B1); PG8_BAR; PG8_SCHED;
            PG8_LDA(At, 0, 1); PG8_STAGE(PG8_SB(0, 0), b2, voffB); PG8_STAGE(PG8_SB(0, 1), b2 + hstep, voffB); PG8_STAGE(PG8_SA(0, 0), a2, voffA);
            PG8_WAIT_V(8); PG8_WAIT_L(0); PG8_BAR; PG8_MMA(1, 0, At, B0); PG8_MMA(1, 1, At, B1); PG8_BAR; PG8_SCHED;
            PG8_LDB(B0, 1, 0); PG8_LDB(B1, 1, 1); PG8_SCHED; PG8_LDA(At, 1, 0); PG8_STAGE(PG8_SA(0, 1), a2 + hstep, voffA);
            PG8_WAIT_V(8); PG8_WAIT_L(0); PG8_BAR; PG8_MMA(0, 0, At, B0); PG8_MMA(0, 1, At, B1); PG8_BAR; PG8_SCHED;
            PG8_LDA(At, 1, 1); PG8_STAGE(PG8_SB(1, 0), b3, voffB); PG8_STAGE(PG8_SB(1, 1), b3 + hstep, voffB); PG8_STAGE(PG8_SA(1, 0), a3, voffA);
            PG8_WAIT_V(8); PG8_WAIT_L(0); PG8_BAR; PG8_MMA(1, 0, At, B0); PG8_MMA(1, 1, At, B1); PG8_BAR; PG8_SCHED;
            } else {
            PG8_LDB(B0, 0, 0); PG8_SCHED; PG8_LDA(At, 0, 0); PG8_STAGE(PG8_SA(1, 1), a1 + hstep, voffA);
            PG8_WAIT_L(8); PG8_BAR; PG8_WAIT_L(0); PG8_MMA(0, 0, At, B0); PG8_BAR; PG8_SCHED;
            PG8_LDB(B1, 0, 1); PG8_STAGE(PG8_SB(0, 0), b2, voffB);
            PG8_BAR; PG8_WAIT_L(0); PG8_MMA(0, 1, At, B1); PG8_BAR;
            PG8_LDA(At, 0, 1); PG8_STAGE(PG8_SA(0, 0), a2, voffA);
            PG8_BAR; PG8_WAIT_L(0); PG8_MMA(1, 0, At, B0); PG8_BAR; PG8_SCHED;
            PG8_STAGE(PG8_SB(0, 1), b2 + hstep, voffB);
            PG8_WAIT_V(6); PG8_BAR; PG8_MMA(1, 1, At, B1); PG8_BAR;
            PG8_LDB(B0, 1, 0); PG8_SCHED; PG8_LDA(At, 1, 0); PG8_STAGE(PG8_SA(0, 1), a2 + hstep, voffA);
            PG8_WAIT_L(8); PG8_BAR; PG8_WAIT_L(0); PG8_MMA(0, 0, At, B0); PG8_BAR; PG8_SCHED;
            PG8_LDB(B1, 1, 1); PG8_STAGE(PG8_SB(1, 0), b3, voffB);
            PG8_BAR; PG8_WAIT_L(0); PG8_MMA(0, 1, At, B1); PG8_BAR;
            PG8_LDA(At, 1, 1); PG8_STAGE(PG8_SA(1, 0), a3, voffA);
            PG8_BAR; PG8_WAIT_L(0); PG8_MMA(1, 0, At, B0); PG8_BAR; PG8_SCHED;
            PG8_STAGE(PG8_SB(1, 1), b3 + hstep, voffB);
            PG8_WAIT_V(6); PG8_BAR; PG8_MMA(1, 1, At, B1); PG8_BAR;
            }
        }
        if constexpr (ALIGN_EPI) { if (wr == 0) PG8_BAR; }
        if constexpr (!Epi::AFTER_DRAIN) { E(acc, cur, wr, wc, fr, fq); S.done(cur); }
        if (!has_next) break;
#pragma unroll
        for (int a = 0; a < 2; ++a)
#pragma unroll
            for (int b = 0; b < 2; ++b)
#pragma unroll
                for (int m = 0; m < 4; ++m)
#pragma unroll
                    for (int n = 0; n < 2; ++n) acc[a][b][m][n] = (f32x4){0.f, 0.f, 0.f, 0.f};
        cur = nxt; cA = nA; cB = nB; cA2 = nA2; cB2 = nB2; ++ui;
        if constexpr (ALIGN_EPI) { if (wr == 1) PG8_BAR; }
    }
    PG8_WAIT_V(0);
    if constexpr (!ALIGN_EPI) { if (wr == 0) PG8_BAR; }
    PG8_BAR;
    if constexpr (Epi::AFTER_DRAIN) { E.fused(acc, cur, wr, wc, fr, fq, lds, wid, lane); S.done(cur); }
#undef PG8_SA
#undef PG8_SB
#undef PG8_STAGE
#undef PG8_LDA
#undef PG8_LDB
#undef PG8_MMA
#undef PG8_WAIT_V
#undef PG8_WAIT_L
#undef PG8_BAR
#undef PG8_SCHED
}
}
constexpr int D = 1024, NB = 8, SEQ = 4096, FF = 2816, CWID = 31, HD = 64, HQ = 16, HKV = 4, INW = 5632;
constexpr int M_FULL = NB * SEQ;
constexpr int NWAVES = 8, NTHREADS = 512;
constexpr int LDS_BYTES = 147456;
constexpr int RING_BYTES = 131072;
constexpr size_t CTL_ZERO_BYTES = 16384;

#define LAS __attribute__((address_space(3)))
typedef unsigned short bf16;
typedef unsigned v4u __attribute__((ext_vector_type(4)));
typedef unsigned v2u __attribute__((ext_vector_type(2)));
typedef float f32x4 __attribute__((ext_vector_type(4)));
typedef float f32x2 __attribute__((ext_vector_type(2)));
typedef float f32x16 __attribute__((ext_vector_type(16)));
typedef short bf16x8 __attribute__((ext_vector_type(8)));
typedef short s16x4 __attribute__((ext_vector_type(4)));

__device__ const unsigned char T5B[128] = {0, 1, 2, 3, 4, 5, 6, 7, 8, 9, 10, 11, 12, 13, 14, 15, 16, 16, 16, 17, 17, 18, 18, 18, 19, 19, 19, 20, 20, 20, 20, 21, 21, 21, 21, 22, 22, 22, 22, 22, 23, 23, 23, 23, 23, 23, 24, 24, 24, 24, 24, 24, 25, 25, 25, 25, 25, 25, 25, 26, 26, 26, 26, 26, 26, 26, 26, 27, 27, 27, 27, 27, 27, 27, 27, 27, 27, 28, 28, 28, 28, 28, 28, 28, 28, 28, 28, 29, 29, 29, 29, 29, 29, 29, 29, 29, 29, 29, 29, 30, 30, 30, 30, 30, 30, 30, 30, 30, 30, 30, 30, 30, 30, 31, 31, 31, 31, 31, 31, 31, 31, 31, 31, 31, 31, 31, 31, 31};

struct Args {
    const float *x, *ffn1_norm, *ffn1_w_in, *ffn1_w_out, *mix_norm, *w_in, *conv_w, *conv_b, *ln_g, *ln_b, *conv_proj, *q_norm, *k_norm, *sinks, *rel_bias, *attn_wo, *w_out, *ffn2_norm, *ffn2_w_in, *ffn2_w_out;
    float *x1, *x2, *out;
    unsigned* ctl;
    float *ssq0, *ssq1, *ssq2;
    bf16 *W1i, *W1o, *Wmx, *Wcp, *Wao, *Wot, *W2i, *W2o;
    bf16 *xb, *H, *H2, *z, *q, *k, *v, *gc, *ga, *c, *o, *m1, *mg;
    int M; int pad;
};

__device__ __forceinline__ unsigned f2bf(float f) { unsigned u = __builtin_bit_cast(unsigned, f); return (u + 0x7fffu + ((u >> 16) & 1u)) >> 16; }
__device__ __forceinline__ unsigned pk2(float lo, float hi) { return f2bf(lo) | (f2bf(hi) << 16); }
#define LDS_WAIT() asm volatile("s_waitcnt lgkmcnt(0)" ::: "memory")

__device__ __forceinline__ int src_col(int kind, int n0) {
    if (kind == 0) return n0;
    const int u = n0 >> 8, r = n0 & 255, bj = r >> 7, j = r & 127;
    if (kind == 1) return bj * FF + 128 * u + j;
    if (u < 8) return bj * 1024 + 128 * u + j;
    if (u < 12) return 2048 + 64 * (4 * (u - 8) + (j >> 5)) + 32 * bj;
    if (u == 12) return 3072 + 64 * (j >> 5) + 32 * bj;
    if (u == 13) return n0;
    return 3584 + bj * 1024 + 128 * (u - 14) + j;
}
__device__ __forceinline__ void p0_transpose_item(const float* W, int K, int Nsrc, int N, bf16* WT, const float* gain, int kind, LAS float* scr, int item, int lane) {
    const int nblk = N / 32, kb = item / nblk, nb = item % nblk, k0 = 64 * kb, n0 = 32 * nb, s0 = src_col(kind, n0);
    const int kr = lane >> 3, c4 = (lane & 7) * 4;
    f32x4 v[8]; float g[8];
#pragma unroll
    for (int i = 0; i < 8; ++i) v[i] = *(const f32x4*)(W + (size_t)(k0 + kr + 8 * i) * Nsrc + s0 + c4);
#pragma unroll
    for (int i = 0; i < 8; ++i) g[i] = gain ? gain[k0 + kr + 8 * i] : 1.0f;
#pragma unroll
    for (int i = 0; i < 8; ++i) { LAS float* d = scr + (kr + 8 * i) * 33 + c4; d[0] = g[i] * v[i][0]; d[1] = g[i] * v[i][1]; d[2] = g[i] * v[i][2]; d[3] = g[i] * v[i][3]; }
    LDS_WAIT(); asm volatile("" ::: "memory");
    const int c = lane & 7;
#pragma unroll
    for (int j = 0; j < 4; ++j) { const int n = (lane >> 3) + 8 * j; const LAS float* s = scr + (8 * c) * 33 + n;
        v4u o; o.x = pg8::cvt_pk_bf16(s[0 * 33], s[1 * 33]); o.y = pg8::cvt_pk_bf16(s[2 * 33], s[3 * 33]); o.z = pg8::cvt_pk_bf16(s[4 * 33], s[5 * 33]); o.w = pg8::cvt_pk_bf16(s[6 * 33], s[7 * 33]);
        *(v4u*)(WT + (size_t)(n0 + n) * K + k0 + 8 * c) = o; }
    LDS_WAIT(); asm volatile("" ::: "memory");
}
__device__ __forceinline__ float wave_sum(float v) {
#pragma unroll
    for (int o = 1; o < 64; o <<= 1) v += __shfl_xor(v, o);
    return v;
}
__device__ __forceinline__ void p0_prologue(const Args& A, LAS unsigned char* lds, int gw, int NGW, int lane) {
    LAS float* scr = (LAS float*)(lds + (threadIdx.x >> 6) * 16384);
    constexpr int I_IN = (D / 64) * (INW / 32), I_OUT = (FF / 64) * (D / 32), I_SQ = (D / 64) * (D / 32);
    constexpr int NITEMS = 3 * I_IN + 2 * I_OUT + 3 * I_SQ;
    for (int it = gw; it < NITEMS; it += NGW) {
        int r = it;
        if (r < I_IN) { p0_transpose_item(A.ffn1_w_in, D, 2 * FF, 2 * FF, A.W1i, A.ffn1_norm, 1, scr, r, lane); continue; } r -= I_IN;
        if (r < I_IN) { p0_transpose_item(A.w_in, D, INW, INW, A.Wmx, A.mix_norm, 2, scr, r, lane); continue; } r -= I_IN;
        if (r < I_IN) { p0_transpose_item(A.ffn2_w_in, D, 2 * FF, 2 * FF, A.W2i, A.ffn2_norm, 1, scr, r, lane); continue; } r -= I_IN;
        if (r < I_OUT) { p0_transpose_item(A.ffn1_w_out, FF, D, D, A.W1o, nullptr, 0, scr, r, lane); continue; } r -= I_OUT;
        if (r < I_OUT) { p0_transpose_item(A.ffn2_w_out, FF, D, D, A.W2o, nullptr, 0, scr, r, lane); continue; } r -= I_OUT;
        if (r < I_SQ) { p0_transpose_item(A.conv_proj, D, D, D, A.Wcp, nullptr, 0, scr, r, lane); continue; } r -= I_SQ;
        if (r < I_SQ) { p0_transpose_item(A.attn_wo, D, D, D, A.Wao, nullptr, 0, scr, r, lane); continue; } r -= I_SQ;
        p0_transpose_item(A.w_out, D, D, D, A.Wot, nullptr, 0, scr, r, lane);
    }
    for (int m = 2 * gw; m < A.M; m += 2 * NGW) {
        const f32x4* xr = (const f32x4*)(A.x + (size_t)m * D) + lane;
        f32x4 v[8];
#pragma unroll
        for (int j = 0; j < 8; ++j) v[j] = xr[64 * j];
        float s0 = 0.f, s1 = 0.f;
#pragma unroll
        for (int j = 0; j < 4; ++j) { s0 += (v[j][0] * v[j][0] + v[j][1] * v[j][1]) + (v[j][2] * v[j][2] + v[j][3] * v[j][3]); s1 += (v[j + 4][0] * v[j + 4][0] + v[j + 4][1] * v[j + 4][1]) + (v[j + 4][2] * v[j + 4][2] + v[j + 4][3] * v[j + 4][3]); }
        s0 = wave_sum(s0); s1 = wave_sum(s1);
        v2u* o8 = (v2u*)(A.xb + (size_t)m * D) + lane;
#pragma unroll
        for (int j = 0; j < 8; ++j) { v2u w; w.x = pg8::cvt_pk_bf16(v[j][0], v[j][1]); w.y = pg8::cvt_pk_bf16(v[j][2], v[j][3]); o8[64 * j] = w; }
        if (lane < 2) { const float s = lane ? s1 : s0; A.ssq0[m + lane] = s; A.ssq1[m + lane] = 0.f; A.ssq2[m + lane] = 0.f; }
    }
}

__device__ __forceinline__ f32x2 bf2_to_f2(unsigned z) { return (f32x2){__uint_as_float(z << 16), __uint_as_float(z & 0xffff0000u)}; }
template <int N, int OFF> __device__ __forceinline__ void rs_step(float (&v)[32], int lane) {
    const bool up = (lane & OFF) != 0;
#pragma unroll
    for (int i = 0; i < N; ++i) { const float keep = up ? v[i + N] : v[i], send = up ? v[i] : v[i + N]; v[i] = keep + __shfl_xor(send, OFF); }
}
template <int N2> __device__ __forceinline__ float reduce_scatter(float (&v)[32], int lane) {
    static_assert(N2 == 32, "32 values over 64 lanes");
    rs_step<16, 32>(v, lane); rs_step<8, 16>(v, lane); rs_step<4, 8>(v, lane); rs_step<2, 4>(v, lane); rs_step<1, 2>(v, lane);
    return v[0] + __shfl_xor(v[0], 1);
}
template <int BASE> __device__ __forceinline__ void conv_step16(const Args& A, f32x2 (&h)[32], unsigned (&zin)[16], const f32x2 (&w)[CWID], f32x2 bias, f32x2 g2, f32x2 b2,
                                                               const bf16* znext, bool have_next, bf16* orow, LAS float* red, LAS f32x2* STAT, int lane, int wid) {
    f32x2 y[16];
#pragma unroll
    for (int s = 0; s < 16; ++s) {
        h[BASE + s] = bf2_to_f2(zin[s]);
        f32x2 a = bias;
#pragma unroll
        for (int k = 0; k < CWID; ++k) a = __builtin_elementwise_fma(w[k], h[(BASE + s + 2 + k) & 31], a);
        y[s] = a;
    }
    {
        float v[32];
#pragma unroll
        for (int s = 0; s < 16; ++s) { v[2 * s] = y[s][0] + y[s][1]; v[2 * s + 1] = y[s][0] * y[s][0] + y[s][1] * y[s][1]; }
        const float r = reduce_scatter<32>(v, lane);
        if ((lane & 1) == 0) red[wid * 32 + (lane >> 1)] = r;
    }
    if (have_next) {
#pragma unroll
        for (int s = 0; s < 16; ++s) zin[s] = *(const unsigned*)(znext + (size_t)s * D);
    }
    __syncthreads();
    {
        float tot = 0.f;
#pragma unroll
        for (int wv = 0; wv < 8; ++wv) tot += red[wv * 32 + (lane & 31)];
        const float other = __shfl_xor(tot, 1);
        const float sm = (lane & 1) ? other : tot, sq = (lane & 1) ? tot : other;
        const float mu = sm * (1.0f / D), rs = __builtin_amdgcn_rsqf(sq * (1.0f / D) - mu * mu + 1e-6f);
        if ((lane & 33) == 0) STAT[lane >> 1] = (f32x2){mu, rs};
    }
#pragma unroll
    for (int s = 0; s < 16; ++s) {
        const f32x2 st = STAT[s];
        f32x2 v = (y[s] - st[0]) * st[1] * g2 + b2;
        v[0] = v[0] * pg8::fast_sigmoid(v[0]); v[1] = v[1] * pg8::fast_sigmoid(v[1]);
        *(unsigned*)(orow + (size_t)s * D) = pg8::cvt_pk_bf16(v[0], v[1]);
    }
}
__device__ __forceinline__ void conv_phase(const Args& A, LAS unsigned char* lds) {
    int tid_ = threadIdx.x; asm volatile("" : "+v"(tid_));
    const int tid = tid_, lane = tid & 63, wid = tid >> 6, c0 = 2 * tid;
    LAS float* RED = (LAS float*)lds;
    LAS f32x2* STAT = (LAS f32x2*)(lds + 4096) + wid * 16;
    f32x2 w[CWID];
#pragma unroll
    for (int k = 0; k < CWID; ++k) w[k] = *(const f32x2*)(A.conv_w + k * D + c0);
    const f32x2 bias = *(const f32x2*)(A.conv_b + c0), g2 = *(const f32x2*)(A.ln_g + c0), b2 = *(const f32x2*)(A.ln_b + c0);
    const int nchunks = A.M / 128;
    for (int ch = blockIdx.x; ch < nchunks; ch += gridDim.x) {
        const int t0 = ch * 128; const bool first = (t0 % SEQ) == 0;
        const bf16* zp = A.z + (size_t)t0 * D + c0;
        bf16* op = A.c + (size_t)t0 * D + c0;
        f32x2 h[32];
        unsigned zin[16];
#pragma unroll
        for (int s = 0; s < 16; ++s) zin[s] = *(const unsigned*)(zp + (size_t)s * D);
#pragma unroll
        for (int i = 2; i < 32; ++i) { unsigned zz = 0u; if (!first) zz = *(const unsigned*)(zp - (size_t)(32 - i) * D); h[i] = bf2_to_f2(zz); }
#pragma unroll 1
        for (int tb = 0; tb < 128; tb += 32) {
            conv_step16<0>(A, h, zin, w, bias, g2, b2, zp + (size_t)(tb + 16) * D, true, op + (size_t)tb * D, RED, STAT, lane, wid);
            conv_step16<16>(A, h, zin, w, bias, g2, b2, zp + (size_t)(tb + 32) * D, tb + 32 < 128, op + (size_t)(tb + 16) * D, RED + 256, STAT, lane, wid);
        }
    }
    __syncthreads();
}

constexpr int ATT_K_OFF = 0, ATT_V_OFF = 32768, ATT_TB_OFF = 65536, ATT_LS_OFF = 69632, ATT_OST_OFF = 73728;
__device__ __forceinline__ s16x4 vtr(const LAS unsigned char* p) { typedef short v4i16_t __attribute__((ext_vector_type(4))); return __builtin_bit_cast(s16x4, __builtin_amdgcn_ds_read_tr16_b64_v4i16((LAS v4i16_t*)p)); }
__device__ __forceinline__ void attn_phase(const Args& A, LAS unsigned char* lds) {
    int tid_ = threadIdx.x; asm volatile("" : "+v"(tid_));
    const int tid = tid_, lane = tid & 63, r32 = lane & 31, hi = lane >> 5; const int wid = __builtin_amdgcn_readfirstlane(tid >> 6);
    const int nunits = (A.M / 128) * HKV;
    LAS float* TB = (LAS float*)(lds + ATT_TB_OFF);
    LAS float* LS = (LAS float*)(lds + ATT_LS_OFF) + wid * 64;
    LAS bf16* OST = (LAS bf16*)(lds + ATT_OST_OFF) + wid * 2048;
    for (int u = blockIdx.x; u < nunits; u += gridDim.x) {
        const int blk = u >> 2, hk = u & 3, t0 = blk * 128; const bool first = (t0 % SEQ) == 0;
#pragma unroll
        for (int i = 0; i < 4; ++i) {
            const int idx = tid + 512 * i, key = idx >> 3, cc = idx & 7;
            if (!(first && key < 128)) {
                const size_t g = (size_t)(t0 - 128 + key) * 256 + hk * 64 + cc * 8;
                const v4u kv = *(const v4u*)(A.k + g), vv = *(const v4u*)(A.v + g);
                *(LAS v4u*)(lds + ATT_K_OFF + (((key >> 5) * 4 + (cc >> 1)) * 2 + (cc & 1)) * 512 + (key & 31) * 16) = kv;
                *(LAS v4u*)(lds + ATT_V_OFF + ((key >> 2) * 2 + (cc >> 2)) * 256 + (key & 3) * 64 + (cc & 3) * 16) = vv;
            }
        }
        for (int e = tid; e < 4 * 192; e += NTHREADS) {
            const int g = e / 192, dist = e % 192 - 32;
            TB[e] = (dist >= 0 && dist < 128) ? A.rel_bias[T5B[dist] * HQ + hk * 4 + g] * pg8::LOG2E : -3.0e38f;
        }
        __syncthreads();
#pragma unroll 1
        for (int ti = 0; ti < 2; ++ti) {
            const int task = wid + 8 * ti, g = task >> 2, sub = task & 3, h = hk * 4 + g;
            const size_t qrow = (size_t)(t0 + 32 * sub + r32) * D + h * HD;
            bf16x8 qf[4];
#pragma unroll
            for (int d0 = 0; d0 < 4; ++d0) qf[d0] = *(const bf16x8*)(A.q + qrow + 16 * d0 + 8 * hi);
            f32x16 s[5];
            const LAS float* tb = TB + g * 192 + 32 + r32 - 4 * hi;
#pragma unroll
            for (int di = 0; di < 5; ++di)
#pragma unroll
                for (int r = 0; r < 16; ++r) s[di][r] = tb[32 * di - ((r & 3) + 8 * (r >> 2))];
            const float sink2 = A.sinks[h] * pg8::LOG2E;
            float mx = sink2;
#pragma unroll
            for (int di = 0; di < 5; ++di) {
                const int kt = sub + 4 - di;
                if (!(first && kt < 4)) {
#pragma unroll
                    for (int d0 = 0; d0 < 4; ++d0) {
                        const bf16x8 kf = *(const LAS bf16x8*)(lds + ATT_K_OFF + ((kt * 4 + d0) * 2 + hi) * 512 + r32 * 16);
                        s[di] = __builtin_amdgcn_mfma_f32_32x32x16_bf16(kf, qf[d0], s[di], 0, 0, 0);
                    }
#pragma unroll
                    for (int r = 0; r < 16; ++r) mx = fmaxf(mx, s[di][r]);
                }
            }
            mx = fmaxf(mx, __shfl_xor(mx, 32));
            float l = 0.f;
            f32x16 o0, o1;
#pragma unroll
            for (int r = 0; r < 16; ++r) { o0[r] = 0.f; o1[r] = 0.f; }
#pragma unroll
            for (int di = 0; di < 5; ++di) {
                const int kt = sub + 4 - di;
                if (!(first && kt < 4)) {
#pragma unroll
                    for (int r = 0; r < 16; ++r) { s[di][r] = __builtin_amdgcn_exp2f(s[di][r] - mx); l += s[di][r]; }
#pragma unroll
                    for (int s2 = 0; s2 < 2; ++s2) {
                        v4u pw; pw.x = pg8::cvt_pk_bf16(s[di][8 * s2 + 0], s[di][8 * s2 + 1]); pw.y = pg8::cvt_pk_bf16(s[di][8 * s2 + 2], s[di][8 * s2 + 3]);
                        pw.z = pg8::cvt_pk_bf16(s[di][8 * s2 + 4], s[di][8 * s2 + 5]); pw.w = pg8::cvt_pk_bf16(s[di][8 * s2 + 6], s[di][8 * s2 + 7]);
                        const bf16x8 pa = __builtin_bit_cast(bf16x8, pw);
                        const LAS unsigned char* vp = lds + ATT_V_OFF + ((8 * kt + 4 * s2 + hi) * 2) * 256 + ((lane & 15) >> 2) * 64 + (((lane >> 4) & 1) * 16 + (lane & 3) * 4) * 2;
                        const s16x4 a0 = vtr(vp), a1 = vtr(vp + 2 * 512), b0 = vtr(vp + 256), b1 = vtr(vp + 256 + 2 * 512);
                        const bf16x8 v0 = (bf16x8){a0[0], a0[1], a0[2], a0[3], a1[0], a1[1], a1[2], a1[3]};
                        const bf16x8 v1 = (bf16x8){b0[0], b0[1], b0[2], b0[3], b1[0], b1[1], b1[2], b1[3]};
                        o0 = __builtin_amdgcn_mfma_f32_32x32x16_bf16(pa, v0, o0, 0, 0, 0);
                        o1 = __builtin_amdgcn_mfma_f32_32x32x16_bf16(pa, v1, o1, 0, 0, 0);
                    }
                }
            }
            l += __shfl_xor(l, 32);
            l += __builtin_amdgcn_exp2f(sink2 - mx);
            if (hi == 0) LS[r32] = __builtin_amdgcn_rcpf(l);
#pragma unroll
            for (int r = 0; r < 16; ++r) {
                const int qq = (r & 3) + 8 * (r >> 2) + 4 * hi;
                const float li = LS[qq];
                OST[qq * 64 + r32] = (bf16)(pg8::cvt_pk_bf16(o0[r] * li, 0.f) & 0xffffu);
                OST[qq * 64 + 32 + r32] = (bf16)(pg8::cvt_pk_bf16(o1[r] * li, 0.f) & 0xffffu);
            }
            bf16* ob = A.o + (size_t)(t0 + 32 * sub) * D + h * HD;
#pragma unroll
            for (int i = 0; i < 4; ++i) { const int row = i * 8 + (lane >> 3), chn = lane & 7; *(v4u*)(ob + (size_t)row * D + chn * 8) = *(const LAS v4u*)(OST + row * 64 + chn * 8); }
        }
        __syncthreads();
    }
}
typedef unsigned gu32_t;
#define XB_TMO      128
#define XB_XCNT(j)  (256  + 64 * (j))
#define XB_XSUB(j)  (1280 + 64 * (j))
#define XB_XGEN(j)  (2304 + 64 * (j))
#define XB_TOP      3328
#define XB_TOPGEN   3392
#define XCD_BAR_WORDS 3456
#define XB_SPIN_CAP (1u << 18)

__device__ __forceinline__ unsigned xb_ld(unsigned* p)              { return __hip_atomic_load(p, __ATOMIC_RELAXED, __HIP_MEMORY_SCOPE_AGENT); }
__device__ __forceinline__ unsigned xb_add(unsigned* p, unsigned v) { return __hip_atomic_fetch_add(p, v, __ATOMIC_RELAXED, __HIP_MEMORY_SCOPE_AGENT); }
__device__ __forceinline__ unsigned xb_xcc_id() { return (unsigned)__builtin_amdgcn_s_getreg((3 << 11) | 20) & 0xFu; }
#define XB_SPIN(cond, bar) do { unsigned _sp = 0; while (cond) { __builtin_amdgcn_s_sleep(1); \
    if ((++_sp & 255u) == 0u) { if (xb_ld(&(bar)[XB_TMO])) break; if (_sp > XB_SPIN_CAP) { atomicAdd(&(bar)[XB_TMO], 1u); break; } } } } while (0)

struct XcdBarrier {
    unsigned* bar; unsigned x;
    volatile LAS unsigned* st;
};

__device__ __forceinline__ XcdBarrier xcd_barrier_post(unsigned* bar, volatile LAS unsigned* st) {
    XcdBarrier b; b.bar = bar; b.x = xb_xcc_id(); b.st = st;
    if (threadIdx.x == 0) (void)xb_add(&bar[XB_XCNT(b.x)], 1u);
    return b;
}
__device__ __forceinline__ void xcd_barrier_complete(unsigned* bar, unsigned x, unsigned& nloc, unsigned& nx) {
    const unsigned G = gridDim.x * gridDim.y * gridDim.z;
    unsigned sum, cnt, mine, sp = 0u;
    for (;;) {
        sum = 0u; cnt = 0u; mine = 0u;
#pragma unroll
        for (unsigned j = 0; j < 16; ++j) { const unsigned c = xb_ld(&bar[XB_XCNT(j)]); sum += c; cnt += (c > 0u) ? 1u : 0u; mine = (j == x) ? c : mine; }
        if (sum == G) break;
        __builtin_amdgcn_s_sleep(1);
        if ((++sp & 255u) == 0u) { if (xb_ld(&bar[XB_TMO])) break; if (sp > XB_SPIN_CAP) { atomicAdd(&bar[XB_TMO], 1u); break; } }
    }
    nloc = mine > 0u ? mine : 1u; nx = cnt > 0u ? cnt : 1u;
}

__device__ __forceinline__ void xcd_barrier(const XcdBarrier& b) {
    asm volatile("s_waitcnt vmcnt(0)" ::: "memory");
    __syncthreads();
    if (threadIdx.x == 0) {
        unsigned* bar = b.bar;
        __builtin_amdgcn_s_waitcnt(0);
        unsigned nloc = b.st[0], nx = b.st[1];
        if (nloc == 0u) { xcd_barrier_complete(bar, b.x, nloc, nx); b.st[0] = nloc; b.st[1] = nx; }
        const unsigned old = xb_add(&bar[XB_XSUB(b.x)], 1u);
        const unsigned gen = old / nloc;
        if (old + 1u == (gen + 1u) * nloc) {
            __builtin_amdgcn_fence(__ATOMIC_RELEASE, "agent");
            asm volatile("s_waitcnt vmcnt(0)" ::: "memory");
            const unsigned og = xb_add(&bar[XB_TOP], 1u);
            const unsigned tg = og / nx;
            if (og + 1u == (tg + 1u) * nx) xb_add(&bar[XB_TOPGEN], 1u);
            else XB_SPIN(xb_ld(&bar[XB_TOPGEN]) == tg, bar);
            __builtin_amdgcn_fence(__ATOMIC_ACQUIRE, "agent");
            xb_add(&bar[XB_XGEN(b.x)], 1u);
            asm volatile("s_waitcnt vmcnt(0)" ::: "memory");
        } else {
            XB_SPIN(xb_ld(&bar[XB_XGEN(b.x)]) == gen, bar);
            __builtin_amdgcn_fence(__ATOMIC_ACQUIRE, "agent");
            asm volatile("s_waitcnt vmcnt(0)" ::: "memory");
        }
    }
    __syncthreads();
}

typedef pg8::EpiResid<true, true, true> EpiRes2; typedef pg8::EpiResid<false, true, false> EpiRes6; typedef pg8::EpiResid<false, false, true> EpiRes8;
#ifndef STOP_AFTER
#define STOP_AFTER 99
#endif
#ifndef DUP_MASK
#define DUP_MASK 0
#endif
__global__ void __launch_bounds__(NTHREADS, 2) mega_fwd(Args A) {
    extern __shared__ __attribute__((aligned(16))) unsigned char lds_raw[];
    LAS unsigned char* lds = (LAS unsigned char*)lds_raw;
    const int tid = threadIdx.x, lane = tid & 63, wave = tid >> 6, G = gridDim.x;
    const int vcu = (G % 8 == 0) ? ((int)blockIdx.x % 8) * (G / 8) + (int)blockIdx.x / 8 : (int)blockIdx.x;
    const int M = A.M;
    volatile LAS unsigned* MISC = (volatile LAS unsigned*)(lds + RING_BYTES);
    if (tid < 16) MISC[tid] = 0u;
    __syncthreads();
    const XcdBarrier bar = xcd_barrier_post(A.ctl, MISC);
#define GRID_SYNC() xcd_barrier(bar)
#define GEMM_PHASE(EPI_T, AP, BP, NN, KK, ...) do { pg8::Gemm g_{AP, BP, M, NN, KK}; pg8::StaticOrder S_; S_.init(M, NN, G, (int)blockIdx.x); EPI_T E_{__VA_ARGS__}; \
        pg8::gemm_phase<EPI_T, pg8::StaticOrder, true, true>(lds, g_, S_, E_); } while (0)

    p0_prologue(A, lds, vcu * NWAVES + wave, G * NWAVES, lane);
    if (DUP_MASK & 1) { __syncthreads(); p0_prologue(A, lds, vcu * NWAVES + wave, G * NWAVES, lane); }
    GRID_SYNC();
    if (DUP_MASK & 8) GEMM_PHASE(pg8::EpiSwiglu, A.xb, A.W1i, 2 * FF, D, A.H, FF, A.ssq0);
    if (DUP_MASK & 64) GEMM_PHASE(pg8::EpiProbe<0>, A.xb, A.W1i, 2 * FF, D, A.H, FF, A.ssq0);
    if (DUP_MASK & 128) GEMM_PHASE(pg8::EpiProbe<1>, A.xb, A.W1i, 2 * FF, D, A.H, FF, A.ssq0);
    GEMM_PHASE(pg8::EpiSwiglu, A.xb, A.W1i, 2 * FF, D, A.H, FF, A.ssq0);
    GRID_SYNC();
    if (STOP_AFTER <= 1) return;
    if (DUP_MASK & 256) GEMM_PHASE(EpiRes2, A.H, A.W1o, D, FF, A.x, nullptr, A.x1, A.xb, A.ssq0);
    if (DUP_MASK & 512) GEMM_PHASE(pg8::EpiProbe<0>, A.H, A.W1o, D, FF, A.H, FF, A.ssq0);
    GEMM_PHASE(EpiRes2, A.H, A.W1o, D, FF, A.x, nullptr, A.x1, A.xb, A.ssq1);
    GRID_SYNC();
    if (STOP_AFTER <= 2) return;
    GEMM_PHASE(pg8::EpiMix, A.xb, A.Wmx, INW, D, A.ssq1, A.z, A.q, A.k, A.v, A.gc, A.ga, A.q_norm, A.k_norm);
    if (DUP_MASK & 16) GEMM_PHASE(pg8::EpiMix, A.xb, A.Wmx, INW, D, A.ssq1, A.z, A.q, A.k, A.v, A.gc, A.ga, A.q_norm, A.k_norm);
    GRID_SYNC();
    if (STOP_AFTER <= 3) return;
    conv_phase(A, lds);
    if (DUP_MASK & 2) conv_phase(A, lds);
    attn_phase(A, lds);
    if (DUP_MASK & 4) attn_phase(A, lds);
    GRID_SYNC();
    if (STOP_AFTER <= 4) return;
    do { pg8::Gemm g_{A.c, A.Wcp, M, D, D, A.o, A.Wao}; pg8::StaticOrder S_; S_.init(M, D, G, (int)blockIdx.x); pg8::EpiMerge E_{A.gc, A.ga, A.mg};
         pg8::gemm_phase<pg8::EpiMerge, pg8::StaticOrder, true, true, 2>(lds, g_, S_, E_); } while (0);
    GRID_SYNC();
    if (STOP_AFTER <= 6) return;
    GEMM_PHASE(EpiRes6, A.mg, A.Wot, D, D, nullptr, A.xb, A.x2, A.xb, A.ssq2);
    GRID_SYNC();
    if (STOP_AFTER <= 7) return;
    GEMM_PHASE(pg8::EpiSwiglu, A.xb, A.W2i, 2 * FF, D, A.H2, FF, A.ssq2);
    if (DUP_MASK & 32) GEMM_PHASE(pg8::EpiSwiglu, A.xb, A.W2i, 2 * FF, D, A.H2, FF, A.ssq2);
    GRID_SYNC();
    GEMM_PHASE(EpiRes8, A.H2, A.W2o, D, FF, nullptr, A.xb, A.out, nullptr, nullptr);
#undef GEMM_PHASE
#undef GRID_SYNC
}

static size_t ws_map(Args& a, unsigned char* ws, int M, bool alias) {
    size_t off = 0;
    auto take = [&](size_t bytes) { unsigned char* p = ws + off; off += (bytes + 255) & ~(size_t)255; return p; };
    a.ctl = (unsigned*)take(1u << 20);
    a.ssq0 = (float*)take((size_t)M * 4); a.ssq1 = (float*)take((size_t)M * 4); a.ssq2 = (float*)take((size_t)M * 4);
    a.W1i = (bf16*)take((size_t)2 * FF * D * 2); a.W1o = (bf16*)take((size_t)D * FF * 2); a.Wmx = (bf16*)take((size_t)INW * D * 2);
    a.Wcp = (bf16*)take((size_t)D * D * 2); a.Wao = (bf16*)take((size_t)D * D * 2); a.Wot = (bf16*)take((size_t)D * D * 2);
    a.W2i = (bf16*)take((size_t)2 * FF * D * 2); a.W2o = (bf16*)take((size_t)D * FF * 2);
    const size_t act = (size_t)M * D * 2;
    a.xb = (bf16*)take(act);
    a.H = (bf16*)take((size_t)M * FF * 2); a.H2 = a.H;
    if (alias) {
        a.z = a.H; a.q = a.z + (size_t)M * D; a.k = a.q + (size_t)M * D; a.v = a.k + (size_t)M * 256;
        a.gc = (bf16*)take(act); a.ga = (bf16*)take(act); a.c = (bf16*)take(act);
        a.o = a.q; a.m1 = nullptr; a.mg = a.z;
    } else {
        a.z = (bf16*)take(act); a.q = (bf16*)take(act); a.k = (bf16*)take((size_t)M * 256 * 2); a.v = (bf16*)take((size_t)M * 256 * 2);
        a.gc = (bf16*)take(act); a.ga = (bf16*)take(act); a.c = (bf16*)take(act);
        a.o = (bf16*)take(act); a.m1 = nullptr; a.mg = (bf16*)take(act);
    }
    return off;
}
static void set_inputs(Args& a, void* const* d_in) {
    a.x = (const float*)d_in[0]; a.ffn1_norm = (const float*)d_in[1]; a.ffn1_w_in = (const float*)d_in[2]; a.ffn1_w_out = (const float*)d_in[3];
    a.mix_norm = (const float*)d_in[4]; a.w_in = (const float*)d_in[5]; a.conv_w = (const float*)d_in[6]; a.conv_b = (const float*)d_in[7];
    a.ln_g = (const float*)d_in[8]; a.ln_b = (const float*)d_in[9]; a.conv_proj = (const float*)d_in[10]; a.q_norm = (const float*)d_in[11];
    a.k_norm = (const float*)d_in[12]; a.sinks = (const float*)d_in[13]; a.rel_bias = (const float*)d_in[14]; a.attn_wo = (const float*)d_in[15];
    a.w_out = (const float*)d_in[16]; a.ffn2_norm = (const float*)d_in[17]; a.ffn2_w_in = (const float*)d_in[18]; a.ffn2_w_out = (const float*)d_in[19];
}
static int g_grid = 0;
static bool launch_mega(Args& a, hipStream_t stream) {
    if (g_grid == 0) {
        int dev = 0, cus = 0, per_cu = 0;
        if (hipGetDevice(&dev) != hipSuccess || hipDeviceGetAttribute(&cus, hipDeviceAttributeMultiprocessorCount, dev) != hipSuccess) { g_grid = -1; return false; }
        if (hipFuncSetAttribute((const void*)mega_fwd, hipFuncAttributeMaxDynamicSharedMemorySize, LDS_BYTES) != hipSuccess) { fprintf(stderr, "hipFuncSetAttribute failed\n"); g_grid = -1; return false; }
        if (hipOccupancyMaxActiveBlocksPerMultiprocessor(&per_cu, (const void*)mega_fwd, NTHREADS, LDS_BYTES) != hipSuccess || per_cu < 1) { fprintf(stderr, "occupancy query: %d blocks per CU\n", per_cu); g_grid = -1; (void)hipGetLastError(); return false; }
        g_grid = cus;
    }
    if (g_grid < 0) return false;
    void* args[] = {&a};
    const hipError_t e = hipLaunchCooperativeKernel((const void*)mega_fwd, dim3(g_grid), dim3(NTHREADS), args, LDS_BYTES, stream);
    if (e != hipSuccess) { fprintf(stderr, "cooperative launch failed: %s (grid %d)\n", hipGetErrorString(e), g_grid); return false; }
    return true;
}
#if DEBUG_ORACLE
namespace nv {
constexpr int S = SEQ, B = NB;
constexpr float EPS = 1e-6f;
__device__ __forceinline__ float sigmoidf_(float v) { return 1.f / (1.f + expf(-v)); }
__device__ __forceinline__ float siluf_(float v) { return v / (1.f + expf(-v)); }
__device__ __forceinline__ float block_sum_256(float v, float* red) {
    for (int o = 32; o > 0; o >>= 1) v += __shfl_xor(v, o);
    const int w = threadIdx.x >> 6, l = threadIdx.x & 63;
    __syncthreads(); if (l == 0) red[w] = v; __syncthreads();
    return red[0] + red[1] + red[2] + red[3];
}
__global__ void rms_rows(const float* x, const float* g, float* out) {
    __shared__ float red[4];
    const size_t r = blockIdx.x;
    const float4 v = ((const float4*)(x + r * D))[threadIdx.x];
    const float ss = block_sum_256(v.x * v.x + v.y * v.y + v.z * v.z + v.w * v.w, red);
    const float rs = rsqrtf(ss * (1.f / D) + EPS);
    const float4 gg = ((const float4*)g)[threadIdx.x];
    float4 o; o.x = v.x * rs * gg.x; o.y = v.y * rs * gg.y; o.z = v.z * rs * gg.z; o.w = v.w * rs * gg.w;
    ((float4*)(out + r * D))[threadIdx.x] = o;
}
__global__ void gemm_f32(const float* __restrict__ A, int lda, const float* __restrict__ Bm, int ldb, float* __restrict__ C, int ldc, int K) {
    __shared__ float As[16][68];
    __shared__ float Bs[16][68];
    const int tx = threadIdx.x & 15, ty = threadIdx.x >> 4;
    const int m0 = blockIdx.y * 64, n0 = blockIdx.x * 64;
    float acc[4][4] = {};
    for (int k0 = 0; k0 < K; k0 += 16) {
        {
            const int r = threadIdx.x >> 2, kq = (threadIdx.x & 3) * 4;
            const float4 a = *(const float4*)(A + (size_t)(m0 + r) * lda + k0 + kq);
            As[kq + 0][r] = a.x; As[kq + 1][r] = a.y; As[kq + 2][r] = a.z; As[kq + 3][r] = a.w;
            const int kr = threadIdx.x >> 4, c4 = (threadIdx.x & 15) * 4;
            *(float4*)&Bs[kr][c4] = *(const float4*)(Bm + (size_t)(k0 + kr) * ldb + n0 + c4);
        }
        __syncthreads();
#pragma unroll
        for (int k = 0; k < 16; ++k) {
            const float4 a = *(const float4*)&As[k][ty * 4];
            const float4 b = *(const float4*)&Bs[k][tx * 4];
            const float av[4] = {a.x, a.y, a.z, a.w}, bv[4] = {b.x, b.y, b.z, b.w};
#pragma unroll
            for (int i = 0; i < 4; ++i)
#pragma unroll
                for (int j = 0; j < 4; ++j) acc[i][j] = fmaf(av[i], bv[j], acc[i][j]);
        }
        __syncthreads();
    }
#pragma unroll
    for (int i = 0; i < 4; ++i) { float4 o; o.x = acc[i][0]; o.y = acc[i][1]; o.z = acc[i][2]; o.w = acc[i][3]; *(float4*)(C + (size_t)(m0 + ty * 4 + i) * ldc + n0 + tx * 4) = o; }
}
__global__ void swiglu_k(const float* U, float* H, int rows) {
    const size_t i = (size_t)blockIdx.x * blockDim.x + threadIdx.x;
    if (i >= (size_t)rows * FF) return;
    const size_t t = i / FF; const int j = (int)(i % FF);
    H[i] = siluf_(U[t * (2 * FF) + j]) * U[t * (2 * FF) + FF + j];
}
__global__ void resid_k(const float* xin, const float* y, float scale, float* out, size_t n) {
    const size_t i = (size_t)blockIdx.x * blockDim.x + threadIdx.x;
    if (i < n) out[i] = xin[i] + scale * y[i];
}
__global__ void glu_k(const float* P, float* z, int rows) {
    const size_t i = (size_t)blockIdx.x * blockDim.x + threadIdx.x;
    if (i >= (size_t)rows * D) return;
    const size_t t = i / D; const int c = (int)(i % D);
    z[i] = P[t * INW + c] * sigmoidf_(P[t * INW + D + c]);
}
__global__ void conv_k(const float* z, const float* w, const float* bias, float* y) {
    const size_t i = (size_t)blockIdx.x * blockDim.x + threadIdx.x;
    if (i >= (size_t)S * D) return;
    const int t = (int)(i / D), c = (int)(i % D);
    float acc = bias[c];
    for (int k = 0; k < CWID; ++k) { const int tt = t - (CWID - 1) + k; if (tt >= 0) acc = fmaf(w[k * D + c], z[(size_t)tt * D + c], acc); }
    y[i] = acc;
}
__global__ void ln_silu_k(const float* y, const float* g, const float* b, float* out) {
    __shared__ float red[4];
    const size_t r = blockIdx.x;
    const float4 v = ((const float4*)(y + r * D))[threadIdx.x];
    const float mu = block_sum_256(v.x + v.y + v.z + v.w, red) * (1.f / D);
    const float dx = v.x - mu, dy = v.y - mu, dz = v.z - mu, dw = v.w - mu;
    const float var = block_sum_256(dx * dx + dy * dy + dz * dz + dw * dw, red) * (1.f / D);
    const float rs = rsqrtf(var + EPS);
    const float4 gg = ((const float4*)g)[threadIdx.x], bb = ((const float4*)b)[threadIdx.x];
    float4 o; o.x = siluf_(dx * rs * gg.x + bb.x); o.y = siluf_(dy * rs * gg.y + bb.y); o.z = siluf_(dz * rs * gg.z + bb.z); o.w = siluf_(dw * rs * gg.w + bb.w);
    ((float4*)(out + r * D))[threadIdx.x] = o;
}
__global__ void qknorm_k(const float* P, const float* qg, const float* kg, float* qn, float* kn) {
    const int wv = (blockIdx.x * 4) + (threadIdx.x >> 6), lane = threadIdx.x & 63;
    const int t = wv / (HQ + HKV), hh = wv % (HQ + HKV);
    if (t >= S) return;
    const bool isq = hh < HQ;
    const int h = isq ? hh : hh - HQ;
    const float v = P[(size_t)t * INW + (isq ? 2 * D + h * HD : 3 * D + h * HD) + lane];
    float ss = v * v;
    for (int o = 32; o > 0; o >>= 1) ss += __shfl_xor(ss, o);
    const float rs = rsqrtf(ss * (1.f / HD) + EPS);
    if (isq) qn[(size_t)t * (HQ * HD) + h * HD + lane] = v * rs * qg[lane];
    else     kn[(size_t)t * (HKV * HD) + h * HD + lane] = v * rs * kg[lane];
}
__global__ void attn_k(const float* qn, const float* kn, const float* P, const float* sinks, const float* rel_bias, float* o) {
    const int wv = (blockIdx.x * 4) + (threadIdx.x >> 6), lane = threadIdx.x & 63;
    const int t = wv / HQ, h = wv % HQ, hk = h / (HQ / HKV);
    if (t >= S) return;
    const float* q = qn + (size_t)t * (HQ * HD) + h * HD;
    float s[2];
#pragma unroll
    for (int u = 0; u < 2; ++u) {
        const int dist = lane + 64 * u, key = t - dist;
        float acc = -3.0e38f;
        if (key >= 0) {
            const float* kr = kn + (size_t)key * (HKV * HD) + hk * HD;
            float d = 0.f;
            for (int e = 0; e < HD; ++e) d = fmaf(q[e], kr[e], d);
            acc = d * 0.125f + rel_bias[T5B[dist] * HQ + h];
        }
        s[u] = acc;
    }
    const float sink = sinks[h];
    float m = fmaxf(fmaxf(s[0], s[1]), sink);
    for (int of = 32; of > 0; of >>= 1) m = fmaxf(m, __shfl_xor(m, of));
    float p0 = (t - lane >= 0) ? expf(s[0] - m) : 0.f, p1 = (t - lane - 64 >= 0) ? expf(s[1] - m) : 0.f;
    float l = p0 + p1;
    for (int of = 32; of > 0; of >>= 1) l += __shfl_xor(l, of);
    l += expf(sink - m);
    const float inv = 1.f / l;
    float acc = 0.f;
    for (int j = 0; j < 64; ++j) {
        const float pj0 = __shfl(p0, j), pj1 = __shfl(p1, j);
        const int k0 = t - j, k1 = t - j - 64;
        if (k0 >= 0) acc = fmaf(pj0, P[(size_t)k0 * INW + 3 * D + HKV * HD + hk * HD + lane], acc);
        if (k1 >= 0) acc = fmaf(pj1, P[(size_t)k1 * INW + 3 * D + HKV * HD + hk * HD + lane], acc);
    }
    o[(size_t)t * (HQ * HD) + h * HD + lane] = acc * inv;
}
__global__ void merge_k(const float* P, const float* a, const float* b, float* mg, int rows) {
    const size_t i = (size_t)blockIdx.x * blockDim.x + threadIdx.x;
    if (i >= (size_t)rows * D) return;
    const size_t t = i / D; const int c = (int)(i % D);
    mg[i] = sigmoidf_(P[t * INW + 3584 + c]) * a[i] + sigmoidf_(P[t * INW + 4608 + c]) * b[i];
}
static void gemm(const float* A, int lda, const float* Bm, int ldb, float* C, int ldc, int M, int N, int K, hipStream_t st) {
    hipLaunchKernelGGL(gemm_f32, dim3(N / 64, M / 64), dim3(256), 0, st, A, lda, Bm, ldb, C, ldc, K);
}
__global__ void cmp_k(const void* a, int a_is_bf16, int lda, float ascale, const float* ref, int ldr, int sig, int rows, int cols, unsigned* slot) {
    const size_t i = (size_t)blockIdx.x * blockDim.x + threadIdx.x;
    float d = 0.f, r2 = 0.f;
    if (i < (size_t)rows * cols) {
        const size_t t = i / cols; const int c = (int)(i % cols);
        float av = a_is_bf16 ? __uint_as_float((unsigned)((const unsigned short*)a)[t * lda + c] << 16) : ((const float*)a)[t * lda + c];
        float rv = ref[t * ldr + c]; if (sig) rv = sigmoidf_(rv);
        d = fabsf(av * ascale - rv); if (!(d == d)) d = 1e30f; r2 = rv * rv;
    }
    float d2 = d * d;
    for (int o = 32; o > 0; o >>= 1) { d = fmaxf(d, __shfl_xor(d, o)); r2 += __shfl_xor(r2, o); d2 += __shfl_xor(d2, o); }
    if ((threadIdx.x & 63) == 0) { atomicMax(slot, __float_as_uint(d)); atomicAdd((float*)(slot + 1), r2); atomicAdd((float*)(slot + 2), d2); }
}
constexpr int NCHK = 16;
struct Counts { float c[NCHK]; };
__global__ void decide_k(unsigned* slots, Counts cnt, float tol, float* code_out) {
    if (threadIdx.x != 0 || blockIdx.x != 0) return;
    float code = 0.f;
    for (int k = 0; k < NCHK; ++k) {
        if (cnt.c[k] <= 0.f) continue;
        const float md = __uint_as_float(slots[4 * k]), rr = __uint_as_float(slots[4 * k + 1]), dd = __uint_as_float(slots[4 * k + 2]);
        const float rms = sqrtf(rr / cnt.c[k]), rmsr = sqrtf(dd / fmaxf(rr, 1e-30f));
        if (!(rmsr <= tol) || !(md <= 0.5f * rms)) { code = (float)(k + 1) + (rmsr < 0.03f ? 0.f : rmsr < 0.3f ? 0.3f : 0.6f); break; }
    }
    *code_out = code;
}
__global__ void finish_k(float* out, const float* mega_out, size_t dbg_off, size_t dbg_n, size_t n, const float* code) {
    const size_t i = (size_t)blockIdx.x * blockDim.x + threadIdx.x;
    if (i >= n) return;
    const float c = *code;
    float v = out[i];
    if (c == 0.f && i >= dbg_off && i < dbg_off + dbg_n) v = mega_out[i - dbg_off];
    out[i] = v * (1.f + c);
}
}
#ifndef DBG_B
#define DBG_B 5
#endif
#ifndef DBG_TOL
#define DBG_TOL 0.01f
#endif
#endif

extern "C" void kernel_launch(void* const* d_in, const int* in_sizes, int n_in, void* d_out, int out_size, void* d_ws, size_t ws_size, hipStream_t stream) {
    (void)in_sizes; (void)n_in; (void)out_size; (void)ws_size;
#if !DEBUG_ORACLE
    Args a{};
    set_inputs(a, d_in);
    a.out = (float*)d_out; a.x1 = nullptr; a.x2 = nullptr;
    ws_map(a, (unsigned char*)d_ws, M_FULL, true);
    a.M = M_FULL;
    if (hipMemsetAsync(a.ctl, 0, CTL_ZERO_BYTES, stream) != hipSuccess) return;
    launch_mega(a, stream);
#else
    using namespace nv;
    unsigned char* wsb = (unsigned char*)d_ws;
    Args a{};
    set_inputs(a, d_in);
    a.x += (size_t)DBG_B * S * D;
    size_t used = ws_map(a, wsb, S, false);
    auto takeb = [&](size_t bytes) { unsigned char* p = wsb + used; used += (bytes + 255) & ~(size_t)255; return p; };
    a.x1 = (float*)takeb((size_t)S * D * 4); a.x2 = (float*)takeb((size_t)S * D * 4); a.out = (float*)takeb((size_t)S * D * 4);
    a.H2 = (bf16*)takeb((size_t)S * FF * 2);
    a.M = S;
    unsigned* slots = (unsigned*)takeb(256); float* code = (float*)takeb(256);
    Counts hc{};
    const float* x = (const float*)d_in[0];
    float* out = (float*)d_out;
    float* xn = (float*)takeb((size_t)S * D * 4); float* U = (float*)takeb((size_t)S * INW * 4); float* Hh = (float*)takeb((size_t)S * FF * 4); float* Y = (float*)takeb((size_t)S * D * 4);
    float* z = (float*)takeb((size_t)S * D * 4); float* cy = xn; float* cv = (float*)takeb((size_t)S * D * 4); float* qn = (float*)takeb((size_t)S * D * 4);
    float* kn = (float*)takeb((size_t)S * 256 * 4); float* ao = (float*)takeb((size_t)S * D * 4); float* av = (float*)takeb((size_t)S * D * 4); float* bv = (float*)takeb((size_t)S * D * 4);
    float* mg = (float*)takeb((size_t)S * D * 4);
    if (used > ws_size) { fprintf(stderr, "debug build needs %zu bytes of workspace, have %zu\n", used, ws_size); return; }
    hipMemsetAsync(slots, 0, 256, stream);
    hipMemsetAsync(a.ctl, 0, CTL_ZERO_BYTES, stream);
    launch_mega(a, stream);
    const int EB = 256; const size_t n1 = (size_t)S * D;
    int nchk = 0;
    auto chk = [&](const void* ap, int isbf, int lda, float asc, const float* ref, int ldr, int sig, int rows, int cols) {
        const size_t n = (size_t)rows * cols;
        hipLaunchKernelGGL(cmp_k, dim3((unsigned)((n + 255) / 256)), dim3(256), 0, stream, ap, isbf, lda, asc, ref, ldr, sig, rows, cols, slots + 4 * nchk);
        hc.c[nchk] = (float)n; ++nchk;
    };
    for (int bi = 0; bi < B; ++bi) {
        const int b = (bi == B - 1) ? DBG_B : (bi >= DBG_B ? bi + 1 : bi);
        const bool dbg = (b == DBG_B);
        const float* xbp = x + (size_t)b * S * D; float* ob = out + (size_t)b * S * D;
        hipLaunchKernelGGL(rms_rows, dim3(S), dim3(256), 0, stream, xbp, a.ffn1_norm, xn);
        gemm(xn, D, a.ffn1_w_in, 2 * FF, U, 2 * FF, S, 2 * FF, D, stream);
        hipLaunchKernelGGL(swiglu_k, dim3((unsigned)(((size_t)S * FF + EB - 1) / EB)), dim3(EB), 0, stream, U, Hh, S);
        if (dbg) chk(a.H, 1, FF, 1.f, Hh, FF, 0, S, FF);
        gemm(Hh, FF, a.ffn1_w_out, D, Y, D, S, D, FF, stream);
        hipLaunchKernelGGL(resid_k, dim3((unsigned)((n1 + EB - 1) / EB)), dim3(EB), 0, stream, xbp, Y, 0.5f, ob, n1);
        if (dbg) chk(a.x1, 0, D, 1.f, ob, D, 0, S, D);
        hipLaunchKernelGGL(rms_rows, dim3(S), dim3(256), 0, stream, ob, a.mix_norm, xn);
        gemm(xn, D, a.w_in, INW, U, INW, S, INW, D, stream);
        hipLaunchKernelGGL(glu_k, dim3((unsigned)((n1 + EB - 1) / EB)), dim3(EB), 0, stream, U, z, S);
        if (dbg) chk(a.z, 1, D, 1.f, z, D, 0, S, D);
        hipLaunchKernelGGL(qknorm_k, dim3(S * (HQ + HKV) / 4), dim3(256), 0, stream, U, a.q_norm, a.k_norm, qn, kn);
        if (dbg) { chk(a.q, 1, D, 1.f / (0.125f * 1.4426950408889634f), qn, D, 0, S, D);
                   chk(a.k, 1, 256, 1.f, kn, 256, 0, S, 256);
                   chk(a.v, 1, 256, 1.f, U + 3328, INW, 0, S, 256);
                   chk(a.ga, 1, D, 1.f, U + 4608, INW, 1, S, D);
                   chk(a.ga, 1, D, 1.f, U + 4608, INW, 1, S, D); }
        hipLaunchKernelGGL(conv_k, dim3((unsigned)((n1 + EB - 1) / EB)), dim3(EB), 0, stream, z, a.conv_w, a.conv_b, cy);
        hipLaunchKernelGGL(ln_silu_k, dim3(S), dim3(256), 0, stream, cy, a.ln_g, a.ln_b, cv);
        if (dbg) chk(a.c, 1, D, 1.f, cv, D, 0, S, D);
        gemm(cv, D, a.conv_proj, D, av, D, S, D, D, stream);
        hipLaunchKernelGGL(attn_k, dim3(S * HQ / 4), dim3(256), 0, stream, qn, kn, U, a.sinks, a.rel_bias, ao);
        if (dbg) chk(a.o, 1, D, 1.f, ao, D, 0, S, D);
        gemm(ao, D, a.attn_wo, D, bv, D, S, D, D, stream);
        hipLaunchKernelGGL(merge_k, dim3((unsigned)((n1 + EB - 1) / EB)), dim3(EB), 0, stream, U, av, bv, mg, S);
        if (dbg) chk(a.mg, 1, D, 1.f, mg, D, 0, S, D);
        gemm(mg, D, a.w_out, D, Y, D, S, D, D, stream);
        hipLaunchKernelGGL(resid_k, dim3((unsigned)((n1 + EB - 1) / EB)), dim3(EB), 0, stream, ob, Y, 1.0f, ob, n1);
        if (dbg) chk(a.x2, 0, D, 1.f, ob, D, 0, S, D);
        hipLaunchKernelGGL(rms_rows, dim3(S), dim3(256), 0, stream, ob, a.ffn2_norm, xn);
        gemm(xn, D, a.ffn2_w_in, 2 * FF, U, 2 * FF, S, 2 * FF, D, stream);
        hipLaunchKernelGGL(swiglu_k, dim3((unsigned)(((size_t)S * FF + EB - 1) / EB)), dim3(EB), 0, stream, U, Hh, S);
        if (dbg) chk(a.H2, 1, FF, 1.f, Hh, FF, 0, S, FF);
        gemm(Hh, FF, a.ffn2_w_out, D, Y, D, S, D, FF, stream);
        hipLaunchKernelGGL(resid_k, dim3((unsigned)((n1 + EB - 1) / EB)), dim3(EB), 0, stream, ob, Y, 0.5f, ob, n1);
        if (dbg) chk(a.out, 0, D, 1.f, ob, D, 0, S, D);
    }
    hipLaunchKernelGGL(decide_k, dim3(1), dim3(64), 0, stream, slots, hc, DBG_TOL, code);
    const size_t nall = (size_t)B * S * D;
    hipLaunchKernelGGL(finish_k, dim3((unsigned)((nall + 255) / 256)), dim3(256), 0, stream, out, a.out, (size_t)DBG_B * S * D, (size_t)S * D, nall, code);
#endif
}
```

```cpp
#include <hip/hip_runtime.h>
#include <cstdio>
#include <cstdint>
#ifndef GEMM_DESYNC
#define GEMM_DESYNC 0
#endif
#ifndef DEBUG_ORACLE
#define DEBUG_ORACLE 0
#endif
namespace pg8 {
#define PG8_LAS __attribute__((address_space(3)))
typedef unsigned short bf16_t;
typedef short bf16x8 __attribute__((ext_vector_type(8)));
typedef float f32x4 __attribute__((ext_vector_type(4)));
typedef unsigned u32x4 __attribute__((ext_vector_type(4)));
constexpr int BM = 256, BK = 64, HALF = 128, HTB = HALF * BK * 2  , STAGE_BYTES = 8 * HTB, NXCD = 8, WGM = 8;

__host__ __device__ __forceinline__ int lds_byte(int r, int c) { const int st = (r >> 4) * 2 + (c >> 5), rr = r & 15, cc = c & 31, ob = rr * 64 + cc * 2; return st * 1024 + (ob ^ (((ob >> 9) & 1) << 5)); }
__host__ __device__ __forceinline__ void stage_rc(int b, int& R, int& C) { const int st = b / 1024, sb = b % 1024, swz = sb ^ (((sb >> 9) & 1) << 5); R = (st >> 1) * 16 + swz / 64; C = (st & 1) * 32 + (swz % 64) / 2; }
__host__ __device__ __forceinline__ int perm32(int rho) { const int n = rho >> 4, i = rho & 15; return 8 * (i >> 2) + 4 * n + (i & 3); }

__device__ __forceinline__ int fresh_lane_id() { int l; asm volatile("v_mbcnt_lo_u32_b32 %0, -1, 0\n\tv_mbcnt_hi_u32_b32 %0, -1, %0" : "=v"(l)); return l; }
struct Unit { int pm, pn; };
struct Gemm { const bf16_t* A; const bf16_t* Bt; int M, N, K; const bf16_t* A2; const bf16_t* Bt2; };

struct StaticOrder {
    int nM, nN, nwg, G, c, rev;
    __host__ __device__ void init(int M, int N, int G_, int c_, int rev_ = 0) { nM = M / BM; nN = N / BM; nwg = nM * nN; G = G_; c = c_; rev = rev_; }
    __host__ __device__ bool next(int i, Unit& u) const {
        const int nr = nwg / G; if (rev == 2) { if (i >= 2 * nr) return false; i %= nr; }
        const int ii = (rev == 1 && nwg % G == 0 && i < nr) ? nr - 1 - i : i;
        const long L = (long)ii * G + c; if (L >= nwg) return false;
        int wgid = (int)L; { const int q = nwg / NXCD, r = nwg % NXCD, xcd = wgid % NXCD, off = wgid / NXCD; wgid = (xcd < r ? xcd * (q + 1) : r * (q + 1) + (xcd - r) * q) + off; }
        const int nig = WGM * nN, gid = wgid / nig, fm = gid * WGM, gsz = (nM - fm) < WGM ? (nM - fm) : WGM;
        u.pm = fm + ((wgid % nig) % gsz); u.pn = (wgid % nig) / gsz; if (rev == 3) { u.pm = 0; u.pn = 0; }
        return true;
    }
    __device__ __forceinline__ void a_ready(const Unit&) const {}
    __device__ __forceinline__ void done(const Unit&) const {}
};

constexpr float RMS_EPS = 1e-6f;
constexpr float LOG2E = 1.4426950408889634f;
typedef float f32x2 __attribute__((ext_vector_type(2)));
typedef __bf16 bf16x2_t __attribute__((ext_vector_type(2)));
__device__ __forceinline__ unsigned cvt_pk_bf16(float lo, float hi) { f32x2 v = {lo, hi}; bf16x2_t b = __builtin_convertvector(v, bf16x2_t); return __builtin_bit_cast(unsigned, b); }
__device__ __forceinline__ u32x4 pack8(const f32x4 a, const f32x4 b) { u32x4 w; w.x = cvt_pk_bf16(a[0], a[1]); w.y = cvt_pk_bf16(a[2], a[3]); w.z = cvt_pk_bf16(b[0], b[1]); w.w = cvt_pk_bf16(b[2], b[3]); return w; }
__device__ __forceinline__ void unpack8(const u32x4 w, f32x4& a, f32x4& b) {
    a[0] = __uint_as_float(w.x << 16); a[1] = __uint_as_float(w.x & 0xffff0000u); a[2] = __uint_as_float(w.y << 16); a[3] = __uint_as_float(w.y & 0xffff0000u);
    b[0] = __uint_as_float(w.z << 16); b[1] = __uint_as_float(w.z & 0xffff0000u); b[2] = __uint_as_float(w.w << 16); b[3] = __uint_as_float(w.w & 0xffff0000u); }
__device__ __forceinline__ float fast_sigmoid(float v) { return __builtin_amdgcn_rcpf(1.0f + __builtin_amdgcn_exp2f(-LOG2E * v)); }
__device__ __forceinline__ f32x4 sigmoid4(const f32x4 v) { f32x4 o; o[0] = fast_sigmoid(v[0]); o[1] = fast_sigmoid(v[1]); o[2] = fast_sigmoid(v[2]); o[3] = fast_sigmoid(v[3]); return o; }
#ifndef NT_STORE_ALL
#define NT_STORE_ALL 0
#endif
#if NT_STORE_ALL == 2
__device__ __forceinline__ void st16_sc1(void* p, u32x4 v) { asm volatile("global_store_dwordx4 %0, %1, off sc1\n\ts_nop 1" :: "v"(p), "v"(v) : "memory"); }
#define EPI_ST16(ptr, val) st16_sc1((void*)(ptr), (val))
#define EPI_ST16F(ptr, val) st16_sc1((void*)(ptr), __builtin_bit_cast(u32x4, (val)))
#elif NT_STORE_ALL
#define EPI_ST16(ptr, val) __builtin_nontemporal_store((val), (u32x4*)(ptr))
#define EPI_ST16F(ptr, val) __builtin_nontemporal_store((val), (f32x4*)(ptr))
#else
#define EPI_ST16(ptr, val) (*(u32x4*)(ptr) = (val))
#ifndef NT_STORE_OUT
#define NT_STORE_OUT 1
#endif
#if NT_STORE_OUT
#define EPI_ST16F(ptr, val) __builtin_nontemporal_store((val), (f32x4*)(ptr))
#else
#define EPI_ST16F(ptr, val) (*(f32x4*)(ptr) = (val))
#endif
#endif
#ifndef NT_LOAD_EPI
#define NT_LOAD_EPI 0
#endif
#if NT_LOAD_EPI
#define EPI_LD16(ptr) __builtin_nontemporal_load((const u32x4*)(ptr))
#else
#define EPI_LD16(ptr) (*(const u32x4*)(ptr))
#endif
#ifndef NT_STORE_H
#define NT_STORE_H 0
#endif
#ifndef BLOCKED_ACT
#define BLOCKED_ACT 0
#endif
__device__ __forceinline__ size_t blk_off(int row, int col, int K) { return BLOCKED_ACT ? ((size_t)(row >> 4) * (K >> 5) + (col >> 5)) * 512 + (row & 15) * 32 + (col & 31) : (size_t)row * K + col; }
#ifndef BLOCKED_H
#define BLOCKED_H 0
#endif
__device__ __forceinline__ size_t blk_off_h(int row, int col, int K) { return (BLOCKED_ACT || BLOCKED_H) ? ((size_t)(row >> 4) * (K >> 5) + (col >> 5)) * 512 + (row & 15) * 32 + (col & 31) : (size_t)row * K + col; }
constexpr int BJ_STEP = BLOCKED_ACT ? (HALF / 32) * 512 : HALF;
__device__ __forceinline__ float dot4(const f32x4 v) { return (v[0] * v[0] + v[1] * v[1]) + (v[2] * v[2] + v[3] * v[3]); }

struct EpiSwiglu {
    static constexpr bool PERM = true, AFTER_DRAIN = false; static constexpr int VMOPS = 12;
    bf16_t* H; int ldh; const float* ssq;
    __device__ __forceinline__ void operator()(const f32x4 (&acc)[2][2][4][2], const Unit& u, int wr, int wc, int fr, int fq) const {
        const int row0 = u.pm * BM + wr * 64 + fr, col0 = u.pn * HALF + wc * 32 + 8 * fq;
        float rs[2][4];
#pragma unroll
        for (int ai = 0; ai < 2; ++ai)
#pragma unroll
            for (int m = 0; m < 4; ++m) rs[ai][m] = ssq[row0 + ai * HALF + m * 16];
#pragma unroll
        for (int ai = 0; ai < 2; ++ai)
#pragma unroll
            for (int m = 0; m < 4; ++m) {
                const float r = __builtin_amdgcn_rsqf(rs[ai][m] * (1.0f / 1024.0f) + RMS_EPS), c1 = -LOG2E * r, r2 = r * r;
                f32x4 h[2];
#pragma unroll
                for (int n = 0; n < 2; ++n) {
#pragma unroll
                    for (int j = 0; j < 4; ++j) { const float a = acc[ai][0][m][n][j], b = acc[ai][1][m][n][j]; h[n][j] = (a * b) * (r2 * __builtin_amdgcn_rcpf(1.0f + __builtin_amdgcn_exp2f(a * c1))); } }
#if NT_STORE_H
                __builtin_nontemporal_store(pack8(h[0], h[1]), (u32x4*)(H + blk_off_h(row0 + ai * HALF + m * 16, col0, ldh)));
#else
                EPI_ST16(H + blk_off_h(row0 + ai * HALF + m * 16, col0, ldh), pack8(h[0], h[1]));
#endif
            }
    }
};

template <int MODE> struct EpiProbe {
    static constexpr bool PERM = true, AFTER_DRAIN = false; static constexpr int VMOPS = 0;
    bf16_t* H; int ldh; const float* ssq;
    __device__ __forceinline__ void operator()(const f32x4 (&acc)[2][2][4][2], const Unit& u, int wr, int wc, int fr, int fq) const {
        const int row0 = u.pm * BM + wr * 64 + fr, col0 = u.pn * HALF + wc * 32 + 8 * fq;
#pragma unroll
        for (int ai = 0; ai < 2; ++ai)
#pragma unroll
            for (int m = 0; m < 4; ++m) {
                if (MODE == 0) { asm volatile("" :: "v"(acc[ai][0][m][0]), "v"(acc[ai][0][m][1]), "v"(acc[ai][1][m][0]), "v"(acc[ai][1][m][1])); }
                else if (MODE == 2) { const float r = __builtin_amdgcn_rsqf(ssq[row0 + ai * HALF + m * 16] * (1.0f / 1024.0f) + RMS_EPS); f32x4 h[2];
                    _Pragma("unroll") for (int n = 0; n < 2; ++n) { const f32x4 a = acc[ai][0][m][n] * r, b = acc[ai][1][m][n] * r; h[n] = a * sigmoid4(a) * b; }
                    const u32x4 pk = pack8(h[0], h[1]); asm volatile("" :: "v"(pk)); }
                else { EPI_ST16(H + (size_t)(row0 + ai * HALF + m * 16) * ldh + col0, pack8(acc[ai][0][m][0] + acc[ai][1][m][0], acc[ai][0][m][1] + acc[ai][1][m][1])); }
            }
    }
};

#ifndef RES_NT
#define RES_NT 1
#endif
template <bool RES_F32, bool WANT_XB, bool HALF_SCALE> struct EpiResid {
    static constexpr bool PERM = true, AFTER_DRAIN = false; static constexpr int VMOPS = 16;
    const float* res32; const bf16_t* res16; float* out32; bf16_t* xb; float* ssq_out;
    __device__ __forceinline__ void operator()(const f32x4 (&acc)[2][2][4][2], const Unit& u, int wr, int wc, int fr, int fq) const {
        const int row0 = u.pm * BM + wr * 64 + fr, col0 = u.pn * BM + wc * 32 + 8 * fq;
        constexpr float scale = HALF_SCALE ? 0.5f : 1.0f;
#pragma unroll
        for (int ai = 0; ai < 2; ++ai)
#pragma unroll
            for (int m = 0; m < 4; ++m) {
                const size_t off = (size_t)(row0 + ai * HALF + m * 16) * 1024 + col0, boff = blk_off(row0 + ai * HALF + m * 16, col0, 1024);
                float ss = 0.f;
#pragma unroll
                for (int bj = 0; bj < 2; ++bj) {
                    f32x4 r0, r1;
                    if (RES_F32) { r0 = *(const f32x4*)(res32 + off + bj * HALF); r1 = *(const f32x4*)(res32 + off + bj * HALF + 4); }
                    else unpack8((!WANT_XB && RES_NT) ? __builtin_nontemporal_load((const u32x4*)(res16 + boff + bj * BJ_STEP)) : EPI_LD16(res16 + boff + bj * BJ_STEP), r0, r1);
                    const f32x4 v0 = r0 + acc[ai][bj][m][0] * scale, v1 = r1 + acc[ai][bj][m][1] * scale;
                    if (out32) { EPI_ST16F(out32 + off + bj * HALF, v0); EPI_ST16F(out32 + off + bj * HALF + 4, v1); }
                    if (WANT_XB) { EPI_ST16(xb + boff + bj * BJ_STEP, pack8(v0, v1)); ss += dot4(v0) + dot4(v1); }
                }
                if (WANT_XB) { ss += __shfl_xor(ss, 16); ss += __shfl_xor(ss, 32); if (fq == 0) atomicAdd(ssq_out + row0 + ai * HALF + m * 16, ss); }
                if (m & 1) asm volatile("" ::: "memory");
            }
    }
};

struct EpiMix {
    static constexpr bool PERM = true, AFTER_DRAIN = false; static constexpr int VMOPS = 12;
    const float* ssq; bf16_t *z, *q, *k, *v, *gc, *ga; const float *qg, *kg;
    __device__ __forceinline__ void operator()(const f32x4 (&acc)[2][2][4][2], const Unit& u, int wr, int wc, int fr, int fq) const {
        const int row0 = u.pm * BM + wr * 64 + fr, pn = u.pn;
        float rs[2][4];
#pragma unroll
        for (int ai = 0; ai < 2; ++ai)
#pragma unroll
            for (int m = 0; m < 4; ++m) rs[ai][m] = ssq[row0 + ai * HALF + m * 16];
#pragma unroll
        for (int ai = 0; ai < 2; ++ai)
#pragma unroll
            for (int m = 0; m < 4; ++m) rs[ai][m] = __builtin_amdgcn_rsqf(rs[ai][m] * (1.0f / 1024.0f) + RMS_EPS);
        if (pn < 8) {
            const int col0 = pn * HALF + wc * 32 + 8 * fq;
#pragma unroll
            for (int ai = 0; ai < 2; ++ai)
#pragma unroll
                for (int m = 0; m < 4; ++m) {
                    const float r = rs[ai][m]; f32x4 h[2];
#pragma unroll
                    for (int n = 0; n < 2; ++n) { const f32x4 a = acc[ai][0][m][n] * r, g = acc[ai][1][m][n] * r; h[n] = a * sigmoid4(g); }
                    EPI_ST16(z + (size_t)(row0 + ai * HALF + m * 16) * 1024 + col0, pack8(h[0], h[1]));
                }
        } else if (pn < 13) {
            const bool isq = pn < 12;
            const float* gp = isq ? qg : kg; const float gs = isq ? 0.125f * LOG2E : 1.0f;
            bf16_t* ob = isq ? q : k; const int ld = isq ? 1024 : 256, head = isq ? 4 * (pn - 8) + wc : wc;
            f32x4 gv[2][2];
#pragma unroll
            for (int bj = 0; bj < 2; ++bj)
#pragma unroll
                for (int n = 0; n < 2; ++n) gv[bj][n] = *(const f32x4*)(gp + 32 * bj + 8 * fq + 4 * n) * gs;
#pragma unroll
            for (int ai = 0; ai < 2; ++ai)
#pragma unroll
                for (int m = 0; m < 4; ++m) {
                    const float r = rs[ai][m]; f32x4 y[2][2]; float ss = 0.f;
#pragma unroll
                    for (int bj = 0; bj < 2; ++bj)
#pragma unroll
                        for (int n = 0; n < 2; ++n) { y[bj][n] = acc[ai][bj][m][n] * r; ss += dot4(y[bj][n]); }
                    ss += __shfl_xor(ss, 16); ss += __shfl_xor(ss, 32);
                    const float rh = __builtin_amdgcn_rsqf(ss * (1.0f / 64.0f) + RMS_EPS);
                    bf16_t* rowp = ob + (size_t)(row0 + ai * HALF + m * 16) * ld + 64 * head + 8 * fq;
#pragma unroll
                    for (int bj = 0; bj < 2; ++bj) EPI_ST16(rowp + 32 * bj, pack8(y[bj][0] * rh * gv[bj][0], y[bj][1] * rh * gv[bj][1]));
                }
        } else if (pn == 13) {
            const int col0 = wc * 32 + 8 * fq;
#pragma unroll
            for (int ai = 0; ai < 2; ++ai)
#pragma unroll
                for (int m = 0; m < 4; ++m) {
                    const float r = rs[ai][m]; bf16_t* rowp = v + (size_t)(row0 + ai * HALF + m * 16) * 256 + col0;
#pragma unroll
                    for (int bj = 0; bj < 2; ++bj) EPI_ST16(rowp + bj * HALF, pack8(acc[ai][bj][m][0] * r, acc[ai][bj][m][1] * r));
                }
        } else {
            const int col0 = (pn - 14) * HALF + wc * 32 + 8 * fq;
#pragma unroll
            for (int ai = 0; ai < 2; ++ai)
#pragma unroll
                for (int m = 0; m < 4; ++m) {
                    const float r = rs[ai][m]; f32x4 rtv[2], sav[2];
#pragma unroll
                    for (int n = 0; n < 2; ++n) {
                        const f32x4 gc_ = acc[ai][0][m][n] * r, ga_ = acc[ai][1][m][n] * r;
#pragma unroll
                        for (int j = 0; j < 4; ++j) {
                            const float ec = __builtin_amdgcn_exp2f(-LOG2E * gc_[j]), ea = __builtin_amdgcn_exp2f(-LOG2E * ga_[j]);
                            sav[n][j] = __builtin_amdgcn_rcpf(1.0f + ea); rtv[n][j] = (1.0f + ea) * __builtin_amdgcn_rcpf(1.0f + ec);
                        }
                    }
                    const size_t off = blk_off(row0 + ai * HALF + m * 16, col0, 1024);
                    EPI_ST16(gc + off, pack8(rtv[0], rtv[1])); EPI_ST16(ga + off, pack8(sav[0], sav[1]));
                }
        }
    }
};

#ifndef GATE_NT
#define GATE_NT 1
#endif
struct EpiMerge {
    static constexpr bool PERM = true, AFTER_DRAIN = false; static constexpr int VMOPS = 16;
    const bf16_t* rt; const bf16_t* sa; bf16_t* O;
    __device__ __forceinline__ void mid(f32x4 (&acc)[2][2][4][2], const Unit& u, int wr, int wc, int fr, int fq) const {
        const int row0 = u.pm * BM + wr * 64 + fr, col0 = u.pn * BM + wc * 32 + 8 * fq;
        u32x4 g[2][4][2];
#pragma unroll
        for (int ai = 0; ai < 2; ++ai)
#pragma unroll
            for (int m = 0; m < 4; ++m) {
                const size_t off = blk_off(row0 + ai * HALF + m * 16, col0, 1024);
#pragma unroll
                for (int bj = 0; bj < 2; ++bj) g[ai][m][bj] = GATE_NT ? __builtin_nontemporal_load((const u32x4*)(rt + off + bj * BJ_STEP)) : *(const u32x4*)(rt + off + bj * BJ_STEP);
            }
#pragma unroll
        for (int ai = 0; ai < 2; ++ai)
#pragma unroll
            for (int m = 0; m < 4; ++m)
#pragma unroll
                for (int bj = 0; bj < 2; ++bj) { f32x4 g0, g1; unpack8(g[ai][m][bj], g0, g1); acc[ai][bj][m][0] *= g0; acc[ai][bj][m][1] *= g1; }
    }
    __device__ __forceinline__ void operator()(const f32x4 (&acc)[2][2][4][2], const Unit& u, int wr, int wc, int fr, int fq) const {
        const int row0 = u.pm * BM + wr * 64 + fr, col0 = u.pn * BM + wc * 32 + 8 * fq;
#pragma unroll
        for (int ai = 0; ai < 2; ++ai)
#pragma unroll
            for (int m = 0; m < 4; ++m) {
                const size_t off = blk_off(row0 + ai * HALF + m * 16, col0, 1024);
#pragma unroll
                for (int bj = 0; bj < 2; ++bj) { f32x4 g0, g1; unpack8(GATE_NT ? __builtin_nontemporal_load((const u32x4*)(sa + off + bj * BJ_STEP)) : EPI_LD16(sa + off + bj * BJ_STEP), g0, g1); EPI_ST16(O + off + bj * BJ_STEP, pack8(g0 * acc[ai][bj][m][0], g1 * acc[ai][bj][m][1])); }
                if (m & 1) asm volatile("" ::: "memory");
            }
    }
};

template <class Epi, class Sched, bool ALIGN_EPI = false, bool SP2 = false, int NSEG = 1, bool A_BLK = false, int PROBE = 0  ,
          int A_AUX = 0  ,
          int PF = 0  ,
          bool BAL = false  >
__device__ __forceinline__ void gemm_phase(PG8_LAS unsigned char* lds, const Gemm g, const Sched S, const Epi E, const int wave_id  ) {
    int tid_ = wave_id * 64 + fresh_lane_id(); asm volatile("" : "+v"(tid_));
    const int tid = tid_, wid = __builtin_amdgcn_readfirstlane(tid >> 6), lane = tid & 63, wr = wid >> 2, wc = wid & 3, fr = lane & 15, fq = lane >> 4;
#ifndef GEMM_A_FIRST
#define GEMM_A_FIRST 1
#endif
    constexpr bool A_FIRST = (GEMM_A_FIRST != 0);
    const int K = g.K, mt = K / BK, nt = NSEG * mt;
    unsigned voffA[2], voffB[2];
#pragma unroll
    for (int i = 0; i < 2; ++i) { int R, C; stage_rc(tid * 16 + i * 8192, R, C); const int Rb = Epi::PERM ? ((R & ~31) + perm32(R & 31)) : R;
        voffA[i] = A_BLK ? (unsigned)(((R >> 4) * (K / 32) + (C >> 5)) * 1024 + (R & 15) * 64 + (C & 31) * 2) : (unsigned)(R * K + C) * 2u;
        voffB[i] = (unsigned)(Rb * K + C) * 2u; }
    const unsigned voffP = (unsigned)(((wid & 3) * 64 + lane) * K) * 2u;
    static_assert(PF == 0 || !A_BLK, "the prefetch addresses assume a row-major A");
    static_assert(!BAL || (SP2 && PF == 0 && PROBE == 0), "BAL: the SP2 schedule, no prefetch touches, no probes");
    const size_t kstep = (size_t)(BK * 2);
    const size_t kstepA = A_BLK ? (size_t)2048 : kstep;
    const size_t hstep = (size_t)HALF * K * 2;
    const size_t tstep = 2 * hstep;
    unsigned long long lo_ = (unsigned long long)g.A < (unsigned long long)g.Bt ? (unsigned long long)g.A : (unsigned long long)g.Bt;
    if constexpr (NSEG == 2) { if ((unsigned long long)g.A2 < lo_) lo_ = (unsigned long long)g.A2; if ((unsigned long long)g.Bt2 < lo_) lo_ = (unsigned long long)g.Bt2; }
    const __amdgpu_buffer_rsrc_t srd = __builtin_amdgcn_make_buffer_rsrc((void*)lo_, (short)0, 0x7fffffff, 0x00020000);
    const unsigned base_lo = (unsigned)lo_, lds_lo = (unsigned)(unsigned long long)lds;
    const unsigned ldsw = (unsigned)wid * 1024u;
    const int aoff = lds_byte(wr * 64 + fr, fq * 8), boff = lds_byte(wc * 32 + fr, fq * 8);
#define PG8_SA(b, h) (((b) * 2 + (h)) * HTB)
#define PG8_SB(b, h) ((4 + (b) * 2 + (h)) * HTB)
#ifndef GEMM_BUFDMA
#define GEMM_BUFDMA 0
#endif
#define PG8_BUFPIECE(ldsoff, gbase, vo) asm volatile("s_mov_b32 m0, %0\n\ts_nop 0\n\tbuffer_load_dwordx4 %1, %2, %3 offen lds" :: "s"(lds_lo + (unsigned)(ldsoff)), "v"(vo), "s"(srd), "s"((unsigned)(unsigned long long)(gbase) - base_lo) : "m0", "memory")
#define PG8_STAGE(bufoff, gbase, voff) do { if (PROBE == 0) _Pragma("unroll") for (int _i = 0; _i < 2; ++_i) { \
        if constexpr (GEMM_BUFDMA != 0) PG8_BUFPIECE((bufoff) + ldsw + _i * 8192, gbase, (voff)[_i]); \
        else __builtin_amdgcn_global_load_lds((const unsigned*)((const char*)(gbase) + (voff)[_i]), (PG8_LAS unsigned*)(lds + (bufoff) + ldsw + _i * 8192), 16, 0, 0); } } while (0)
#define PG8_STAGE_A(bufoff, gbase, voff) do { if (PROBE == 0) _Pragma("unroll") for (int _i = 0; _i < 2; ++_i) { \
        if constexpr (A_AUX == 2) __builtin_amdgcn_global_load_lds((const unsigned*)((const char*)(gbase) + (voff)[_i]), (PG8_LAS unsigned*)(lds + (bufoff) + ldsw + _i * 8192), 16, 0, 2); \
        else if constexpr (GEMM_BUFDMA != 0) PG8_BUFPIECE((bufoff) + ldsw + _i * 8192, gbase, (voff)[_i]); \
        else __builtin_amdgcn_global_load_lds((const unsigned*)((const char*)(gbase) + (voff)[_i]), (PG8_LAS unsigned*)(lds + (bufoff) + ldsw + _i * 8192), 16, 0, 0); } } while (0)
#define PG8_LDA(dst, b, h) do { if (PROBE != 1) _Pragma("unroll") for (int m = 0; m < 4; ++m) _Pragma("unroll") for (int k = 0; k < 2; ++k) dst[m][k] = *(const PG8_LAS bf16x8*)(lds + PG8_SA(b, h) + aoff + m * 2048 + k * 1024); } while (0)
#define PG8_LDB(dst, b, h) do { if (PROBE != 1) _Pragma("unroll") for (int n = 0; n < 2; ++n) _Pragma("unroll") for (int k = 0; k < 2; ++k) dst[n][k] = *(const PG8_LAS bf16x8*)(lds + PG8_SB(b, h) + boff + n * 2048 + k * 1024); } while (0)
#ifndef GEMM_MMA_ORDER
#define GEMM_MMA_ORDER 1
#endif
#define PG8_MMA(ai, bj, At, Bt) do { __builtin_amdgcn_s_setprio(1); \
        if constexpr (GEMM_MMA_ORDER == 0) { _Pragma("unroll") for (int m = 0; m < 4; ++m) _Pragma("unroll") for (int n = 0; n < 2; ++n) _Pragma("unroll") for (int k = 0; k < 2; ++k) \
            acc[ai][bj][m][n] = __builtin_amdgcn_mfma_f32_16x16x32_bf16(Bt[n][k], At[m][k], acc[ai][bj][m][n], 0, 0, 0); } \
        else { _Pragma("unroll") for (int k = 0; k < 2; ++k) _Pragma("unroll") for (int m = 0; m < 4; ++m) _Pragma("unroll") for (int n = 0; n < 2; ++n) \
            acc[ai][bj][m][n] = __builtin_amdgcn_mfma_f32_16x16x32_bf16(Bt[n][k], At[m][k], acc[ai][bj][m][n], 0, 0, 0); } \
        __builtin_amdgcn_s_setprio(0); } while (0)
#define PG8_WAIT_V(n) asm volatile("s_waitcnt vmcnt(" #n ")" ::: "memory")
#define PG8_WAIT_V8R(rel) asm volatile("s_cmp_lg_u32 %0, 0\n\ts_cbranch_scc1 .Lpg8r%=\n\ts_waitcnt vmcnt(8)\n\ts_branch .Lpg8e%=\n.Lpg8r%=:\n\ts_waitcnt vmcnt(%1)\n.Lpg8e%=:" :: "s"(__builtin_amdgcn_readfirstlane(rel)), "n"(8 + Epi::VMOPS) : "memory", "scc")
#define PG8_WAIT_L(n) asm volatile("s_waitcnt lgkmcnt(" #n ")" ::: "memory")
#define PG8_WAIT_VP(n) do { if (PROBE == 3) asm volatile("s_waitcnt vmcnt(24)" ::: "memory"); else if (PF != 0) asm volatile("s_waitcnt vmcnt(9)" ::: "memory"); else PG8_WAIT_V(n); } while (0)
#define PG8_PREFETCH(tau) do { if (PF != 0) { const int tau_ = (tau); const char* pa_; const char* pb_; \
        if (tau_ < nt) { const bool sg_ = (NSEG == 2) && (tau_ >= mt); pa_ = sg_ ? cA2 + (size_t)(tau_ - mt) * kstepA : cA + (size_t)tau_ * kstepA; pb_ = sg_ ? cB2 + (size_t)(tau_ - mt) * kstep : cB + (size_t)tau_ * kstep; } \
        else { pa_ = nA + (size_t)(tau_ - nt) * kstepA; pb_ = nB + (size_t)(tau_ - nt) * kstep; } \
        __builtin_amdgcn_global_load_lds((const unsigned*)((wid >= 4 ? pb_ : pa_) + voffP), (PG8_LAS unsigned*)(lds + STAGE_BYTES + 4096 + wid * 256), 4, 0, 0); } } while (0)
#ifndef GEMM_LATEW
#define GEMM_LATEW 0
#endif
#define PG8_WAIT_T(n) do { if (!GEMM_LATEW || wr == 1) PG8_WAIT_VP(n); } while (0)
#define PG8_WAIT_H(n) do { if (GEMM_LATEW && wr == 0) PG8_WAIT_VP(n); } while (0)
#define PG8_BAR __builtin_amdgcn_s_barrier()
#define PG8_SCHED __builtin_amdgcn_sched_barrier(0)
    Unit cur, nxt; int ui = 0;
    if (!S.next(0, cur)) return;
#if GEMM_DESYNC
    if (g.N > 2048) { const unsigned long long t0_ = __builtin_amdgcn_s_memrealtime(); const unsigned d_ = ((unsigned)S.c * 2654435761u >> 28) * GEMM_DESYNC;
      while (__builtin_amdgcn_s_memrealtime() - t0_ < d_) __builtin_amdgcn_s_sleep(1); }
#endif
    f32x4 acc[2][2][4][2];
#pragma unroll
    for (int a = 0; a < 2; ++a)
#pragma unroll
        for (int b = 0; b < 2; ++b)
#pragma unroll
            for (int m = 0; m < 4; ++m)
#pragma unroll
                for (int n = 0; n < 2; ++n) acc[a][b][m][n] = (f32x4){0.f, 0.f, 0.f, 0.f};
    bf16x8 At[4][2], B0[2][2], B1[2][2];
    if (PROBE == 1) { _Pragma("unroll") for (int i_ = 0; i_ < 4; ++i_) _Pragma("unroll") for (int k_ = 0; k_ < 2; ++k_) { _Pragma("unroll") for (int e_ = 0; e_ < 8; ++e_) At[i_][k_][e_] = (short)(0x3c00 + 37 * lane + 11 * e_ + i_); asm volatile("" : "+v"(At[i_][k_])); }
        _Pragma("unroll") for (int i_ = 0; i_ < 2; ++i_) _Pragma("unroll") for (int k_ = 0; k_ < 2; ++k_) { _Pragma("unroll") for (int e_ = 0; e_ < 8; ++e_) { B0[i_][k_][e_] = (short)(0x3d00 + 29 * lane + 7 * e_ + i_); B1[i_][k_][e_] = (short)(0xbd00 + 23 * lane + 5 * e_ + k_); } asm volatile("" : "+v"(B0[i_][k_]), "+v"(B1[i_][k_])); } }
    const char* cA = (const char*)g.A + (size_t)cur.pm * tstep; const char* cB = (const char*)g.Bt + (size_t)cur.pn * tstep;
    const char* cA2 = (NSEG == 2) ? (const char*)g.A2 + (size_t)cur.pm * tstep : cA; const char* cB2 = (NSEG == 2) ? (const char*)g.Bt2 + (size_t)cur.pn * tstep : cB;
    S.a_ready(cur);
    if constexpr (SP2) {
        PG8_STAGE(PG8_SB(0, 0), cB, voffB); PG8_STAGE(PG8_SB(0, 1), cB + hstep, voffB); PG8_STAGE_A(PG8_SA(0, 0), cA, voffA); PG8_STAGE_A(PG8_SA(0, 1), cA + hstep, voffA);
        if (wr == 1) PG8_BAR;
        PG8_WAIT_V(2); PG8_BAR;
        if constexpr (BAL) { PG8_STAGE(PG8_SB(1, 0), cB + kstep, voffB); PG8_STAGE_A(PG8_SA(1, 0), cA + kstepA, voffA); PG8_WAIT_V(4); PG8_BAR; }
        else {
        PG8_STAGE(PG8_SB(1, 0), cB + kstep, voffB); PG8_STAGE_A(PG8_SA(1, 0), cA + kstepA, voffA); PG8_STAGE(PG8_SB(1, 1), cB + hstep + kstep, voffB);
        PG8_WAIT_V(6); PG8_BAR;
        }
    } else {
        PG8_STAGE(PG8_SB(0, 0), cB, voffB); PG8_STAGE_A(PG8_SA(0, 0), cA, voffA); PG8_STAGE(PG8_SB(0, 1), cB + hstep, voffB); PG8_STAGE_A(PG8_SA(0, 1), cA + hstep, voffA);
        if (wr == 1) PG8_BAR;
        PG8_WAIT_V(4); PG8_BAR;
        PG8_STAGE(PG8_SB(1, 0), cB + kstep, voffB); PG8_STAGE_A(PG8_SA(1, 0), cA + kstepA, voffA); PG8_STAGE(PG8_SB(1, 1), cB + hstep + kstep, voffB);
        PG8_WAIT_V(6); PG8_BAR;
    }
    for (;;) {
        const bool has_next = S.next(ui + 1, nxt);
        const char* nA = has_next ? (const char*)g.A + (size_t)nxt.pm * tstep : cA; const char* nB = has_next ? (const char*)g.Bt + (size_t)nxt.pn * tstep : cB;
        const char* nA2 = (NSEG == 2 && has_next) ? (const char*)g.A2 + (size_t)nxt.pm * tstep : cA2; const char* nB2 = (NSEG == 2 && has_next) ? (const char*)g.Bt2 + (size_t)nxt.pn * tstep : cB2;
        for (int t = 0; t < nt; t += 2) {
            const bool last = (t == nt - 2);
            const int relax = ((t == 0) && (ui > 0) && (Epi::VMOPS > 0)) ? 1 : 0;
            if constexpr (NSEG == 2) { if (t == mt) E.mid(acc, cur, wr, wc, fr, fq); }
            const bool s1 = (NSEG == 2) && (t + 1 >= mt), s2 = (NSEG == 2) && (t + 2 >= mt);
            const char* a1 = s1 ? cA2 + (size_t)(t + 1 - mt) * kstepA : cA + (size_t)(t + 1) * kstepA;
            const char* a2 = last ? nA : (s2 ? cA2 + (size_t)(t + 2 - mt) * kstepA : cA + (size_t)(t + 2) * kstepA);
            const char* b2 = last ? nB : (s2 ? cB2 + (size_t)(t + 2 - mt) * kstep : cB + (size_t)(t + 2) * kstep);
            const char* a3 = a2 + kstepA; const char* b3 = b2 + kstep;
            if (last && has_next) S.a_ready(nxt);
            if constexpr (BAL) {
            const char* b1 = s1 ? cB2 + (size_t)(t + 1 - mt) * kstep : cB + (size_t)(t + 1) * kstep;
            PG8_LDB(B0, 0, 0); PG8_LDB(B1, 0, 1); PG8_SCHED; PG8_LDA(At, 0, 0); PG8_STAGE(PG8_SB(1, 1), b1 + hstep, voffB); PG8_STAGE_A(PG8_SA(1, 1), a1 + hstep, voffA);
            PG8_WAIT_V(8); PG8_WAIT_L(0); PG8_BAR; PG8_MMA(0, 0, At, B0); PG8_MMA(0, 1, At, B1); PG8_BAR; PG8_SCHED;
            PG8_LDA(At, 0, 1); PG8_STAGE(PG8_SB(0, 0), b2, voffB); PG8_STAGE_A(PG8_SA(0, 0), a2, voffA);
            PG8_WAIT_V(6); PG8_WAIT_L(0); PG8_BAR; PG8_MMA(1, 0, At, B0); PG8_MMA(1, 1, At, B1); PG8_BAR; PG8_SCHED;
            PG8_LDB(B0, 1, 0); PG8_LDB(B1, 1, 1); PG8_SCHED; PG8_LDA(At, 1, 0); PG8_STAGE(PG8_SB(0, 1), b2 + hstep, voffB); PG8_STAGE_A(PG8_SA(0, 1), a2 + hstep, voffA);
            PG8_WAIT_V(8); PG8_WAIT_L(0); PG8_BAR; PG8_MMA(0, 0, At, B0); PG8_MMA(0, 1, At, B1); PG8_BAR; PG8_SCHED;
            PG8_LDA(At, 1, 1); PG8_STAGE(PG8_SB(1, 0), b3, voffB); PG8_STAGE_A(PG8_SA(1, 0), a3, voffA);
            PG8_WAIT_V(6); PG8_WAIT_L(0); PG8_BAR; PG8_MMA(1, 0, At, B0); PG8_MMA(1, 1, At, B1); PG8_BAR; PG8_SCHED;
            } else if constexpr (SP2) {
            PG8_LDB(B0, 0, 0); PG8_LDB(B1, 0, 1); PG8_SCHED; PG8_LDA(At, 0, 0); PG8_STAGE_A(PG8_SA(1, 1), a1 + hstep, voffA);
            PG8_WAIT_T(8); PG8_WAIT_L(0); PG8_BAR; PG8_MMA(0, 0, At, B0); PG8_MMA(0, 1, At, B1); PG8_WAIT_H(8); PG8_BAR; PG8_SCHED;
            PG8_LDA(At, 0, 1); if constexpr (A_FIRST) PG8_STAGE_A(PG8_SA(0, 0), a2, voffA); PG8_STAGE(PG8_SB(0, 0), b2, voffB); PG8_STAGE(PG8_SB(0, 1), b2 + hstep, voffB); if constexpr (!A_FIRST) PG8_STAGE_A(PG8_SA(0, 0), a2, voffA); PG8_PREFETCH(t + PF);
            PG8_WAIT_T(8); PG8_WAIT_L(0); PG8_BAR; PG8_MMA(1, 0, At, B0); PG8_MMA(1, 1, At, B1); PG8_WAIT_H(8); PG8_BAR; PG8_SCHED;
            PG8_LDB(B0, 1, 0); PG8_LDB(B1, 1, 1); PG8_SCHED; PG8_LDA(At, 1, 0); PG8_STAGE_A(PG8_SA(0, 1), a2 + hstep, voffA);
            PG8_WAIT_T(8); PG8_WAIT_L(0); PG8_BAR; PG8_MMA(0, 0, At, B0); PG8_MMA(0, 1, At, B1); PG8_WAIT_H(8); PG8_BAR; PG8_SCHED;
            PG8_LDA(At, 1, 1); if constexpr (A_FIRST) PG8_STAGE_A(PG8_SA(1, 0), a3, voffA); PG8_STAGE(PG8_SB(1, 0), b3, voffB); PG8_STAGE(PG8_SB(1, 1), b3 + hstep, voffB); if constexpr (!A_FIRST) PG8_STAGE_A(PG8_SA(1, 0), a3, voffA); PG8_PREFETCH(t + 1 + PF);
            PG8_WAIT_T(8); PG8_WAIT_L(0); PG8_BAR; PG8_MMA(1, 0, At, B0); PG8_MMA(1, 1, At, B1); PG8_WAIT_H(8); PG8_BAR; PG8_SCHED;
            } else {
            PG8_LDB(B0, 0, 0); PG8_SCHED; PG8_LDA(At, 0, 0); PG8_STAGE_A(PG8_SA(1, 1), a1 + hstep, voffA);
            PG8_WAIT_L(8); PG8_BAR; PG8_WAIT_L(0); PG8_MMA(0, 0, At, B0); PG8_BAR; PG8_SCHED;
            PG8_LDB(B1, 0, 1); PG8_STAGE(PG8_SB(0, 0), b2, voffB);
            PG8_BAR; PG8_WAIT_L(0); PG8_MMA(0, 1, At, B1); PG8_BAR;
            PG8_LDA(At, 0, 1); PG8_STAGE_A(PG8_SA(0, 0), a2, voffA);
            PG8_BAR; PG8_WAIT_L(0); PG8_MMA(1, 0, At, B0); PG8_BAR; PG8_SCHED;
            PG8_STAGE(PG8_SB(0, 1), b2 + hstep, voffB);
            PG8_WAIT_V(6); PG8_BAR; PG8_MMA(1, 1, At, B1); PG8_BAR;
            PG8_LDB(B0, 1, 0); PG8_SCHED; PG8_LDA(At, 1, 0); PG8_STAGE_A(PG8_SA(0, 1), a2 + hstep, voffA);
            PG8_WAIT_L(8); PG8_BAR; PG8_WAIT_L(0); PG8_MMA(0, 0, At, B0); PG8_BAR; PG8_SCHED;
            PG8_LDB(B1, 1, 1); PG8_STAGE(PG8_SB(1, 0), b3, voffB);
            PG8_BAR; PG8_WAIT_L(0); PG8_MMA(0, 1, At, B1); PG8_BAR;
            PG8_LDA(At, 1, 1); PG8_STAGE_A(PG8_SA(1, 0), a3, voffA);
            PG8_BAR; PG8_WAIT_L(0); PG8_MMA(1, 0, At, B0); PG8_BAR; PG8_SCHED;
            PG8_STAGE(PG8_SB(1, 1), b3 + hstep, voffB);
            PG8_WAIT_V(6); PG8_BAR; PG8_MMA(1, 1, At, B1); PG8_BAR;
            }
        }
        if constexpr (ALIGN_EPI) { if (wr == 0) PG8_BAR; }
        if constexpr (!Epi::AFTER_DRAIN) { E(acc, cur, wr, wc, fr, fq); S.done(cur); }
        if (!has_next) break;
#pragma unroll
        for (int a = 0; a < 2; ++a)
#pragma unroll
            for (int b = 0; b < 2; ++b)
#pragma unroll
                for (int m = 0; m < 4; ++m)
#pragma unroll
                    for (int n = 0; n < 2; ++n) acc[a][b][m][n] = (f32x4){0.f, 0.f, 0.f, 0.f};
        cur = nxt; cA = nA; cB = nB; cA2 = nA2; cB2 = nB2; ++ui;
        if constexpr (ALIGN_EPI) { if (wr == 1) PG8_BAR; }
    }
    PG8_WAIT_V(0);
    if constexpr (!ALIGN_EPI) { if (wr == 0) PG8_BAR; }
    PG8_BAR;
    if constexpr (Epi::AFTER_DRAIN) { E.fused(acc, cur, wr, wc, fr, fq, lds, wid, lane); S.done(cur); }
#undef PG8_SA
#undef PG8_SB
#undef PG8_STAGE
#undef PG8_STAGE_A
#undef PG8_BUFPIECE
#undef PG8_LDA
#undef PG8_LDB
#undef PG8_MMA
#undef PG8_WAIT_V
#undef PG8_WAIT_V8R
#undef PG8_WAIT_L
#undef PG8_WAIT_VP
#undef PG8_WAIT_T
#undef PG8_WAIT_H
#undef PG8_PREFETCH
#undef PG8_BAR
#undef PG8_SCHED
}
}
constexpr int D = 1024, NB = 8, SEQ = 4096, FF = 2816, CWID = 31, HD = 64, HQ = 16, HKV = 4, INW = 5632;
constexpr int M_FULL = NB * SEQ;
constexpr int NWAVES = 8, NTHREADS = 512;
constexpr int LDS_BYTES = 147456;
constexpr int RING_BYTES = 131072;
constexpr size_t CTL_ZERO_BYTES = 16384;

#define LAS __attribute__((address_space(3)))
typedef unsigned short bf16;
typedef unsigned v4u __attribute__((ext_vector_type(4)));
typedef unsigned v2u __attribute__((ext_vector_type(2)));
typedef float f32x4 __attribute__((ext_vector_type(4)));
typedef float f32x2 __attribute__((ext_vector_type(2)));
typedef float f32x16 __attribute__((ext_vector_type(16)));
typedef short bf16x8 __attribute__((ext_vector_type(8)));
typedef short s16x4 __attribute__((ext_vector_type(4)));

__device__ const unsigned char T5B[128] = {0, 1, 2, 3, 4, 5, 6, 7, 8, 9, 10, 11, 12, 13, 14, 15, 16, 16, 16, 17, 17, 18, 18, 18, 19, 19, 19, 20, 20, 20, 20, 21, 21, 21, 21, 22, 22, 22, 22, 22, 23, 23, 23, 23, 23, 23, 24, 24, 24, 24, 24, 24, 25, 25, 25, 25, 25, 25, 25, 26, 26, 26, 26, 26, 26, 26, 26, 27, 27, 27, 27, 27, 27, 27, 27, 27, 27, 28, 28, 28, 28, 28, 28, 28, 28, 28, 28, 29, 29, 29, 29, 29, 29, 29, 29, 29, 29, 29, 29, 30, 30, 30, 30, 30, 30, 30, 30, 30, 30, 30, 30, 30, 30, 31, 31, 31, 31, 31, 31, 31, 31, 31, 31, 31, 31, 31, 31, 31};

struct Args {
    const float *x, *ffn1_norm, *ffn1_w_in, *ffn1_w_out, *mix_norm, *w_in, *conv_w, *conv_b, *ln_g, *ln_b, *conv_proj, *q_norm, *k_norm, *sinks, *rel_bias, *attn_wo, *w_out, *ffn2_norm, *ffn2_w_in, *ffn2_w_out;
    float *x1, *x2, *out;
    unsigned* ctl;
    float *ssq0, *ssq1, *ssq2;
    bf16 *W1i, *W1o, *Wmx, *Wcp, *Wao, *Wot, *W2i, *W2o;
    bf16 *xb, *H, *H2, *z, *q, *k, *v, *gc, *ga, *c, *o, *m1, *mg;
    int M; int pad;
};

#ifndef CA_NT
#define CA_NT 0
#endif
#ifndef P0_NT
#define P0_NT 1
#endif
__device__ __forceinline__ unsigned f2bf(float f) { unsigned u = __builtin_bit_cast(unsigned, f); return (u + 0x7fffu + ((u >> 16) & 1u)) >> 16; }
__device__ __forceinline__ unsigned pk2(float lo, float hi) { return f2bf(lo) | (f2bf(hi) << 16); }
#define LDS_WAIT() asm volatile("s_waitcnt lgkmcnt(0)" ::: "memory")

__device__ __forceinline__ int src_col(int kind, int n0) {
    if (kind == 0) return n0;
    const int u = n0 >> 8, r = n0 & 255, bj = r >> 7, j = r & 127;
    if (kind == 1) return bj * FF + 128 * u + j;
    if (u < 8) return bj * 1024 + 128 * u + j;
    if (u < 12) return 2048 + 64 * (4 * (u - 8) + (j >> 5)) + 32 * bj;
    if (u == 12) return 3072 + 64 * (j >> 5) + 32 * bj;
    if (u == 13) return n0;
    return 3584 + bj * 1024 + 128 * (u - 14) + j;
}
#ifndef P0_NT_WT
#define P0_NT_WT 1
#endif
struct P0Item { const float* W; const float* gain; bf16* WT; int K, Nsrc, N, kind, item; bool kperm; bool nt; };
__device__ __forceinline__ void p0_item_load(const P0Item& I, int tid, f32x4 (&v)[8], float (&g)[8]) {
    const int nblk = I.N / 256, kb = I.item / nblk, nb = I.item % nblk, k0 = 64 * kb, n0 = 256 * nb;
    const int wv = tid >> 6, lane = tid & 63;
    const int s4 = src_col(I.kind, n0 + 32 * (lane >> 3)) + 4 * (lane & 7);
#pragma unroll
    for (int i = 0; i < 8; ++i) { const int kl = wv * 8 + i, ks = k0 + (I.kperm ? (kl >> 1) + 32 * (kl & 1) : kl);
        v[i] = P0_NT ? __builtin_nontemporal_load((const f32x4*)(I.W + (size_t)ks * I.Nsrc + s4)) : *(const f32x4*)(I.W + (size_t)ks * I.Nsrc + s4); }
#pragma unroll
    for (int i = 0; i < 8; ++i) g[i] = I.gain ? I.gain[k0 + wv * 8 + i] : 1.0f;
}
__device__ __forceinline__ void p0_item_store(const P0Item& I, int tid, const f32x4 (&v)[8], const float (&g)[8], LAS float* tile) {
    const int nblk = I.N / 256, kb = I.item / nblk, nb = I.item % nblk, k0 = 64 * kb, n0 = 256 * nb;
    const int wv = tid >> 6, lane = tid & 63;
#pragma unroll
    for (int i = 0; i < 8; ++i) { LAS float* d = tile + (wv * 8 + i) * 257 + 4 * lane; d[0] = g[i] * v[i][0]; d[1] = g[i] * v[i][1]; d[2] = g[i] * v[i][2]; d[3] = g[i] * v[i][3]; }
    __syncthreads();
    const int c = tid & 7;
#pragma unroll
    for (int j = 0; j < 4; ++j) { const int n = (tid >> 3) + 64 * j; const LAS float* s = tile + (8 * c) * 257 + n;
        v4u o; o.x = pg8::cvt_pk_bf16(s[0 * 257], s[1 * 257]); o.y = pg8::cvt_pk_bf16(s[2 * 257], s[3 * 257]); o.z = pg8::cvt_pk_bf16(s[4 * 257], s[5 * 257]); o.w = pg8::cvt_pk_bf16(s[6 * 257], s[7 * 257]);
        const int kk_ = k0 + 8 * c;
        if (P0_NT_WT && I.nt) __builtin_nontemporal_store(o, (v4u*)(I.WT + (size_t)(n0 + n) * I.K + kk_)); else *(v4u*)(I.WT + (size_t)(n0 + n) * I.K + kk_) = o; }
    __syncthreads();
}
__device__ __forceinline__ float wave_sum(float v) {
#pragma unroll
    for (int o = 1; o < 64; o <<= 1) v += __shfl_xor(v, o);
    return v;
}
__device__ __forceinline__ void p0_prologue(const Args& A, LAS unsigned char* lds, int gw, int NGW, int lane) {
    LAS float* tile = (LAS float*)lds;
    constexpr int I_IN = (D / 64) * (INW / 256), I_OUT = (FF / 64) * (D / 256), I_SQ = (D / 64) * (D / 256);
    constexpr int NITEMS = 3 * I_IN + 2 * I_OUT + 3 * I_SQ;
    const int vwg = gw >> 3, NWG = NGW >> 3, tid = ((gw & 7) << 6) + lane;
    auto resolve = [&](int it) -> P0Item {
        int r = it;
        if (r < I_IN) return P0Item{A.ffn1_w_in, A.ffn1_norm, A.W1i, D, 2 * FF, 2 * FF, 1, r, false, false}; r -= I_IN;
        if (r < I_IN) return P0Item{A.w_in, A.mix_norm, A.Wmx, D, INW, INW, 2, r, false, true}; r -= I_IN;
        if (r < I_IN) return P0Item{A.ffn2_w_in, A.ffn2_norm, A.W2i, D, 2 * FF, 2 * FF, 1, r, false, true}; r -= I_IN;
        if (r < I_OUT) return P0Item{A.ffn1_w_out, nullptr, A.W1o, FF, D, D, 0, r, false, true}; r -= I_OUT;
        if (r < I_OUT) return P0Item{A.ffn2_w_out, nullptr, A.W2o, FF, D, D, 0, r, false, true}; r -= I_OUT;
        if (r < I_SQ) return P0Item{A.conv_proj, nullptr, A.Wcp, D, D, D, 0, r, false, true}; r -= I_SQ;
        if (r < I_SQ) return P0Item{A.attn_wo, nullptr, A.Wao, D, D, D, 0, r, true, true}; r -= I_SQ;
        return P0Item{A.w_out, nullptr, A.Wot, D, D, D, 0, r, false, true};
    };
    {   f32x4 v[8], vn[8]; float g[8], gn[8];
        f32x4 xv[8], xn[8];
        int it = vwg; P0Item cur = resolve(it < NITEMS ? it : 0);
        if (it < NITEMS) p0_item_load(cur, tid, v, g);
        int m = 2 * gw;
        if (m < A.M) { const f32x4* xr = (const f32x4*)(A.x + (size_t)m * D) + lane;
#pragma unroll
            for (int j = 0; j < 8; ++j) xv[j] = P0_NT ? __builtin_nontemporal_load(xr + 64 * j) : xr[64 * j]; }
#pragma unroll 1
        while (it < NITEMS || m < A.M) {
            const bool has_it = it < NITEMS, more = it + NWG < NITEMS;
            const P0Item nxt = resolve(more ? it + NWG : 0);
            if (more) p0_item_load(nxt, tid, vn, gn);
            if (m + 2 * NGW < A.M) { const f32x4* xr = (const f32x4*)(A.x + (size_t)(m + 2 * NGW) * D) + lane;
#pragma unroll
                for (int j = 0; j < 8; ++j) xn[j] = P0_NT ? __builtin_nontemporal_load(xr + 64 * j) : xr[64 * j]; }
            if (has_it) {
                p0_item_store(cur, tid, v, g, tile);
#pragma unroll
                for (int i = 0; i < 8; ++i) { v[i] = vn[i]; g[i] = gn[i]; }
                cur = nxt; it += NWG;
            }
            if (m < A.M) {
                float s0 = 0.f, s1 = 0.f;
#pragma unroll
                for (int j = 0; j < 4; ++j) { s0 += (xv[j][0] * xv[j][0] + xv[j][1] * xv[j][1]) + (xv[j][2] * xv[j][2] + xv[j][3] * xv[j][3]); s1 += (xv[j + 4][0] * xv[j + 4][0] + xv[j + 4][1] * xv[j + 4][1]) + (xv[j + 4][2] * xv[j + 4][2] + xv[j + 4][3] * xv[j + 4][3]); }
                s0 = wave_sum(s0); s1 = wave_sum(s1);
#pragma unroll
                for (int j = 0; j < 8; ++j) { v2u w; w.x = pg8::cvt_pk_bf16(xv[j][0], xv[j][1]); w.y = pg8::cvt_pk_bf16(xv[j][2], xv[j][3]);
                    const int row = m + (j >> 2), col = 4 * (lane + 64 * (j & 3));
                    *(v2u*)(A.xb + pg8::blk_off(row, col, D)) = w; }
                if (lane < 2) { const float s = lane ? s1 : s0; A.ssq0[m + lane] = s; A.ssq1[m + lane] = 0.f; A.ssq2[m + lane] = 0.f; }
#pragma unroll
                for (int j = 0; j < 8; ++j) xv[j] = xn[j];
                m += 2 * NGW;
            }
        }
    }
}

__device__ __forceinline__ f32x2 bf2_to_f2(unsigned z) { return (f32x2){__uint_as_float(z << 16), __uint_as_float(z & 0xffff0000u)}; }
template <int N, int OFF> __device__ __forceinline__ void rs_step(float (&v)[32], int lane) {
    const bool up = (lane & OFF) != 0;
#pragma unroll
    for (int i = 0; i < N; ++i) { const float keep = up ? v[i + N] : v[i], send = up ? v[i] : v[i + N]; v[i] = keep + __shfl_xor(send, OFF); }
}
template <int N2> __device__ __forceinline__ float reduce_scatter(float (&v)[32], int lane) {
    static_assert(N2 == 32, "32 values over 64 lanes");
    rs_step<16, 32>(v, lane); rs_step<8, 16>(v, lane); rs_step<4, 8>(v, lane); rs_step<2, 4>(v, lane); rs_step<1, 2>(v, lane);
    return v[0] + __shfl_xor(v[0], 1);
}
template <int BASE, int CVAR = 0  > __device__ __forceinline__ void conv_step16(const Args& A, f32x2 (&h)[32], unsigned (&zin)[16], const f32x2 (&w)[CWID], f32x2 bias, f32x2 g2, f32x2 b2,
                                                               const bf16* znext, bool have_next, bf16* orow, LAS float* red, LAS f32x2* STAT, int lane, int wid) {
    f32x2 y[16];
#pragma unroll
    for (int s = 0; s < 16; ++s) {
        h[BASE + s] = bf2_to_f2(zin[s]);
        f32x2 a = bias;
        if constexpr (CVAR == 1) {
            typedef _Float16 h2_t __attribute__((ext_vector_type(2)));
#pragma unroll
            for (int k = 0; k < 16; ++k) { const h2_t zp_ = __builtin_bit_cast(h2_t, h[(BASE + s + 2 + 2 * k) & 31][0]), wp_ = __builtin_bit_cast(h2_t, w[2 * k][0]), zq_ = __builtin_bit_cast(h2_t, h[(BASE + s + 2 + 2 * k) & 31][1]), wq_ = __builtin_bit_cast(h2_t, w[2 * k][1]);
                a[0] = __builtin_amdgcn_fdot2(zp_, wp_, a[0], false); a[1] = __builtin_amdgcn_fdot2(zq_, wq_, a[1], false); }
        } else {
#pragma unroll
        for (int k = 0; k < CWID; ++k) a = __builtin_elementwise_fma(w[k], h[(BASE + s + 2 + k) & 31], a);
        }
        y[s] = a;
    }
    {
        float v[32];
#pragma unroll
        for (int s = 0; s < 16; ++s) { v[2 * s] = y[s][0] + y[s][1]; v[2 * s + 1] = y[s][0] * y[s][0] + y[s][1] * y[s][1]; }
        const float r = reduce_scatter<32>(v, lane);
        if ((lane & 1) == 0) red[wid * 32 + (lane >> 1)] = r;
    }
    if (have_next) {
#pragma unroll
        for (int s = 0; s < 16; ++s) zin[s] = CA_NT ? __builtin_nontemporal_load((const unsigned*)(znext + (size_t)s * D)) : *(const unsigned*)(znext + (size_t)s * D);
    }
    __syncthreads();
    {
        float tot = 0.f;
#pragma unroll
        for (int wv = 0; wv < 8; ++wv) tot += red[wv * 32 + (lane & 31)];
        const float other = __shfl_xor(tot, 1);
        const float sm = (lane & 1) ? other : tot, sq = (lane & 1) ? tot : other;
        const float mu = sm * (1.0f / D), rs = __builtin_amdgcn_rsqf(fmaxf(sq * (1.0f / D) - mu * mu, 0.0f) + 1e-6f);
        if ((lane & 33) == 0) STAT[lane >> 1] = (f32x2){mu, rs};
    }
#pragma unroll
    for (int s = 0; s < 16; ++s) {
        const f32x2 st = STAT[s];
        f32x2 v = (y[s] - st[0]) * st[1] * g2 + b2;
        v[0] = v[0] * pg8::fast_sigmoid(v[0]); v[1] = v[1] * pg8::fast_sigmoid(v[1]);
        *(unsigned*)(orow + (size_t)s * D) = pg8::cvt_pk_bf16(v[0], v[1]);
    }
}
template <int CVAR = 0> __device__ __forceinline__ void conv_phase(const Args& A, LAS unsigned char* lds, const int wave_id, const int ch0, const int chstep) {
    int tid_ = wave_id * 64 + pg8::fresh_lane_id(); asm volatile("" : "+v"(tid_));
    const int tid = tid_, lane = tid & 63, wid = tid >> 6, c0 = 2 * tid;
    LAS float* RED = (LAS float*)lds;
    LAS f32x2* STAT = (LAS f32x2*)(lds + 4096) + wid * 16;
    f32x2 w[CWID];
#pragma unroll
    for (int k = 0; k < CWID; ++k) w[k] = *(const f32x2*)(A.conv_w + k * D + c0);
    const f32x2 bias = *(const f32x2*)(A.conv_b + c0), g2 = *(const f32x2*)(A.ln_g + c0), b2 = *(const f32x2*)(A.ln_b + c0);
    const int nchunks = A.M / 128;
    for (int ch = ch0; ch < nchunks; ch += chstep) {
        const int t0 = ch * 128; const bool first = (t0 % SEQ) == 0;
        const bf16* zp = A.z + (size_t)t0 * D + c0;
        bf16* op = A.c + (size_t)t0 * D + c0;
        f32x2 h[32];
        unsigned zin[16];
#pragma unroll
        for (int s = 0; s < 16; ++s) zin[s] = CA_NT ? __builtin_nontemporal_load((const unsigned*)(zp + (size_t)s * D)) : *(const unsigned*)(zp + (size_t)s * D);
#pragma unroll
        for (int i = 2; i < 32; ++i) { unsigned zz = 0u; if (!first) zz = *(const unsigned*)(zp - (size_t)(32 - i) * D); h[i] = bf2_to_f2(zz); }
#pragma unroll 1
        for (int tb = 0; tb < 128; tb += 32) {
            conv_step16<0, CVAR>(A, h, zin, w, bias, g2, b2, zp + (size_t)(tb + 16) * D, true, op + (size_t)tb * D, RED, STAT, lane, wid);
            conv_step16<16, CVAR>(A, h, zin, w, bias, g2, b2, zp + (size_t)(tb + 32) * D, tb + 32 < 128, op + (size_t)(tb + 16) * D, RED + 256, STAT, lane, wid);
        }
    }
    __syncthreads();
}

constexpr int ATT_K_OFF = 0, ATT_V_OFF = 32768, ATT_TB_OFF = 65536, ATT_LS_OFF = 69632, ATT_OST_OFF = 73728;
__device__ __forceinline__ s16x4 vtr(const LAS unsigned char* p) { typedef short v4i16_t __attribute__((ext_vector_type(4))); return __builtin_bit_cast(s16x4, __builtin_amdgcn_ds_read_tr16_b64_v4i16((LAS v4i16_t*)p)); }
template <int VAR  > __device__ __forceinline__ void attn_phase(const Args& A, LAS unsigned char* lds, const int wave_id, const int u0, const int ustep, const int uend) {
    int tid_ = wave_id * 64 + pg8::fresh_lane_id(); asm volatile("" : "+v"(tid_));
    const int tid = tid_, lane = tid & 63, r32 = lane & 31, hi = lane >> 5; const int wid = __builtin_amdgcn_readfirstlane(tid >> 6);
    const int nunits = (A.M / 128) * HKV;
    LAS float* TB = (LAS float*)(lds + ATT_TB_OFF);
    LAS float* LS = (LAS float*)(lds + ATT_LS_OFF) + wid * 64;
    v4u kreg[4], vreg[4];
#define ATT_LOAD_KV(u_) do { const int blk_ = (u_) >> 2, hk_ = (u_) & 3, t0_ = blk_ * 128; const bool first_ = (t0_ % SEQ) == 0; \
        _Pragma("unroll") for (int i = 0; i < 4; ++i) { const int idx = tid + 512 * i, key = idx >> 3, cc = idx & 7; \
            if (!(first_ && key < 128)) { const size_t g_ = (size_t)(t0_ - 128 + key) * 256 + hk_ * 64 + cc * 8; kreg[i] = *(const v4u*)(A.k + g_); vreg[i] = *(const v4u*)(A.v + g_); } } } while (0)
    float shift; bool use_bound;
    { float gq = fabsf(A.q_norm[lane]), gk = fabsf(A.k_norm[lane]), bm = 0.f;
#pragma unroll
      for (int i = 0; i < 8; ++i) bm = fmaxf(bm, fabsf(A.rel_bias[lane + 64 * i]));
#pragma unroll
      for (int o = 1; o < 64; o <<= 1) { gq = fmaxf(gq, __shfl_xor(gq, o)); gk = fmaxf(gk, __shfl_xor(gk, o)); bm = fmaxf(bm, __shfl_xor(bm, o)); }
      const float bnd = (8.0f * gq * gk + bm) * pg8::LOG2E; use_bound = bnd <= 40.0f; shift = use_bound ? bnd : 0.0f; }
    int u = u0;
    bf16x8 qn[4];
#define ATT_LOAD_Q0(u_) do { const int t0_ = ((u_) >> 2) * 128, hk_ = (u_) & 3, g_ = wid >> 2, sub_ = wid & 3; const size_t qrow_ = (size_t)(t0_ + 32 * sub_ + r32) * D + (hk_ * 4 + g_) * HD; \
        _Pragma("unroll") for (int d0 = 0; d0 < 4; ++d0) qn[d0] = CA_NT ? __builtin_nontemporal_load((const bf16x8*)(A.q + qrow_ + 16 * d0 + 8 * hi)) : *(const bf16x8*)(A.q + qrow_ + 16 * d0 + 8 * hi); } while (0)
    if (u < uend) { ATT_LOAD_KV(u); ATT_LOAD_Q0(u); }
    int tb_hk = -1;
    for (; u < uend; u += ustep) {
        const int blk = u >> 2, hk = u & 3, t0 = blk * 128; const bool first = (t0 % SEQ) == 0;
#pragma unroll
        for (int i = 0; i < 4; ++i) {
            const int idx = tid + 512 * i, key = idx >> 3, cc = idx & 7;
            const bool dead = first && key < 128;
            *(LAS v4u*)(lds + ATT_K_OFF + key * 128 + ((cc ^ ((key >> 1) & 7)) << 4)) = dead ? (v4u){0u, 0u, 0u, 0u} : kreg[i];
            *(LAS v4u*)(lds + ATT_V_OFF + ((key >> 2) * 2 + (cc >> 2)) * 256 + (key & 3) * 64 + (cc & 3) * 16) = dead ? (v4u){0u, 0u, 0u, 0u} : vreg[i];
        }
        if (hk != tb_hk) {
            for (int e = tid; e < 4 * 192; e += NTHREADS) {
                const int g = e / 192, dist = e % 192 - 32;
                TB[e] = (dist >= 0 && dist < 128) ? A.rel_bias[T5B[dist] * HQ + hk * 4 + g] * pg8::LOG2E - shift : -3.0e38f;
            }
            tb_hk = hk;
        }
        __syncthreads();
        bf16x8 qf[2][4];
#pragma unroll
        for (int d0 = 0; d0 < 4; ++d0) qf[0][d0] = qn[d0];
        {   const int task = wid + 8, g = task >> 2, sub = task & 3;
            const size_t qrow = (size_t)(t0 + 32 * sub + r32) * D + (hk * 4 + g) * HD;
#pragma unroll
            for (int d0 = 0; d0 < 4; ++d0) qf[1][d0] = CA_NT ? __builtin_nontemporal_load((const bf16x8*)(A.q + qrow + 16 * d0 + 8 * hi)) : *(const bf16x8*)(A.q + qrow + 16 * d0 + 8 * hi); }
        if (u + ustep < uend) { ATT_LOAD_KV(u + ustep); ATT_LOAD_Q0(u + ustep); }
#define ATT_SBAR() __builtin_amdgcn_sched_barrier(0)
        if (VAR == 1) { asm volatile("" :: "v"(qf[0][0]), "v"(qf[0][1]), "v"(qf[0][2]), "v"(qf[0][3]), "v"(qf[1][0]), "v"(qf[1][1]), "v"(qf[1][2]), "v"(qf[1][3])); }
#ifndef ATT_PAIR
#define ATT_PAIR 0
#endif
        if (ATT_PAIR && VAR == 0 && use_bound) {
            const int sub = wid & 3, g0 = wid >> 2, hA = hk * 4 + g0;
            const LAS float* tbA = TB + g0 * 192 + 32 + r32 - 4 * hi; const LAS float* tbB = tbA + 2 * 192;
            const float sinkA = A.sinks[hA] * pg8::LOG2E - shift, sinkB = A.sinks[hA + 2] * pg8::LOG2E - shift;
            f32x16 oA0, oA1, oB0, oB1;
#pragma unroll
            for (int r = 0; r < 16; ++r) { oA0[r] = 0.f; oA1[r] = 0.f; oB0[r] = 0.f; oB1[r] = 0.f; }
            float lA = 0.f, lB = 0.f;
            bf16x8 kfr[4]; s16x4 vfr[2][4];
            const LAS unsigned char* kbase = lds + ATT_K_OFF + r32 * 128; const int kx = (r32 >> 1) & 7;
            const LAS unsigned char* vbase = lds + ATT_V_OFF + hi * 512 + ((lane & 15) >> 2) * 64 + (((lane >> 4) & 1) * 16 + (lane & 3) * 4) * 2;
#define ATT_LOADK(buf, kt_) do { _Pragma("unroll") for (int d0 = 0; d0 < 4; ++d0) kfr[d0] = *(const LAS bf16x8*)(kbase + (kt_) * 4096 + (((2 * d0 + hi) ^ kx) << 4)); } while (0)
#define ATT_LOADV(buf, kt_, s2_) do { const LAS unsigned char* vp_ = vbase + ((8 * (kt_) + 4 * (s2_)) * 2) * 256; vfr[buf][0] = vtr(vp_); vfr[buf][1] = vtr(vp_ + 2 * 512); vfr[buf][2] = vtr(vp_ + 256); vfr[buf][3] = vtr(vp_ + 256 + 2 * 512); } while (0)
#define ATT_PV(sX, oX0, oX1, lX) do { \
                _Pragma("unroll") for (int r = 0; r < 16; ++r) { sX[r] = __builtin_amdgcn_exp2f(sX[r]); lX += sX[r]; } \
                _Pragma("unroll") for (int s2 = 0; s2 < 2; ++s2) { \
                    v4u pw; pw.x = pg8::cvt_pk_bf16(sX[8 * s2 + 0], sX[8 * s2 + 1]); pw.y = pg8::cvt_pk_bf16(sX[8 * s2 + 2], sX[8 * s2 + 3]); pw.z = pg8::cvt_pk_bf16(sX[8 * s2 + 4], sX[8 * s2 + 5]); pw.w = pg8::cvt_pk_bf16(sX[8 * s2 + 6], sX[8 * s2 + 7]); \
                    const bf16x8 pa = __builtin_bit_cast(bf16x8, pw); \
                    const s16x4 a0 = vfr[s2][0], a1 = vfr[s2][1], b0 = vfr[s2][2], b1 = vfr[s2][3]; \
                    const bf16x8 v0 = (bf16x8){a0[0], a0[1], a0[2], a0[3], a1[0], a1[1], a1[2], a1[3]}; \
                    const bf16x8 v1 = (bf16x8){b0[0], b0[1], b0[2], b0[3], b1[0], b1[1], b1[2], b1[3]}; \
                    oX0 = __builtin_amdgcn_mfma_f32_32x32x16_bf16(pa, v0, oX0, 0, 0, 0); oX1 = __builtin_amdgcn_mfma_f32_32x32x16_bf16(pa, v1, oX1, 0, 0, 0); } } while (0)
            ATT_LOADK(0, sub + 4);
#pragma unroll
            for (int di = 0; di < 5; ++di) {
                const int kt = sub + 4 - di;
                f32x16 sA, sB;
#pragma unroll
                for (int r = 0; r < 16; ++r) { sA[r] = tbA[32 * di - ((r & 3) + 8 * (r >> 2))]; sB[r] = tbB[32 * di - ((r & 3) + 8 * (r >> 2))]; }
                ATT_LOADV(0, kt, 0); ATT_LOADV(1, kt, 1);
                ATT_SBAR();
#pragma unroll
                for (int d0 = 0; d0 < 4; ++d0) sA = __builtin_amdgcn_mfma_f32_32x32x16_bf16(kfr[d0], qf[0][d0], sA, 0, 0, 0);
#pragma unroll
                for (int d0 = 0; d0 < 4; ++d0) sB = __builtin_amdgcn_mfma_f32_32x32x16_bf16(kfr[d0], qf[1][d0], sB, 0, 0, 0);
                ATT_SBAR();
                if (di < 4) ATT_LOADK(0, kt - 1);
                if (first && kt < 4) {
#pragma unroll
                    for (int r = 0; r < 16; ++r) { sA[r] = -3.0e38f; sB[r] = -3.0e38f; }
                }
                ATT_PV(sA, oA0, oA1, lA);
                ATT_PV(sB, oB0, oB1, lB);
            }
#define ATT_EPI(oX0, oX1, lX, sinkX, hX) do { \
                float l_ = lX + __shfl_xor(lX, 32); l_ += __builtin_amdgcn_exp2f(sinkX); const float linv = __builtin_amdgcn_rcpf(l_); \
                unsigned* ob = (unsigned*)(A.o + (size_t)(t0 + 32 * sub + 4 * hi) * D + (hX) * HD) + r32; \
                _Pragma("unroll") for (int r = 0; r < 16; ++r) { \
                    const float li0 = __builtin_bit_cast(float, __builtin_amdgcn_readlane(__builtin_bit_cast(int, linv), (r & 3) + 8 * (r >> 2))); \
                    const float li1 = __builtin_bit_cast(float, __builtin_amdgcn_readlane(__builtin_bit_cast(int, linv), (r & 3) + 8 * (r >> 2) + 4)); \
                    const float li = hi ? li1 : li0; \
                    ob[(size_t)((r & 3) + 8 * (r >> 2)) * (D / 2)] = pg8::cvt_pk_bf16(oX0[r] * li, oX1[r] * li); } } while (0)
            ATT_EPI(oA0, oA1, lA, sinkA, hA);
            ATT_EPI(oB0, oB1, lB, sinkB, hA + 2);
#undef ATT_EPI
#undef ATT_PV
#undef ATT_LOADK
#undef ATT_LOADV
        } else
#pragma unroll
        for (int ti = 0; ti < (VAR == 1 ? 0 : 2); ++ti) {
            const int task = wid + 8 * ti, g = task >> 2, sub = task & 3, h = hk * 4 + g;
            f32x16 s[5];
            const LAS float* tb = TB + g * 192 + 32 + r32 - 4 * hi;
#pragma unroll
            for (int di = 0; di < 5; ++di)
#pragma unroll
                for (int r = 0; r < 16; ++r) s[di][r] = tb[32 * di - ((r & 3) + 8 * (r >> 2))];
            float sink2 = A.sinks[h] * pg8::LOG2E - shift;
            bf16x8 kfr[2][4];
            const LAS unsigned char* kbase = lds + ATT_K_OFF + r32 * 128; const int kx = (r32 >> 1) & 7;
#define ATT_LOADK(buf, kt_) do { _Pragma("unroll") for (int d0 = 0; d0 < 4; ++d0) kfr[buf][d0] = *(const LAS bf16x8*)(kbase + (kt_) * 4096 + (((2 * d0 + hi) ^ kx) << 4)); } while (0)
            ATT_LOADK(0, sub + 4);
#pragma unroll
            for (int di = 0; di < 5; ++di) {
                const int kt = sub + 4 - di;
                if (di < 4) ATT_LOADK((di + 1) & 1, kt - 1);
                ATT_SBAR();
#pragma unroll
                for (int d0 = 0; d0 < 4; ++d0) s[di] = __builtin_amdgcn_mfma_f32_32x32x16_bf16(kfr[di & 1][d0], qf[ti][d0], s[di], 0, 0, 0);
                ATT_SBAR();
                if (first && kt < 4) {
#pragma unroll
                    for (int r = 0; r < 16; ++r) s[di][r] = -3.0e38f;
                }
            }
            if (VAR == 3) { asm volatile("" :: "v"(s[0]), "v"(s[1]), "v"(s[2]), "v"(s[3]), "v"(s[4])); continue; }
            s16x4 vfr[2][4];
            const LAS unsigned char* vbase = lds + ATT_V_OFF + hi * 512 + ((lane & 15) >> 2) * 64 + (((lane >> 4) & 1) * 16 + (lane & 3) * 4) * 2;
#define ATT_LOADV(buf, kt_, s2_) do { const LAS unsigned char* vp_ = vbase + ((8 * (kt_) + 4 * (s2_)) * 2) * 256; vfr[buf][0] = vtr(vp_); vfr[buf][1] = vtr(vp_ + 2 * 512); vfr[buf][2] = vtr(vp_ + 256); vfr[buf][3] = vtr(vp_ + 256 + 2 * 512); } while (0)
            ATT_LOADV(0, sub + 4, 0);
            if (!use_bound) {
                float mx = sink2;
#pragma unroll
                for (int di = 0; di < 5; ++di)
#pragma unroll
                    for (int r = 0; r < 16; r += 2) mx = fmaxf(mx, fmaxf(s[di][r], s[di][r + 1]));
                mx = fmaxf(mx, __shfl_xor(mx, 32));
#pragma unroll
                for (int di = 0; di < 5; ++di)
#pragma unroll
                    for (int r = 0; r < 16; ++r) s[di][r] -= mx;
                sink2 -= mx;
            }
            float l = 0.f;
#pragma unroll
            for (int di = 0; di < 5; ++di)
#pragma unroll
                for (int r = 0; r < 16; ++r) { s[di][r] = __builtin_amdgcn_exp2f(s[di][r]); l += s[di][r]; }
            f32x16 o0, o1;
#pragma unroll
            for (int r = 0; r < 16; ++r) { o0[r] = 0.f; o1[r] = 0.f; }
#pragma unroll
            for (int j = 0; j < 10; ++j) {
                const int di = j >> 1, s2 = j & 1;
                if (j < 9) ATT_LOADV((j + 1) & 1, sub + 4 - ((j + 1) >> 1), (j + 1) & 1);
                ATT_SBAR();
                v4u pw; pw.x = pg8::cvt_pk_bf16(s[di][8 * s2 + 0], s[di][8 * s2 + 1]); pw.y = pg8::cvt_pk_bf16(s[di][8 * s2 + 2], s[di][8 * s2 + 3]);
                pw.z = pg8::cvt_pk_bf16(s[di][8 * s2 + 4], s[di][8 * s2 + 5]); pw.w = pg8::cvt_pk_bf16(s[di][8 * s2 + 6], s[di][8 * s2 + 7]);
                const bf16x8 pa = __builtin_bit_cast(bf16x8, pw);
                const s16x4 a0 = vfr[j & 1][0], a1 = vfr[j & 1][1], b0 = vfr[j & 1][2], b1 = vfr[j & 1][3];
                const bf16x8 v0 = (bf16x8){a0[0], a0[1], a0[2], a0[3], a1[0], a1[1], a1[2], a1[3]};
                const bf16x8 v1 = (bf16x8){b0[0], b0[1], b0[2], b0[3], b1[0], b1[1], b1[2], b1[3]};
                o0 = __builtin_amdgcn_mfma_f32_32x32x16_bf16(pa, v0, o0, 0, 0, 0);
                o1 = __builtin_amdgcn_mfma_f32_32x32x16_bf16(pa, v1, o1, 0, 0, 0);
                ATT_SBAR();
            }
            if (VAR == 2) { asm volatile("" :: "v"(o0), "v"(o1), "v"(l)); continue; }
            l += __shfl_xor(l, 32);
            l += __builtin_amdgcn_exp2f(sink2);
            const float linv = __builtin_amdgcn_rcpf(l);
            unsigned* ob = (unsigned*)(A.o + (size_t)(t0 + 32 * sub + 4 * hi) * D + h * HD) + r32;
#pragma unroll
            for (int r = 0; r < 16; ++r) {
                const float li0 = __builtin_bit_cast(float, __builtin_amdgcn_readlane(__builtin_bit_cast(int, linv), (r & 3) + 8 * (r >> 2)));
                const float li1 = __builtin_bit_cast(float, __builtin_amdgcn_readlane(__builtin_bit_cast(int, linv), (r & 3) + 8 * (r >> 2) + 4));
                const float li = hi ? li1 : li0;
                ob[(size_t)((r & 3) + 8 * (r >> 2)) * (D / 2)] = pg8::cvt_pk_bf16(o0[r] * li, o1[r] * li);
            }
        }
#undef ATT_LOADK
#undef ATT_LOADV
#undef ATT_SBAR
        __syncthreads();
    }
#undef ATT_LOAD_KV
#undef ATT_LOAD_Q0
}
typedef unsigned gu32_t;
#define XB_TMO      128
#define XB_XCNT(j)  (256  + 64 * (j))
#define XB_XSUB(j)  (1280 + 64 * (j))
#define XB_XGEN(j)  (2304 + 64 * (j))
#define XB_TOP      3328
#define XB_TOPGEN   3392
#define XCD_BAR_WORDS 3456
#ifndef XB_FLAT
#define XB_FLAT 1
#endif
#define XB_SPIN_CAP (1u << 18)

__device__ __forceinline__ unsigned xb_ld(unsigned* p)              { return __hip_atomic_load(p, __ATOMIC_RELAXED, __HIP_MEMORY_SCOPE_AGENT); }
__device__ __forceinline__ unsigned xb_add(unsigned* p, unsigned v) { return __hip_atomic_fetch_add(p, v, __ATOMIC_RELAXED, __HIP_MEMORY_SCOPE_AGENT); }
__device__ __forceinline__ unsigned xb_xcc_id() { return (unsigned)__builtin_amdgcn_s_getreg((3 << 11) | 20) & 0xFu; }
#define XB_SPIN(cond, bar) do { unsigned _sp = 0; while (cond) { __builtin_amdgcn_s_sleep(1); \
    if ((++_sp & 255u) == 0u) { if (xb_ld(&(bar)[XB_TMO])) break; if (_sp > XB_SPIN_CAP) { atomicAdd(&(bar)[XB_TMO], 1u); break; } } } } while (0)

struct XcdBarrier {
    unsigned* bar; unsigned x; int w;
    volatile LAS unsigned* st;
};

__device__ __forceinline__ XcdBarrier xcd_barrier_post(unsigned* bar, volatile LAS unsigned* st) {
    XcdBarrier b; b.bar = bar; b.x = xb_xcc_id(); b.st = st; b.w = __builtin_amdgcn_readfirstlane((int)threadIdx.x >> 6);
    if (threadIdx.x == 0) st[2] = xb_add(&bar[XB_XCNT(b.x)], 1u);
    return b;
}
__device__ __forceinline__ void xcd_barrier_complete(unsigned* bar, unsigned x, unsigned& nloc, unsigned& nx) {
    const unsigned G = gridDim.x * gridDim.y * gridDim.z;
    unsigned sum, cnt, mine, sp = 0u;
    for (;;) {
        sum = 0u; cnt = 0u; mine = 0u;
#pragma unroll
        for (unsigned j = 0; j < 16; ++j) { const unsigned c = xb_ld(&bar[XB_XCNT(j)]); sum += c; cnt += (c > 0u) ? (XB_FLAT ? (1u << j) : 1u) : 0u; mine = (j == x) ? c : mine; }
        if (sum == G) break;
        __builtin_amdgcn_s_sleep(1);
        if ((++sp & 255u) == 0u) { if (xb_ld(&bar[XB_TMO])) break; if (sp > XB_SPIN_CAP) { atomicAdd(&bar[XB_TMO], 1u); break; } }
    }
    nloc = mine > 0u ? mine : 1u; nx = cnt > 0u ? cnt : 1u;
}
__device__ __forceinline__ unsigned xcd_even_placement(unsigned* bar) {
    const unsigned G = gridDim.x * gridDim.y * gridDim.z; unsigned ok = (G % 8u == 0u) ? 1u : 0u;
#pragma unroll
    for (unsigned j = 0; j < 16; ++j) { const unsigned c = xb_ld(&bar[XB_XCNT(j)]); ok &= (c == (j < 8u ? G / 8u : 0u)) ? 1u : 0u; }
    return ok;
}

#ifndef XB_FLAT
#define XB_FLAT 1
#endif
#define XB_FLAG 3408
__device__ __forceinline__ void xcd_barrier(const XcdBarrier& b) {
    asm volatile("s_waitcnt vmcnt(0)" ::: "memory");
    __syncthreads();
    if (b.w == 0 && pg8::fresh_lane_id() == 0) {
        unsigned* bar = b.bar;
        __builtin_amdgcn_s_waitcnt(0);
        unsigned nloc = b.st[0], nx = b.st[1];
        if (nloc == 0u) { xcd_barrier_complete(bar, b.x, nloc, nx); b.st[0] = nloc; b.st[1] = nx; b.st[3] = xcd_even_placement(bar); }
        const unsigned old = xb_add(&bar[XB_XSUB(b.x)], 1u);
        const unsigned gen = old / nloc;
#if XB_FLAT
        if (old + 1u == (gen + 1u) * nloc) {
            __builtin_amdgcn_fence(__ATOMIC_RELEASE, "agent");
            asm volatile("s_waitcnt vmcnt(0)" ::: "memory");
            __hip_atomic_store(&bar[XB_FLAG + b.x], gen + 1u, __ATOMIC_RELAXED, __HIP_MEMORY_SCOPE_AGENT);
        }
        {   unsigned sp = 0u;
            for (;;) {
                unsigned pending = 0u;
#pragma unroll
                for (unsigned j = 0; j < 16; ++j) { const unsigned f = xb_ld(&bar[XB_FLAG + j]); pending |= ((int)(f - (gen + 1u)) < 0) ? (1u << j) : 0u; }
                if ((pending & nx) == 0u) break;
                __builtin_amdgcn_s_sleep(1);
                if ((++sp & 255u) == 0u) { if (xb_ld(&bar[XB_TMO])) break; if (sp > XB_SPIN_CAP) { atomicAdd(&bar[XB_TMO], 1u); break; } }
            }
        }
        __builtin_amdgcn_fence(__ATOMIC_ACQUIRE, "agent");
        asm volatile("s_waitcnt vmcnt(0)" ::: "memory");
#else
        if (old + 1u == (gen + 1u) * nloc) {
            __builtin_amdgcn_fence(__ATOMIC_RELEASE, "agent");
            asm volatile("s_waitcnt vmcnt(0)" ::: "memory");
            const unsigned og = xb_add(&bar[XB_TOP], 1u);
            const unsigned tg = og / nx;
            if (og + 1u == (tg + 1u) * nx) xb_add(&bar[XB_TOPGEN], 1u);
            else XB_SPIN(xb_ld(&bar[XB_TOPGEN]) == tg, bar);
            __builtin_amdgcn_fence(__ATOMIC_ACQUIRE, "agent");
            xb_add(&bar[XB_XGEN(b.x)], 1u);
            asm volatile("s_waitcnt vmcnt(0)" ::: "memory");
        } else {
            XB_SPIN(xb_ld(&bar[XB_XGEN(b.x)]) == gen, bar);
            __builtin_amdgcn_fence(__ATOMIC_ACQUIRE, "agent");
            asm volatile("s_waitcnt vmcnt(0)" ::: "memory");
        }
#endif
    }
    __syncthreads();
}

#define XB_LSUB(j)  (3456 + 8 * (j))
__device__ __forceinline__ void xcd_local_barrier(const XcdBarrier& b) {
    asm volatile("s_waitcnt vmcnt(0)" ::: "memory");
    __syncthreads();
    if (b.w == 0 && pg8::fresh_lane_id() == 0) {
        unsigned* bar = b.bar;
        __builtin_amdgcn_s_waitcnt(0);
        const unsigned nloc = b.st[0];
        const unsigned old = xb_add(&bar[XB_LSUB(b.x)], 1u);
        const unsigned want = (old / nloc + 1u) * nloc;
        XB_SPIN((int)(xb_ld(&bar[XB_LSUB(b.x)]) - want) < 0, bar);
        __builtin_amdgcn_fence(__ATOMIC_ACQUIRE, "agent");
        asm volatile("s_waitcnt vmcnt(0)" ::: "memory");
    }
    __syncthreads();
}
typedef pg8::EpiResid<false, true, true> EpiRes2; typedef pg8::EpiResid<false, true, false> EpiRes6; typedef pg8::EpiResid<false, false, true> EpiRes8;
#ifndef STOP_AFTER
#define STOP_AFTER 99
#endif
#ifndef H_REV
#define H_REV 0
#endif
#ifndef H_NT
#define H_NT 0
#endif
#ifndef GEMM_PF
#define GEMM_PF 0
#endif
#ifndef CONV_PROBE_VAR
#define CONV_PROBE_VAR 0
#endif
#ifndef ATTN_PROBE_VAR
#define ATTN_PROBE_VAR 0
#endif
#ifndef DUP_MASK
#define DUP_MASK 0
#endif
__global__ void __launch_bounds__(NTHREADS, 2) mega_fwd(Args A) {
    extern __shared__ __attribute__((aligned(16))) unsigned char lds_raw[];
    LAS unsigned char* lds = (LAS unsigned char*)lds_raw;
    const int tid = threadIdx.x, lane = tid & 63, wave = __builtin_amdgcn_readfirstlane(tid >> 6), G = gridDim.x;
    const int vcu = (G % 8 == 0) ? ((int)blockIdx.x % 8) * (G / 8) + (int)blockIdx.x / 8 : (int)blockIdx.x;
    const int M = A.M;
    volatile LAS unsigned* MISC = (volatile LAS unsigned*)(lds + RING_BYTES);
    if (tid < 16) MISC[tid] = 0u;
    __syncthreads();
    const XcdBarrier bar = xcd_barrier_post(A.ctl, MISC);
#ifndef XCC_PROBE
#define XCC_PROBE 0
#endif
    if (XCC_PROBE && tid == 0 && xb_xcc_id() != (blockIdx.x & 7u)) { const unsigned long long t0_ = __builtin_amdgcn_s_memrealtime(); while ((unsigned)(__builtin_amdgcn_s_memrealtime() - t0_) < 30000u) __builtin_amdgcn_s_sleep(8); }
#define GRID_SYNC() xcd_barrier(bar)
#ifndef LOCAL_CHAIN
#define LOCAL_CHAIN 1
#endif
#define SEAM_SYNC() do { if (LOCALM) xcd_local_barrier(bar); else xcd_barrier(bar); } while (0)
#ifndef GEMM_BAL
#define GEMM_BAL 0
#endif
#ifndef PROBE_PHASE
#define PROBE_PHASE -1
#endif
#ifndef CLK_PROBE
#define CLK_PROBE 0
#endif
#define STAMP(k) do { if (PROBE_PHASE >= 0 && blockIdx.x == 0 && tid == 0) { const unsigned long long t_ = __builtin_amdgcn_s_memrealtime(); const unsigned long long c_ = CLK_PROBE ? (unsigned long long)clock64() : 0ull; if ((k) == PROBE_PHASE) { MISC[4] = (unsigned)t_; MISC[6] = (unsigned)c_; } if ((k) == PROBE_PHASE + 1) { MISC[5] = (unsigned)t_; MISC[7] = (unsigned)c_; } } } while (0)
#define GEMM_PHASE_X(ABLK, AAUX, REVX, EPI_T, AP, BP, NN, KK, ...) do { pg8::Gemm g_{AP, BP, M, NN, KK}; pg8::StaticOrder S_; S_.init(M, NN, G, cvirt, REVX); EPI_T E_{__VA_ARGS__}; \
        pg8::gemm_phase<EPI_T, pg8::StaticOrder, true, true, 1, ABLK, 0, AAUX, GEMM_PF, (GEMM_BAL != 0)>(lds, g_, S_, E_, wave); } while (0)
#define GEMM_PHASE_(ABLK, ...) GEMM_PHASE_X(ABLK, 0, 0, __VA_ARGS__)
#define GEMM_PHASE_HNT(...) GEMM_PHASE_X((BLOCKED_ACT != 0 || BLOCKED_H != 0), H_NT, H_REV, __VA_ARGS__)
#define GEMM_PHASE(...) GEMM_PHASE_(false, __VA_ARGS__)
#define GEMM_PHASE_B(...) GEMM_PHASE_((BLOCKED_ACT != 0), __VA_ARGS__)

    STAMP(0);
    p0_prologue(A, lds, vcu * NWAVES + wave, G * NWAVES, lane);
    if (DUP_MASK & 1) { __syncthreads(); p0_prologue(A, lds, vcu * NWAVES + wave, G * NWAVES, lane); }
    GRID_SYNC();
    const bool LOCALM = LOCAL_CHAIN && NB == 8 && M == M_FULL && __builtin_amdgcn_readfirstlane((int)MISC[3]) != 0;
    const int cvirt = LOCALM ? __builtin_amdgcn_readfirstlane((int)MISC[2]) * 8 + (int)bar.x : (int)blockIdx.x;
    STAMP(1);
    if (DUP_MASK & 8) GEMM_PHASE(pg8::EpiSwiglu, A.xb, A.W1i, 2 * FF, D, A.H, FF, A.ssq0);
    if (DUP_MASK & 64) GEMM_PHASE(pg8::EpiProbe<0>, A.xb, A.W1i, 2 * FF, D, A.H, FF, A.ssq0);
    if (DUP_MASK & 32768) GEMM_PHASE_X(false, 0, 3, pg8::EpiProbe<0>, A.xb, A.W1i, 2 * FF, D, A.H, FF, A.ssq0);
    if (DUP_MASK & 128) GEMM_PHASE(pg8::EpiProbe<1>, A.xb, A.W1i, 2 * FF, D, A.H, FF, A.ssq0);
    if (DUP_MASK & 2048) GEMM_PHASE(pg8::EpiProbe<2>, A.xb, A.W1i, 2 * FF, D, A.H, FF, A.ssq0);
    if (DUP_MASK & 4096) do { pg8::Gemm g_{A.xb, A.W1i, M, 2 * FF, D}; pg8::StaticOrder S_; S_.init(M, 2 * FF, G, (int)blockIdx.x); pg8::EpiProbe<0> E_{A.H, FF, A.ssq0}; pg8::gemm_phase<pg8::EpiProbe<0>, pg8::StaticOrder, true, true, 1, false, 1>(lds, g_, S_, E_, wave); } while (0);
    if (DUP_MASK & 16384) do { pg8::Gemm g_{A.xb, A.W1i, M, 2 * FF, D}; pg8::StaticOrder S_; S_.init(M, 2 * FF, G, (int)blockIdx.x); pg8::EpiProbe<0> E_{A.H, FF, A.ssq0}; pg8::gemm_phase<pg8::EpiProbe<0>, pg8::StaticOrder, true, true, 1, false, 3>(lds, g_, S_, E_, wave); } while (0);
    if (DUP_MASK & 8192) do { pg8::Gemm g_{A.xb, A.W1i, M, 2 * FF, D}; pg8::StaticOrder S_; S_.init(M, 2 * FF, G, (int)blockIdx.x); pg8::EpiProbe<0> E_{A.H, FF, A.ssq0}; pg8::gemm_phase<pg8::EpiProbe<0>, pg8::StaticOrder, true, true, 1, false, 2>(lds, g_, S_, E_, wave); } while (0);
#ifndef G1_TWICE
#define G1_TWICE 0
#endif
    GEMM_PHASE_X((BLOCKED_ACT != 0), 0, (G1_TWICE ? 2 : 0), pg8::EpiSwiglu, A.xb, A.W1i, 2 * FF, D, A.H, FF, A.ssq0);
    SEAM_SYNC();
    STAMP(2);
    if (STOP_AFTER <= 1) return;
    if (DUP_MASK & 256) GEMM_PHASE_B(pg8::EpiProbe<0>, A.H, A.W1o, D, FF, A.H, FF, A.ssq0);
    if (DUP_MASK & 512) GEMM_PHASE_B(pg8::EpiProbe<0>, A.H, A.W1o, D, FF, A.H, FF, A.ssq0);
    GEMM_PHASE_HNT(EpiRes2, A.H, A.W1o, D, FF, nullptr, A.xb, A.x1, A.xb, A.ssq1);
    SEAM_SYNC();
    STAMP(3);
    if (STOP_AFTER <= 2) return;
    GEMM_PHASE_B(pg8::EpiMix, A.xb, A.Wmx, INW, D, A.ssq1, A.z, A.q, A.k, A.v, A.gc, A.ga, A.q_norm, A.k_norm);
    if (DUP_MASK & 16) GEMM_PHASE_B(pg8::EpiMix, A.xb, A.Wmx, INW, D, A.ssq1, A.z, A.q, A.k, A.v, A.gc, A.ga, A.q_norm, A.k_norm);
    SEAM_SYNC();
    STAMP(4);
    if (STOP_AFTER <= 3) return;
    const int cv_r = cvirt >> 3, cv_x = cvirt & 7;
    const int ch0 = LOCALM ? 32 * cv_x + cv_r : (int)blockIdx.x, chstep = LOCALM ? M / 128 : G;
    const int u0 = LOCALM ? (32 * cv_x + (cv_r >> 2)) * 4 + (cv_r & 3) : (int)blockIdx.x, ustep = LOCALM ? 32 : G, uend = LOCALM ? (cv_x + 1) * 128 : (M / 128) * HKV;
    if (DUP_MASK & 2) conv_phase<CONV_PROBE_VAR>(A, lds, wave, ch0, chstep);
#ifndef CA_ALTERNATE
#define CA_ALTERNATE 0
#endif
    {   const bool attn_first = CA_ALTERNATE && DUP_MASK == 0 && PROBE_PHASE < 0 && (cv_r & 1);
        _Pragma("unroll 1") for (int st_ = 0; st_ < 2; ++st_) {
            if ((st_ == 1) == attn_first) { conv_phase<0>(A, lds, wave, ch0, chstep); STAMP(5); }
            else {
                if ((DUP_MASK & 4) && ATTN_PROBE_VAR != 0) attn_phase<ATTN_PROBE_VAR>(A, lds, wave, u0, ustep, uend);
                _Pragma("unroll 1") for (int rep_ = 0; rep_ < (((DUP_MASK & 4) && ATTN_PROBE_VAR == 0) ? 2 : 1); ++rep_) attn_phase<0>(A, lds, wave, u0, ustep, uend);
            }
        }
    }
    SEAM_SYNC();
    STAMP(6);
    if (STOP_AFTER <= 4) return;
    do { pg8::Gemm g_{A.c, A.Wcp, M, D, D, A.o, A.Wao}; pg8::StaticOrder S_; S_.init(M, D, G, cvirt); pg8::EpiMerge E_{A.gc, A.ga, A.mg};
         pg8::gemm_phase<pg8::EpiMerge, pg8::StaticOrder, true, true, 2, false, 0, 0, GEMM_PF, (GEMM_BAL != 0)>(lds, g_, S_, E_, wave); } while (0);
    SEAM_SYNC();
    STAMP(7);
    if (STOP_AFTER <= 6) return;
    GEMM_PHASE_B(EpiRes6, A.mg, A.Wot, D, D, nullptr, A.xb, A.x2, A.xb, A.ssq2);
    SEAM_SYNC();
    STAMP(8);
    if (STOP_AFTER <= 7) return;
    GEMM_PHASE_B(pg8::EpiSwiglu, A.xb, A.W2i, 2 * FF, D, A.H2, FF, A.ssq2);
    if (DUP_MASK & 32) GEMM_PHASE_B(pg8::EpiSwiglu, A.xb, A.W2i, 2 * FF, D, A.H2, FF, A.ssq2);
    SEAM_SYNC();
    STAMP(9);
#ifndef G8_TWICE
#define G8_TWICE 0
#endif
    GEMM_PHASE_X((BLOCKED_ACT != 0 || BLOCKED_H != 0), H_NT, (G8_TWICE ? 2 : H_REV), EpiRes8, A.H2, A.W2o, D, FF, nullptr, A.xb, A.out, nullptr, nullptr);
    if (PROBE_PHASE >= 0) { __syncthreads(); STAMP(10); if (blockIdx.x == 0) { __syncthreads(); const unsigned d_ = CLK_PROBE ? (unsigned)((unsigned long long)(MISC[7] - MISC[6]) * 1000ull / (MISC[5] - MISC[4])) : 8u * (MISC[5] - MISC[4]); const unsigned long long t0_ = __builtin_amdgcn_s_memrealtime(); while ((unsigned)(__builtin_amdgcn_s_memrealtime() - t0_) < d_) __builtin_amdgcn_s_sleep(8); } }
    if (DUP_MASK & 1024) { _Pragma("unroll 1") for (int i_ = 0; i_ < 8; ++i_) GRID_SYNC(); }
#undef GEMM_PHASE
#undef GEMM_PHASE_B
#undef GEMM_PHASE_
#undef GEMM_PHASE_X
#undef GEMM_PHASE_HNT
#undef GRID_SYNC
}

static size_t ws_map(Args& a, unsigned char* ws, int M, bool alias) {
    size_t off = 0;
    auto take = [&](size_t bytes) { unsigned char* p = ws + off; off += (bytes + 255) & ~(size_t)255; return p; };
    a.ctl = (unsigned*)take(1u << 20);
    a.ssq0 = (float*)take((size_t)M * 4); a.ssq1 = (float*)take((size_t)M * 4); a.ssq2 = (float*)take((size_t)M * 4);
    a.W1i = (bf16*)take((size_t)2 * FF * D * 2); a.W1o = (bf16*)take((size_t)D * FF * 2); a.Wmx = (bf16*)take((size_t)INW * D * 2);
    a.Wcp = (bf16*)take((size_t)D * D * 2); a.Wao = (bf16*)take((size_t)D * D * 2); a.Wot = (bf16*)take((size_t)D * D * 2);
    a.W2i = (bf16*)take((size_t)2 * FF * D * 2); a.W2o = (bf16*)take((size_t)D * FF * 2);
    const size_t act = (size_t)M * D * 2;
    a.xb = (bf16*)take(act);
    a.H = (bf16*)take((size_t)M * FF * 2); a.H2 = a.H;
    if (alias) {
        a.z = a.H; a.q = a.z + (size_t)M * D; a.k = a.q + (size_t)M * D; a.v = a.k + (size_t)M * 256;
        a.gc = (bf16*)take(act); a.ga = (bf16*)take(act); a.c = (bf16*)take(act);
        a.o = a.q; a.m1 = nullptr; a.mg = a.z;
    } else {
        a.z = (bf16*)take(act); a.q = (bf16*)take(act); a.k = (bf16*)take((size_t)M * 256 * 2); a.v = (bf16*)take((size_t)M * 256 * 2);
        a.gc = (bf16*)take(act); a.ga = (bf16*)take(act); a.c = (bf16*)take(act);
        a.o = (bf16*)take(act); a.m1 = nullptr; a.mg = (bf16*)take(act);
    }
    return off;
}
static void set_inputs(Args& a, void* const* d_in) {
    a.x = (const float*)d_in[0]; a.ffn1_norm = (const float*)d_in[1]; a.ffn1_w_in = (const float*)d_in[2]; a.ffn1_w_out = (const float*)d_in[3];
    a.mix_norm = (const float*)d_in[4]; a.w_in = (const float*)d_in[5]; a.conv_w = (const float*)d_in[6]; a.conv_b = (const float*)d_in[7];
    a.ln_g = (const float*)d_in[8]; a.ln_b = (const float*)d_in[9]; a.conv_proj = (const float*)d_in[10]; a.q_norm = (const float*)d_in[11];
    a.k_norm = (const float*)d_in[12]; a.sinks = (const float*)d_in[13]; a.rel_bias = (const float*)d_in[14]; a.attn_wo = (const float*)d_in[15];
    a.w_out = (const float*)d_in[16]; a.ffn2_norm = (const float*)d_in[17]; a.ffn2_w_in = (const float*)d_in[18]; a.ffn2_w_out = (const float*)d_in[19];
}
static int g_grid = 0;
static bool launch_mega(Args& a, hipStream_t stream) {
    if (g_grid == 0) {
        int dev = 0, cus = 0, per_cu = 0;
        if (hipGetDevice(&dev) != hipSuccess || hipDeviceGetAttribute(&cus, hipDeviceAttributeMultiprocessorCount, dev) != hipSuccess) { g_grid = -1; return false; }
        if (hipFuncSetAttribute((const void*)mega_fwd, hipFuncAttributeMaxDynamicSharedMemorySize, LDS_BYTES) != hipSuccess) { fprintf(stderr, "hipFuncSetAttribute failed\n"); g_grid = -1; return false; }
        if (hipOccupancyMaxActiveBlocksPerMultiprocessor(&per_cu, (const void*)mega_fwd, NTHREADS, LDS_BYTES) != hipSuccess || per_cu < 1) { fprintf(stderr, "occupancy query: %d blocks per CU\n", per_cu); g_grid = -1; (void)hipGetLastError(); return false; }
        g_grid = cus;
    }
    if (g_grid < 0) return false;
    void* args[] = {&a};
    const hipError_t e = hipLaunchCooperativeKernel((const void*)mega_fwd, dim3(g_grid), dim3(NTHREADS), args, LDS_BYTES, stream);
    if (e != hipSuccess) { fprintf(stderr, "cooperative launch failed: %s (grid %d)\n", hipGetErrorString(e), g_grid); return false; }
    return true;
}
#if DEBUG_ORACLE
namespace nv {
constexpr int S = SEQ, B = NB;
constexpr float EPS = 1e-6f;
__device__ __forceinline__ float sigmoidf_(float v) { return 1.f / (1.f + expf(-v)); }
__device__ __forceinline__ float siluf_(float v) { return v / (1.f + expf(-v)); }
__device__ __forceinline__ float block_sum_256(float v, float* red) {
    for (int o = 32; o > 0; o >>= 1) v += __shfl_xor(v, o);
    const int w = threadIdx.x >> 6, l = threadIdx.x & 63;
    __syncthreads(); if (l == 0) red[w] = v; __syncthreads();
    return red[0] + red[1] + red[2] + red[3];
}
__global__ void rms_rows(const float* x, const float* g, float* out) {
    __shared__ float red[4];
    const size_t r = blockIdx.x;
    const float4 v = ((const float4*)(x + r * D))[threadIdx.x];
    const float ss = block_sum_256(v.x * v.x + v.y * v.y + v.z * v.z + v.w * v.w, red);
    const float rs = rsqrtf(ss * (1.f / D) + EPS);
    const float4 gg = ((const float4*)g)[threadIdx.x];
    float4 o; o.x = v.x * rs * gg.x; o.y = v.y * rs * gg.y; o.z = v.z * rs * gg.z; o.w = v.w * rs * gg.w;
    ((float4*)(out + r * D))[threadIdx.x] = o;
}
__global__ void gemm_f32(const float* __restrict__ A, int lda, const float* __restrict__ Bm, int ldb, float* __restrict__ C, int ldc, int K) {
    __shared__ float As[16][68];
    __shared__ float Bs[16][68];
    const int tx = threadIdx.x & 15, ty = threadIdx.x >> 4;
    const int m0 = blockIdx.y * 64, n0 = blockIdx.x * 64;
    float acc[4][4] = {};
    for (int k0 = 0; k0 < K; k0 += 16) {
        {
            const int r = threadIdx.x >> 2, kq = (threadIdx.x & 3) * 4;
            const float4 a = *(const float4*)(A + (size_t)(m0 + r) * lda + k0 + kq);
            As[kq + 0][r] = a.x; As[kq + 1][r] = a.y; As[kq + 2][r] = a.z; As[kq + 3][r] = a.w;
            const int kr = threadIdx.x >> 4, c4 = (threadIdx.x & 15) * 4;
            *(float4*)&Bs[kr][c4] = *(const float4*)(Bm + (size_t)(k0 + kr) * ldb + n0 + c4);
        }
        __syncthreads();
#pragma unroll
        for (int k = 0; k < 16; ++k) {
            const float4 a = *(const float4*)&As[k][ty * 4];
            const float4 b = *(const float4*)&Bs[k][tx * 4];
            const float av[4] = {a.x, a.y, a.z, a.w}, bv[4] = {b.x, b.y, b.z, b.w};
#pragma unroll
            for (int i = 0; i < 4; ++i)
#pragma unroll
                for (int j = 0; j < 4; ++j) acc[i][j] = fmaf(av[i], bv[j], acc[i][j]);
        }
        __syncthreads();
    }
#pragma unroll
    for (int i = 0; i < 4; ++i) { float4 o; o.x = acc[i][0]; o.y = acc[i][1]; o.z = acc[i][2]; o.w = acc[i][3]; *(float4*)(C + (size_t)(m0 + ty * 4 + i) * ldc + n0 + tx * 4) = o; }
}
__global__ void swiglu_k(const float* U, float* H, int rows) {
    const size_t i = (size_t)blockIdx.x * blockDim.x + threadIdx.x;
    if (i >= (size_t)rows * FF) return;
    const size_t t = i / FF; const int j = (int)(i % FF);
    H[i] = siluf_(U[t * (2 * FF) + j]) * U[t * (2 * FF) + FF + j];
}
__global__ void resid_k(const float* xin, const float* y, float scale, float* out, size_t n) {
    const size_t i = (size_t)blockIdx.x * blockDim.x + threadIdx.x;
    if (i < n) out[i] = xin[i] + scale * y[i];
}
__global__ void glu_k(const float* P, float* z, int rows) {
    const size_t i = (size_t)blockIdx.x * blockDim.x + threadIdx.x;
    if (i >= (size_t)rows * D) return;
    const size_t t = i / D; const int c = (int)(i % D);
    z[i] = P[t * INW + c] * sigmoidf_(P[t * INW + D + c]);
}
__global__ void conv_k(const float* z, const float* w, const float* bias, float* y) {
    const size_t i = (size_t)blockIdx.x * blockDim.x + threadIdx.x;
    if (i >= (size_t)S * D) return;
    const int t = (int)(i / D), c = (int)(i % D);
    float acc = bias[c];
    for (int k = 0; k < CWID; ++k) { const int tt = t - (CWID - 1) + k; if (tt >= 0) acc = fmaf(w[k * D + c], z[(size_t)tt * D + c], acc); }
    y[i] = acc;
}
__global__ void ln_silu_k(const float* y, const float* g, const float* b, float* out) {
    __shared__ float red[4];
    const size_t r = blockIdx.x;
    const float4 v = ((const float4*)(y + r * D))[threadIdx.x];
    const float mu = block_sum_256(v.x + v.y + v.z + v.w, red) * (1.f / D);
    const float dx = v.x - mu, dy = v.y - mu, dz = v.z - mu, dw = v.w - mu;
    const float var = block_sum_256(dx * dx + dy * dy + dz * dz + dw * dw, red) * (1.f / D);
    const float rs = rsqrtf(var + EPS);
    const float4 gg = ((const float4*)g)[threadIdx.x], bb = ((const float4*)b)[threadIdx.x];
    float4 o; o.x = siluf_(dx * rs * gg.x + bb.x); o.y = siluf_(dy * rs * gg.y + bb.y); o.z = siluf_(dz * rs * gg.z + bb.z); o.w = siluf_(dw * rs * gg.w + bb.w);
    ((float4*)(out + r * D))[threadIdx.x] = o;
}
__global__ void qknorm_k(const float* P, const float* qg, const float* kg, float* qn, float* kn) {
    const int wv = (blockIdx.x * 4) + (threadIdx.x >> 6), lane = threadIdx.x & 63;
    const int t = wv / (HQ + HKV), hh = wv % (HQ + HKV);
    if (t >= S) return;
    const bool isq = hh < HQ;
    const int h = isq ? hh : hh - HQ;
    const float v = P[(size_t)t * INW + (isq ? 2 * D + h * HD : 3 * D + h * HD) + lane];
    float ss = v * v;
    for (int o = 32; o > 0; o >>= 1) ss += __shfl_xor(ss, o);
    const float rs = rsqrtf(ss * (1.f / HD) + EPS);
    if (isq) qn[(size_t)t * (HQ * HD) + h * HD + lane] = v * rs * qg[lane];
    else     kn[(size_t)t * (HKV * HD) + h * HD + lane] = v * rs * kg[lane];
}
__global__ void attn_k(const float* qn, const float* kn, const float* P, const float* sinks, const float* rel_bias, float* o) {
    const int wv = (blockIdx.x * 4) + (threadIdx.x >> 6), lane = threadIdx.x & 63;
    const int t = wv / HQ, h = wv % HQ, hk = h / (HQ / HKV);
    if (t >= S) return;
    const float* q = qn + (size_t)t * (HQ * HD) + h * HD;
    float s[2];
#pragma unroll
    for (int u = 0; u < 2; ++u) {
        const int dist = lane + 64 * u, key = t - dist;
        float acc = -3.0e38f;
        if (key >= 0) {
            const float* kr = kn + (size_t)key * (HKV * HD) + hk * HD;
            float d = 0.f;
            for (int e = 0; e < HD; ++e) d = fmaf(q[e], kr[e], d);
            acc = d * 0.125f + rel_bias[T5B[dist] * HQ + h];
        }
        s[u] = acc;
    }
    const float sink = sinks[h];
    float m = fmaxf(fmaxf(s[0], s[1]), sink);
    for (int of = 32; of > 0; of >>= 1) m = fmaxf(m, __shfl_xor(m, of));
    float p0 = (t - lane >= 0) ? expf(s[0] - m) : 0.f, p1 = (t - lane - 64 >= 0) ? expf(s[1] - m) : 0.f;
    float l = p0 + p1;
    for (int of = 32; of > 0; of >>= 1) l += __shfl_xor(l, of);
    l += expf(sink - m);
    const float inv = 1.f / l;
    float acc = 0.f;
    for (int j = 0; j < 64; ++j) {
        const float pj0 = __shfl(p0, j), pj1 = __shfl(p1, j);
        const int k0 = t - j, k1 = t - j - 64;
        if (k0 >= 0) acc = fmaf(pj0, P[(size_t)k0 * INW + 3 * D + HKV * HD + hk * HD + lane], acc);
        if (k1 >= 0) acc = fmaf(pj1, P[(size_t)k1 * INW + 3 * D + HKV * HD + hk * HD + lane], acc);
    }
    o[(size_t)t * (HQ * HD) + h * HD + lane] = acc * inv;
}
__global__ void merge_k(const float* P, const float* a, const float* b, float* mg, int rows) {
    const size_t i = (size_t)blockIdx.x * blockDim.x + threadIdx.x;
    if (i >= (size_t)rows * D) return;
    const size_t t = i / D; const int c = (int)(i % D);
    mg[i] = sigmoidf_(P[t * INW + 3584 + c]) * a[i] + sigmoidf_(P[t * INW + 4608 + c]) * b[i];
}
static void gemm(const float* A, int lda, const float* Bm, int ldb, float* C, int ldc, int M, int N, int K, hipStream_t st) {
    hipLaunchKernelGGL(gemm_f32, dim3(N / 64, M / 64), dim3(256), 0, st, A, lda, Bm, ldb, C, ldc, K);
}
__global__ void cmp_k(const void* a, int a_is_bf16, int lda, float ascale, const float* ref, int ldr, int sig, int rows, int cols, unsigned* slot, int blk) {
    const size_t i = (size_t)blockIdx.x * blockDim.x + threadIdx.x;
    float d = 0.f, r2 = 0.f;
    if (i < (size_t)rows * cols) {
        const size_t t = i / cols; const int c = (int)(i % cols);
        const size_t ai_ = blk ? (((t >> 4) * (size_t)(blk >> 5) + (c >> 5)) * 512 + (t & 15) * 32 + (c & 31)) : t * lda + c;
        float av = a_is_bf16 ? __uint_as_float((unsigned)((const unsigned short*)a)[ai_] << 16) : ((const float*)a)[ai_];
        float rv = ref[t * ldr + c]; if (sig) rv = sigmoidf_(rv);
        d = fabsf(av * ascale - rv); if (!(d == d)) d = 1e30f; r2 = rv * rv;
    }
    float d2 = d * d;
    for (int o = 32; o > 0; o >>= 1) { d = fmaxf(d, __shfl_xor(d, o)); r2 += __shfl_xor(r2, o); d2 += __shfl_xor(d2, o); }
    if ((threadIdx.x & 63) == 0) { atomicMax(slot, __float_as_uint(d)); atomicAdd((float*)(slot + 1), r2); atomicAdd((float*)(slot + 2), d2); }
}
constexpr int NCHK = 16;
struct Counts { float c[NCHK]; };
__global__ void decide_k(unsigned* slots, Counts cnt, float tol, float* code_out) {
    if (threadIdx.x != 0 || blockIdx.x != 0) return;
    float code = 0.f;
    for (int k = 0; k < NCHK; ++k) {
        if (cnt.c[k] <= 0.f) continue;
        const float md = __uint_as_float(slots[4 * k]), rr = __uint_as_float(slots[4 * k + 1]), dd = __uint_as_float(slots[4 * k + 2]);
        const float rms = sqrtf(rr / cnt.c[k]), rmsr = sqrtf(dd / fmaxf(rr, 1e-30f));
        if (!(rmsr <= tol) || !(md <= 0.5f * rms)) { code = (float)(k + 1) + (rmsr < 0.03f ? 0.f : rmsr < 0.3f ? 0.3f : 0.6f); break; }
    }
    *code_out = code;
}
__global__ void finish_k(float* out, const float* mega_out, size_t dbg_off, size_t dbg_n, size_t n, const float* code) {
    const size_t i = (size_t)blockIdx.x * blockDim.x + threadIdx.x;
    if (i >= n) return;
    const float c = *code;
    float v = out[i];
    if (c == 0.f && i >= dbg_off && i < dbg_off + dbg_n) v = mega_out[i - dbg_off];
    out[i] = v * (1.f + c);
}
}
#ifndef DBG_B
#define DBG_B 5
#endif
#ifndef DBG_TOL
#define DBG_TOL 0.01f
#endif
#endif

extern "C" void kernel_launch(void* const* d_in, const int* in_sizes, int n_in, void* d_out, int out_size, void* d_ws, size_t ws_size, hipStream_t stream) {
    (void)in_sizes; (void)n_in; (void)out_size; (void)ws_size;
#if !DEBUG_ORACLE
    Args a{};
    set_inputs(a, d_in);
    a.out = (float*)d_out; a.x1 = nullptr; a.x2 = nullptr;
    ws_map(a, (unsigned char*)d_ws, M_FULL, true);
    a.M = M_FULL;
#if (DUP_MASK & 4)
    a.o = (bf16*)d_out;
#endif
    if (hipMemsetAsync(a.ctl, 0, CTL_ZERO_BYTES, stream) != hipSuccess) return;
    launch_mega(a, stream);
#else
    using namespace nv;
    unsigned char* wsb = (unsigned char*)d_ws;
    Args a{};
    set_inputs(a, d_in);
    a.x += (size_t)DBG_B * S * D;
    size_t used = ws_map(a, wsb, S, false);
    auto takeb = [&](size_t bytes) { unsigned char* p = wsb + used; used += (bytes + 255) & ~(size_t)255; return p; };
    a.x1 = (float*)takeb((size_t)S * D * 4); a.x2 = (float*)takeb((size_t)S * D * 4); a.out = (float*)takeb((size_t)S * D * 4);
    a.H2 = (bf16*)takeb((size_t)S * FF * 2);
    a.M = S;
    unsigned* slots = (unsigned*)takeb(256); float* code = (float*)takeb(256);
    Counts hc{};
    const float* x = (const float*)d_in[0];
    float* out = (float*)d_out;
    float* xn = (float*)takeb((size_t)S * D * 4); float* U = (float*)takeb((size_t)S * INW * 4); float* Hh = (float*)takeb((size_t)S * FF * 4); float* Y = (float*)takeb((size_t)S * D * 4);
    float* z = (float*)takeb((size_t)S * D * 4); float* cy = xn; float* cv = (float*)takeb((size_t)S * D * 4); float* qn = (float*)takeb((size_t)S * D * 4);
    float* kn = (float*)takeb((size_t)S * 256 * 4); float* ao = (float*)takeb((size_t)S * D * 4); float* av = (float*)takeb((size_t)S * D * 4); float* bv = (float*)takeb((size_t)S * D * 4);
    float* mg = (float*)takeb((size_t)S * D * 4);
    if (used > ws_size) { fprintf(stderr, "debug build needs %zu bytes of workspace, have %zu\n", used, ws_size); return; }
    hipMemsetAsync(slots, 0, 256, stream);
    hipMemsetAsync(a.ctl, 0, CTL_ZERO_BYTES, stream);
    launch_mega(a, stream);
    const int EB = 256; const size_t n1 = (size_t)S * D;
    int nchk = 0;
    auto chk = [&](const void* ap, int isbf, int lda, float asc, const float* ref, int ldr, int sig, int rows, int cols, int blk = 0) {
        const size_t n = (size_t)rows * cols;
        hipLaunchKernelGGL(cmp_k, dim3((unsigned)((n + 255) / 256)), dim3(256), 0, stream, ap, isbf, lda, asc, ref, ldr, sig, rows, cols, slots + 4 * nchk, BLOCKED_ACT ? blk : 0);
        hc.c[nchk] = (float)n; ++nchk;
    };
    for (int bi = 0; bi < B; ++bi) {
        const int b = (bi == B - 1) ? DBG_B : (bi >= DBG_B ? bi + 1 : bi);
        const bool dbg = (b == DBG_B);
        const float* xbp = x + (size_t)b * S * D; float* ob = out + (size_t)b * S * D;
        hipLaunchKernelGGL(rms_rows, dim3(S), dim3(256), 0, stream, xbp, a.ffn1_norm, xn);
        gemm(xn, D, a.ffn1_w_in, 2 * FF, U, 2 * FF, S, 2 * FF, D, stream);
        hipLaunchKernelGGL(swiglu_k, dim3((unsigned)(((size_t)S * FF + EB - 1) / EB)), dim3(EB), 0, stream, U, Hh, S);
        if (dbg) chk(a.H, 1, FF, 1.f, Hh, FF, 0, S, FF, FF);
        gemm(Hh, FF, a.ffn1_w_out, D, Y, D, S, D, FF, stream);
        hipLaunchKernelGGL(resid_k, dim3((unsigned)((n1 + EB - 1) / EB)), dim3(EB), 0, stream, xbp, Y, 0.5f, ob, n1);
        if (dbg) chk(a.x1, 0, D, 1.f, ob, D, 0, S, D);
        hipLaunchKernelGGL(rms_rows, dim3(S), dim3(256), 0, stream, ob, a.mix_norm, xn);
        gemm(xn, D, a.w_in, INW, U, INW, S, INW, D, stream);
        hipLaunchKernelGGL(glu_k, dim3((unsigned)((n1 + EB - 1) / EB)), dim3(EB), 0, stream, U, z, S);
        if (dbg) chk(a.z, 1, D, 1.f, z, D, 0, S, D);
        hipLaunchKernelGGL(qknorm_k, dim3(S * (HQ + HKV) / 4), dim3(256), 0, stream, U, a.q_norm, a.k_norm, qn, kn);
        if (dbg) { chk(a.q, 1, D, 1.f / (0.125f * 1.4426950408889634f), qn, D, 0, S, D);
                   chk(a.k, 1, 256, 1.f, kn, 256, 0, S, 256);
                   chk(a.v, 1, 256, 1.f, U + 3328, INW, 0, S, 256);
                   chk(a.ga, 1, D, 1.f, U + 4608, INW, 1, S, D, D);
                   chk(a.ga, 1, D, 1.f, U + 4608, INW, 1, S, D, D); }
        hipLaunchKernelGGL(conv_k, dim3((unsigned)((n1 + EB - 1) / EB)), dim3(EB), 0, stream, z, a.conv_w, a.conv_b, cy);
        hipLaunchKernelGGL(ln_silu_k, dim3(S), dim3(256), 0, stream, cy, a.ln_g, a.ln_b, cv);
        if (dbg) chk(a.c, 1, D, 1.f, cv, D, 0, S, D);
        gemm(cv, D, a.conv_proj, D, av, D, S, D, D, stream);
        hipLaunchKernelGGL(attn_k, dim3(S * HQ / 4), dim3(256), 0, stream, qn, kn, U, a.sinks, a.rel_bias, ao);
        if (dbg) chk(a.o, 1, D, 1.f, ao, D, 0, S, D);
        gemm(ao, D, a.attn_wo, D, bv, D, S, D, D, stream);
        hipLaunchKernelGGL(merge_k, dim3((unsigned)((n1 + EB - 1) / EB)), dim3(EB), 0, stream, U, av, bv, mg, S);
        if (dbg) chk(a.mg, 1, D, 1.f, mg, D, 0, S, D, D);
        gemm(mg, D, a.w_out, D, Y, D, S, D, D, stream);
        hipLaunchKernelGGL(resid_k, dim3((unsigned)((n1 + EB - 1) / EB)), dim3(EB), 0, stream, ob, Y, 1.0f, ob, n1);
        if (dbg) chk(a.x2, 0, D, 1.f, ob, D, 0, S, D);
        hipLaunchKernelGGL(rms_rows, dim3(S), dim3(256), 0, stream, ob, a.ffn2_norm, xn);
        gemm(xn, D, a.ffn2_w_in, 2 * FF, U, 2 * FF, S, 2 * FF, D, stream);
        hipLaunchKernelGGL(swiglu_k, dim3((unsigned)(((size_t)S * FF + EB - 1) / EB)), dim3(EB), 0, stream, U, Hh, S);
        if (dbg) chk(a.H2, 1, FF, 1.f, Hh, FF, 0, S, FF, FF);
        gemm(Hh, FF, a.ffn2_w_out, D, Y, D, S, D, FF, stream);
        hipLaunchKernelGGL(resid_k, dim3((unsigned)((n1 + EB - 1) / EB)), dim3(EB), 0, stream, ob, Y, 0.5f, ob, n1);
        if (dbg) chk(a.out, 0, D, 1.f, ob, D, 0, S, D);
    }
    hipLaunchKernelGGL(decide_k, dim3(1), dim3(64), 0, stream, slots, hc, DBG_TOL, code);
    const size_t nall = (size_t)B * S * D;
    hipLaunchKernelGGL(finish_k, dim3((unsigned)((nall + 255) / 256)), dim3(256), 0, stream, out, a.out, (size_t)DBG_B * S * D, (size_t)S * D, nall, code);
#endif
}
```

```cpp
#define NT_STORE_H 2
#include <hip/hip_runtime.h>
#include <cstdio>
#include <cstdint>
#ifndef GEMM_DESYNC
#define GEMM_DESYNC 0
#endif
#ifndef DEBUG_ORACLE
#define DEBUG_ORACLE 0
#endif
namespace pg8 {
#define PG8_LAS __attribute__((address_space(3)))
typedef unsigned short bf16_t;
typedef short bf16x8 __attribute__((ext_vector_type(8)));
typedef float f32x4 __attribute__((ext_vector_type(4)));
typedef unsigned u32x4 __attribute__((ext_vector_type(4)));
constexpr int BM = 256, BK = 64, HALF = 128, HTB = HALF * BK * 2  , STAGE_BYTES = 8 * HTB, NXCD = 8, WGM = 8;

__host__ __device__ __forceinline__ int lds_byte(int r, int c) { const int st = (r >> 4) * 2 + (c >> 5), rr = r & 15, cc = c & 31, ob = rr * 64 + cc * 2; return st * 1024 + (ob ^ (((ob >> 9) & 1) << 5)); }
__host__ __device__ __forceinline__ void stage_rc(int b, int& R, int& C) { const int st = b / 1024, sb = b % 1024, swz = sb ^ (((sb >> 9) & 1) << 5); R = (st >> 1) * 16 + swz / 64; C = (st & 1) * 32 + (swz % 64) / 2; }
__host__ __device__ __forceinline__ int perm32(int rho) { const int n = rho >> 4, i = rho & 15; return 8 * (i >> 2) + 4 * n + (i & 3); }

__device__ __forceinline__ int fresh_lane_id() { int l; asm volatile("v_mbcnt_lo_u32_b32 %0, -1, 0\n\tv_mbcnt_hi_u32_b32 %0, -1, %0" : "=v"(l)); return l; }
struct Unit { int pm, pn; };
struct Gemm { const bf16_t* A; const bf16_t* Bt; int M, N, K; const bf16_t* A2; const bf16_t* Bt2; };

struct StaticOrder {
    int nM, nN, nwg, G, c, rev;
    __host__ __device__ void init(int M, int N, int G_, int c_, int rev_ = 0) { nM = M / BM; nN = N / BM; nwg = nM * nN; G = G_; c = c_; rev = rev_; }
    __host__ __device__ bool next(int i, Unit& u) const {
        const int nr = nwg / G; if (rev == 2) { if (i >= 2 * nr) return false; i %= nr; }
        const int ii = (rev == 1 && nwg % G == 0 && i < nr) ? nr - 1 - i : i;
        const long L = (long)ii * G + c; if (L >= nwg) return false;
        int wgid = (int)L; { const int q = nwg / NXCD, r = nwg % NXCD, xcd = wgid % NXCD, off = wgid / NXCD; wgid = (xcd < r ? xcd * (q + 1) : r * (q + 1) + (xcd - r) * q) + off; }
        const int nig = WGM * nN, gid = wgid / nig, fm = gid * WGM, gsz = (nM - fm) < WGM ? (nM - fm) : WGM;
        u.pm = fm + ((wgid % nig) % gsz); u.pn = (wgid % nig) / gsz; if (rev == 3) { u.pm = 0; u.pn = 0; }
        return true;
    }
    __device__ __forceinline__ void a_ready(const Unit&) const {}
    __device__ __forceinline__ void done(const Unit&) const {}
};

constexpr float RMS_EPS = 1e-6f;
constexpr float LOG2E = 1.4426950408889634f;
typedef float f32x2 __attribute__((ext_vector_type(2)));
typedef __bf16 bf16x2_t __attribute__((ext_vector_type(2)));
__device__ __forceinline__ unsigned cvt_pk_bf16(float lo, float hi) { f32x2 v = {lo, hi}; bf16x2_t b = __builtin_convertvector(v, bf16x2_t); return __builtin_bit_cast(unsigned, b); }
__device__ __forceinline__ u32x4 pack8(const f32x4 a, const f32x4 b) { u32x4 w; w.x = cvt_pk_bf16(a[0], a[1]); w.y = cvt_pk_bf16(a[2], a[3]); w.z = cvt_pk_bf16(b[0], b[1]); w.w = cvt_pk_bf16(b[2], b[3]); return w; }
__device__ __forceinline__ void unpack8(const u32x4 w, f32x4& a, f32x4& b) {
    a[0] = __uint_as_float(w.x << 16); a[1] = __uint_as_float(w.x & 0xffff0000u); a[2] = __uint_as_float(w.y << 16); a[3] = __uint_as_float(w.y & 0xffff0000u);
    b[0] = __uint_as_float(w.z << 16); b[1] = __uint_as_float(w.z & 0xffff0000u); b[2] = __uint_as_float(w.w << 16); b[3] = __uint_as_float(w.w & 0xffff0000u); }
__device__ __forceinline__ float fast_sigmoid(float v) { return __builtin_amdgcn_rcpf(1.0f + __builtin_amdgcn_exp2f(-LOG2E * v)); }
__device__ __forceinline__ f32x4 sigmoid4(const f32x4 v) { f32x4 o; o[0] = fast_sigmoid(v[0]); o[1] = fast_sigmoid(v[1]); o[2] = fast_sigmoid(v[2]); o[3] = fast_sigmoid(v[3]); return o; }
#ifndef NT_STORE_ALL
#define NT_STORE_ALL 0
#endif
__device__ __forceinline__ void st16_sc1(void* p, u32x4 v) { asm volatile("global_store_dwordx4 %0, %1, off sc1\n\ts_nop 1" :: "v"(p), "v"(v) : "memory"); }
#if NT_STORE_ALL == 2
#define EPI_ST16(ptr, val) st16_sc1((void*)(ptr), (val))
#define EPI_ST16F(ptr, val) st16_sc1((void*)(ptr), __builtin_bit_cast(u32x4, (val)))
#elif NT_STORE_ALL
#define EPI_ST16(ptr, val) __builtin_nontemporal_store((val), (u32x4*)(ptr))
#define EPI_ST16F(ptr, val) __builtin_nontemporal_store((val), (f32x4*)(ptr))
#else
#define EPI_ST16(ptr, val) (*(u32x4*)(ptr) = (val))
#ifndef NT_STORE_OUT
#define NT_STORE_OUT 1
#endif
#if NT_STORE_OUT
#define EPI_ST16F(ptr, val) __builtin_nontemporal_store((val), (f32x4*)(ptr))
#else
#define EPI_ST16F(ptr, val) (*(f32x4*)(ptr) = (val))
#endif
#endif
#ifndef NT_LOAD_EPI
#define NT_LOAD_EPI 0
#endif
#if NT_LOAD_EPI
#define EPI_LD16(ptr) __builtin_nontemporal_load((const u32x4*)(ptr))
#else
#define EPI_LD16(ptr) (*(const u32x4*)(ptr))
#endif
#ifndef NT_STORE_H
#define NT_STORE_H 0
#endif
#ifndef BLOCKED_ACT
#define BLOCKED_ACT 0
#endif
__device__ __forceinline__ size_t blk_off(int row, int col, int K) { return BLOCKED_ACT ? ((size_t)(row >> 4) * (K >> 5) + (col >> 5)) * 512 + (row & 15) * 32 + (col & 31) : (size_t)row * K + col; }
#ifndef BLOCKED_H
#define BLOCKED_H 0
#endif
__device__ __forceinline__ size_t blk_off_h(int row, int col, int K) { return (BLOCKED_ACT || BLOCKED_H) ? ((size_t)(row >> 4) * (K >> 5) + (col >> 5)) * 512 + (row & 15) * 32 + (col & 31) : (size_t)row * K + col; }
constexpr int BJ_STEP = BLOCKED_ACT ? (HALF / 32) * 512 : HALF;
__device__ __forceinline__ float dot4(const f32x4 v) { return (v[0] * v[0] + v[1] * v[1]) + (v[2] * v[2] + v[3] * v[3]); }

struct EpiSwiglu {
    static constexpr bool PERM = true, AFTER_DRAIN = false; static constexpr int VMOPS = 12;
    bf16_t* H; int ldh; const float* ssq;
    __device__ __forceinline__ void operator()(const f32x4 (&acc)[2][2][4][2], const Unit& u, int wr, int wc, int fr, int fq) const {
        const int row0 = u.pm * BM + wr * 64 + fr, col0 = u.pn * HALF + wc * 32 + 8 * fq;
        float rs[2][4];
#pragma unroll
        for (int ai = 0; ai < 2; ++ai)
#pragma unroll
            for (int m = 0; m < 4; ++m) rs[ai][m] = ssq[row0 + ai * HALF + m * 16];
#pragma unroll
        for (int ai = 0; ai < 2; ++ai)
#pragma unroll
            for (int m = 0; m < 4; ++m) {
                const float r = __builtin_amdgcn_rsqf(rs[ai][m] * (1.0f / 1024.0f) + RMS_EPS), c1 = -LOG2E * r, r2 = r * r;
                f32x4 h[2];
#pragma unroll
                for (int n = 0; n < 2; ++n) {
#pragma unroll
                    for (int j = 0; j < 4; ++j) { const float a = acc[ai][0][m][n][j], b = acc[ai][1][m][n][j]; h[n][j] = (a * b) * (r2 * __builtin_amdgcn_rcpf(1.0f + __builtin_amdgcn_exp2f(a * c1))); } }
#if NT_STORE_H == 2
                st16_sc1((void*)(H + blk_off_h(row0 + ai * HALF + m * 16, col0, ldh)), pack8(h[0], h[1]));
#elif NT_STORE_H
                __builtin_nontemporal_store(pack8(h[0], h[1]), (u32x4*)(H + blk_off_h(row0 + ai * HALF + m * 16, col0, ldh)));
#else
                EPI_ST16(H + blk_off_h(row0 + ai * HALF + m * 16, col0, ldh), pack8(h[0], h[1]));
#endif
            }
    }
};

template <int MODE> struct EpiProbe {
    static constexpr bool PERM = true, AFTER_DRAIN = false; static constexpr int VMOPS = 0;
    bf16_t* H; int ldh; const float* ssq;
    __device__ __forceinline__ void operator()(const f32x4 (&acc)[2][2][4][2], const Unit& u, int wr, int wc, int fr, int fq) const {
        const int row0 = u.pm * BM + wr * 64 + fr, col0 = u.pn * HALF + wc * 32 + 8 * fq;
#pragma unroll
        for (int ai = 0; ai < 2; ++ai)
#pragma unroll
            for (int m = 0; m < 4; ++m) {
                if (MODE == 0) { asm volatile("" :: "v"(acc[ai][0][m][0]), "v"(acc[ai][0][m][1]), "v"(acc[ai][1][m][0]), "v"(acc[ai][1][m][1])); }
                else if (MODE == 2) { const float r = __builtin_amdgcn_rsqf(ssq[row0 + ai * HALF + m * 16] * (1.0f / 1024.0f) + RMS_EPS); f32x4 h[2];
                    _Pragma("unroll") for (int n = 0; n < 2; ++n) { const f32x4 a = acc[ai][0][m][n] * r, b = acc[ai][1][m][n] * r; h[n] = a * sigmoid4(a) * b; }
                    const u32x4 pk = pack8(h[0], h[1]); asm volatile("" :: "v"(pk)); }
                else { EPI_ST16(H + (size_t)(row0 + ai * HALF + m * 16) * ldh + col0, pack8(acc[ai][0][m][0] + acc[ai][1][m][0], acc[ai][0][m][1] + acc[ai][1][m][1])); }
            }
    }
};

#ifndef RES_NT
#define RES_NT 0
#endif
template <bool RES_F32, bool WANT_XB, bool HALF_SCALE> struct EpiResid {
    static constexpr bool PERM = true, AFTER_DRAIN = false; static constexpr int VMOPS = 16;
    const float* res32; const bf16_t* res16; float* out32; bf16_t* xb; float* ssq_out;
    __device__ __forceinline__ void operator()(const f32x4 (&acc)[2][2][4][2], const Unit& u, int wr, int wc, int fr, int fq) const {
        const int row0 = u.pm * BM + wr * 64 + fr, col0 = u.pn * BM + wc * 32 + 8 * fq;
        constexpr float scale = HALF_SCALE ? 0.5f : 1.0f;
#pragma unroll
        for (int ai = 0; ai < 2; ++ai)
#pragma unroll
            for (int m = 0; m < 4; ++m) {
                const size_t off = (size_t)(row0 + ai * HALF + m * 16) * 1024 + col0, boff = blk_off(row0 + ai * HALF + m * 16, col0, 1024);
                float ss = 0.f;
#pragma unroll
                for (int bj = 0; bj < 2; ++bj) {
                    f32x4 r0, r1;
                    if (RES_F32) { r0 = *(const f32x4*)(res32 + off + bj * HALF); r1 = *(const f32x4*)(res32 + off + bj * HALF + 4); }
                    else unpack8((!WANT_XB && RES_NT) ? __builtin_nontemporal_load((const u32x4*)(res16 + boff + bj * BJ_STEP)) : EPI_LD16(res16 + boff + bj * BJ_STEP), r0, r1);
                    const f32x4 v0 = r0 + acc[ai][bj][m][0] * scale, v1 = r1 + acc[ai][bj][m][1] * scale;
                    if (out32) { EPI_ST16F(out32 + off + bj * HALF, v0); EPI_ST16F(out32 + off + bj * HALF + 4, v1); }
                    if (WANT_XB) { EPI_ST16(xb + boff + bj * BJ_STEP, pack8(v0, v1)); ss += dot4(v0) + dot4(v1); }
                }
                if (WANT_XB) { ss += __shfl_xor(ss, 16); ss += __shfl_xor(ss, 32); if (fq == 0) atomicAdd(ssq_out + row0 + ai * HALF + m * 16, ss); }
                if (m & 1) asm volatile("" ::: "memory");
            }
    }
};

struct EpiMix {
    static constexpr bool PERM = true, AFTER_DRAIN = false; static constexpr int VMOPS = 12;
    const float* ssq; bf16_t *z, *q, *k, *v, *gc, *ga; const float *qg, *kg;
    __device__ __forceinline__ void operator()(const f32x4 (&acc)[2][2][4][2], const Unit& u, int wr, int wc, int fr, int fq) const {
        const int row0 = u.pm * BM + wr * 64 + fr, pn = u.pn;
        float rs[2][4];
#pragma unroll
        for (int ai = 0; ai < 2; ++ai)
#pragma unroll
            for (int m = 0; m < 4; ++m) rs[ai][m] = ssq[row0 + ai * HALF + m * 16];
#pragma unroll
        for (int ai = 0; ai < 2; ++ai)
#pragma unroll
            for (int m = 0; m < 4; ++m) rs[ai][m] = __builtin_amdgcn_rsqf(rs[ai][m] * (1.0f / 1024.0f) + RMS_EPS);
        if (pn < 8) {
            const int col0 = pn * HALF + wc * 32 + 8 * fq;
#pragma unroll
            for (int ai = 0; ai < 2; ++ai)
#pragma unroll
                for (int m = 0; m < 4; ++m) {
                    const float r = rs[ai][m]; f32x4 h[2];
#pragma unroll
                    for (int n = 0; n < 2; ++n) { const f32x4 a = acc[ai][0][m][n] * r, g = acc[ai][1][m][n] * r; h[n] = a * sigmoid4(g); }
                    EPI_ST16(z + (size_t)(row0 + ai * HALF + m * 16) * 1024 + col0, pack8(h[0], h[1]));
                }
        } else if (pn < 13) {
            const bool isq = pn < 12;
            const float* gp = isq ? qg : kg; const float gs = isq ? 0.125f * LOG2E : 1.0f;
            bf16_t* ob = isq ? q : k; const int ld = isq ? 1024 : 256, head = isq ? 4 * (pn - 8) + wc : wc;
            f32x4 gv[2][2];
#pragma unroll
            for (int bj = 0; bj < 2; ++bj)
#pragma unroll
                for (int n = 0; n < 2; ++n) gv[bj][n] = *(const f32x4*)(gp + 32 * bj + 8 * fq + 4 * n) * gs;
#pragma unroll
            for (int ai = 0; ai < 2; ++ai)
#pragma unroll
                for (int m = 0; m < 4; ++m) {
                    const float r = rs[ai][m]; f32x4 y[2][2]; float ss = 0.f;
#pragma unroll
                    for (int bj = 0; bj < 2; ++bj)
#pragma unroll
                        for (int n = 0; n < 2; ++n) { y[bj][n] = acc[ai][bj][m][n] * r; ss += dot4(y[bj][n]); }
                    ss += __shfl_xor(ss, 16); ss += __shfl_xor(ss, 32);
                    const float rh = __builtin_amdgcn_rsqf(ss * (1.0f / 64.0f) + RMS_EPS);
                    bf16_t* rowp = ob + (size_t)(row0 + ai * HALF + m * 16) * ld + 64 * head + 8 * fq;
#pragma unroll
                    for (int bj = 0; bj < 2; ++bj) EPI_ST16(rowp + 32 * bj, pack8(y[bj][0] * rh * gv[bj][0], y[bj][1] * rh * gv[bj][1]));
                }
        } else if (pn == 13) {
            const int col0 = wc * 32 + 8 * fq;
#pragma unroll
            for (int ai = 0; ai < 2; ++ai)
#pragma unroll
                for (int m = 0; m < 4; ++m) {
                    const float r = rs[ai][m]; bf16_t* rowp = v + (size_t)(row0 + ai * HALF + m * 16) * 256 + col0;
#pragma unroll
                    for (int bj = 0; bj < 2; ++bj) EPI_ST16(rowp + bj * HALF, pack8(acc[ai][bj][m][0] * r, acc[ai][bj][m][1] * r));
                }
        } else {
            const int col0 = (pn - 14) * HALF + wc * 32 + 8 * fq;
#pragma unroll
            for (int ai = 0; ai < 2; ++ai)
#pragma unroll
                for (int m = 0; m < 4; ++m) {
                    const float r = rs[ai][m]; f32x4 rtv[2], sav[2];
#pragma unroll
                    for (int n = 0; n < 2; ++n) {
                        const f32x4 gc_ = acc[ai][0][m][n] * r, ga_ = acc[ai][1][m][n] * r;
#pragma unroll
                        for (int j = 0; j < 4; ++j) {
                            const float ec = __builtin_amdgcn_exp2f(-LOG2E * gc_[j]), ea = __builtin_amdgcn_exp2f(-LOG2E * ga_[j]);
                            sav[n][j] = __builtin_amdgcn_rcpf(1.0f + ea); rtv[n][j] = (1.0f + ea) * __builtin_amdgcn_rcpf(1.0f + ec);
                        }
                    }
                    const size_t off = blk_off(row0 + ai * HALF + m * 16, col0, 1024);
                    EPI_ST16(gc + off, pack8(rtv[0], rtv[1])); EPI_ST16(ga + off, pack8(sav[0], sav[1]));
                }
        }
    }
};

#ifndef GATE_NT
#define GATE_NT 1
#endif
struct EpiMerge {
    static constexpr bool PERM = true, AFTER_DRAIN = false; static constexpr int VMOPS = 16;
    const bf16_t* rt; const bf16_t* sa; bf16_t* O;
    __device__ __forceinline__ void mid(f32x4 (&acc)[2][2][4][2], const Unit& u, int wr, int wc, int fr, int fq) const {
        const int row0 = u.pm * BM + wr * 64 + fr, col0 = u.pn * BM + wc * 32 + 8 * fq;
        u32x4 g[2][4][2];
#pragma unroll
        for (int ai = 0; ai < 2; ++ai)
#pragma unroll
            for (int m = 0; m < 4; ++m) {
                const size_t off = blk_off(row0 + ai * HALF + m * 16, col0, 1024);
#pragma unroll
                for (int bj = 0; bj < 2; ++bj) g[ai][m][bj] = GATE_NT ? __builtin_nontemporal_load((const u32x4*)(rt + off + bj * BJ_STEP)) : *(const u32x4*)(rt + off + bj * BJ_STEP);
            }
#pragma unroll
        for (int ai = 0; ai < 2; ++ai)
#pragma unroll
            for (int m = 0; m < 4; ++m)
#pragma unroll
                for (int bj = 0; bj < 2; ++bj) { f32x4 g0, g1; unpack8(g[ai][m][bj], g0, g1); acc[ai][bj][m][0] *= g0; acc[ai][bj][m][1] *= g1; }
    }
    __device__ __forceinline__ void operator()(const f32x4 (&acc)[2][2][4][2], const Unit& u, int wr, int wc, int fr, int fq) const {
        const int row0 = u.pm * BM + wr * 64 + fr, col0 = u.pn * BM + wc * 32 + 8 * fq;
#pragma unroll
        for (int ai = 0; ai < 2; ++ai)
#pragma unroll
            for (int m = 0; m < 4; ++m) {
                const size_t off = blk_off(row0 + ai * HALF + m * 16, col0, 1024);
#pragma unroll
                for (int bj = 0; bj < 2; ++bj) { f32x4 g0, g1; unpack8(GATE_NT ? __builtin_nontemporal_load((const u32x4*)(sa + off + bj * BJ_STEP)) : EPI_LD16(sa + off + bj * BJ_STEP), g0, g1); EPI_ST16(O + off + bj * BJ_STEP, pack8(g0 * acc[ai][bj][m][0], g1 * acc[ai][bj][m][1])); }
                if (m & 1) asm volatile("" ::: "memory");
            }
    }
};

template <class Epi, class Sched, bool ALIGN_EPI = false, bool SP2 = false, int NSEG = 1, bool A_BLK = false, int PROBE = 0  ,
          int A_AUX = 0  ,
          int PF = 0  ,
          bool BAL = false  >
__device__ __forceinline__ void gemm_phase(PG8_LAS unsigned char* lds, const Gemm g, const Sched S, const Epi E, const int wave_id  ) {
    int tid_ = wave_id * 64 + fresh_lane_id(); asm volatile("" : "+v"(tid_));
    const int tid = tid_, wid = __builtin_amdgcn_readfirstlane(tid >> 6), lane = tid & 63, wr = wid >> 2, wc = wid & 3, fr = lane & 15, fq = lane >> 4;
#ifndef GEMM_A_FIRST
#define GEMM_A_FIRST 1
#endif
    constexpr bool A_FIRST = (GEMM_A_FIRST != 0);
    const int K = g.K, mt = K / BK, nt = NSEG * mt;
    unsigned voffA[2], voffB[2];
#pragma unroll
    for (int i = 0; i < 2; ++i) { int R, C; stage_rc(tid * 16 + i * 8192, R, C); const int Rb = Epi::PERM ? ((R & ~31) + perm32(R & 31)) : R;
        voffA[i] = A_BLK ? (unsigned)(((R >> 4) * (K / 32) + (C >> 5)) * 1024 + (R & 15) * 64 + (C & 31) * 2) : (unsigned)(R * K + C) * 2u;
        voffB[i] = (unsigned)(Rb * K + C) * 2u; }
    const unsigned voffP = (unsigned)(((wid & 3) * 64 + lane) * K) * 2u;
    static_assert(PF == 0 || !A_BLK, "the prefetch addresses assume a row-major A");
    static_assert(!BAL || (SP2 && PF == 0 && PROBE == 0), "BAL: the SP2 schedule, no prefetch touches, no probes");
    const size_t kstep = (size_t)(BK * 2);
    const size_t kstepA = A_BLK ? (size_t)2048 : kstep;
    const size_t hstep = (size_t)HALF * K * 2;
    const size_t tstep = 2 * hstep;
    unsigned long long lo_ = (unsigned long long)g.A < (unsigned long long)g.Bt ? (unsigned long long)g.A : (unsigned long long)g.Bt;
    if constexpr (NSEG == 2) { if ((unsigned long long)g.A2 < lo_) lo_ = (unsigned long long)g.A2; if ((unsigned long long)g.Bt2 < lo_) lo_ = (unsigned long long)g.Bt2; }
    const __amdgpu_buffer_rsrc_t srd = __builtin_amdgcn_make_buffer_rsrc((void*)lo_, (short)0, 0x7fffffff, 0x00020000);
    const unsigned base_lo = (unsigned)lo_, lds_lo = (unsigned)(unsigned long long)lds;
    const unsigned ldsw = (unsigned)wid * 1024u;
    const int aoff = lds_byte(wr * 64 + fr, fq * 8), boff = lds_byte(wc * 32 + fr, fq * 8);
#define PG8_SA(b, h) (((b) * 2 + (h)) * HTB)
#define PG8_SB(b, h) ((4 + (b) * 2 + (h)) * HTB)
#ifndef GEMM_BUFDMA
#define GEMM_BUFDMA 0
#endif
#define PG8_BUFPIECE(ldsoff, gbase, vo) asm volatile("s_mov_b32 m0, %0\n\ts_nop 0\n\tbuffer_load_dwordx4 %1, %2, %3 offen lds" :: "s"(lds_lo + (unsigned)(ldsoff)), "v"(vo), "s"(srd), "s"((unsigned)(unsigned long long)(gbase) - base_lo) : "m0", "memory")
#define PG8_STAGE(bufoff, gbase, voff) do { if (PROBE == 0) _Pragma("unroll") for (int _i = 0; _i < 2; ++_i) { \
        if constexpr (GEMM_BUFDMA != 0) PG8_BUFPIECE((bufoff) + ldsw + _i * 8192, gbase, (voff)[_i]); \
        else __builtin_amdgcn_global_load_lds((const unsigned*)((const char*)(gbase) + (voff)[_i]), (PG8_LAS unsigned*)(lds + (bufoff) + ldsw + _i * 8192), 16, 0, 0); } } while (0)
#define PG8_STAGE_A(bufoff, gbase, voff) do { if (PROBE == 0) _Pragma("unroll") for (int _i = 0; _i < 2; ++_i) { \
        if constexpr (A_AUX == 2) __builtin_amdgcn_global_load_lds((const unsigned*)((const char*)(gbase) + (voff)[_i]), (PG8_LAS unsigned*)(lds + (bufoff) + ldsw + _i * 8192), 16, 0, 2); \
        else if constexpr (GEMM_BUFDMA != 0) PG8_BUFPIECE((bufoff) + ldsw + _i * 8192, gbase, (voff)[_i]); \
        else __builtin_amdgcn_global_load_lds((const unsigned*)((const char*)(gbase) + (voff)[_i]), (PG8_LAS unsigned*)(lds + (bufoff) + ldsw + _i * 8192), 16, 0, 0); } } while (0)
#define PG8_LDA(dst, b, h) do { if (PROBE != 1) _Pragma("unroll") for (int m = 0; m < 4; ++m) _Pragma("unroll") for (int k = 0; k < 2; ++k) dst[m][k] = *(const PG8_LAS bf16x8*)(lds + PG8_SA(b, h) + aoff + m * 2048 + k * 1024); } while (0)
#define PG8_LDB(dst, b, h) do { if (PROBE != 1) _Pragma("unroll") for (int n = 0; n < 2; ++n) _Pragma("unroll") for (int k = 0; k < 2; ++k) dst[n][k] = *(const PG8_LAS bf16x8*)(lds + PG8_SB(b, h) + boff + n * 2048 + k * 1024); } while (0)
#ifndef GEMM_MMA_ORDER
#define GEMM_MMA_ORDER 1
#endif
#define PG8_MMA(ai, bj, At, Bt) do { __builtin_amdgcn_s_setprio(1); \
        if constexpr (GEMM_MMA_ORDER == 0) { _Pragma("unroll") for (int m = 0; m < 4; ++m) _Pragma("unroll") for (int n = 0; n < 2; ++n) _Pragma("unroll") for (int k = 0; k < 2; ++k) \
            acc[ai][bj][m][n] = __builtin_amdgcn_mfma_f32_16x16x32_bf16(Bt[n][k], At[m][k], acc[ai][bj][m][n], 0, 0, 0); } \
        else { _Pragma("unroll") for (int k = 0; k < 2; ++k) _Pragma("unroll") for (int m = 0; m < 4; ++m) _Pragma("unroll") for (int n = 0; n < 2; ++n) \
            acc[ai][bj][m][n] = __builtin_amdgcn_mfma_f32_16x16x32_bf16(Bt[n][k], At[m][k], acc[ai][bj][m][n], 0, 0, 0); } \
        __builtin_amdgcn_s_setprio(0); } while (0)
#define PG8_WAIT_V(n) asm volatile("s_waitcnt vmcnt(" #n ")" ::: "memory")
#define PG8_WAIT_V8R(rel) asm volatile("s_cmp_lg_u32 %0, 0\n\ts_cbranch_scc1 .Lpg8r%=\n\ts_waitcnt vmcnt(8)\n\ts_branch .Lpg8e%=\n.Lpg8r%=:\n\ts_waitcnt vmcnt(%1)\n.Lpg8e%=:" :: "s"(__builtin_amdgcn_readfirstlane(rel)), "n"(8 + Epi::VMOPS) : "memory", "scc")
#define PG8_WAIT_L(n) asm volatile("s_waitcnt lgkmcnt(" #n ")" ::: "memory")
#define PG8_WAIT_VP(n) do { if (PROBE == 3) asm volatile("s_waitcnt vmcnt(24)" ::: "memory"); else if (PF != 0) asm volatile("s_waitcnt vmcnt(9)" ::: "memory"); else PG8_WAIT_V(n); } while (0)
#define PG8_PREFETCH(tau) do { if (PF != 0) { const int tau_ = (tau); const char* pa_; const char* pb_; \
        if (tau_ < nt) { const bool sg_ = (NSEG == 2) && (tau_ >= mt); pa_ = sg_ ? cA2 + (size_t)(tau_ - mt) * kstepA : cA + (size_t)tau_ * kstepA; pb_ = sg_ ? cB2 + (size_t)(tau_ - mt) * kstep : cB + (size_t)tau_ * kstep; } \
        else { pa_ = nA + (size_t)(tau_ - nt) * kstepA; pb_ = nB + (size_t)(tau_ - nt) * kstep; } \
        __builtin_amdgcn_global_load_lds((const unsigned*)((wid >= 4 ? pb_ : pa_) + voffP), (PG8_LAS unsigned*)(lds + STAGE_BYTES + 4096 + wid * 256), 4, 0, 0); } } while (0)
#ifndef GEMM_LATEW
#define GEMM_LATEW 0
#endif
#define PG8_WAIT_T(n) do { if (!GEMM_LATEW || wr == 1) PG8_WAIT_VP(n); } while (0)
#define PG8_WAIT_H(n) do { if (GEMM_LATEW && wr == 0) PG8_WAIT_VP(n); } while (0)
#define PG8_BAR __builtin_amdgcn_s_barrier()
#define PG8_SCHED __builtin_amdgcn_sched_barrier(0)
    Unit cur, nxt; int ui = 0;
    if (!S.next(0, cur)) return;
#if GEMM_DESYNC
    if (g.N > 2048) { const unsigned long long t0_ = __builtin_amdgcn_s_memrealtime(); const unsigned d_ = ((unsigned)S.c * 2654435761u >> 28) * GEMM_DESYNC;
      while (__builtin_amdgcn_s_memrealtime() - t0_ < d_) __builtin_amdgcn_s_sleep(1); }
#endif
    f32x4 acc[2][2][4][2];
#pragma unroll
    for (int a = 0; a < 2; ++a)
#pragma unroll
        for (int b = 0; b < 2; ++b)
#pragma unroll
            for (int m = 0; m < 4; ++m)
#pragma unroll
                for (int n = 0; n < 2; ++n) acc[a][b][m][n] = (f32x4){0.f, 0.f, 0.f, 0.f};
    bf16x8 At[4][2], B0[2][2], B1[2][2];
    if (PROBE == 1) { _Pragma("unroll") for (int i_ = 0; i_ < 4; ++i_) _Pragma("unroll") for (int k_ = 0; k_ < 2; ++k_) { _Pragma("unroll") for (int e_ = 0; e_ < 8; ++e_) At[i_][k_][e_] = (short)(0x3c00 + 37 * lane + 11 * e_ + i_); asm volatile("" : "+v"(At[i_][k_])); }
        _Pragma("unroll") for (int i_ = 0; i_ < 2; ++i_) _Pragma("unroll") for (int k_ = 0; k_ < 2; ++k_) { _Pragma("unroll") for (int e_ = 0; e_ < 8; ++e_) { B0[i_][k_][e_] = (short)(0x3d00 + 29 * lane + 7 * e_ + i_); B1[i_][k_][e_] = (short)(0xbd00 + 23 * lane + 5 * e_ + k_); } asm volatile("" : "+v"(B0[i_][k_]), "+v"(B1[i_][k_])); } }
    const char* cA = (const char*)g.A + (size_t)cur.pm * tstep; const char* cB = (const char*)g.Bt + (size_t)cur.pn * tstep;
    const char* cA2 = (NSEG == 2) ? (const char*)g.A2 + (size_t)cur.pm * tstep : cA; const char* cB2 = (NSEG == 2) ? (const char*)g.Bt2 + (size_t)cur.pn * tstep : cB;
    S.a_ready(cur);
    if constexpr (SP2) {
        PG8_STAGE(PG8_SB(0, 0), cB, voffB); PG8_STAGE(PG8_SB(0, 1), cB + hstep, voffB); PG8_STAGE_A(PG8_SA(0, 0), cA, voffA); PG8_STAGE_A(PG8_SA(0, 1), cA + hstep, voffA);
        if (wr == 1) PG8_BAR;
        PG8_WAIT_V(2); PG8_BAR;
        if constexpr (BAL) { PG8_STAGE(PG8_SB(1, 0), cB + kstep, voffB); PG8_STAGE_A(PG8_SA(1, 0), cA + kstepA, voffA); PG8_WAIT_V(4); PG8_BAR; }
        else {
        PG8_STAGE(PG8_SB(1, 0), cB + kstep, voffB); PG8_STAGE_A(PG8_SA(1, 0), cA + kstepA, voffA); PG8_STAGE(PG8_SB(1, 1), cB + hstep + kstep, voffB);
        PG8_WAIT_V(6); PG8_BAR;
        }
    } else {
        PG8_STAGE(PG8_SB(0, 0), cB, voffB); PG8_STAGE_A(PG8_SA(0, 0), cA, voffA); PG8_STAGE(PG8_SB(0, 1), cB + hstep, voffB); PG8_STAGE_A(PG8_SA(0, 1), cA + hstep, voffA);
        if (wr == 1) PG8_BAR;
        PG8_WAIT_V(4); PG8_BAR;
        PG8_STAGE(PG8_SB(1, 0), cB + kstep, voffB); PG8_STAGE_A(PG8_SA(1, 0), cA + kstepA, voffA); PG8_STAGE(PG8_SB(1, 1), cB + hstep + kstep, voffB);
        PG8_WAIT_V(6); PG8_BAR;
    }
    for (;;) {
        const bool has_next = S.next(ui + 1, nxt);
        const char* nA = has_next ? (const char*)g.A + (size_t)nxt.pm * tstep : cA; const char* nB = has_next ? (const char*)g.Bt + (size_t)nxt.pn * tstep : cB;
        const char* nA2 = (NSEG == 2 && has_next) ? (const char*)g.A2 + (size_t)nxt.pm * tstep : cA2; const char* nB2 = (NSEG == 2 && has_next) ? (const char*)g.Bt2 + (size_t)nxt.pn * tstep : cB2;
        for (int t = 0; t < nt; t += 2) {
            const bool last = (t == nt - 2);
            const int relax = ((t == 0) && (ui > 0) && (Epi::VMOPS > 0)) ? 1 : 0;
            if constexpr (NSEG == 2) { if (t == mt) E.mid(acc, cur, wr, wc, fr, fq); }
            const bool s1 = (NSEG == 2) && (t + 1 >= mt), s2 = (NSEG == 2) && (t + 2 >= mt);
            const char* a1 = s1 ? cA2 + (size_t)(t + 1 - mt) * kstepA : cA + (size_t)(t + 1) * kstepA;
            const char* a2 = last ? nA : (s2 ? cA2 + (size_t)(t + 2 - mt) * kstepA : cA + (size_t)(t + 2) * kstepA);
            const char* b2 = last ? nB : (s2 ? cB2 + (size_t)(t + 2 - mt) * kstep : cB + (size_t)(t + 2) * kstep);
            const char* a3 = a2 + kstepA; const char* b3 = b2 + kstep;
            if (last && has_next) S.a_ready(nxt);
            if constexpr (BAL) {
            const char* b1 = s1 ? cB2 + (size_t)(t + 1 - mt) * kstep : cB + (size_t)(t + 1) * kstep;
            PG8_LDB(B0, 0, 0); PG8_LDB(B1, 0, 1); PG8_SCHED; PG8_LDA(At, 0, 0); PG8_STAGE(PG8_SB(1, 1), b1 + hstep, voffB); PG8_STAGE_A(PG8_SA(1, 1), a1 + hstep, voffA);
            PG8_WAIT_V(8); PG8_WAIT_L(0); PG8_BAR; PG8_MMA(0, 0, At, B0); PG8_MMA(0, 1, At, B1); PG8_BAR; PG8_SCHED;
            PG8_LDA(At, 0, 1); PG8_STAGE(PG8_SB(0, 0), b2, voffB); PG8_STAGE_A(PG8_SA(0, 0), a2, voffA);
            PG8_WAIT_V(6); PG8_WAIT_L(0); PG8_BAR; PG8_MMA(1, 0, At, B0); PG8_MMA(1, 1, At, B1); PG8_BAR; PG8_SCHED;
            PG8_LDB(B0, 1, 0); PG8_LDB(B1, 1, 1); PG8_SCHED; PG8_LDA(At, 1, 0); PG8_STAGE(PG8_SB(0, 1), b2 + hstep, voffB); PG8_STAGE_A(PG8_SA(0, 1), a2 + hstep, voffA);
            PG8_WAIT_V(8); PG8_WAIT_L(0); PG8_BAR; PG8_MMA(0, 0, At, B0); PG8_MMA(0, 1, At, B1); PG8_BAR; PG8_SCHED;
            PG8_LDA(At, 1, 1); PG8_STAGE(PG8_SB(1, 0), b3, voffB); PG8_STAGE_A(PG8_SA(1, 0), a3, voffA);
            PG8_WAIT_V(6); PG8_WAIT_L(0); PG8_BAR; PG8_MMA(1, 0, At, B0); PG8_MMA(1, 1, At, B1); PG8_BAR; PG8_SCHED;
            } else if constexpr (SP2) {
            PG8_LDB(B0, 0, 0); PG8_LDB(B1, 0, 1); PG8_SCHED; PG8_LDA(At, 0, 0); PG8_STAGE_A(PG8_SA(1, 1), a1 + hstep, voffA);
            PG8_WAIT_T(8); PG8_WAIT_L(0); PG8_BAR; PG8_MMA(0, 0, At, B0); PG8_MMA(0, 1, At, B1); PG8_WAIT_H(8); PG8_BAR; PG8_SCHED;
            PG8_LDA(At, 0, 1); if constexpr (A_FIRST) PG8_STAGE_A(PG8_SA(0, 0), a2, voffA); PG8_STAGE(PG8_SB(0, 0), b2, voffB); PG8_STAGE(PG8_SB(0, 1), b2 + hstep, voffB); if constexpr (!A_FIRST) PG8_STAGE_A(PG8_SA(0, 0), a2, voffA); PG8_PREFETCH(t + PF);
            PG8_WAIT_T(8); PG8_WAIT_L(0); PG8_BAR; PG8_MMA(1, 0, At, B0); PG8_MMA(1, 1, At, B1); PG8_WAIT_H(8); PG8_BAR; PG8_SCHED;
            PG8_LDB(B0, 1, 0); PG8_LDB(B1, 1, 1); PG8_SCHED; PG8_LDA(At, 1, 0); PG8_STAGE_A(PG8_SA(0, 1), a2 + hstep, voffA);
            PG8_WAIT_T(8); PG8_WAIT_L(0); PG8_BAR; PG8_MMA(0, 0, At, B0); PG8_MMA(0, 1, At, B1); PG8_WAIT_H(8); PG8_BAR; PG8_SCHED;
            PG8_LDA(At, 1, 1); if constexpr (A_FIRST) PG8_STAGE_A(PG8_SA(1, 0), a3, voffA); PG8_STAGE(PG8_SB(1, 0), b3, voffB); PG8_STAGE(PG8_SB(1, 1), b3 + hstep, voffB); if constexpr (!A_FIRST) PG8_STAGE_A(PG8_SA(1, 0), a3, voffA); PG8_PREFETCH(t + 1 + PF);
            PG8_WAIT_T(8); PG8_WAIT_L(0); PG8_BAR; PG8_MMA(1, 0, At, B0); PG8_MMA(1, 1, At, B1); PG8_WAIT_H(8); PG8_BAR; PG8_SCHED;
            } else {
            PG8_LDB(B0, 0, 0); PG8_SCHED; PG8_LDA(At, 0, 0); PG8_STAGE_A(PG8_SA(1, 1), a1 + hstep, voffA);
            PG8_WAIT_L(8); PG8_BAR; PG8_WAIT_L(0); PG8_MMA(0, 0, At, B0); PG8_BAR; PG8_SCHED;
            PG8_LDB(B1, 0, 1); PG8_STAGE(PG8_SB(0, 0), b2, voffB);
            PG8_BAR; PG8_WAIT_L(0); PG8_MMA(0, 1, At, B1); PG8_BAR;
            PG8_LDA(At, 0, 1); PG8_STAGE_A(PG8_SA(0, 0), a2, voffA);
            PG8_BAR; PG8_WAIT_L(0); PG8_MMA(1, 0, At, B0); PG8_BAR; PG8_SCHED;
            PG8_STAGE(PG8_SB(0, 1), b2 + hstep, voffB);
            PG8_WAIT_V(6); PG8_BAR; PG8_MMA(1, 1, At, B1); PG8_BAR;
            PG8_LDB(B0, 1, 0); PG8_SCHED; PG8_LDA(At, 1, 0); PG8_STAGE_A(PG8_SA(0, 1), a2 + hstep, voffA);
            PG8_WAIT_L(8); PG8_BAR; PG8_WAIT_L(0); PG8_MMA(0, 0, At, B0); PG8_BAR; PG8_SCHED;
            PG8_LDB(B1, 1, 1); PG8_STAGE(PG8_SB(1, 0), b3, voffB);
            PG8_BAR; PG8_WAIT_L(0); PG8_MMA(0, 1, At, B1); PG8_BAR;
            PG8_LDA(At, 1, 1); PG8_STAGE_A(PG8_SA(1, 0), a3, voffA);
            PG8_BAR; PG8_WAIT_L(0); PG8_MMA(1, 0, At, B0); PG8_BAR; PG8_SCHED;
            PG8_STAGE(PG8_SB(1, 1), b3 + hstep, voffB);
            PG8_WAIT_V(6); PG8_BAR; PG8_MMA(1, 1, At, B1); PG8_BAR;
            }
        }
        if constexpr (ALIGN_EPI) { if (wr == 0) PG8_BAR; }
        if constexpr (!Epi::AFTER_DRAIN) { E(acc, cur, wr, wc, fr, fq); S.done(cur); }
        if (!has_next) break;
#pragma unroll
        for (int a = 0; a < 2; ++a)
#pragma unroll
            for (int b = 0; b < 2; ++b)
#pragma unroll
                for (int m = 0; m < 4; ++m)
#pragma unroll
                    for (int n = 0; n < 2; ++n) acc[a][b][m][n] = (f32x4){0.f, 0.f, 0.f, 0.f};
        cur = nxt; cA = nA; cB = nB; cA2 = nA2; cB2 = nB2; ++ui;
        if constexpr (ALIGN_EPI) { if (wr == 1) PG8_BAR; }
    }
    PG8_WAIT_V(0);
    if constexpr (!ALIGN_EPI) { if (wr == 0) PG8_BAR; }
    PG8_BAR;
    if constexpr (Epi::AFTER_DRAIN) { E.fused(acc, cur, wr, wc, fr, fq, lds, wid, lane); S.done(cur); }
#undef PG8_SA
#undef PG8_SB
#undef PG8_STAGE
#undef PG8_STAGE_A
#undef PG8_BUFPIECE
#undef PG8_LDA
#undef PG8_LDB
#undef PG8_MMA
#undef PG8_WAIT_V
#undef PG8_WAIT_V8R
#undef PG8_WAIT_L
#undef PG8_WAIT_VP
#undef PG8_WAIT_T
#undef PG8_WAIT_H
#undef PG8_PREFETCH
#undef PG8_BAR
#undef PG8_SCHED
}
}
constexpr int D = 1024, NB = 8, SEQ = 4096, FF = 2816, CWID = 31, HD = 64, HQ = 16, HKV = 4, INW = 5632;
constexpr int M_FULL = NB * SEQ;
constexpr int NWAVES = 8, NTHREADS = 512;
constexpr int LDS_BYTES = 147456;
constexpr int RING_BYTES = 131072;
constexpr size_t CTL_ZERO_BYTES = 16384;

#define LAS __attribute__((address_space(3)))
typedef unsigned short bf16;
typedef unsigned v4u __attribute__((ext_vector_type(4)));
typedef unsigned v2u __attribute__((ext_vector_type(2)));
typedef float f32x4 __attribute__((ext_vector_type(4)));
typedef float f32x2 __attribute__((ext_vector_type(2)));
typedef float f32x16 __attribute__((ext_vector_type(16)));
typedef short bf16x8 __attribute__((ext_vector_type(8)));
typedef short s16x4 __attribute__((ext_vector_type(4)));

__device__ const unsigned char T5B[128] = {0, 1, 2, 3, 4, 5, 6, 7, 8, 9, 10, 11, 12, 13, 14, 15, 16, 16, 16, 17, 17, 18, 18, 18, 19, 19, 19, 20, 20, 20, 20, 21, 21, 21, 21, 22, 22, 22, 22, 22, 23, 23, 23, 23, 23, 23, 24, 24, 24, 24, 24, 24, 25, 25, 25, 25, 25, 25, 25, 26, 26, 26, 26, 26, 26, 26, 26, 27, 27, 27, 27, 27, 27, 27, 27, 27, 27, 28, 28, 28, 28, 28, 28, 28, 28, 28, 28, 29, 29, 29, 29, 29, 29, 29, 29, 29, 29, 29, 29, 30, 30, 30, 30, 30, 30, 30, 30, 30, 30, 30, 30, 30, 30, 31, 31, 31, 31, 31, 31, 31, 31, 31, 31, 31, 31, 31, 31, 31};

struct Args {
    const float *x, *ffn1_norm, *ffn1_w_in, *ffn1_w_out, *mix_norm, *w_in, *conv_w, *conv_b, *ln_g, *ln_b, *conv_proj, *q_norm, *k_norm, *sinks, *rel_bias, *attn_wo, *w_out, *ffn2_norm, *ffn2_w_in, *ffn2_w_out;
    float *x1, *x2, *out;
    unsigned* ctl;
    float *ssq0, *ssq1, *ssq2;
    bf16 *W1i, *W1o, *Wmx, *Wcp, *Wao, *Wot, *W2i, *W2o;
    bf16 *xb, *H, *H2, *z, *q, *k, *v, *gc, *ga, *c, *o, *m1, *mg;
    int M; int pad;
};

#ifndef CA_NT
#define CA_NT 0
#endif
#ifndef P0_NT
#define P0_NT 1
#endif
__device__ __forceinline__ unsigned f2bf(float f) { unsigned u = __builtin_bit_cast(unsigned, f); return (u + 0x7fffu + ((u >> 16) & 1u)) >> 16; }
__device__ __forceinline__ unsigned pk2(float lo, float hi) { return f2bf(lo) | (f2bf(hi) << 16); }
#define LDS_WAIT() asm volatile("s_waitcnt lgkmcnt(0)" ::: "memory")

__device__ __forceinline__ int src_col(int kind, int n0) {
    if (kind == 0) return n0;
    const int u = n0 >> 8, r = n0 & 255, bj = r >> 7, j = r & 127;
    if (kind == 1) return bj * FF + 128 * u + j;
    if (u < 8) return bj * 1024 + 128 * u + j;
    if (u < 12) return 2048 + 64 * (4 * (u - 8) + (j >> 5)) + 32 * bj;
    if (u == 12) return 3072 + 64 * (j >> 5) + 32 * bj;
    if (u == 13) return n0;
    return 3584 + bj * 1024 + 128 * (u - 14) + j;
}
#ifndef P0_NT_WT
#define P0_NT_WT 1
#endif
struct P0Item { const float* W; const float* gain; bf16* WT; int K, Nsrc, N, kind, item; bool kperm; bool nt; };
__device__ __forceinline__ void p0_item_load(const P0Item& I, int tid, f32x4 (&v)[8], float (&g)[8]) {
    const int nblk = I.N / 256, kb = I.item / nblk, nb = I.item % nblk, k0 = 64 * kb, n0 = 256 * nb;
    const int wv = tid >> 6, lane = tid & 63;
    const int s4 = src_col(I.kind, n0 + 32 * (lane >> 3)) + 4 * (lane & 7);
#pragma unroll
    for (int i = 0; i < 8; ++i) { const int kl = wv * 8 + i, ks = k0 + (I.kperm ? (kl >> 1) + 32 * (kl & 1) : kl);
        v[i] = P0_NT ? __builtin_nontemporal_load((const f32x4*)(I.W + (size_t)ks * I.Nsrc + s4)) : *(const f32x4*)(I.W + (size_t)ks * I.Nsrc + s4); }
#pragma unroll
    for (int i = 0; i < 8; ++i) g[i] = I.gain ? I.gain[k0 + wv * 8 + i] : 1.0f;
}
__device__ __forceinline__ void p0_item_store(const P0Item& I, int tid, const f32x4 (&v)[8], const float (&g)[8], LAS float* tile) {
    const int nblk = I.N / 256, kb = I.item / nblk, nb = I.item % nblk, k0 = 64 * kb, n0 = 256 * nb;
    const int wv = tid >> 6, lane = tid & 63;
#pragma unroll
    for (int i = 0; i < 8; ++i) { LAS float* d = tile + (wv * 8 + i) * 257 + 4 * lane; d[0] = g[i] * v[i][0]; d[1] = g[i] * v[i][1]; d[2] = g[i] * v[i][2]; d[3] = g[i] * v[i][3]; }
    __syncthreads();
    const int c = tid & 7;
#pragma unroll
    for (int j = 0; j < 4; ++j) { const int n = (tid >> 3) + 64 * j; const LAS float* s = tile + (8 * c) * 257 + n;
        v4u o; o.x = pg8::cvt_pk_bf16(s[0 * 257], s[1 * 257]); o.y = pg8::cvt_pk_bf16(s[2 * 257], s[3 * 257]); o.z = pg8::cvt_pk_bf16(s[4 * 257], s[5 * 257]); o.w = pg8::cvt_pk_bf16(s[6 * 257], s[7 * 257]);
        const int kk_ = k0 + 8 * c;
        if (P0_NT_WT && I.nt) __builtin_nontemporal_store(o, (v4u*)(I.WT + (size_t)(n0 + n) * I.K + kk_)); else *(v4u*)(I.WT + (size_t)(n0 + n) * I.K + kk_) = o; }
    __syncthreads();
}
__device__ __forceinline__ float wave_sum(float v) {
#pragma unroll
    for (int o = 1; o < 64; o <<= 1) v += __shfl_xor(v, o);
    return v;
}
__device__ __forceinline__ void p0_prologue(const Args& A, LAS unsigned char* lds, int gw, int NGW, int lane) {
    LAS float* tile = (LAS float*)lds;
    constexpr int I_IN = (D / 64) * (INW / 256), I_OUT = (FF / 64) * (D / 256), I_SQ = (D / 64) * (D / 256);
    constexpr int NITEMS = 3 * I_IN + 2 * I_OUT + 3 * I_SQ;
    const int vwg = gw >> 3, NWG = NGW >> 3, tid = ((gw & 7) << 6) + lane;
    auto resolve = [&](int it) -> P0Item {
        int r = it;
        if (r < I_IN) return P0Item{A.ffn1_w_in, A.ffn1_norm, A.W1i, D, 2 * FF, 2 * FF, 1, r, false, false}; r -= I_IN;
        if (r < I_IN) return P0Item{A.w_in, A.mix_norm, A.Wmx, D, INW, INW, 2, r, false, true}; r -= I_IN;
        if (r < I_IN) return P0Item{A.ffn2_w_in, A.ffn2_norm, A.W2i, D, 2 * FF, 2 * FF, 1, r, false, true}; r -= I_IN;
        if (r < I_OUT) return P0Item{A.ffn1_w_out, nullptr, A.W1o, FF, D, D, 0, r, false, true}; r -= I_OUT;
        if (r < I_OUT) return P0Item{A.ffn2_w_out, nullptr, A.W2o, FF, D, D, 0, r, false, true}; r -= I_OUT;
        if (r < I_SQ) return P0Item{A.conv_proj, nullptr, A.Wcp, D, D, D, 0, r, false, true}; r -= I_SQ;
        if (r < I_SQ) return P0Item{A.attn_wo, nullptr, A.Wao, D, D, D, 0, r, true, true}; r -= I_SQ;
        return P0Item{A.w_out, nullptr, A.Wot, D, D, D, 0, r, false, true};
    };
    {   f32x4 v[8], vn[8]; float g[8], gn[8];
        f32x4 xv[8], xn[8];
        int it = vwg; P0Item cur = resolve(it < NITEMS ? it : 0);
        if (it < NITEMS) p0_item_load(cur, tid, v, g);
        int m = 2 * gw;
        if (m < A.M) { const f32x4* xr = (const f32x4*)(A.x + (size_t)m * D) + lane;
#pragma unroll
            for (int j = 0; j < 8; ++j) xv[j] = P0_NT ? __builtin_nontemporal_load(xr + 64 * j) : xr[64 * j]; }
#pragma unroll 1
        while (it < NITEMS || m < A.M) {
            const bool has_it = it < NITEMS, more = it + NWG < NITEMS;
            const P0Item nxt = resolve(more ? it + NWG : 0);
            if (more) p0_item_load(nxt, tid, vn, gn);
            if (m + 2 * NGW < A.M) { const f32x4* xr = (const f32x4*)(A.x + (size_t)(m + 2 * NGW) * D) + lane;
#pragma unroll
                for (int j = 0; j < 8; ++j) xn[j] = P0_NT ? __builtin_nontemporal_load(xr + 64 * j) : xr[64 * j]; }
            if (has_it) {
                p0_item_store(cur, tid, v, g, tile);
#pragma unroll
                for (int i = 0; i < 8; ++i) { v[i] = vn[i]; g[i] = gn[i]; }
                cur = nxt; it += NWG;
            }
            if (m < A.M) {
                float s0 = 0.f, s1 = 0.f;
#pragma unroll
                for (int j = 0; j < 4; ++j) { s0 += (xv[j][0] * xv[j][0] + xv[j][1] * xv[j][1]) + (xv[j][2] * xv[j][2] + xv[j][3] * xv[j][3]); s1 += (xv[j + 4][0] * xv[j + 4][0] + xv[j + 4][1] * xv[j + 4][1]) + (xv[j + 4][2] * xv[j + 4][2] + xv[j + 4][3] * xv[j + 4][3]); }
                s0 = wave_sum(s0); s1 = wave_sum(s1);
#pragma unroll
                for (int j = 0; j < 8; ++j) { v2u w; w.x = pg8::cvt_pk_bf16(xv[j][0], xv[j][1]); w.y = pg8::cvt_pk_bf16(xv[j][2], xv[j][3]);
                    const int row = m + (j >> 2), col = 4 * (lane + 64 * (j & 3));
                    *(v2u*)(A.xb + pg8::blk_off(row, col, D)) = w; }
                if (lane < 2) { const float s = lane ? s1 : s0; A.ssq0[m + lane] = s; A.ssq1[m + lane] = 0.f; A.ssq2[m + lane] = 0.f; }
#pragma unroll
                for (int j = 0; j < 8; ++j) xv[j] = xn[j];
                m += 2 * NGW;
            }
        }
    }
}

__device__ __forceinline__ f32x2 bf2_to_f2(unsigned z) { return (f32x2){__uint_as_float(z << 16), __uint_as_float(z & 0xffff0000u)}; }
template <int N, int OFF> __device__ __forceinline__ void rs_step(float (&v)[32], int lane) {
    const bool up = (lane & OFF) != 0;
#pragma unroll
    for (int i = 0; i < N; ++i) { const float keep = up ? v[i + N] : v[i], send = up ? v[i] : v[i + N]; v[i] = keep + __shfl_xor(send, OFF); }
}
template <int N2> __device__ __forceinline__ float reduce_scatter(float (&v)[32], int lane) {
    static_assert(N2 == 32, "32 values over 64 lanes");
    rs_step<16, 32>(v, lane); rs_step<8, 16>(v, lane); rs_step<4, 8>(v, lane); rs_step<2, 4>(v, lane); rs_step<1, 2>(v, lane);
    return v[0] + __shfl_xor(v[0], 1);
}
template <int BASE, int CVAR = 0  > __device__ __forceinline__ void conv_step16(const Args& A, f32x2 (&h)[32], unsigned (&zin)[16], const f32x2 (&w)[CWID], f32x2 bias, f32x2 g2, f32x2 b2,
                                                               const bf16* znext, bool have_next, bf16* orow, LAS float* red, LAS f32x2* STAT, int lane, int wid) {
    f32x2 y[16];
#pragma unroll
    for (int s = 0; s < 16; ++s) {
        h[BASE + s] = bf2_to_f2(zin[s]);
        f32x2 a = bias;
        if constexpr (CVAR == 1) {
            typedef _Float16 h2_t __attribute__((ext_vector_type(2)));
#pragma unroll
            for (int k = 0; k < 16; ++k) { const h2_t zp_ = __builtin_bit_cast(h2_t, h[(BASE + s + 2 + 2 * k) & 31][0]), wp_ = __builtin_bit_cast(h2_t, w[2 * k][0]), zq_ = __builtin_bit_cast(h2_t, h[(BASE + s + 2 + 2 * k) & 31][1]), wq_ = __builtin_bit_cast(h2_t, w[2 * k][1]);
                a[0] = __builtin_amdgcn_fdot2(zp_, wp_, a[0], false); a[1] = __builtin_amdgcn_fdot2(zq_, wq_, a[1], false); }
        } else {
#pragma unroll
        for (int k = 0; k < CWID; ++k) a = __builtin_elementwise_fma(w[k], h[(BASE + s + 2 + k) & 31], a);
        }
        y[s] = a;
    }
    {
        float v[32];
#pragma unroll
        for (int s = 0; s < 16; ++s) { v[2 * s] = y[s][0] + y[s][1]; v[2 * s + 1] = y[s][0] * y[s][0] + y[s][1] * y[s][1]; }
        const float r = reduce_scatter<32>(v, lane);
        if ((lane & 1) == 0) red[wid * 32 + (lane >> 1)] = r;
    }
    if (have_next) {
#pragma unroll
        for (int s = 0; s < 16; ++s) zin[s] = CA_NT ? __builtin_nontemporal_load((const unsigned*)(znext + (size_t)s * D)) : *(const unsigned*)(znext + (size_t)s * D);
    }
    __syncthreads();
    {
        float tot = 0.f;
#pragma unroll
        for (int wv = 0; wv < 8; ++wv) tot += red[wv * 32 + (lane & 31)];
        const float other = __shfl_xor(tot, 1);
        const float sm = (lane & 1) ? other : tot, sq = (lane & 1) ? tot : other;
        const float mu = sm * (1.0f / D), rs = __builtin_amdgcn_rsqf(fmaxf(sq * (1.0f / D) - mu * mu, 0.0f) + 1e-6f);
        if ((lane & 33) == 0) STAT[lane >> 1] = (f32x2){mu, rs};
    }
#pragma unroll
    for (int s = 0; s < 16; ++s) {
        const f32x2 st = STAT[s];
        f32x2 v = (y[s] - st[0]) * st[1] * g2 + b2;
        v[0] = v[0] * pg8::fast_sigmoid(v[0]); v[1] = v[1] * pg8::fast_sigmoid(v[1]);
        *(unsigned*)(orow + (size_t)s * D) = pg8::cvt_pk_bf16(v[0], v[1]);
    }
}
template <int CVAR = 0> __device__ __forceinline__ void conv_phase(const Args& A, LAS unsigned char* lds, const int wave_id, const int ch0, const int chstep) {
    int tid_ = wave_id * 64 + pg8::fresh_lane_id(); asm volatile("" : "+v"(tid_));
    const int tid = tid_, lane = tid & 63, wid = tid >> 6, c0 = 2 * tid;
    LAS float* RED = (LAS float*)lds;
    LAS f32x2* STAT = (LAS f32x2*)(lds + 4096) + wid * 16;
    f32x2 w[CWID];
#pragma unroll
    for (int k = 0; k < CWID; ++k) w[k] = *(const f32x2*)(A.conv_w + k * D + c0);
    const f32x2 bias = *(const f32x2*)(A.conv_b + c0), g2 = *(const f32x2*)(A.ln_g + c0), b2 = *(const f32x2*)(A.ln_b + c0);
    const int nchunks = A.M / 128;
    for (int ch = ch0; ch < nchunks; ch += chstep) {
        const int t0 = ch * 128; const bool first = (t0 % SEQ) == 0;
        const bf16* zp = A.z + (size_t)t0 * D + c0;
        bf16* op = A.c + (size_t)t0 * D + c0;
        f32x2 h[32];
        unsigned zin[16];
#pragma unroll
        for (int s = 0; s < 16; ++s) zin[s] = CA_NT ? __builtin_nontemporal_load((const unsigned*)(zp + (size_t)s * D)) : *(const unsigned*)(zp + (size_t)s * D);
#pragma unroll
        for (int i = 2; i < 32; ++i) { unsigned zz = 0u; if (!first) zz = *(const unsigned*)(zp - (size_t)(32 - i) * D); h[i] = bf2_to_f2(zz); }
#pragma unroll 1
        for (int tb = 0; tb < 128; tb += 32) {
            conv_step16<0, CVAR>(A, h, zin, w, bias, g2, b2, zp + (size_t)(tb + 16) * D, true, op + (size_t)tb * D, RED, STAT, lane, wid);
            conv_step16<16, CVAR>(A, h, zin, w, bias, g2, b2, zp + (size_t)(tb + 32) * D, tb + 32 < 128, op + (size_t)(tb + 16) * D, RED + 256, STAT, lane, wid);
        }
    }
    __syncthreads();
}

constexpr int ATT_K_OFF = 0, ATT_V_OFF = 32768, ATT_TB_OFF = 65536, ATT_LS_OFF = 69632, ATT_OST_OFF = 73728;
__device__ __forceinline__ s16x4 vtr(const LAS unsigned char* p) { typedef short v4i16_t __attribute__((ext_vector_type(4))); return __builtin_bit_cast(s16x4, __builtin_amdgcn_ds_read_tr16_b64_v4i16((LAS v4i16_t*)p)); }
template <int VAR  > __device__ __forceinline__ void attn_phase(const Args& A, LAS unsigned char* lds, const int wave_id, const int u0, const int ustep, const int uend) {
    int tid_ = wave_id * 64 + pg8::fresh_lane_id(); asm volatile("" : "+v"(tid_));
    const int tid = tid_, lane = tid & 63, r32 = lane & 31, hi = lane >> 5; const int wid = __builtin_amdgcn_readfirstlane(tid >> 6);
    const int nunits = (A.M / 128) * HKV;
    LAS float* TB = (LAS float*)(lds + ATT_TB_OFF);
    LAS float* LS = (LAS float*)(lds + ATT_LS_OFF) + wid * 64;
    v4u kreg[4], vreg[4];
#define ATT_LOAD_KV(u_) do { const int blk_ = (u_) >> 2, hk_ = (u_) & 3, t0_ = blk_ * 128; const bool first_ = (t0_ % SEQ) == 0; \
        _Pragma("unroll") for (int i = 0; i < 4; ++i) { const int idx = tid + 512 * i, key = idx >> 3, cc = idx & 7; \
            if (!(first_ && key < 128)) { const size_t g_ = (size_t)(t0_ - 128 + key) * 256 + hk_ * 64 + cc * 8; kreg[i] = *(const v4u*)(A.k + g_); vreg[i] = *(const v4u*)(A.v + g_); } } } while (0)
    float shift; bool use_bound;
    { float gq = fabsf(A.q_norm[lane]), gk = fabsf(A.k_norm[lane]), bm = 0.f;
#pragma unroll
      for (int i = 0; i < 8; ++i) bm = fmaxf(bm, fabsf(A.rel_bias[lane + 64 * i]));
#pragma unroll
      for (int o = 1; o < 64; o <<= 1) { gq = fmaxf(gq, __shfl_xor(gq, o)); gk = fmaxf(gk, __shfl_xor(gk, o)); bm = fmaxf(bm, __shfl_xor(bm, o)); }
      const float bnd = (8.0f * gq * gk + bm) * pg8::LOG2E; use_bound = bnd <= 40.0f; shift = use_bound ? bnd : 0.0f; }
    int u = u0;
    bf16x8 qn[4];
#define ATT_LOAD_Q0(u_) do { const int t0_ = ((u_) >> 2) * 128, hk_ = (u_) & 3, g_ = wid >> 2, sub_ = wid & 3; const size_t qrow_ = (size_t)(t0_ + 32 * sub_ + r32) * D + (hk_ * 4 + g_) * HD; \
        _Pragma("unroll") for (int d0 = 0; d0 < 4; ++d0) qn[d0] = CA_NT ? __builtin_nontemporal_load((const bf16x8*)(A.q + qrow_ + 16 * d0 + 8 * hi)) : *(const bf16x8*)(A.q + qrow_ + 16 * d0 + 8 * hi); } while (0)
    if (u < uend) { ATT_LOAD_KV(u); ATT_LOAD_Q0(u); }
    int tb_hk = -1;
    for (; u < uend; u += ustep) {
        const int blk = u >> 2, hk = u & 3, t0 = blk * 128; const bool first = (t0 % SEQ) == 0;
#pragma unroll
        for (int i = 0; i < 4; ++i) {
            const int idx = tid + 512 * i, key = idx >> 3, cc = idx & 7;
            const bool dead = first && key < 128;
            *(LAS v4u*)(lds + ATT_K_OFF + key * 128 + ((cc ^ ((key >> 1) & 7)) << 4)) = dead ? (v4u){0u, 0u, 0u, 0u} : kreg[i];
            *(LAS v4u*)(lds + ATT_V_OFF + ((key >> 2) * 2 + (cc >> 2)) * 256 + (key & 3) * 64 + (cc & 3) * 16) = dead ? (v4u){0u, 0u, 0u, 0u} : vreg[i];
        }
        if (hk != tb_hk) {
            for (int e = tid; e < 4 * 192; e += NTHREADS) {
                const int g = e / 192, dist = e % 192 - 32;
                TB[e] = (dist >= 0 && dist < 128) ? A.rel_bias[T5B[dist] * HQ + hk * 4 + g] * pg8::LOG2E - shift : -3.0e38f;
            }
            tb_hk = hk;
        }
        __syncthreads();
        bf16x8 qf[2][4];
#pragma unroll
        for (int d0 = 0; d0 < 4; ++d0) qf[0][d0] = qn[d0];
        {   const int task = wid + 8, g = task >> 2, sub = task & 3;
            const size_t qrow = (size_t)(t0 + 32 * sub + r32) * D + (hk * 4 + g) * HD;
#pragma unroll
            for (int d0 = 0; d0 < 4; ++d0) qf[1][d0] = CA_NT ? __builtin_nontemporal_load((const bf16x8*)(A.q + qrow + 16 * d0 + 8 * hi)) : *(const bf16x8*)(A.q + qrow + 16 * d0 + 8 * hi); }
        if (u + ustep < uend) { ATT_LOAD_KV(u + ustep); ATT_LOAD_Q0(u + ustep); }
#define ATT_SBAR() __builtin_amdgcn_sched_barrier(0)
        if (VAR == 1) { asm volatile("" :: "v"(qf[0][0]), "v"(qf[0][1]), "v"(qf[0][2]), "v"(qf[0][3]), "v"(qf[1][0]), "v"(qf[1][1]), "v"(qf[1][2]), "v"(qf[1][3])); }
#ifndef ATT_PAIR
#define ATT_PAIR 0
#endif
        if (ATT_PAIR && VAR == 0 && use_bound) {
            const int sub = wid & 3, g0 = wid >> 2, hA = hk * 4 + g0;
            const LAS float* tbA = TB + g0 * 192 + 32 + r32 - 4 * hi; const LAS float* tbB = tbA + 2 * 192;
            const float sinkA = A.sinks[hA] * pg8::LOG2E - shift, sinkB = A.sinks[hA + 2] * pg8::LOG2E - shift;
            f32x16 oA0, oA1, oB0, oB1;
#pragma unroll
            for (int r = 0; r < 16; ++r) { oA0[r] = 0.f; oA1[r] = 0.f; oB0[r] = 0.f; oB1[r] = 0.f; }
            float lA = 0.f, lB = 0.f;
            bf16x8 kfr[4]; s16x4 vfr[2][4];
            const LAS unsigned char* kbase = lds + ATT_K_OFF + r32 * 128; const int kx = (r32 >> 1) & 7;
            const LAS unsigned char* vbase = lds + ATT_V_OFF + hi * 512 + ((lane & 15) >> 2) * 64 + (((lane >> 4) & 1) * 16 + (lane & 3) * 4) * 2;
#define ATT_LOADK(buf, kt_) do { _Pragma("unroll") for (int d0 = 0; d0 < 4; ++d0) kfr[d0] = *(const LAS bf16x8*)(kbase + (kt_) * 4096 + (((2 * d0 + hi) ^ kx) << 4)); } while (0)
#define ATT_LOADV(buf, kt_, s2_) do { const LAS unsigned char* vp_ = vbase + ((8 * (kt_) + 4 * (s2_)) * 2) * 256; vfr[buf][0] = vtr(vp_); vfr[buf][1] = vtr(vp_ + 2 * 512); vfr[buf][2] = vtr(vp_ + 256); vfr[buf][3] = vtr(vp_ + 256 + 2 * 512); } while (0)
#define ATT_PV(sX, oX0, oX1, lX) do { \
                _Pragma("unroll") for (int r = 0; r < 16; ++r) { sX[r] = __builtin_amdgcn_exp2f(sX[r]); lX += sX[r]; } \
                _Pragma("unroll") for (int s2 = 0; s2 < 2; ++s2) { \
                    v4u pw; pw.x = pg8::cvt_pk_bf16(sX[8 * s2 + 0], sX[8 * s2 + 1]); pw.y = pg8::cvt_pk_bf16(sX[8 * s2 + 2], sX[8 * s2 + 3]); pw.z = pg8::cvt_pk_bf16(sX[8 * s2 + 4], sX[8 * s2 + 5]); pw.w = pg8::cvt_pk_bf16(sX[8 * s2 + 6], sX[8 * s2 + 7]); \
                    const bf16x8 pa = __builtin_bit_cast(bf16x8, pw); \
                    const s16x4 a0 = vfr[s2][0], a1 = vfr[s2][1], b0 = vfr[s2][2], b1 = vfr[s2][3]; \
                    const bf16x8 v0 = (bf16x8){a0[0], a0[1], a0[2], a0[3], a1[0], a1[1], a1[2], a1[3]}; \
                    const bf16x8 v1 = (bf16x8){b0[0], b0[1], b0[2], b0[3], b1[0], b1[1], b1[2], b1[3]}; \
                    oX0 = __builtin_amdgcn_mfma_f32_32x32x16_bf16(pa, v0, oX0, 0, 0, 0); oX1 = __builtin_amdgcn_mfma_f32_32x32x16_bf16(pa, v1, oX1, 0, 0, 0); } } while (0)
            ATT_LOADK(0, sub + 4);
#pragma unroll
            for (int di = 0; di < 5; ++di) {
                const int kt = sub + 4 - di;
                f32x16 sA, sB;
#pragma unroll
                for (int r = 0; r < 16; ++r) { sA[r] = tbA[32 * di - ((r & 3) + 8 * (r >> 2))]; sB[r] = tbB[32 * di - ((r & 3) + 8 * (r >> 2))]; }
                ATT_LOADV(0, kt, 0); ATT_LOADV(1, kt, 1);
                ATT_SBAR();
#pragma unroll
                for (int d0 = 0; d0 < 4; ++d0) sA = __builtin_amdgcn_mfma_f32_32x32x16_bf16(kfr[d0], qf[0][d0], sA, 0, 0, 0);
#pragma unroll
                for (int d0 = 0; d0 < 4; ++d0) sB = __builtin_amdgcn_mfma_f32_32x32x16_bf16(kfr[d0], qf[1][d0], sB, 0, 0, 0);
                ATT_SBAR();
                if (di < 4) ATT_LOADK(0, kt - 1);
                if (first && kt < 4) {
#pragma unroll
                    for (int r = 0; r < 16; ++r) { sA[r] = -3.0e38f; sB[r] = -3.0e38f; }
                }
                ATT_PV(sA, oA0, oA1, lA);
                ATT_PV(sB, oB0, oB1, lB);
            }
#define ATT_EPI(oX0, oX1, lX, sinkX, hX) do { \
                float l_ = lX + __shfl_xor(lX, 32); l_ += __builtin_amdgcn_exp2f(sinkX); const float linv = __builtin_amdgcn_rcpf(l_); \
                unsigned* ob = (unsigned*)(A.o + (size_t)(t0 + 32 * sub + 4 * hi) * D + (hX) * HD) + r32; \
                _Pragma("unroll") for (int r = 0; r < 16; ++r) { \
                    const float li0 = __builtin_bit_cast(float, __builtin_amdgcn_readlane(__builtin_bit_cast(int, linv), (r & 3) + 8 * (r >> 2))); \
                    const float li1 = __builtin_bit_cast(float, __builtin_amdgcn_readlane(__builtin_bit_cast(int, linv), (r & 3) + 8 * (r >> 2) + 4)); \
                    const float li = hi ? li1 : li0; \
                    ob[(size_t)((r & 3) + 8 * (r >> 2)) * (D / 2)] = pg8::cvt_pk_bf16(oX0[r] * li, oX1[r] * li); } } while (0)
            ATT_EPI(oA0, oA1, lA, sinkA, hA);
            ATT_EPI(oB0, oB1, lB, sinkB, hA + 2);
#undef ATT_EPI
#undef ATT_PV
#undef ATT_LOADK
#undef ATT_LOADV
        } else
#pragma unroll
        for (int ti = 0; ti < (VAR == 1 ? 0 : 2); ++ti) {
            const int task = wid + 8 * ti, g = task >> 2, sub = task & 3, h = hk * 4 + g;
            f32x16 s[5];
            const LAS float* tb = TB + g * 192 + 32 + r32 - 4 * hi;
#pragma unroll
            for (int di = 0; di < 5; ++di)
#pragma unroll
                for (int r = 0; r < 16; ++r) s[di][r] = tb[32 * di - ((r & 3) + 8 * (r >> 2))];
            float sink2 = A.sinks[h] * pg8::LOG2E - shift;
            bf16x8 kfr[2][4];
            const LAS unsigned char* kbase = lds + ATT_K_OFF + r32 * 128; const int kx = (r32 >> 1) & 7;
#define ATT_LOADK(buf, kt_) do { _Pragma("unroll") for (int d0 = 0; d0 < 4; ++d0) kfr[buf][d0] = *(const LAS bf16x8*)(kbase + (kt_) * 4096 + (((2 * d0 + hi) ^ kx) << 4)); } while (0)
            ATT_LOADK(0, sub + 4);
#pragma unroll
            for (int di = 0; di < 5; ++di) {
                const int kt = sub + 4 - di;
                if (di < 4) ATT_LOADK((di + 1) & 1, kt - 1);
                ATT_SBAR();
#pragma unroll
                for (int d0 = 0; d0 < 4; ++d0) s[di] = __builtin_amdgcn_mfma_f32_32x32x16_bf16(kfr[di & 1][d0], qf[ti][d0], s[di], 0, 0, 0);
                ATT_SBAR();
                if (first && kt < 4) {
#pragma unroll
                    for (int r = 0; r < 16; ++r) s[di][r] = -3.0e38f;
                }
            }
            if (VAR == 3) { asm volatile("" :: "v"(s[0]), "v"(s[1]), "v"(s[2]), "v"(s[3]), "v"(s[4])); continue; }
            s16x4 vfr[2][4];
            const LAS unsigned char* vbase = lds + ATT_V_OFF + hi * 512 + ((lane & 15) >> 2) * 64 + (((lane >> 4) & 1) * 16 + (lane & 3) * 4) * 2;
#define ATT_LOADV(buf, kt_, s2_) do { const LAS unsigned char* vp_ = vbase + ((8 * (kt_) + 4 * (s2_)) * 2) * 256; vfr[buf][0] = vtr(vp_); vfr[buf][1] = vtr(vp_ + 2 * 512); vfr[buf][2] = vtr(vp_ + 256); vfr[buf][3] = vtr(vp_ + 256 + 2 * 512); } while (0)
            ATT_LOADV(0, sub + 4, 0);
            if (!use_bound) {
                float mx = sink2;
#pragma unroll
                for (int di = 0; di < 5; ++di)
#pragma unroll
                    for (int r = 0; r < 16; r += 2) mx = fmaxf(mx, fmaxf(s[di][r], s[di][r + 1]));
                mx = fmaxf(mx, __shfl_xor(mx, 32));
#pragma unroll
                for (int di = 0; di < 5; ++di)
#pragma unroll
                    for (int r = 0; r < 16; ++r) s[di][r] -= mx;
                sink2 -= mx;
            }
            float l = 0.f;
#pragma unroll
            for (int di = 0; di < 5; ++di)
#pragma unroll
                for (int r = 0; r < 16; ++r) { s[di][r] = __builtin_amdgcn_exp2f(s[di][r]); l += s[di][r]; }
            f32x16 o0, o1;
#pragma unroll
            for (int r = 0; r < 16; ++r) { o0[r] = 0.f; o1[r] = 0.f; }
#pragma unroll
            for (int j = 0; j < 10; ++j) {
                const int di = j >> 1, s2 = j & 1;
                if (j < 9) ATT_LOADV((j + 1) & 1, sub + 4 - ((j + 1) >> 1), (j + 1) & 1);
                ATT_SBAR();
                v4u pw; pw.x = pg8::cvt_pk_bf16(s[di][8 * s2 + 0], s[di][8 * s2 + 1]); pw.y = pg8::cvt_pk_bf16(s[di][8 * s2 + 2], s[di][8 * s2 + 3]);
                pw.z = pg8::cvt_pk_bf16(s[di][8 * s2 + 4], s[di][8 * s2 + 5]); pw.w = pg8::cvt_pk_bf16(s[di][8 * s2 + 6], s[di][8 * s2 + 7]);
                const bf16x8 pa = __builtin_bit_cast(bf16x8, pw);
                const s16x4 a0 = vfr[j & 1][0], a1 = vfr[j & 1][1], b0 = vfr[j & 1][2], b1 = vfr[j & 1][3];
                const bf16x8 v0 = (bf16x8){a0[0], a0[1], a0[2], a0[3], a1[0], a1[1], a1[2], a1[3]};
                const bf16x8 v1 = (bf16x8){b0[0], b0[1], b0[2], b0[3], b1[0], b1[1], b1[2], b1[3]};
                o0 = __builtin_amdgcn_mfma_f32_32x32x16_bf16(pa, v0, o0, 0, 0, 0);
                o1 = __builtin_amdgcn_mfma_f32_32x32x16_bf16(pa, v1, o1, 0, 0, 0);
                ATT_SBAR();
            }
            if (VAR == 2) { asm volatile("" :: "v"(o0), "v"(o1), "v"(l)); continue; }
            l += __shfl_xor(l, 32);
            l += __builtin_amdgcn_exp2f(sink2);
            const float linv = __builtin_amdgcn_rcpf(l);
            unsigned* ob = (unsigned*)(A.o + (size_t)(t0 + 32 * sub + 4 * hi) * D + h * HD) + r32;
#pragma unroll
            for (int r = 0; r < 16; ++r) {
                const float li0 = __builtin_bit_cast(float, __builtin_amdgcn_readlane(__builtin_bit_cast(int, linv), (r & 3) + 8 * (r >> 2)));
                const float li1 = __builtin_bit_cast(float, __builtin_amdgcn_readlane(__builtin_bit_cast(int, linv), (r & 3) + 8 * (r >> 2) + 4));
                const float li = hi ? li1 : li0;
                ob[(size_t)((r & 3) + 8 * (r >> 2)) * (D / 2)] = pg8::cvt_pk_bf16(o0[r] * li, o1[r] * li);
            }
        }
#undef ATT_LOADK
#undef ATT_LOADV
#undef ATT_SBAR
        __syncthreads();
    }
#undef ATT_LOAD_KV
#undef ATT_LOAD_Q0
}
typedef unsigned gu32_t;
#define XB_TMO      128
#define XB_XCNT(j)  (256  + 64 * (j))
#define XB_XSUB(j)  (1280 + 64 * (j))
#define XB_XGEN(j)  (2304 + 64 * (j))
#define XB_TOP      3328
#define XB_TOPGEN   3392
#define XCD_BAR_WORDS 3456
#ifndef XB_FLAT
#define XB_FLAT 1
#endif
#define XB_SPIN_CAP (1u << 18)

__device__ __forceinline__ unsigned xb_ld(unsigned* p)              { return __hip_atomic_load(p, __ATOMIC_RELAXED, __HIP_MEMORY_SCOPE_AGENT); }
__device__ __forceinline__ unsigned xb_add(unsigned* p, unsigned v) { return __hip_atomic_fetch_add(p, v, __ATOMIC_RELAXED, __HIP_MEMORY_SCOPE_AGENT); }
__device__ __forceinline__ unsigned xb_xcc_id() { return (unsigned)__builtin_amdgcn_s_getreg((3 << 11) | 20) & 0xFu; }
#define XB_SPIN(cond, bar) do { unsigned _sp = 0; while (cond) { __builtin_amdgcn_s_sleep(1); \
    if ((++_sp & 255u) == 0u) { if (xb_ld(&(bar)[XB_TMO])) break; if (_sp > XB_SPIN_CAP) { atomicAdd(&(bar)[XB_TMO], 1u); break; } } } } while (0)

struct XcdBarrier {
    unsigned* bar; unsigned x; int w;
    volatile LAS unsigned* st;
};

__device__ __forceinline__ XcdBarrier xcd_barrier_post(unsigned* bar, volatile LAS unsigned* st) {
    XcdBarrier b; b.bar = bar; b.x = xb_xcc_id(); b.st = st; b.w = __builtin_amdgcn_readfirstlane((int)threadIdx.x >> 6);
    if (threadIdx.x == 0) st[2] = xb_add(&bar[XB_XCNT(b.x)], 1u);
    return b;
}
__device__ __forceinline__ void xcd_barrier_complete(unsigned* bar, unsigned x, unsigned& nloc, unsigned& nx) {
    const unsigned G = gridDim.x * gridDim.y * gridDim.z;
    unsigned sum, cnt, mine, sp = 0u;
    for (;;) {
        sum = 0u; cnt = 0u; mine = 0u;
#pragma unroll
        for (unsigned j = 0; j < 16; ++j) { const unsigned c = xb_ld(&bar[XB_XCNT(j)]); sum += c; cnt += (c > 0u) ? (XB_FLAT ? (1u << j) : 1u) : 0u; mine = (j == x) ? c : mine; }
        if (sum == G) break;
        __builtin_amdgcn_s_sleep(1);
        if ((++sp & 255u) == 0u) { if (xb_ld(&bar[XB_TMO])) break; if (sp > XB_SPIN_CAP) { atomicAdd(&bar[XB_TMO], 1u); break; } }
    }
    nloc = mine > 0u ? mine : 1u; nx = cnt > 0u ? cnt : 1u;
}
__device__ __forceinline__ unsigned xcd_even_placement(unsigned* bar) {
    const unsigned G = gridDim.x * gridDim.y * gridDim.z; unsigned ok = (G % 8u == 0u) ? 1u : 0u;
#pragma unroll
    for (unsigned j = 0; j < 16; ++j) { const unsigned c = xb_ld(&bar[XB_XCNT(j)]); ok &= (c == (j < 8u ? G / 8u : 0u)) ? 1u : 0u; }
    return ok;
}

#ifndef XB_FLAT
#define XB_FLAT 1
#endif
#define XB_FLAG 3408
__device__ __forceinline__ void xcd_barrier(const XcdBarrier& b) {
    asm volatile("s_waitcnt vmcnt(0)" ::: "memory");
    __syncthreads();
    if (b.w == 0 && pg8::fresh_lane_id() == 0) {
        unsigned* bar = b.bar;
        __builtin_amdgcn_s_waitcnt(0);
        unsigned nloc = b.st[0], nx = b.st[1];
        if (nloc == 0u) { xcd_barrier_complete(bar, b.x, nloc, nx); b.st[0] = nloc; b.st[1] = nx; b.st[3] = xcd_even_placement(bar); }
        const unsigned old = xb_add(&bar[XB_XSUB(b.x)], 1u);
        const unsigned gen = old / nloc;
#if XB_FLAT
        if (old + 1u == (gen + 1u) * nloc) {
            __builtin_amdgcn_fence(__ATOMIC_RELEASE, "agent");
            asm volatile("s_waitcnt vmcnt(0)" ::: "memory");
            __hip_atomic_store(&bar[XB_FLAG + b.x], gen + 1u, __ATOMIC_RELAXED, __HIP_MEMORY_SCOPE_AGENT);
        }
        {   unsigned sp = 0u;
            for (;;) {
                unsigned pending = 0u;
#pragma unroll
                for (unsigned j = 0; j < 16; ++j) { const unsigned f = xb_ld(&bar[XB_FLAG + j]); pending |= ((int)(f - (gen + 1u)) < 0) ? (1u << j) : 0u; }
                if ((pending & nx) == 0u) break;
                __builtin_amdgcn_s_sleep(1);
                if ((++sp & 255u) == 0u) { if (xb_ld(&bar[XB_TMO])) break; if (sp > XB_SPIN_CAP) { atomicAdd(&bar[XB_TMO], 1u); break; } }
            }
        }
        __builtin_amdgcn_fence(__ATOMIC_ACQUIRE, "agent");
        asm volatile("s_waitcnt vmcnt(0)" ::: "memory");
#else
        if (old + 1u == (gen + 1u) * nloc) {
            __builtin_amdgcn_fence(__ATOMIC_RELEASE, "agent");
            asm volatile("s_waitcnt vmcnt(0)" ::: "memory");
            const unsigned og = xb_add(&bar[XB_TOP], 1u);
            const unsigned tg = og / nx;
            if (og + 1u == (tg + 1u) * nx) xb_add(&bar[XB_TOPGEN], 1u);
            else XB_SPIN(xb_ld(&bar[XB_TOPGEN]) == tg, bar);
            __builtin_amdgcn_fence(__ATOMIC_ACQUIRE, "agent");
            xb_add(&bar[XB_XGEN(b.x)], 1u);
            asm volatile("s_waitcnt vmcnt(0)" ::: "memory");
        } else {
            XB_SPIN(xb_ld(&bar[XB_XGEN(b.x)]) == gen, bar);
            __builtin_amdgcn_fence(__ATOMIC_ACQUIRE, "agent");
            asm volatile("s_waitcnt vmcnt(0)" ::: "memory");
        }
#endif
    }
    __syncthreads();
}

#define XB_LSUB(j)  (3456 + 8 * (j))
__device__ __forceinline__ void xcd_local_barrier(const XcdBarrier& b) {
    asm volatile("s_waitcnt vmcnt(0)" ::: "memory");
    __syncthreads();
    if (b.w == 0 && pg8::fresh_lane_id() == 0) {
        unsigned* bar = b.bar;
        __builtin_amdgcn_s_waitcnt(0);
        const unsigned nloc = b.st[0];
        const unsigned old = xb_add(&bar[XB_LSUB(b.x)], 1u);
        const unsigned want = (old / nloc + 1u) * nloc;
        XB_SPIN((int)(xb_ld(&bar[XB_LSUB(b.x)]) - want) < 0, bar);
        __builtin_amdgcn_fence(__ATOMIC_ACQUIRE, "agent");
        asm volatile("s_waitcnt vmcnt(0)" ::: "memory");
    }
    __syncthreads();
}
typedef pg8::EpiResid<false, true, true> EpiRes2; typedef pg8::EpiResid<false, true, false> EpiRes6; typedef pg8::EpiResid<false, false, true> EpiRes8;
#ifndef STOP_AFTER
#define STOP_AFTER 99
#endif
#ifndef H_REV
#define H_REV 0
#endif
#ifndef H_NT
#define H_NT 0
#endif
#ifndef GEMM_PF
#define GEMM_PF 0
#endif
#ifndef CONV_PROBE_VAR
#define CONV_PROBE_VAR 0
#endif
#ifndef ATTN_PROBE_VAR
#define ATTN_PROBE_VAR 0
#endif
#ifndef DUP_MASK
#define DUP_MASK 0
#endif
__global__ void __launch_bounds__(NTHREADS, 2) mega_fwd(Args A) {
    extern __shared__ __attribute__((aligned(16))) unsigned char lds_raw[];
    LAS unsigned char* lds = (LAS unsigned char*)lds_raw;
    const int tid = threadIdx.x, lane = tid & 63, wave = __builtin_amdgcn_readfirstlane(tid >> 6), G = gridDim.x;
    const int vcu = (G % 8 == 0) ? ((int)blockIdx.x % 8) * (G / 8) + (int)blockIdx.x / 8 : (int)blockIdx.x;
    const int M = A.M;
    volatile LAS unsigned* MISC = (volatile LAS unsigned*)(lds + RING_BYTES);
    if (tid < 16) MISC[tid] = 0u;
    __syncthreads();
    const XcdBarrier bar = xcd_barrier_post(A.ctl, MISC);
#ifndef XCC_PROBE
#define XCC_PROBE 0
#endif
    if (XCC_PROBE && tid == 0 && xb_xcc_id() != (blockIdx.x & 7u)) { const unsigned long long t0_ = __builtin_amdgcn_s_memrealtime(); while ((unsigned)(__builtin_amdgcn_s_memrealtime() - t0_) < 30000u) __builtin_amdgcn_s_sleep(8); }
#define GRID_SYNC() xcd_barrier(bar)
#ifndef LOCAL_CHAIN
#define LOCAL_CHAIN 1
#endif
#define SEAM_SYNC() do { if (LOCALM) xcd_local_barrier(bar); else xcd_barrier(bar); } while (0)
#ifndef GEMM_BAL
#define GEMM_BAL 0
#endif
#ifndef PROBE_PHASE
#define PROBE_PHASE -1
#endif
#ifndef CLK_PROBE
#define CLK_PROBE 0
#endif
#define STAMP(k) do { if (PROBE_PHASE >= 0 && blockIdx.x == 0 && tid == 0) { const unsigned long long t_ = __builtin_amdgcn_s_memrealtime(); const unsigned long long c_ = CLK_PROBE ? (unsigned long long)clock64() : 0ull; if ((k) == PROBE_PHASE) { MISC[4] = (unsigned)t_; MISC[6] = (unsigned)c_; } if ((k) == PROBE_PHASE + 1) { MISC[5] = (unsigned)t_; MISC[7] = (unsigned)c_; } } } while (0)
#define GEMM_PHASE_X(ABLK, AAUX, REVX, EPI_T, AP, BP, NN, KK, ...) do { pg8::Gemm g_{AP, BP, M, NN, KK}; pg8::StaticOrder S_; S_.init(M, NN, G, cvirt, REVX); EPI_T E_{__VA_ARGS__}; \
        pg8::gemm_phase<EPI_T, pg8::StaticOrder, true, true, 1, ABLK, 0, AAUX, GEMM_PF, (GEMM_BAL != 0)>(lds, g_, S_, E_, wave); } while (0)
#define GEMM_PHASE_(ABLK, ...) GEMM_PHASE_X(ABLK, 0, 0, __VA_ARGS__)
#define GEMM_PHASE_HNT(...) GEMM_PHASE_X((BLOCKED_ACT != 0 || BLOCKED_H != 0), H_NT, H_REV, __VA_ARGS__)
#define GEMM_PHASE(...) GEMM_PHASE_(false, __VA_ARGS__)
#define GEMM_PHASE_B(...) GEMM_PHASE_((BLOCKED_ACT != 0), __VA_ARGS__)

    STAMP(0);
    p0_prologue(A, lds, vcu * NWAVES + wave, G * NWAVES, lane);
    if (DUP_MASK & 1) { __syncthreads(); p0_prologue(A, lds, vcu * NWAVES + wave, G * NWAVES, lane); }
    GRID_SYNC();
    const bool LOCALM = LOCAL_CHAIN && NB == 8 && M == M_FULL && __builtin_amdgcn_readfirstlane((int)MISC[3]) != 0;
    const int cvirt = LOCALM ? __builtin_amdgcn_readfirstlane((int)MISC[2]) * 8 + (int)bar.x : (int)blockIdx.x;
    STAMP(1);
    if (DUP_MASK & 8) GEMM_PHASE(pg8::EpiSwiglu, A.xb, A.W1i, 2 * FF, D, A.H, FF, A.ssq0);
    if (DUP_MASK & 64) GEMM_PHASE(pg8::EpiProbe<0>, A.xb, A.W1i, 2 * FF, D, A.H, FF, A.ssq0);
    if (DUP_MASK & 32768) GEMM_PHASE_X(false, 0, 3, pg8::EpiProbe<0>, A.xb, A.W1i, 2 * FF, D, A.H, FF, A.ssq0);
    if (DUP_MASK & 128) GEMM_PHASE(pg8::EpiProbe<1>, A.xb, A.W1i, 2 * FF, D, A.H, FF, A.ssq0);
    if (DUP_MASK & 2048) GEMM_PHASE(pg8::EpiProbe<2>, A.xb, A.W1i, 2 * FF, D, A.H, FF, A.ssq0);
    if (DUP_MASK & 4096) do { pg8::Gemm g_{A.xb, A.W1i, M, 2 * FF, D}; pg8::StaticOrder S_; S_.init(M, 2 * FF, G, (int)blockIdx.x); pg8::EpiProbe<0> E_{A.H, FF, A.ssq0}; pg8::gemm_phase<pg8::EpiProbe<0>, pg8::StaticOrder, true, true, 1, false, 1>(lds, g_, S_, E_, wave); } while (0);
    if (DUP_MASK & 16384) do { pg8::Gemm g_{A.xb, A.W1i, M, 2 * FF, D}; pg8::StaticOrder S_; S_.init(M, 2 * FF, G, (int)blockIdx.x); pg8::EpiProbe<0> E_{A.H, FF, A.ssq0}; pg8::gemm_phase<pg8::EpiProbe<0>, pg8::StaticOrder, true, true, 1, false, 3>(lds, g_, S_, E_, wave); } while (0);
    if (DUP_MASK & 8192) do { pg8::Gemm g_{A.xb, A.W1i, M, 2 * FF, D}; pg8::StaticOrder S_; S_.init(M, 2 * FF, G, (int)blockIdx.x); pg8::EpiProbe<0> E_{A.H, FF, A.ssq0}; pg8::gemm_phase<pg8::EpiProbe<0>, pg8::StaticOrder, true, true, 1, false, 2>(lds, g_, S_, E_, wave); } while (0);
#ifndef G1_TWICE
#define G1_TWICE 0
#endif
    GEMM_PHASE_X((BLOCKED_ACT != 0), 0, (G1_TWICE ? 2 : 0), pg8::EpiSwiglu, A.xb, A.W1i, 2 * FF, D, A.H, FF, A.ssq0);
    SEAM_SYNC();
    STAMP(2);
    if (STOP_AFTER <= 1) return;
    if (DUP_MASK & 256) GEMM_PHASE_B(pg8::EpiProbe<0>, A.H, A.W1o, D, FF, A.H, FF, A.ssq0);
    if (DUP_MASK & 512) GEMM_PHASE_B(pg8::EpiProbe<0>, A.H, A.W1o, D, FF, A.H, FF, A.ssq0);
    GEMM_PHASE_HNT(EpiRes2, A.H, A.W1o, D, FF, nullptr, A.xb, A.x1, A.xb, A.ssq1);
    SEAM_SYNC();
    STAMP(3);
    if (STOP_AFTER <= 2) return;
    GEMM_PHASE_B(pg8::EpiMix, A.xb, A.Wmx, INW, D, A.ssq1, A.z, A.q, A.k, A.v, A.gc, A.ga, A.q_norm, A.k_norm);
    if (DUP_MASK & 16) GEMM_PHASE_B(pg8::EpiMix, A.xb, A.Wmx, INW, D, A.ssq1, A.z, A.q, A.k, A.v, A.gc, A.ga, A.q_norm, A.k_norm);
    SEAM_SYNC();
    STAMP(4);
    if (STOP_AFTER <= 3) return;
    const int cv_r = cvirt >> 3, cv_x = cvirt & 7;
    const int ch0 = LOCALM ? 32 * cv_x + cv_r : (int)blockIdx.x, chstep = LOCALM ? M / 128 : G;
    const int u0 = LOCALM ? (32 * cv_x + (cv_r >> 2)) * 4 + (cv_r & 3) : (int)blockIdx.x, ustep = LOCALM ? 32 : G, uend = LOCALM ? (cv_x + 1) * 128 : (M / 128) * HKV;
    if (DUP_MASK & 2) conv_phase<CONV_PROBE_VAR>(A, lds, wave, ch0, chstep);
#ifndef CA_ALTERNATE
#define CA_ALTERNATE 0
#endif
    {   const bool attn_first = CA_ALTERNATE && DUP_MASK == 0 && PROBE_PHASE < 0 && (cv_r & 1);
        _Pragma("unroll 1") for (int st_ = 0; st_ < 2; ++st_) {
            if ((st_ == 1) == attn_first) { conv_phase<0>(A, lds, wave, ch0, chstep); STAMP(5); }
            else {
                if ((DUP_MASK & 4) && ATTN_PROBE_VAR != 0) attn_phase<ATTN_PROBE_VAR>(A, lds, wave, u0, ustep, uend);
                _Pragma("unroll 1") for (int rep_ = 0; rep_ < (((DUP_MASK & 4) && ATTN_PROBE_VAR == 0) ? 2 : 1); ++rep_) attn_phase<0>(A, lds, wave, u0, ustep, uend);
            }
        }
    }
    SEAM_SYNC();
    STAMP(6);
    if (STOP_AFTER <= 4) return;
    do { pg8::Gemm g_{A.c, A.Wcp, M, D, D, A.o, A.Wao}; pg8::StaticOrder S_; S_.init(M, D, G, cvirt); pg8::EpiMerge E_{A.gc, A.ga, A.mg};
         pg8::gemm_phase<pg8::EpiMerge, pg8::StaticOrder, true, true, 2, false, 0, 0, GEMM_PF, (GEMM_BAL != 0)>(lds, g_, S_, E_, wave); } while (0);
    SEAM_SYNC();
    STAMP(7);
    if (STOP_AFTER <= 6) return;
    GEMM_PHASE_B(EpiRes6, A.mg, A.Wot, D, D, nullptr, A.xb, A.x2, A.xb, A.ssq2);
    SEAM_SYNC();
    STAMP(8);
    if (STOP_AFTER <= 7) return;
    GEMM_PHASE_B(pg8::EpiSwiglu, A.xb, A.W2i, 2 * FF, D, A.H2, FF, A.ssq2);
    if (DUP_MASK & 32) GEMM_PHASE_B(pg8::EpiSwiglu, A.xb, A.W2i, 2 * FF, D, A.H2, FF, A.ssq2);
    SEAM_SYNC();
    STAMP(9);
#ifndef G8_TWICE
#define G8_TWICE 0
#endif
    GEMM_PHASE_X((BLOCKED_ACT != 0 || BLOCKED_H != 0), H_NT, (G8_TWICE ? 2 : H_REV), EpiRes8, A.H2, A.W2o, D, FF, nullptr, A.xb, A.out, nullptr, nullptr);
    if (PROBE_PHASE >= 0) { __syncthreads(); STAMP(10); if (blockIdx.x == 0) { __syncthreads(); const unsigned d_ = CLK_PROBE ? (unsigned)((unsigned long long)(MISC[7] - MISC[6]) * 1000ull / (MISC[5] - MISC[4])) : 8u * (MISC[5] - MISC[4]); const unsigned long long t0_ = __builtin_amdgcn_s_memrealtime(); while ((unsigned)(__builtin_amdgcn_s_memrealtime() - t0_) < d_) __builtin_amdgcn_s_sleep(8); } }
    if (DUP_MASK & 1024) { _Pragma("unroll 1") for (int i_ = 0; i_ < 8; ++i_) GRID_SYNC(); }
#undef GEMM_PHASE
#undef GEMM_PHASE_B
#undef GEMM_PHASE_
#undef GEMM_PHASE_X
#undef GEMM_PHASE_HNT
#undef GRID_SYNC
}

static size_t ws_map(Args& a, unsigned char* ws, int M, bool alias) {
    size_t off = 0;
    auto take = [&](size_t bytes) { unsigned char* p = ws + off; off += (bytes + 255) & ~(size_t)255; return p; };
    a.ctl = (unsigned*)take(1u << 20);
    a.ssq0 = (float*)take((size_t)M * 4); a.ssq1 = (float*)take((size_t)M * 4); a.ssq2 = (float*)take((size_t)M * 4);
    a.W1i = (bf16*)take((size_t)2 * FF * D * 2); a.W1o = (bf16*)take((size_t)D * FF * 2); a.Wmx = (bf16*)take((size_t)INW * D * 2);
    a.Wcp = (bf16*)take((size_t)D * D * 2); a.Wao = (bf16*)take((size_t)D * D * 2); a.Wot = (bf16*)take((size_t)D * D * 2);
    a.W2i = (bf16*)take((size_t)2 * FF * D * 2); a.W2o = (bf16*)take((size_t)D * FF * 2);
    const size_t act = (size_t)M * D * 2;
    a.xb = (bf16*)take(act);
    a.H = (bf16*)take((size_t)M * FF * 2); a.H2 = a.H;
    if (alias) {
        a.z = a.H; a.q = a.z + (size_t)M * D; a.k = a.q + (size_t)M * D; a.v = a.k + (size_t)M * 256;
        a.gc = (bf16*)take(act); a.ga = (bf16*)take(act); a.c = (bf16*)take(act);
        a.o = a.q; a.m1 = nullptr; a.mg = a.z;
    } else {
        a.z = (bf16*)take(act); a.q = (bf16*)take(act); a.k = (bf16*)take((size_t)M * 256 * 2); a.v = (bf16*)take((size_t)M * 256 * 2);
        a.gc = (bf16*)take(act); a.ga = (bf16*)take(act); a.c = (bf16*)take(act);
        a.o = (bf16*)take(act); a.m1 = nullptr; a.mg = (bf16*)take(act);
    }
    return off;
}
static void set_inputs(Args& a, void* const* d_in) {
    a.x = (const float*)d_in[0]; a.ffn1_norm = (const float*)d_in[1]; a.ffn1_w_in = (const float*)d_in[2]; a.ffn1_w_out = (const float*)d_in[3];
    a.mix_norm = (const float*)d_in[4]; a.w_in = (const float*)d_in[5]; a.conv_w = (const float*)d_in[6]; a.conv_b = (const float*)d_in[7];
    a.ln_g = (const float*)d_in[8]; a.ln_b = (const float*)d_in[9]; a.conv_proj = (const float*)d_in[10]; a.q_norm = (const float*)d_in[11];
    a.k_norm = (const float*)d_in[12]; a.sinks = (const float*)d_in[13]; a.rel_bias = (const float*)d_in[14]; a.attn_wo = (const float*)d_in[15];
    a.w_out = (const float*)d_in[16]; a.ffn2_norm = (const float*)d_in[17]; a.ffn2_w_in = (const float*)d_in[18]; a.ffn2_w_out = (const float*)d_in[19];
}
static int g_grid = 0;
static bool launch_mega(Args& a, hipStream_t stream) {
    if (g_grid == 0) {
        int dev = 0, cus = 0, per_cu = 0;
        if (hipGetDevice(&dev) != hipSuccess || hipDeviceGetAttribute(&cus, hipDeviceAttributeMultiprocessorCount, dev) != hipSuccess) { g_grid = -1; return false; }
        if (hipFuncSetAttribute((const void*)mega_fwd, hipFuncAttributeMaxDynamicSharedMemorySize, LDS_BYTES) != hipSuccess) { fprintf(stderr, "hipFuncSetAttribute failed\n"); g_grid = -1; return false; }
        if (hipOccupancyMaxActiveBlocksPerMultiprocessor(&per_cu, (const void*)mega_fwd, NTHREADS, LDS_BYTES) != hipSuccess || per_cu < 1) { fprintf(stderr, "occupancy query: %d blocks per CU\n", per_cu); g_grid = -1; (void)hipGetLastError(); return false; }
        g_grid = cus;
    }
    if (g_grid < 0) return false;
    void* args[] = {&a};
    const hipError_t e = hipLaunchCooperativeKernel((const void*)mega_fwd, dim3(g_grid), dim3(NTHREADS), args, LDS_BYTES, stream);
    if (e != hipSuccess) { fprintf(stderr, "cooperative launch failed: %s (grid %d)\n", hipGetErrorString(e), g_grid); return false; }
    return true;
}
#if DEBUG_ORACLE
namespace nv {
constexpr int S = SEQ, B = NB;
constexpr float EPS = 1e-6f;
__device__ __forceinline__ float sigmoidf_(float v) { return 1.f / (1.f + expf(-v)); }
__device__ __forceinline__ float siluf_(float v) { return v / (1.f + expf(-v)); }
__device__ __forceinline__ float block_sum_256(float v, float* red) {
    for (int o = 32; o > 0; o >>= 1) v += __shfl_xor(v, o);
    const int w = threadIdx.x >> 6, l = threadIdx.x & 63;
    __syncthreads(); if (l == 0) red[w] = v; __syncthreads();
    return red[0] + red[1] + red[2] + red[3];
}
__global__ void rms_rows(const float* x, const float* g, float* out) {
    __shared__ float red[4];
    const size_t r = blockIdx.x;
    const float4 v = ((const float4*)(x + r * D))[threadIdx.x];
    const float ss = block_sum_256(v.x * v.x + v.y * v.y + v.z * v.z + v.w * v.w, red);
    const float rs = rsqrtf(ss * (1.f / D) + EPS);
    const float4 gg = ((const float4*)g)[threadIdx.x];
    float4 o; o.x = v.x * rs * gg.x; o.y = v.y * rs * gg.y; o.z = v.z * rs * gg.z; o.w = v.w * rs * gg.w;
    ((float4*)(out + r * D))[threadIdx.x] = o;
}
__global__ void gemm_f32(const float* __restrict__ A, int lda, const float* __restrict__ Bm, int ldb, float* __restrict__ C, int ldc, int K) {
    __shared__ float As[16][68];
    __shared__ float Bs[16][68];
    const int tx = threadIdx.x & 15, ty = threadIdx.x >> 4;
    const int m0 = blockIdx.y * 64, n0 = blockIdx.x * 64;
    float acc[4][4] = {};
    for (int k0 = 0; k0 < K; k0 += 16) {
        {
            const int r = threadIdx.x >> 2, kq = (threadIdx.x & 3) * 4;
            const float4 a = *(const float4*)(A + (size_t)(m0 + r) * lda + k0 + kq);
            As[kq + 0][r] = a.x; As[kq + 1][r] = a.y; As[kq + 2][r] = a.z; As[kq + 3][r] = a.w;
            const int kr = threadIdx.x >> 4, c4 = (threadIdx.x & 15) * 4;
            *(float4*)&Bs[kr][c4] = *(const float4*)(Bm + (size_t)(k0 + kr) * ldb + n0 + c4);
        }
        __syncthreads();
#pragma unroll
        for (int k = 0; k < 16; ++k) {
            const float4 a = *(const float4*)&As[k][ty * 4];
            const float4 b = *(const float4*)&Bs[k][tx * 4];
            const float av[4] = {a.x, a.y, a.z, a.w}, bv[4] = {b.x, b.y, b.z, b.w};
#pragma unroll
            for (int i = 0; i < 4; ++i)
#pragma unroll
                for (int j = 0; j < 4; ++j) acc[i][j] = fmaf(av[i], bv[j], acc[i][j]);
        }
        __syncthreads();
    }
#pragma unroll
    for (int i = 0; i < 4; ++i) { float4 o; o.x = acc[i][0]; o.y = acc[i][1]; o.z = acc[i][2]; o.w = acc[i][3]; *(float4*)(C + (size_t)(m0 + ty * 4 + i) * ldc + n0 + tx * 4) = o; }
}
__global__ void swiglu_k(const float* U, float* H, int rows) {
    const size_t i = (size_t)blockIdx.x * blockDim.x + threadIdx.x;
    if (i >= (size_t)rows * FF) return;
    const size_t t = i / FF; const int j = (int)(i % FF);
    H[i] = siluf_(U[t * (2 * FF) + j]) * U[t * (2 * FF) + FF + j];
}
__global__ void resid_k(const float* xin, const float* y, float scale, float* out, size_t n) {
    const size_t i = (size_t)blockIdx.x * blockDim.x + threadIdx.x;
    if (i < n) out[i] = xin[i] + scale * y[i];
}
__global__ void glu_k(const float* P, float* z, int rows) {
    const size_t i = (size_t)blockIdx.x * blockDim.x + threadIdx.x;
    if (i >= (size_t)rows * D) return;
    const size_t t = i / D; const int c = (int)(i % D);
    z[i] = P[t * INW + c] * sigmoidf_(P[t * INW + D + c]);
}
__global__ void conv_k(const float* z, const float* w, const float* bias, float* y) {
    const size_t i = (size_t)blockIdx.x * blockDim.x + threadIdx.x;
    if (i >= (size_t)S * D) return;
    const int t = (int)(i / D), c = (int)(i % D);
    float acc = bias[c];
    for (int k = 0; k < CWID; ++k) { const int tt = t - (CWID - 1) + k; if (tt >= 0) acc = fmaf(w[k * D + c], z[(size_t)tt * D + c], acc); }
    y[i] = acc;
}
__global__ void ln_silu_k(const float* y, const float* g, const float* b, float* out) {
    __shared__ float red[4];
    const size_t r = blockIdx.x;
    const float4 v = ((const float4*)(y + r * D))[threadIdx.x];
    const float mu = block_sum_256(v.x + v.y + v.z + v.w, red) * (1.f / D);
    const float dx = v.x - mu, dy = v.y - mu, dz = v.z - mu, dw = v.w - mu;
    const float var = block_sum_256(dx * dx + dy * dy + dz * dz + dw * dw, red) * (1.f / D);
    const float rs = rsqrtf(var + EPS);
    const float4 gg = ((const float4*)g)[threadIdx.x], bb = ((const float4*)b)[threadIdx.x];
    float4 o; o.x = siluf_(dx * rs * gg.x + bb.x); o.y = siluf_(dy * rs * gg.y + bb.y); o.z = siluf_(dz * rs * gg.z + bb.z); o.w = siluf_(dw * rs * gg.w + bb.w);
    ((float4*)(out + r * D))[threadIdx.x] = o;
}
__global__ void qknorm_k(const float* P, const float* qg, const float* kg, float* qn, float* kn) {
    const int wv = (blockIdx.x * 4) + (threadIdx.x >> 6), lane = threadIdx.x & 63;
    const int t = wv / (HQ + HKV), hh = wv % (HQ + HKV);
    if (t >= S) return;
    const bool isq = hh < HQ;
    const int h = isq ? hh : hh - HQ;
    const float v = P[(size_t)t * INW + (isq ? 2 * D + h * HD : 3 * D + h * HD) + lane];
    float ss = v * v;
    for (int o = 32; o > 0; o >>= 1) ss += __shfl_xor(ss, o);
    const float rs = rsqrtf(ss * (1.f / HD) + EPS);
    if (isq) qn[(size_t)t * (HQ * HD) + h * HD + lane] = v * rs * qg[lane];
    else     kn[(size_t)t * (HKV * HD) + h * HD + lane] = v * rs * kg[lane];
}
__global__ void attn_k(const float* qn, const float* kn, const float* P, const float* sinks, const float* rel_bias, float* o) {
    const int wv = (blockIdx.x * 4) + (threadIdx.x >> 6), lane = threadIdx.x & 63;
    const int t = wv / HQ, h = wv % HQ, hk = h / (HQ / HKV);
    if (t >= S) return;
    const float* q = qn + (size_t)t * (HQ * HD) + h * HD;
    float s[2];
#pragma unroll
    for (int u = 0; u < 2; ++u) {
        const int dist = lane + 64 * u, key = t - dist;
        float acc = -3.0e38f;
        if (key >= 0) {
            const float* kr = kn + (size_t)key * (HKV * HD) + hk * HD;
            float d = 0.f;
            for (int e = 0; e < HD; ++e) d = fmaf(q[e], kr[e], d);
            acc = d * 0.125f + rel_bias[T5B[dist] * HQ + h];
        }
        s[u] = acc;
    }
    const float sink = sinks[h];
    float m = fmaxf(fmaxf(s[0], s[1]), sink);
    for (int of = 32; of > 0; of >>= 1) m = fmaxf(m, __shfl_xor(m, of));
    float p0 = (t - lane >= 0) ? expf(s[0] - m) : 0.f, p1 = (t - lane - 64 >= 0) ? expf(s[1] - m) : 0.f;
    float l = p0 + p1;
    for (int of = 32; of > 0; of >>= 1) l += __shfl_xor(l, of);
    l += expf(sink - m);
    const float inv = 1.f / l;
    float acc = 0.f;
    for (int j = 0; j < 64; ++j) {
        const float pj0 = __shfl(p0, j), pj1 = __shfl(p1, j);
        const int k0 = t - j, k1 = t - j - 64;
        if (k0 >= 0) acc = fmaf(pj0, P[(size_t)k0 * INW + 3 * D + HKV * HD + hk * HD + lane], acc);
        if (k1 >= 0) acc = fmaf(pj1, P[(size_t)k1 * INW + 3 * D + HKV * HD + hk * HD + lane], acc);
    }
    o[(size_t)t * (HQ * HD) + h * HD + lane] = acc * inv;
}
__global__ void merge_k(const float* P, const float* a, const float* b, float* mg, int rows) {
    const size_t i = (size_t)blockIdx.x * blockDim.x + threadIdx.x;
    if (i >= (size_t)rows * D) return;
    const size_t t = i / D; const int c = (int)(i % D);
    mg[i] = sigmoidf_(P[t * INW + 3584 + c]) * a[i] + sigmoidf_(P[t * INW + 4608 + c]) * b[i];
}
static void gemm(const float* A, int lda, const float* Bm, int ldb, float* C, int ldc, int M, int N, int K, hipStream_t st) {
    hipLaunchKernelGGL(gemm_f32, dim3(N / 64, M / 64), dim3(256), 0, st, A, lda, Bm, ldb, C, ldc, K);
}
__global__ void cmp_k(const void* a, int a_is_bf16, int lda, float ascale, const float* ref, int ldr, int sig, int rows, int cols, unsigned* slot, int blk) {
    const size_t i = (size_t)blockIdx.x * blockDim.x + threadIdx.x;
    float d = 0.f, r2 = 0.f;
    if (i < (size_t)rows * cols) {
        const size_t t = i / cols; const int c = (int)(i % cols);
        const size_t ai_ = blk ? (((t >> 4) * (size_t)(blk >> 5) + (c >> 5)) * 512 + (t & 15) * 32 + (c & 31)) : t * lda + c;
        float av = a_is_bf16 ? __uint_as_float((unsigned)((const unsigned short*)a)[ai_] << 16) : ((const float*)a)[ai_];
        float rv = ref[t * ldr + c]; if (sig) rv = sigmoidf_(rv);
        d = fabsf(av * ascale - rv); if (!(d == d)) d = 1e30f; r2 = rv * rv;
    }
    float d2 = d * d;
    for (int o = 32; o > 0; o >>= 1) { d = fmaxf(d, __shfl_xor(d, o)); r2 += __shfl_xor(r2, o); d2 += __shfl_xor(d2, o); }
    if ((threadIdx.x & 63) == 0) { atomicMax(slot, __float_as_uint(d)); atomicAdd((float*)(slot + 1), r2); atomicAdd((float*)(slot + 2), d2); }
}
constexpr int NCHK = 16;
struct Counts { float c[NCHK]; };
__global__ void decide_k(unsigned* slots, Counts cnt, float tol, float* code_out) {
    if (threadIdx.x != 0 || blockIdx.x != 0) return;
    float code = 0.f;
    for (int k = 0; k < NCHK; ++k) {
        if (cnt.c[k] <= 0.f) continue;
        const float md = __uint_as_float(slots[4 * k]), rr = __uint_as_float(slots[4 * k + 1]), dd = __uint_as_float(slots[4 * k + 2]);
        const float rms = sqrtf(rr / cnt.c[k]), rmsr = sqrtf(dd / fmaxf(rr, 1e-30f));
        if (!(rmsr <= tol) || !(md <= 0.5f * rms)) { code = (float)(k + 1) + (rmsr < 0.03f ? 0.f : rmsr < 0.3f ? 0.3f : 0.6f); break; }
    }
    *code_out = code;
}
__global__ void finish_k(float* out, const float* mega_out, size_t dbg_off, size_t dbg_n, size_t n, const float* code) {
    const size_t i = (size_t)blockIdx.x * blockDim.x + threadIdx.x;
    if (i >= n) return;
    const float c = *code;
    float v = out[i];
    if (c == 0.f && i >= dbg_off && i < dbg_off + dbg_n) v = mega_out[i - dbg_off];
    out[i] = v * (1.f + c);
}
}
#ifndef DBG_B
#define DBG_B 5
#endif
#ifndef DBG_TOL
#define DBG_TOL 0.01f
#endif
#endif

extern "C" void kernel_launch(void* const* d_in, const int* in_sizes, int n_in, void* d_out, int out_size, void* d_ws, size_t ws_size, hipStream_t stream) {
    (void)in_sizes; (void)n_in; (void)out_size; (void)ws_size;
#if !DEBUG_ORACLE
    Args a{};
    set_inputs(a, d_in);
    a.out = (float*)d_out; a.x1 = nullptr; a.x2 = nullptr;
    ws_map(a, (unsigned char*)d_ws, M_FULL, true);
    a.M = M_FULL;
#if (DUP_MASK & 4)
    a.o = (bf16*)d_out;
#endif
    if (hipMemsetAsync(a.ctl, 0, CTL_ZERO_BYTES, stream) != hipSuccess) return;
    launch_mega(a, stream);
#else
    using namespace nv;
    unsigned char* wsb = (unsigned char*)d_ws;
    Args a{};
    set_inputs(a, d_in);
    a.x += (size_t)DBG_B * S * D;
    size_t used = ws_map(a, wsb, S, false);
    auto takeb = [&](size_t bytes) { unsigned char* p = wsb + used; used += (bytes + 255) & ~(size_t)255; return p; };
    a.x1 = (float*)takeb((size_t)S * D * 4); a.x2 = (float*)takeb((size_t)S * D * 4); a.out = (float*)takeb((size_t)S * D * 4);
    a.H2 = (bf16*)takeb((size_t)S * FF * 2);
    a.M = S;
    unsigned* slots = (unsigned*)takeb(256); float* code = (float*)takeb(256);
    Counts hc{};
    const float* x = (const float*)d_in[0];
    float* out = (float*)d_out;
    float* xn = (float*)takeb((size_t)S * D * 4); float* U = (float*)takeb((size_t)S * INW * 4); float* Hh = (float*)takeb((size_t)S * FF * 4); float* Y = (float*)takeb((size_t)S * D * 4);
    float* z = (float*)takeb((size_t)S * D * 4); float* cy = xn; float* cv = (float*)takeb((size_t)S * D * 4); float* qn = (float*)takeb((size_t)S * D * 4);
    float* kn = (float*)takeb((size_t)S * 256 * 4); float* ao = (float*)takeb((size_t)S * D * 4); float* av = (float*)takeb((size_t)S * D * 4); float* bv = (float*)takeb((size_t)S * D * 4);
    float* mg = (float*)takeb((size_t)S * D * 4);
    if (used > ws_size) { fprintf(stderr, "debug build needs %zu bytes of workspace, have %zu\n", used, ws_size); return; }
    hipMemsetAsync(slots, 0, 256, stream);
    hipMemsetAsync(a.ctl, 0, CTL_ZERO_BYTES, stream);
    launch_mega(a, stream);
    const int EB = 256; const size_t n1 = (size_t)S * D;
    int nchk = 0;
    auto chk = [&](const void* ap, int isbf, int lda, float asc, const float* ref, int ldr, int sig, int rows, int cols, int blk = 0) {
        const size_t n = (size_t)rows * cols;
        hipLaunchKernelGGL(cmp_k, dim3((unsigned)((n + 255) / 256)), dim3(256), 0, stream, ap, isbf, lda, asc, ref, ldr, sig, rows, cols, slots + 4 * nchk, BLOCKED_ACT ? blk : 0);
        hc.c[nchk] = (float)n; ++nchk;
    };
    for (int bi = 0; bi < B; ++bi) {
        const int b = (bi == B - 1) ? DBG_B : (bi >= DBG_B ? bi + 1 : bi);
        const bool dbg = (b == DBG_B);
        const float* xbp = x + (size_t)b * S * D; float* ob = out + (size_t)b * S * D;
        hipLaunchKernelGGL(rms_rows, dim3(S), dim3(256), 0, stream, xbp, a.ffn1_norm, xn);
        gemm(xn, D, a.ffn1_w_in, 2 * FF, U, 2 * FF, S, 2 * FF, D, stream);
        hipLaunchKernelGGL(swiglu_k, dim3((unsigned)(((size_t)S * FF + EB - 1) / EB)), dim3(EB), 0, stream, U, Hh, S);
        if (dbg) chk(a.H, 1, FF, 1.f, Hh, FF, 0, S, FF, FF);
        gemm(Hh, FF, a.ffn1_w_out, D, Y, D, S, D, FF, stream);
        hipLaunchKernelGGL(resid_k, dim3((unsigned)((n1 + EB - 1) / EB)), dim3(EB), 0, stream, xbp, Y, 0.5f, ob, n1);
        if (dbg) chk(a.x1, 0, D, 1.f, ob, D, 0, S, D);
        hipLaunchKernelGGL(rms_rows, dim3(S), dim3(256), 0, stream, ob, a.mix_norm, xn);
        gemm(xn, D, a.w_in, INW, U, INW, S, INW, D, stream);
        hipLaunchKernelGGL(glu_k, dim3((unsigned)((n1 + EB - 1) / EB)), dim3(EB), 0, stream, U, z, S);
        if (dbg) chk(a.z, 1, D, 1.f, z, D, 0, S, D);
        hipLaunchKernelGGL(qknorm_k, dim3(S * (HQ + HKV) / 4), dim3(256), 0, stream, U, a.q_norm, a.k_norm, qn, kn);
        if (dbg) { chk(a.q, 1, D, 1.f / (0.125f * 1.4426950408889634f), qn, D, 0, S, D);
                   chk(a.k, 1, 256, 1.f, kn, 256, 0, S, 256);
                   chk(a.v, 1, 256, 1.f, U + 3328, INW, 0, S, 256);
                   chk(a.ga, 1, D, 1.f, U + 4608, INW, 1, S, D, D);
                   chk(a.ga, 1, D, 1.f, U + 4608, INW, 1, S, D, D); }
        hipLaunchKernelGGL(conv_k, dim3((unsigned)((n1 + EB - 1) / EB)), dim3(EB), 0, stream, z, a.conv_w, a.conv_b, cy);
        hipLaunchKernelGGL(ln_silu_k, dim3(S), dim3(256), 0, stream, cy, a.ln_g, a.ln_b, cv);
        if (dbg) chk(a.c, 1, D, 1.f, cv, D, 0, S, D);
        gemm(cv, D, a.conv_proj, D, av, D, S, D, D, stream);
        hipLaunchKernelGGL(attn_k, dim3(S * HQ / 4), dim3(256), 0, stream, qn, kn, U, a.sinks, a.rel_bias, ao);
        if (dbg) chk(a.o, 1, D, 1.f, ao, D, 0, S, D);
        gemm(ao, D, a.attn_wo, D, bv, D, S, D, D, stream);
        hipLaunchKernelGGL(merge_k, dim3((unsigned)((n1 + EB - 1) / EB)), dim3(EB), 0, stream, U, av, bv, mg, S);
        if (dbg) chk(a.mg, 1, D, 1.f, mg, D, 0, S, D, D);
        gemm(mg, D, a.w_out, D, Y, D, S, D, D, stream);
        hipLaunchKernelGGL(resid_k, dim3((unsigned)((n1 + EB - 1) / EB)), dim3(EB), 0, stream, ob, Y, 1.0f, ob, n1);
        if (dbg) chk(a.x2, 0, D, 1.f, ob, D, 0, S, D);
        hipLaunchKernelGGL(rms_rows, dim3(S), dim3(256), 0, stream, ob, a.ffn2_norm, xn);
        gemm(xn, D, a.ffn2_w_in, 2 * FF, U, 2 * FF, S, 2 * FF, D, stream);
        hipLaunchKernelGGL(swiglu_k, dim3((unsigned)(((size_t)S * FF + EB - 1) / EB)), dim3(EB), 0, stream, U, Hh, S);
        if (dbg) chk(a.H2, 1, FF, 1.f, Hh, FF, 0, S, FF, FF);
        gemm(Hh, FF, a.ffn2_w_out, D, Y, D, S, D, FF, stream);
        hipLaunchKernelGGL(resid_k, dim3((unsigned)((n1 + EB - 1) / EB)), dim3(EB), 0, stream, ob, Y, 0.5f, ob, n1);
        if (dbg) chk(a.out, 0, D, 1.f, ob, D, 0, S, D);
    }
    hipLaunchKernelGGL(decide_k, dim3(1), dim3(64), 0, stream, slots, hc, DBG_TOL, code);
    const size_t nall = (size_t)B * S * D;
    hipLaunchKernelGGL(finish_k, dim3((unsigned)((nall + 255) / 256)), dim3(256), 0, stream, out, a.out, (size_t)DBG_B * S * D, (size_t)S * D, nall, code);
#endif
}
```

```cpp
#include <hip/hip_runtime.h>
#include <cstdio>
#include <cstdint>
#ifndef GEMM_DESYNC
#define GEMM_DESYNC 0
#endif
#ifndef DEBUG_ORACLE
#define DEBUG_ORACLE 0
#endif
namespace pg8 {
#define PG8_LAS __attribute__((address_space(3)))
typedef unsigned short bf16_t;
typedef short bf16x8 __attribute__((ext_vector_type(8)));
typedef float f32x4 __attribute__((ext_vector_type(4)));
typedef unsigned u32x4 __attribute__((ext_vector_type(4)));
constexpr int BM = 256, BK = 64, HALF = 128, HTB = HALF * BK * 2  , STAGE_BYTES = 8 * HTB, NXCD = 8, WGM = 8;

__host__ __device__ __forceinline__ int lds_byte(int r, int c) { const int st = (r >> 4) * 2 + (c >> 5), rr = r & 15, cc = c & 31, ob = rr * 64 + cc * 2; return st * 1024 + (ob ^ (((ob >> 9) & 1) << 5)); }
__host__ __device__ __forceinline__ void stage_rc(int b, int& R, int& C) { const int st = b / 1024, sb = b % 1024, swz = sb ^ (((sb >> 9) & 1) << 5); R = (st >> 1) * 16 + swz / 64; C = (st & 1) * 32 + (swz % 64) / 2; }
__host__ __device__ __forceinline__ int perm32(int rho) { const int n = rho >> 4, i = rho & 15; return 8 * (i >> 2) + 4 * n + (i & 3); }

__device__ __forceinline__ int fresh_lane_id() { int l; asm volatile("v_mbcnt_lo_u32_b32 %0, -1, 0\n\tv_mbcnt_hi_u32_b32 %0, -1, %0" : "=v"(l)); return l; }
struct Unit { int pm, pn; };
struct Gemm { const bf16_t* A; const bf16_t* Bt; int M, N, K; const bf16_t* A2; const bf16_t* Bt2; };

struct StaticOrder {
    int nM, nN, nwg, G, c, rev;
    __host__ __device__ void init(int M, int N, int G_, int c_, int rev_ = 0) { nM = M / BM; nN = N / BM; nwg = nM * nN; G = G_; c = c_; rev = rev_; }
    __host__ __device__ bool next(int i, Unit& u) const {
        const int nr = nwg / G; if (rev == 2) { if (i >= 2 * nr) return false; i %= nr; }
        const int ii = (rev == 1 && nwg % G == 0 && i < nr) ? nr - 1 - i : i;
        const long L = (long)ii * G + c; if (L >= nwg) return false;
        int wgid = (int)L; { const int q = nwg / NXCD, r = nwg % NXCD, xcd = wgid % NXCD, off = wgid / NXCD; wgid = (xcd < r ? xcd * (q + 1) : r * (q + 1) + (xcd - r) * q) + off; }
        const int nig = WGM * nN, gid = wgid / nig, fm = gid * WGM, gsz = (nM - fm) < WGM ? (nM - fm) : WGM;
        u.pm = fm + ((wgid % nig) % gsz); u.pn = (wgid % nig) / gsz; if (rev == 3) { u.pm = 0; u.pn = 0; }
        return true;
    }
    __device__ __forceinline__ void a_ready(const Unit&) const {}
    __device__ __forceinline__ void done(const Unit&) const {}
};

constexpr float RMS_EPS = 1e-6f;
constexpr float LOG2E = 1.4426950408889634f;
typedef float f32x2 __attribute__((ext_vector_type(2)));
typedef __bf16 bf16x2_t __attribute__((ext_vector_type(2)));
__device__ __forceinline__ unsigned cvt_pk_bf16(float lo, float hi) { f32x2 v = {lo, hi}; bf16x2_t b = __builtin_convertvector(v, bf16x2_t); return __builtin_bit_cast(unsigned, b); }
__device__ __forceinline__ u32x4 pack8(const f32x4 a, const f32x4 b) { u32x4 w; w.x = cvt_pk_bf16(a[0], a[1]); w.y = cvt_pk_bf16(a[2], a[3]); w.z = cvt_pk_bf16(b[0], b[1]); w.w = cvt_pk_bf16(b[2], b[3]); return w; }
__device__ __forceinline__ void unpack8(const u32x4 w, f32x4& a, f32x4& b) {
    a[0] = __uint_as_float(w.x << 16); a[1] = __uint_as_float(w.x & 0xffff0000u); a[2] = __uint_as_float(w.y << 16); a[3] = __uint_as_float(w.y & 0xffff0000u);
    b[0] = __uint_as_float(w.z << 16); b[1] = __uint_as_float(w.z & 0xffff0000u); b[2] = __uint_as_float(w.w << 16); b[3] = __uint_as_float(w.w & 0xffff0000u); }
__device__ __forceinline__ float fast_sigmoid(float v) { return __builtin_amdgcn_rcpf(1.0f + __builtin_amdgcn_exp2f(-LOG2E * v)); }
__device__ __forceinline__ f32x4 sigmoid4(const f32x4 v) { f32x4 o; o[0] = fast_sigmoid(v[0]); o[1] = fast_sigmoid(v[1]); o[2] = fast_sigmoid(v[2]); o[3] = fast_sigmoid(v[3]); return o; }
#ifndef NT_STORE_ALL
#define NT_STORE_ALL 0
#endif
__device__ __forceinline__ void st16_sc1(void* p, u32x4 v) { asm volatile("global_store_dwordx4 %0, %1, off sc1\n\ts_nop 1" :: "v"(p), "v"(v) : "memory"); }
#if NT_STORE_ALL == 2
#define EPI_ST16(ptr, val) st16_sc1((void*)(ptr), (val))
#define EPI_ST16F(ptr, val) st16_sc1((void*)(ptr), __builtin_bit_cast(u32x4, (val)))
#elif NT_STORE_ALL
#define EPI_ST16(ptr, val) __builtin_nontemporal_store((val), (u32x4*)(ptr))
#define EPI_ST16F(ptr, val) __builtin_nontemporal_store((val), (f32x4*)(ptr))
#else
#define EPI_ST16(ptr, val) (*(u32x4*)(ptr) = (val))
#ifndef NT_STORE_OUT
#define NT_STORE_OUT 1
#endif
#if NT_STORE_OUT
#define EPI_ST16F(ptr, val) __builtin_nontemporal_store((val), (f32x4*)(ptr))
#else
#define EPI_ST16F(ptr, val) (*(f32x4*)(ptr) = (val))
#endif
#endif
#ifndef NT_LOAD_EPI
#define NT_LOAD_EPI 0
#endif
#if NT_LOAD_EPI
#define EPI_LD16(ptr) __builtin_nontemporal_load((const u32x4*)(ptr))
#else
#define EPI_LD16(ptr) (*(const u32x4*)(ptr))
#endif
#ifndef NT_STORE_H
#define NT_STORE_H 0
#endif
#ifndef BLOCKED_ACT
#define BLOCKED_ACT 0
#endif
__device__ __forceinline__ size_t blk_off(int row, int col, int K) { return BLOCKED_ACT ? ((size_t)(row >> 4) * (K >> 5) + (col >> 5)) * 512 + (row & 15) * 32 + (col & 31) : (size_t)row * K + col; }
#ifndef BLOCKED_H
#define BLOCKED_H 1
#endif
__device__ __forceinline__ size_t blk_off_h(int row, int col, int K) { return (BLOCKED_ACT || BLOCKED_H) ? ((size_t)(row >> 4) * (K >> 5) + (col >> 5)) * 512 + (row & 15) * 32 + (col & 31) : (size_t)row * K + col; }
constexpr int BJ_STEP = BLOCKED_ACT ? (HALF / 32) * 512 : HALF;
__device__ __forceinline__ float dot4(const f32x4 v) { return (v[0] * v[0] + v[1] * v[1]) + (v[2] * v[2] + v[3] * v[3]); }

struct EpiSwiglu {
    static constexpr bool PERM = true, AFTER_DRAIN = false; static constexpr int VMOPS = 12;
    bf16_t* H; int ldh; const float* ssq;
    __device__ __forceinline__ void operator()(const f32x4 (&acc)[2][2][4][2], const Unit& u, int wr, int wc, int fr, int fq) const {
        const int row0 = u.pm * BM + wr * 64 + fr, col0 = u.pn * HALF + wc * 32 + 8 * fq;
        float rs[2][4];
#pragma unroll
        for (int ai = 0; ai < 2; ++ai)
#pragma unroll
            for (int m = 0; m < 4; ++m) rs[ai][m] = ssq[row0 + ai * HALF + m * 16];
#pragma unroll
        for (int ai = 0; ai < 2; ++ai)
#pragma unroll
            for (int m = 0; m < 4; ++m) {
                const float r = __builtin_amdgcn_rsqf(rs[ai][m] * (1.0f / 1024.0f) + RMS_EPS), c1 = -LOG2E * r, r2 = r * r;
                f32x4 h[2];
#pragma unroll
                for (int n = 0; n < 2; ++n) {
#pragma unroll
                    for (int j = 0; j < 4; ++j) { const float a = acc[ai][0][m][n][j], b = acc[ai][1][m][n][j]; h[n][j] = (a * b) * (r2 * __builtin_amdgcn_rcpf(1.0f + __builtin_amdgcn_exp2f(a * c1))); } }
#if NT_STORE_H == 2
                st16_sc1((void*)(H + blk_off_h(row0 + ai * HALF + m * 16, col0, ldh)), pack8(h[0], h[1]));
#elif NT_STORE_H
                __builtin_nontemporal_store(pack8(h[0], h[1]), (u32x4*)(H + blk_off_h(row0 + ai * HALF + m * 16, col0, ldh)));
#else
                EPI_ST16(H + blk_off_h(row0 + ai * HALF + m * 16, col0, ldh), pack8(h[0], h[1]));
#endif
            }
    }
};

template <int MODE> struct EpiProbe {
    static constexpr bool PERM = true, AFTER_DRAIN = false; static constexpr int VMOPS = 0;
    bf16_t* H; int ldh; const float* ssq;
    __device__ __forceinline__ void operator()(const f32x4 (&acc)[2][2][4][2], const Unit& u, int wr, int wc, int fr, int fq) const {
        const int row0 = u.pm * BM + wr * 64 + fr, col0 = u.pn * HALF + wc * 32 + 8 * fq;
#pragma unroll
        for (int ai = 0; ai < 2; ++ai)
#pragma unroll
            for (int m = 0; m < 4; ++m) {
                if (MODE == 0) { asm volatile("" :: "v"(acc[ai][0][m][0]), "v"(acc[ai][0][m][1]), "v"(acc[ai][1][m][0]), "v"(acc[ai][1][m][1])); }
                else if (MODE == 2) { const float r = __builtin_amdgcn_rsqf(ssq[row0 + ai * HALF + m * 16] * (1.0f / 1024.0f) + RMS_EPS); f32x4 h[2];
                    _Pragma("unroll") for (int n = 0; n < 2; ++n) { const f32x4 a = acc[ai][0][m][n] * r, b = acc[ai][1][m][n] * r; h[n] = a * sigmoid4(a) * b; }
                    const u32x4 pk = pack8(h[0], h[1]); asm volatile("" :: "v"(pk)); }
                else { EPI_ST16(H + (size_t)(row0 + ai * HALF + m * 16) * ldh + col0, pack8(acc[ai][0][m][0] + acc[ai][1][m][0], acc[ai][0][m][1] + acc[ai][1][m][1])); }
            }
    }
};

#ifndef RESID_BATCH
#define RESID_BATCH 1
#endif
#ifndef RES_NT
#define RES_NT 0
#endif
template <bool RES_F32, bool WANT_XB, bool HALF_SCALE> struct EpiResid {
    static constexpr bool PERM = true, AFTER_DRAIN = false; static constexpr int VMOPS = 16;
    const float* res32; const bf16_t* res16; float* out32; bf16_t* xb; float* ssq_out;
    __device__ __forceinline__ void operator()(const f32x4 (&acc)[2][2][4][2], const Unit& u, int wr, int wc, int fr, int fq) const {
        const int row0 = u.pm * BM + wr * 64 + fr, col0 = u.pn * BM + wc * 32 + 8 * fq;
        constexpr float scale = HALF_SCALE ? 0.5f : 1.0f;
#if RESID_BATCH
        if constexpr (!RES_F32) {
            u32x4 rr[2][4][2];
#pragma unroll
            for (int ai = 0; ai < 2; ++ai)
#pragma unroll
                for (int m = 0; m < 4; ++m) {
                    const size_t boff = blk_off(row0 + ai * HALF + m * 16, col0, 1024);
#pragma unroll
                    for (int bj = 0; bj < 2; ++bj) rr[ai][m][bj] = (!WANT_XB && RES_NT) ? __builtin_nontemporal_load((const u32x4*)(res16 + boff + bj * BJ_STEP)) : EPI_LD16(res16 + boff + bj * BJ_STEP);
                }
            float ssv[2][4];
#pragma unroll
            for (int ai = 0; ai < 2; ++ai)
#pragma unroll
                for (int m = 0; m < 4; ++m) {
                    const size_t off = (size_t)(row0 + ai * HALF + m * 16) * 1024 + col0, boff = blk_off(row0 + ai * HALF + m * 16, col0, 1024);
                    float ss = 0.f;
#pragma unroll
                    for (int bj = 0; bj < 2; ++bj) {
                        f32x4 r0, r1; unpack8(rr[ai][m][bj], r0, r1);
                        const f32x4 v0 = r0 + acc[ai][bj][m][0] * scale, v1 = r1 + acc[ai][bj][m][1] * scale;
                        if (out32) { EPI_ST16F(out32 + off + bj * HALF, v0); EPI_ST16F(out32 + off + bj * HALF + 4, v1); }
                        if (WANT_XB) { EPI_ST16(xb + boff + bj * BJ_STEP, pack8(v0, v1)); ss += dot4(v0) + dot4(v1); }
                    }
                    ssv[ai][m] = ss;
                }
            if (WANT_XB) {
                float t[2][4];
#pragma unroll
                for (int ai = 0; ai < 2; ++ai)
#pragma unroll
                    for (int m = 0; m < 4; ++m) t[ai][m] = __shfl_xor(ssv[ai][m], 16);
                __builtin_amdgcn_sched_barrier(0);
#pragma unroll
                for (int ai = 0; ai < 2; ++ai)
#pragma unroll
                    for (int m = 0; m < 4; ++m) ssv[ai][m] += t[ai][m];
#pragma unroll
                for (int ai = 0; ai < 2; ++ai)
#pragma unroll
                    for (int m = 0; m < 4; ++m) t[ai][m] = __shfl_xor(ssv[ai][m], 32);
                __builtin_amdgcn_sched_barrier(0);
#pragma unroll
                for (int ai = 0; ai < 2; ++ai)
#pragma unroll
                    for (int m = 0; m < 4; ++m) if (fq == 0) atomicAdd(ssq_out + row0 + ai * HALF + m * 16, ssv[ai][m] + t[ai][m]);
            }
            return;
        }
#endif
#pragma unroll
        for (int ai = 0; ai < 2; ++ai)
#pragma unroll
            for (int m = 0; m < 4; ++m) {
                const size_t off = (size_t)(row0 + ai * HALF + m * 16) * 1024 + col0, boff = blk_off(row0 + ai * HALF + m * 16, col0, 1024);
                float ss = 0.f;
#pragma unroll
                for (int bj = 0; bj < 2; ++bj) {
                    f32x4 r0, r1;
                    if (RES_F32) { r0 = *(const f32x4*)(res32 + off + bj * HALF); r1 = *(const f32x4*)(res32 + off + bj * HALF + 4); }
                    else unpack8((!WANT_XB && RES_NT) ? __builtin_nontemporal_load((const u32x4*)(res16 + boff + bj * BJ_STEP)) : EPI_LD16(res16 + boff + bj * BJ_STEP), r0, r1);
                    const f32x4 v0 = r0 + acc[ai][bj][m][0] * scale, v1 = r1 + acc[ai][bj][m][1] * scale;
                    if (out32) { EPI_ST16F(out32 + off + bj * HALF, v0); EPI_ST16F(out32 + off + bj * HALF + 4, v1); }
                    if (WANT_XB) { EPI_ST16(xb + boff + bj * BJ_STEP, pack8(v0, v1)); ss += dot4(v0) + dot4(v1); }
                }
                if (WANT_XB) { ss += __shfl_xor(ss, 16); ss += __shfl_xor(ss, 32); if (fq == 0) atomicAdd(ssq_out + row0 + ai * HALF + m * 16, ss); }
                if (m & 1) asm volatile("" ::: "memory");
            }
    }
};

#ifndef GATE_ST
#define GATE_ST 0
#endif
#ifndef MIX_SC1
#define MIX_SC1 0
#endif
#if MIX_SC1
#define MIX_ST16(ptr, val) st16_sc1((void*)(ptr), (val))
#else
#define MIX_ST16(ptr, val) EPI_ST16(ptr, val)
#endif
struct EpiMix {
    static constexpr bool PERM = true, AFTER_DRAIN = false; static constexpr int VMOPS = 12;
    const float* ssq; bf16_t *z, *q, *k, *v, *gc, *ga; const float *qg, *kg;
    __device__ __forceinline__ void operator()(const f32x4 (&acc)[2][2][4][2], const Unit& u, int wr, int wc, int fr, int fq) const {
        const int row0 = u.pm * BM + wr * 64 + fr, pn = u.pn;
        float rs[2][4];
#pragma unroll
        for (int ai = 0; ai < 2; ++ai)
#pragma unroll
            for (int m = 0; m < 4; ++m) rs[ai][m] = ssq[row0 + ai * HALF + m * 16];
#pragma unroll
        for (int ai = 0; ai < 2; ++ai)
#pragma unroll
            for (int m = 0; m < 4; ++m) rs[ai][m] = __builtin_amdgcn_rsqf(rs[ai][m] * (1.0f / 1024.0f) + RMS_EPS);
        if (pn < 8) {
            const int col0 = pn * HALF + wc * 32 + 8 * fq;
#pragma unroll
            for (int ai = 0; ai < 2; ++ai)
#pragma unroll
                for (int m = 0; m < 4; ++m) {
                    const float r = rs[ai][m]; f32x4 h[2];
#pragma unroll
                    for (int n = 0; n < 2; ++n) { const f32x4 a = acc[ai][0][m][n] * r, g = acc[ai][1][m][n] * r; h[n] = a * sigmoid4(g); }
                    MIX_ST16(z + (size_t)(row0 + ai * HALF + m * 16) * 1024 + col0, pack8(h[0], h[1]));
                }
        } else if (pn < 13) {
            const bool isq = pn < 12;
            const float* gp = isq ? qg : kg; const float gs = isq ? 0.125f * LOG2E : 1.0f;
            bf16_t* ob = isq ? q : k; const int ld = isq ? 1024 : 256, head = isq ? 4 * (pn - 8) + wc : wc;
            f32x4 gv[2][2];
#pragma unroll
            for (int bj = 0; bj < 2; ++bj)
#pragma unroll
                for (int n = 0; n < 2; ++n) gv[bj][n] = *(const f32x4*)(gp + 32 * bj + 8 * fq + 4 * n) * gs;
            float ssv[2][4], tt[2][4];
#pragma unroll
            for (int ai = 0; ai < 2; ++ai)
#pragma unroll
                for (int m = 0; m < 4; ++m) {
                    const float r = rs[ai][m]; float ss = 0.f;
#pragma unroll
                    for (int bj = 0; bj < 2; ++bj)
#pragma unroll
                        for (int n = 0; n < 2; ++n) { const f32x4 y = acc[ai][bj][m][n] * r; ss += dot4(y); }
                    ssv[ai][m] = ss;
                }
#pragma unroll
            for (int ai = 0; ai < 2; ++ai)
#pragma unroll
                for (int m = 0; m < 4; ++m) tt[ai][m] = __shfl_xor(ssv[ai][m], 16);
            __builtin_amdgcn_sched_barrier(0);
#pragma unroll
            for (int ai = 0; ai < 2; ++ai)
#pragma unroll
                for (int m = 0; m < 4; ++m) ssv[ai][m] += tt[ai][m];
#pragma unroll
            for (int ai = 0; ai < 2; ++ai)
#pragma unroll
                for (int m = 0; m < 4; ++m) tt[ai][m] = __shfl_xor(ssv[ai][m], 32);
            __builtin_amdgcn_sched_barrier(0);
#pragma unroll
            for (int ai = 0; ai < 2; ++ai)
#pragma unroll
                for (int m = 0; m < 4; ++m) {
                    const float rh = __builtin_amdgcn_rsqf((ssv[ai][m] + tt[ai][m]) * (1.0f / 64.0f) + RMS_EPS) * rs[ai][m];
                    bf16_t* rowp = ob + (size_t)(row0 + ai * HALF + m * 16) * ld + 64 * head + 8 * fq;
#pragma unroll
                    for (int bj = 0; bj < 2; ++bj) MIX_ST16(rowp + 32 * bj, pack8(acc[ai][bj][m][0] * rh * gv[bj][0], acc[ai][bj][m][1] * rh * gv[bj][1]));
                }
        } else if (pn == 13) {
            const int col0 = wc * 32 + 8 * fq;
#pragma unroll
            for (int ai = 0; ai < 2; ++ai)
#pragma unroll
                for (int m = 0; m < 4; ++m) {
                    const float r = rs[ai][m]; bf16_t* rowp = v + (size_t)(row0 + ai * HALF + m * 16) * 256 + col0;
#pragma unroll
                    for (int bj = 0; bj < 2; ++bj) MIX_ST16(rowp + bj * HALF, pack8(acc[ai][bj][m][0] * r, acc[ai][bj][m][1] * r));
                }
        } else {
            const int col0 = (pn - 14) * HALF + wc * 32 + 8 * fq;
#pragma unroll
            for (int ai = 0; ai < 2; ++ai)
#pragma unroll
                for (int m = 0; m < 4; ++m) {
                    const float r = rs[ai][m]; f32x4 rtv[2], sav[2];
#pragma unroll
                    for (int n = 0; n < 2; ++n) {
                        const f32x4 gc_ = acc[ai][0][m][n] * r, ga_ = acc[ai][1][m][n] * r;
#pragma unroll
                        for (int j = 0; j < 4; ++j) {
                            const float ec = __builtin_amdgcn_exp2f(-LOG2E * gc_[j]), ea = __builtin_amdgcn_exp2f(-LOG2E * ga_[j]);
                            sav[n][j] = __builtin_amdgcn_rcpf(1.0f + ea); rtv[n][j] = (1.0f + ea) * __builtin_amdgcn_rcpf(1.0f + ec);
                        }
                    }
                    const size_t off = blk_off(row0 + ai * HALF + m * 16, col0, 1024);
                    if (GATE_ST == 1) { __builtin_nontemporal_store(pack8(rtv[0], rtv[1]), (u32x4*)(gc + off)); __builtin_nontemporal_store(pack8(sav[0], sav[1]), (u32x4*)(ga + off)); }
                    else if (GATE_ST == 2) { st16_sc1((void*)(gc + off), pack8(rtv[0], rtv[1])); st16_sc1((void*)(ga + off), pack8(sav[0], sav[1])); }
                    else { MIX_ST16(gc + off, pack8(rtv[0], rtv[1])); MIX_ST16(ga + off, pack8(sav[0], sav[1])); }
                }
        }
    }
};

#ifndef GATE_NT
#define GATE_NT 1
#endif
#ifndef MERGE_BATCH
#define MERGE_BATCH 1
#endif
struct EpiMerge {
    static constexpr bool PERM = true, AFTER_DRAIN = false; static constexpr int VMOPS = 16;
    const bf16_t* rt; const bf16_t* sa; bf16_t* O;
    __device__ __forceinline__ void mid(f32x4 (&acc)[2][2][4][2], const Unit& u, int wr, int wc, int fr, int fq) const {
        const int row0 = u.pm * BM + wr * 64 + fr, col0 = u.pn * BM + wc * 32 + 8 * fq;
        u32x4 g[2][4][2];
#pragma unroll
        for (int ai = 0; ai < 2; ++ai)
#pragma unroll
            for (int m = 0; m < 4; ++m) {
                const size_t off = blk_off(row0 + ai * HALF + m * 16, col0, 1024);
#pragma unroll
                for (int bj = 0; bj < 2; ++bj) g[ai][m][bj] = GATE_NT ? __builtin_nontemporal_load((const u32x4*)(rt + off + bj * BJ_STEP)) : *(const u32x4*)(rt + off + bj * BJ_STEP);
            }
#pragma unroll
        for (int ai = 0; ai < 2; ++ai)
#pragma unroll
            for (int m = 0; m < 4; ++m)
#pragma unroll
                for (int bj = 0; bj < 2; ++bj) { f32x4 g0, g1; unpack8(g[ai][m][bj], g0, g1); acc[ai][bj][m][0] *= g0; acc[ai][bj][m][1] *= g1; }
    }
    __device__ __forceinline__ void operator()(const f32x4 (&acc)[2][2][4][2], const Unit& u, int wr, int wc, int fr, int fq) const {
        const int row0 = u.pm * BM + wr * 64 + fr, col0 = u.pn * BM + wc * 32 + 8 * fq;
#if MERGE_BATCH
        u32x4 g[2][4][2];
#pragma unroll
        for (int ai = 0; ai < 2; ++ai)
#pragma unroll
            for (int m = 0; m < 4; ++m) {
                const size_t off = blk_off(row0 + ai * HALF + m * 16, col0, 1024);
#pragma unroll
                for (int bj = 0; bj < 2; ++bj) g[ai][m][bj] = GATE_NT ? __builtin_nontemporal_load((const u32x4*)(sa + off + bj * BJ_STEP)) : *(const u32x4*)(sa + off + bj * BJ_STEP);
            }
#pragma unroll
        for (int ai = 0; ai < 2; ++ai)
#pragma unroll
            for (int m = 0; m < 4; ++m) {
                const size_t off = blk_off(row0 + ai * HALF + m * 16, col0, 1024);
#pragma unroll
                for (int bj = 0; bj < 2; ++bj) { f32x4 g0, g1; unpack8(g[ai][m][bj], g0, g1); EPI_ST16(O + off + bj * BJ_STEP, pack8(g0 * acc[ai][bj][m][0], g1 * acc[ai][bj][m][1])); }
            }
#else
#pragma unroll
        for (int ai = 0; ai < 2; ++ai)
#pragma unroll
            for (int m = 0; m < 4; ++m) {
                const size_t off = blk_off(row0 + ai * HALF + m * 16, col0, 1024);
#pragma unroll
                for (int bj = 0; bj < 2; ++bj) { f32x4 g0, g1; unpack8(GATE_NT ? __builtin_nontemporal_load((const u32x4*)(sa + off + bj * BJ_STEP)) : EPI_LD16(sa + off + bj * BJ_STEP), g0, g1); EPI_ST16(O + off + bj * BJ_STEP, pack8(g0 * acc[ai][bj][m][0], g1 * acc[ai][bj][m][1])); }
                if (m & 1) asm volatile("" ::: "memory");
            }
#endif
    }
};

template <class Epi, class Sched, bool ALIGN_EPI = false, bool SP2 = false, int NSEG = 1, bool A_BLK = false, int PROBE = 0  ,
          int A_AUX = 0  ,
          int PF = 0  ,
          bool BAL = false  >
__device__ __forceinline__ void gemm_phase(PG8_LAS unsigned char* lds, const Gemm g, const Sched S, const Epi E, const int wave_id  ) {
    int tid_ = wave_id * 64 + fresh_lane_id(); asm volatile("" : "+v"(tid_));
    const int tid = tid_, wid = __builtin_amdgcn_readfirstlane(tid >> 6), lane = tid & 63, wr = wid >> 2, wc = wid & 3, fr = lane & 15, fq = lane >> 4;
#ifndef GEMM_A_FIRST
#define GEMM_A_FIRST 1
#endif
    constexpr bool A_FIRST = (GEMM_A_FIRST != 0);
    const int K = g.K, mt = K / BK, nt = NSEG * mt;
    unsigned voffA[2], voffB[2];
#pragma unroll
    for (int i = 0; i < 2; ++i) { int R, C; stage_rc(tid * 16 + i * 8192, R, C); const int Rb = Epi::PERM ? ((R & ~31) + perm32(R & 31)) : R;
        voffA[i] = A_BLK ? (unsigned)(((R >> 4) * (K / 32) + (C >> 5)) * 1024 + (R & 15) * 64 + (C & 31) * 2) : (unsigned)(R * K + C) * 2u;
        voffB[i] = (unsigned)(Rb * K + C) * 2u; }
    const unsigned voffP = (unsigned)(((wid & 3) * 64 + lane) * K) * 2u;
    static_assert(PF == 0 || !A_BLK, "the prefetch addresses assume a row-major A");
    static_assert(!BAL || (SP2 && PF == 0 && PROBE == 0), "BAL: the SP2 schedule, no prefetch touches, no probes");
    const size_t kstep = (size_t)(BK * 2);
    const size_t kstepA = A_BLK ? (size_t)2048 : kstep;
    const size_t hstep = (size_t)HALF * K * 2;
    const size_t tstep = 2 * hstep;
    unsigned long long lo_ = (unsigned long long)g.A < (unsigned long long)g.Bt ? (unsigned long long)g.A : (unsigned long long)g.Bt;
    if constexpr (NSEG == 2) { if ((unsigned long long)g.A2 < lo_) lo_ = (unsigned long long)g.A2; if ((unsigned long long)g.Bt2 < lo_) lo_ = (unsigned long long)g.Bt2; }
    const __amdgpu_buffer_rsrc_t srd = __builtin_amdgcn_make_buffer_rsrc((void*)lo_, (short)0, 0x7fffffff, 0x00020000);
    const unsigned base_lo = (unsigned)lo_, lds_lo = (unsigned)(unsigned long long)lds;
    const unsigned ldsw = (unsigned)wid * 1024u;
    const int aoff = lds_byte(wr * 64 + fr, fq * 8), boff = lds_byte(wc * 32 + fr, fq * 8);
#define PG8_SA(b, h) (((b) * 2 + (h)) * HTB)
#define PG8_SB(b, h) ((4 + (b) * 2 + (h)) * HTB)
#ifndef GEMM_BUFDMA
#define GEMM_BUFDMA 0
#endif
#define PG8_BUFPIECE(ldsoff, gbase, vo) asm volatile("s_mov_b32 m0, %0\n\ts_nop 0\n\tbuffer_load_dwordx4 %1, %2, %3 offen lds" :: "s"(lds_lo + (unsigned)(ldsoff)), "v"(vo), "s"(srd), "s"((unsigned)(unsigned long long)(gbase) - base_lo) : "m0", "memory")
#define PG8_STAGE(bufoff, gbase, voff) do { if (PROBE == 0) _Pragma("unroll") for (int _i = 0; _i < 2; ++_i) { \
        if constexpr (GEMM_BUFDMA != 0) PG8_BUFPIECE((bufoff) + ldsw + _i * 8192, gbase, (voff)[_i]); \
        else __builtin_amdgcn_global_load_lds((const unsigned*)((const char*)(gbase) + (voff)[_i]), (PG8_LAS unsigned*)(lds + (bufoff) + ldsw + _i * 8192), 16, 0, 0); } } while (0)
#define PG8_STAGE_A(bufoff, gbase, voff) do { if (PROBE == 0) _Pragma("unroll") for (int _i = 0; _i < 2; ++_i) { \
        if constexpr (A_AUX == 2) __builtin_amdgcn_global_load_lds((const unsigned*)((const char*)(gbase) + (voff)[_i]), (PG8_LAS unsigned*)(lds + (bufoff) + ldsw + _i * 8192), 16, 0, 2); \
        else if constexpr (GEMM_BUFDMA != 0) PG8_BUFPIECE((bufoff) + ldsw + _i * 8192, gbase, (voff)[_i]); \
        else __builtin_amdgcn_global_load_lds((const unsigned*)((const char*)(gbase) + (voff)[_i]), (PG8_LAS unsigned*)(lds + (bufoff) + ldsw + _i * 8192), 16, 0, 0); } } while (0)
#define PG8_LDA(dst, b, h) do { if (PROBE != 1) _Pragma("unroll") for (int m = 0; m < 4; ++m) _Pragma("unroll") for (int k = 0; k < 2; ++k) dst[m][k] = *(const PG8_LAS bf16x8*)(lds + PG8_SA(b, h) + aoff + m * 2048 + k * 1024); } while (0)
#define PG8_LDB(dst, b, h) do { if (PROBE != 1) _Pragma("unroll") for (int n = 0; n < 2; ++n) _Pragma("unroll") for (int k = 0; k < 2; ++k) dst[n][k] = *(const PG8_LAS bf16x8*)(lds + PG8_SB(b, h) + boff + n * 2048 + k * 1024); } while (0)
#ifndef GEMM_MMA_ORDER
#define GEMM_MMA_ORDER 1
#endif
#define PG8_MMA(ai, bj, At, Bt) do { __builtin_amdgcn_s_setprio(1); \
        if constexpr (GEMM_MMA_ORDER == 0) { _Pragma("unroll") for (int m = 0; m < 4; ++m) _Pragma("unroll") for (int n = 0; n < 2; ++n) _Pragma("unroll") for (int k = 0; k < 2; ++k) \
            acc[ai][bj][m][n] = __builtin_amdgcn_mfma_f32_16x16x32_bf16(Bt[n][k], At[m][k], acc[ai][bj][m][n], 0, 0, 0); } \
        else { _Pragma("unroll") for (int k = 0; k < 2; ++k) _Pragma("unroll") for (int m = 0; m < 4; ++m) _Pragma("unroll") for (int n = 0; n < 2; ++n) \
            acc[ai][bj][m][n] = __builtin_amdgcn_mfma_f32_16x16x32_bf16(Bt[n][k], At[m][k], acc[ai][bj][m][n], 0, 0, 0); } \
        __builtin_amdgcn_s_setprio(0); } while (0)
#define PG8_WAIT_V(n) asm volatile("s_waitcnt vmcnt(" #n ")" ::: "memory")
#define PG8_WAIT_V8R(rel) asm volatile("s_cmp_lg_u32 %0, 0\n\ts_cbranch_scc1 .Lpg8r%=\n\ts_waitcnt vmcnt(8)\n\ts_branch .Lpg8e%=\n.Lpg8r%=:\n\ts_waitcnt vmcnt(%1)\n.Lpg8e%=:" :: "s"(__builtin_amdgcn_readfirstlane(rel)), "n"(8 + Epi::VMOPS) : "memory", "scc")
#define PG8_WAIT_L(n) asm volatile("s_waitcnt lgkmcnt(" #n ")" ::: "memory")
#define PG8_WAIT_VP(n) do { if (PROBE == 3) asm volatile("s_waitcnt vmcnt(24)" ::: "memory"); else if (PF != 0) asm volatile("s_waitcnt vmcnt(9)" ::: "memory"); else PG8_WAIT_V(n); } while (0)
#define PG8_PREFETCH(tau) do { if (PF != 0) { const int tau_ = (tau); const char* pa_; const char* pb_; \
        if (tau_ < nt) { const bool sg_ = (NSEG == 2) && (tau_ >= mt); pa_ = sg_ ? cA2 + (size_t)(tau_ - mt) * kstepA : cA + (size_t)tau_ * kstepA; pb_ = sg_ ? cB2 + (size_t)(tau_ - mt) * kstep : cB + (size_t)tau_ * kstep; } \
        else { pa_ = nA + (size_t)(tau_ - nt) * kstepA; pb_ = nB + (size_t)(tau_ - nt) * kstep; } \
        __builtin_amdgcn_global_load_lds((const unsigned*)((wid >= 4 ? pb_ : pa_) + voffP), (PG8_LAS unsigned*)(lds + STAGE_BYTES + 4096 + wid * 256), 4, 0, 0); } } while (0)
#ifndef GEMM_LATEW
#define GEMM_LATEW 0
#endif
#define PG8_WAIT_T(n) do { if (!GEMM_LATEW || wr == 1) PG8_WAIT_VP(n); } while (0)
#define PG8_WAIT_H(n) do { if (GEMM_LATEW && wr == 0) PG8_WAIT_VP(n); } while (0)
#define PG8_BAR __builtin_amdgcn_s_barrier()
#define PG8_SCHED __builtin_amdgcn_sched_barrier(0)
    Unit cur, nxt; int ui = 0;
    if (!S.next(0, cur)) return;
#if GEMM_DESYNC
    if (g.N > 2048) { const unsigned long long t0_ = __builtin_amdgcn_s_memrealtime(); const unsigned d_ = ((unsigned)S.c * 2654435761u >> 28) * GEMM_DESYNC;
      while (__builtin_amdgcn_s_memrealtime() - t0_ < d_) __builtin_amdgcn_s_sleep(1); }
#endif
    f32x4 acc[2][2][4][2];
#pragma unroll
    for (int a = 0; a < 2; ++a)
#pragma unroll
        for (int b = 0; b < 2; ++b)
#pragma unroll
            for (int m = 0; m < 4; ++m)
#pragma unroll
                for (int n = 0; n < 2; ++n) acc[a][b][m][n] = (f32x4){0.f, 0.f, 0.f, 0.f};
    bf16x8 At[4][2], B0[2][2], B1[2][2];
    if (PROBE == 1) { _Pragma("unroll") for (int i_ = 0; i_ < 4; ++i_) _Pragma("unroll") for (int k_ = 0; k_ < 2; ++k_) { _Pragma("unroll") for (int e_ = 0; e_ < 8; ++e_) At[i_][k_][e_] = (short)(0x3c00 + 37 * lane + 11 * e_ + i_); asm volatile("" : "+v"(At[i_][k_])); }
        _Pragma("unroll") for (int i_ = 0; i_ < 2; ++i_) _Pragma("unroll") for (int k_ = 0; k_ < 2; ++k_) { _Pragma("unroll") for (int e_ = 0; e_ < 8; ++e_) { B0[i_][k_][e_] = (short)(0x3d00 + 29 * lane + 7 * e_ + i_); B1[i_][k_][e_] = (short)(0xbd00 + 23 * lane + 5 * e_ + k_); } asm volatile("" : "+v"(B0[i_][k_]), "+v"(B1[i_][k_])); } }
    const char* cA = (const char*)g.A + (size_t)cur.pm * tstep; const char* cB = (const char*)g.Bt + (size_t)cur.pn * tstep;
    const char* cA2 = (NSEG == 2) ? (const char*)g.A2 + (size_t)cur.pm * tstep : cA; const char* cB2 = (NSEG == 2) ? (const char*)g.Bt2 + (size_t)cur.pn * tstep : cB;
    S.a_ready(cur);
    if constexpr (SP2) {
        PG8_STAGE(PG8_SB(0, 0), cB, voffB); PG8_STAGE(PG8_SB(0, 1), cB + hstep, voffB); PG8_STAGE_A(PG8_SA(0, 0), cA, voffA); PG8_STAGE_A(PG8_SA(0, 1), cA + hstep, voffA);
#ifndef GEMM_PRO_EARLY
#define GEMM_PRO_EARLY 0
#endif
        if constexpr (GEMM_PRO_EARLY && !BAL) {
            PG8_STAGE(PG8_SB(1, 0), cB + kstep, voffB); PG8_STAGE_A(PG8_SA(1, 0), cA + kstepA, voffA); PG8_STAGE(PG8_SB(1, 1), cB + hstep + kstep, voffB);
            if (wr == 1) PG8_BAR;
            PG8_WAIT_V(8); PG8_BAR;
            PG8_WAIT_V(6); PG8_BAR;
        } else {
        if (wr == 1) PG8_BAR;
        PG8_WAIT_V(2); PG8_BAR;
        if constexpr (BAL) { PG8_STAGE(PG8_SB(1, 0), cB + kstep, voffB); PG8_STAGE_A(PG8_SA(1, 0), cA + kstepA, voffA); PG8_WAIT_V(4); PG8_BAR; }
        else {
        PG8_STAGE(PG8_SB(1, 0), cB + kstep, voffB); PG8_STAGE_A(PG8_SA(1, 0), cA + kstepA, voffA); PG8_STAGE(PG8_SB(1, 1), cB + hstep + kstep, voffB);
        PG8_WAIT_V(6); PG8_BAR;
        }
        }
    } else {
        PG8_STAGE(PG8_SB(0, 0), cB, voffB); PG8_STAGE_A(PG8_SA(0, 0), cA, voffA); PG8_STAGE(PG8_SB(0, 1), cB + hstep, voffB); PG8_STAGE_A(PG8_SA(0, 1), cA + hstep, voffA);
        if (wr == 1) PG8_BAR;
        PG8_WAIT_V(4); PG8_BAR;
        PG8_STAGE(PG8_SB(1, 0), cB + kstep, voffB); PG8_STAGE_A(PG8_SA(1, 0), cA + kstepA, voffA); PG8_STAGE(PG8_SB(1, 1), cB + hstep + kstep, voffB);
        PG8_WAIT_V(6); PG8_BAR;
    }
    for (;;) {
        const bool has_next = S.next(ui + 1, nxt);
        const char* nA = has_next ? (const char*)g.A + (size_t)nxt.pm * tstep : cA; const char* nB = has_next ? (const char*)g.Bt + (size_t)nxt.pn * tstep : cB;
        const char* nA2 = (NSEG == 2 && has_next) ? (const char*)g.A2 + (size_t)nxt.pm * tstep : cA2; const char* nB2 = (NSEG == 2 && has_next) ? (const char*)g.Bt2 + (size_t)nxt.pn * tstep : cB2;
        for (int t = 0; t < nt; t += 2) {
            const bool last = (t == nt - 2);
            const int relax = ((t == 0) && (ui > 0) && (Epi::VMOPS > 0)) ? 1 : 0;
            if constexpr (NSEG == 2) { if (t == mt) E.mid(acc, cur, wr, wc, fr, fq); }
            const bool s1 = (NSEG == 2) && (t + 1 >= mt), s2 = (NSEG == 2) && (t + 2 >= mt);
            const char* a1 = s1 ? cA2 + (size_t)(t + 1 - mt) * kstepA : cA + (size_t)(t + 1) * kstepA;
            const char* a2 = last ? nA : (s2 ? cA2 + (size_t)(t + 2 - mt) * kstepA : cA + (size_t)(t + 2) * kstepA);
            const char* b2 = last ? nB : (s2 ? cB2 + (size_t)(t + 2 - mt) * kstep : cB + (size_t)(t + 2) * kstep);
            const char* a3 = a2 + kstepA; const char* b3 = b2 + kstep;
            if (last && has_next) S.a_ready(nxt);
            if constexpr (BAL) {
            const char* b1 = s1 ? cB2 + (size_t)(t + 1 - mt) * kstep : cB + (size_t)(t + 1) * kstep;
            PG8_LDB(B0, 0, 0); PG8_LDB(B1, 0, 1); PG8_SCHED; PG8_LDA(At, 0, 0); PG8_STAGE(PG8_SB(1, 1), b1 + hstep, voffB); PG8_STAGE_A(PG8_SA(1, 1), a1 + hstep, voffA);
            PG8_WAIT_V(8); PG8_WAIT_L(0); PG8_BAR; PG8_MMA(0, 0, At, B0); PG8_MMA(0, 1, At, B1); PG8_BAR; PG8_SCHED;
            PG8_LDA(At, 0, 1); PG8_STAGE(PG8_SB(0, 0), b2, voffB); PG8_STAGE_A(PG8_SA(0, 0), a2, voffA);
            PG8_WAIT_V(6); PG8_WAIT_L(0); PG8_BAR; PG8_MMA(1, 0, At, B0); PG8_MMA(1, 1, At, B1); PG8_BAR; PG8_SCHED;
            PG8_LDB(B0, 1, 0); PG8_LDB(B1, 1, 1); PG8_SCHED; PG8_LDA(At, 1, 0); PG8_STAGE(PG8_SB(0, 1), b2 + hstep, voffB); PG8_STAGE_A(PG8_SA(0, 1), a2 + hstep, voffA);
            PG8_WAIT_V(8); PG8_WAIT_L(0); PG8_BAR; PG8_MMA(0, 0, At, B0); PG8_MMA(0, 1, At, B1); PG8_BAR; PG8_SCHED;
            PG8_LDA(At, 1, 1); PG8_STAGE(PG8_SB(1, 0), b3, voffB); PG8_STAGE_A(PG8_SA(1, 0), a3, voffA);
            PG8_WAIT_V(6); PG8_WAIT_L(0); PG8_BAR; PG8_MMA(1, 0, At, B0); PG8_MMA(1, 1, At, B1); PG8_BAR; PG8_SCHED;
            } else if constexpr (SP2) {
            PG8_LDB(B0, 0, 0); PG8_LDB(B1, 0, 1); PG8_SCHED; PG8_LDA(At, 0, 0); PG8_STAGE_A(PG8_SA(1, 1), a1 + hstep, voffA);
            PG8_WAIT_T(8); PG8_WAIT_L(0); PG8_BAR; PG8_MMA(0, 0, At, B0); PG8_MMA(0, 1, At, B1); PG8_WAIT_H(8); PG8_BAR; PG8_SCHED;
            PG8_LDA(At, 0, 1); if constexpr (A_FIRST) PG8_STAGE_A(PG8_SA(0, 0), a2, voffA); PG8_STAGE(PG8_SB(0, 0), b2, voffB); PG8_STAGE(PG8_SB(0, 1), b2 + hstep, voffB); if constexpr (!A_FIRST) PG8_STAGE_A(PG8_SA(0, 0), a2, voffA); PG8_PREFETCH(t + PF);
            PG8_WAIT_T(8); PG8_WAIT_L(0); PG8_BAR; PG8_MMA(1, 0, At, B0); PG8_MMA(1, 1, At, B1); PG8_WAIT_H(8); PG8_BAR; PG8_SCHED;
            PG8_LDB(B0, 1, 0); PG8_LDB(B1, 1, 1); PG8_SCHED; PG8_LDA(At, 1, 0); PG8_STAGE_A(PG8_SA(0, 1), a2 + hstep, voffA);
            PG8_WAIT_T(8); PG8_WAIT_L(0); PG8_BAR; PG8_MMA(0, 0, At, B0); PG8_MMA(0, 1, At, B1); PG8_WAIT_H(8); PG8_BAR; PG8_SCHED;
            PG8_LDA(At, 1, 1); if constexpr (A_FIRST) PG8_STAGE_A(PG8_SA(1, 0), a3, voffA); PG8_STAGE(PG8_SB(1, 0), b3, voffB); PG8_STAGE(PG8_SB(1, 1), b3 + hstep, voffB); if constexpr (!A_FIRST) PG8_STAGE_A(PG8_SA(1, 0), a3, voffA); PG8_PREFETCH(t + 1 + PF);
            PG8_WAIT_T(8); PG8_WAIT_L(0); PG8_BAR; PG8_MMA(1, 0, At, B0); PG8_MMA(1, 1, At, B1); PG8_WAIT_H(8); PG8_BAR; PG8_SCHED;
            } else {
            PG8_LDB(B0, 0, 0); PG8_SCHED; PG8_LDA(At, 0, 0); PG8_STAGE_A(PG8_SA(1, 1), a1 + hstep, voffA);
            PG8_WAIT_L(8); PG8_BAR; PG8_WAIT_L(0); PG8_MMA(0, 0, At, B0); PG8_BAR; PG8_SCHED;
            PG8_LDB(B1, 0, 1); PG8_STAGE(PG8_SB(0, 0), b2, voffB);
            PG8_BAR; PG8_WAIT_L(0); PG8_MMA(0, 1, At, B1); PG8_BAR;
            PG8_LDA(At, 0, 1); PG8_STAGE_A(PG8_SA(0, 0), a2, voffA);
            PG8_BAR; PG8_WAIT_L(0); PG8_MMA(1, 0, At, B0); PG8_BAR; PG8_SCHED;
            PG8_STAGE(PG8_SB(0, 1), b2 + hstep, voffB);
            PG8_WAIT_V(6); PG8_BAR; PG8_MMA(1, 1, At, B1); PG8_BAR;
            PG8_LDB(B0, 1, 0); PG8_SCHED; PG8_LDA(At, 1, 0); PG8_STAGE_A(PG8_SA(0, 1), a2 + hstep, voffA);
            PG8_WAIT_L(8); PG8_BAR; PG8_WAIT_L(0); PG8_MMA(0, 0, At, B0); PG8_BAR; PG8_SCHED;
            PG8_LDB(B1, 1, 1); PG8_STAGE(PG8_SB(1, 0), b3, voffB);
            PG8_BAR; PG8_WAIT_L(0); PG8_MMA(0, 1, At, B1); PG8_BAR;
            PG8_LDA(At, 1, 1); PG8_STAGE_A(PG8_SA(1, 0), a3, voffA);
            PG8_BAR; PG8_WAIT_L(0); PG8_MMA(1, 0, At, B0); PG8_BAR; PG8_SCHED;
            PG8_STAGE(PG8_SB(1, 1), b3 + hstep, voffB);
            PG8_WAIT_V(6); PG8_BAR; PG8_MMA(1, 1, At, B1); PG8_BAR;
            }
        }
        if constexpr (ALIGN_EPI) { if (wr == 0) PG8_BAR; }
        if constexpr (!Epi::AFTER_DRAIN) { E(acc, cur, wr, wc, fr, fq); S.done(cur); }
        if (!has_next) break;
#pragma unroll
        for (int a = 0; a < 2; ++a)
#pragma unroll
            for (int b = 0; b < 2; ++b)
#pragma unroll
                for (int m = 0; m < 4; ++m)
#pragma unroll
                    for (int n = 0; n < 2; ++n) acc[a][b][m][n] = (f32x4){0.f, 0.f, 0.f, 0.f};
        cur = nxt; cA = nA; cB = nB; cA2 = nA2; cB2 = nB2; ++ui;
        if constexpr (ALIGN_EPI) { if (wr == 1) PG8_BAR; }
    }
    PG8_WAIT_V(0);
    if constexpr (!ALIGN_EPI) { if (wr == 0) PG8_BAR; }
    PG8_BAR;
    if constexpr (Epi::AFTER_DRAIN) { E.fused(acc, cur, wr, wc, fr, fq, lds, wid, lane); S.done(cur); }
#undef PG8_SA
#undef PG8_SB
#undef PG8_STAGE
#undef PG8_STAGE_A
#undef PG8_BUFPIECE
#undef PG8_LDA
#undef PG8_LDB
#undef PG8_MMA
#undef PG8_WAIT_V
#undef PG8_WAIT_V8R
#undef PG8_WAIT_L
#undef PG8_WAIT_VP
#undef PG8_WAIT_T
#undef PG8_WAIT_H
#undef PG8_PREFETCH
#undef PG8_BAR
#undef PG8_SCHED
}
}
constexpr int D = 1024, NB = 8, SEQ = 4096, FF = 2816, CWID = 31, HD = 64, HQ = 16, HKV = 4, INW = 5632;
constexpr int M_FULL = NB * SEQ;
constexpr int NWAVES = 8, NTHREADS = 512;
constexpr int LDS_BYTES = 147456;
constexpr int RING_BYTES = 131072;
constexpr size_t CTL_ZERO_BYTES = 16384;

#define LAS __attribute__((address_space(3)))
typedef unsigned short bf16;
typedef unsigned v4u __attribute__((ext_vector_type(4)));
typedef unsigned v2u __attribute__((ext_vector_type(2)));
typedef float f32x4 __attribute__((ext_vector_type(4)));
typedef float f32x2 __attribute__((ext_vector_type(2)));
typedef float f32x16 __attribute__((ext_vector_type(16)));
typedef short bf16x8 __attribute__((ext_vector_type(8)));
typedef short s16x4 __attribute__((ext_vector_type(4)));

__device__ const unsigned char T5B[128] = {0, 1, 2, 3, 4, 5, 6, 7, 8, 9, 10, 11, 12, 13, 14, 15, 16, 16, 16, 17, 17, 18, 18, 18, 19, 19, 19, 20, 20, 20, 20, 21, 21, 21, 21, 22, 22, 22, 22, 22, 23, 23, 23, 23, 23, 23, 24, 24, 24, 24, 24, 24, 25, 25, 25, 25, 25, 25, 25, 26, 26, 26, 26, 26, 26, 26, 26, 27, 27, 27, 27, 27, 27, 27, 27, 27, 27, 28, 28, 28, 28, 28, 28, 28, 28, 28, 28, 29, 29, 29, 29, 29, 29, 29, 29, 29, 29, 29, 29, 30, 30, 30, 30, 30, 30, 30, 30, 30, 30, 30, 30, 30, 30, 31, 31, 31, 31, 31, 31, 31, 31, 31, 31, 31, 31, 31, 31, 31};

struct Args {
    const float *x, *ffn1_norm, *ffn1_w_in, *ffn1_w_out, *mix_norm, *w_in, *conv_w, *conv_b, *ln_g, *ln_b, *conv_proj, *q_norm, *k_norm, *sinks, *rel_bias, *attn_wo, *w_out, *ffn2_norm, *ffn2_w_in, *ffn2_w_out;
    float *x1, *x2, *out;
    unsigned* ctl;
    float *ssq0, *ssq1, *ssq2;
    bf16 *W1i, *W1o, *Wmx, *Wcp, *Wao, *Wot, *W2i, *W2o;
    bf16 *xb, *H, *H2, *z, *q, *k, *v, *gc, *ga, *c, *o, *m1, *mg;
    int M; int pad;
};

#ifndef CA_NT
#define CA_NT 0
#endif
#ifndef P0_NT
#define P0_NT 1
#endif
__device__ __forceinline__ unsigned f2bf(float f) { unsigned u = __builtin_bit_cast(unsigned, f); return (u + 0x7fffu + ((u >> 16) & 1u)) >> 16; }
__device__ __forceinline__ unsigned pk2(float lo, float hi) { return f2bf(lo) | (f2bf(hi) << 16); }
#define LDS_WAIT() asm volatile("s_waitcnt lgkmcnt(0)" ::: "memory")

__device__ __forceinline__ int src_col(int kind, int n0) {
    if (kind == 0) return n0;
    const int u = n0 >> 8, r = n0 & 255, bj = r >> 7, j = r & 127;
    if (kind == 1) return bj * FF + 128 * u + j;
    if (u < 8) return bj * 1024 + 128 * u + j;
    if (u < 12) return 2048 + 64 * (4 * (u - 8) + (j >> 5)) + 32 * bj;
    if (u == 12) return 3072 + 64 * (j >> 5) + 32 * bj;
    if (u == 13) return n0;
    return 3584 + bj * 1024 + 128 * (u - 14) + j;
}
#ifndef P0_NT_WT
#define P0_NT_WT 1
#endif
struct P0Item { const float* W; const float* gain; bf16* WT; int K, Nsrc, N, kind, item; bool kperm; bool nt; };
__device__ __forceinline__ void p0_item_load(const P0Item& I, int tid, f32x4 (&v)[8], float (&g)[8]) {
    const int nblk = I.N / 256, kb = I.item / nblk, nb = I.item % nblk, k0 = 64 * kb, n0 = 256 * nb;
    const int wv = tid >> 6, lane = tid & 63;
    const int s4 = src_col(I.kind, n0 + 32 * (lane >> 3)) + 4 * (lane & 7);
#pragma unroll
    for (int i = 0; i < 8; ++i) { const int kl = wv * 8 + i, ks = k0 + (I.kperm ? (kl >> 1) + 32 * (kl & 1) : kl);
        v[i] = P0_NT ? __builtin_nontemporal_load((const f32x4*)(I.W + (size_t)ks * I.Nsrc + s4)) : *(const f32x4*)(I.W + (size_t)ks * I.Nsrc + s4); }
#pragma unroll
    for (int i = 0; i < 8; ++i) g[i] = I.gain ? I.gain[k0 + wv * 8 + i] : 1.0f;
}
__device__ __forceinline__ void p0_item_store(const P0Item& I, int tid, const f32x4 (&v)[8], const float (&g)[8], LAS float* tile) {
    const int nblk = I.N / 256, kb = I.item / nblk, nb = I.item % nblk, k0 = 64 * kb, n0 = 256 * nb;
    const int wv = tid >> 6, lane = tid & 63;
#pragma unroll
    for (int i = 0; i < 8; ++i) { LAS float* d = tile + (wv * 8 + i) * 257 + 4 * lane; d[0] = g[i] * v[i][0]; d[1] = g[i] * v[i][1]; d[2] = g[i] * v[i][2]; d[3] = g[i] * v[i][3]; }
    __syncthreads();
    const int c = tid & 7;
#pragma unroll
    for (int j = 0; j < 4; ++j) { const int n = (tid >> 3) + 64 * j; const LAS float* s = tile + (8 * c) * 257 + n;
        v4u o; o.x = pg8::cvt_pk_bf16(s[0 * 257], s[1 * 257]); o.y = pg8::cvt_pk_bf16(s[2 * 257], s[3 * 257]); o.z = pg8::cvt_pk_bf16(s[4 * 257], s[5 * 257]); o.w = pg8::cvt_pk_bf16(s[6 * 257], s[7 * 257]);
        const int kk_ = k0 + 8 * c;
        if (P0_NT_WT && I.nt) __builtin_nontemporal_store(o, (v4u*)(I.WT + (size_t)(n0 + n) * I.K + kk_)); else *(v4u*)(I.WT + (size_t)(n0 + n) * I.K + kk_) = o; }
    __syncthreads();
}
__device__ __forceinline__ float wave_sum(float v) {
#pragma unroll
    for (int o = 1; o < 64; o <<= 1) v += __shfl_xor(v, o);
    return v;
}
__device__ __forceinline__ void p0_prologue(const Args& A, LAS unsigned char* lds, int gw, int NGW, int lane) {
    LAS float* tile = (LAS float*)lds;
    constexpr int I_IN = (D / 64) * (INW / 256), I_OUT = (FF / 64) * (D / 256), I_SQ = (D / 64) * (D / 256);
    constexpr int NITEMS = 3 * I_IN + 2 * I_OUT + 3 * I_SQ;
    const int vwg = gw >> 3, NWG = NGW >> 3, tid = ((gw & 7) << 6) + lane;
    auto resolve = [&](int it) -> P0Item {
        int r = it;
        if (r < I_IN) return P0Item{A.ffn1_w_in, A.ffn1_norm, A.W1i, D, 2 * FF, 2 * FF, 1, r, false, false}; r -= I_IN;
        if (r < I_IN) return P0Item{A.w_in, A.mix_norm, A.Wmx, D, INW, INW, 2, r, false, true}; r -= I_IN;
        if (r < I_IN) return P0Item{A.ffn2_w_in, A.ffn2_norm, A.W2i, D, 2 * FF, 2 * FF, 1, r, false, true}; r -= I_IN;
        if (r < I_OUT) return P0Item{A.ffn1_w_out, nullptr, A.W1o, FF, D, D, 0, r, false, true}; r -= I_OUT;
        if (r < I_OUT) return P0Item{A.ffn2_w_out, nullptr, A.W2o, FF, D, D, 0, r, false, true}; r -= I_OUT;
        if (r < I_SQ) return P0Item{A.conv_proj, nullptr, A.Wcp, D, D, D, 0, r, false, true}; r -= I_SQ;
        if (r < I_SQ) return P0Item{A.attn_wo, nullptr, A.Wao, D, D, D, 0, r, true, true}; r -= I_SQ;
        return P0Item{A.w_out, nullptr, A.Wot, D, D, D, 0, r, false, true};
    };
    {   f32x4 v[8], vn[8]; float g[8], gn[8];
        f32x4 xv[8], xn[8];
        int it = vwg; P0Item cur = resolve(it < NITEMS ? it : 0);
        if (it < NITEMS) p0_item_load(cur, tid, v, g);
        int m = 2 * gw;
        if (m < A.M) { const f32x4* xr = (const f32x4*)(A.x + (size_t)m * D) + lane;
#pragma unroll
            for (int j = 0; j < 8; ++j) xv[j] = P0_NT ? __builtin_nontemporal_load(xr + 64 * j) : xr[64 * j]; }
#pragma unroll 1
        while (it < NITEMS || m < A.M) {
            const bool has_it = it < NITEMS, more = it + NWG < NITEMS;
            const P0Item nxt = resolve(more ? it + NWG : 0);
            if (more) p0_item_load(nxt, tid, vn, gn);
            if (m + 2 * NGW < A.M) { const f32x4* xr = (const f32x4*)(A.x + (size_t)(m + 2 * NGW) * D) + lane;
#pragma unroll
                for (int j = 0; j < 8; ++j) xn[j] = P0_NT ? __builtin_nontemporal_load(xr + 64 * j) : xr[64 * j]; }
            if (has_it) {
                p0_item_store(cur, tid, v, g, tile);
#pragma unroll
                for (int i = 0; i < 8; ++i) { v[i] = vn[i]; g[i] = gn[i]; }
                cur = nxt; it += NWG;
            }
            if (m < A.M) {
                float s0 = 0.f, s1 = 0.f;
#pragma unroll
                for (int j = 0; j < 4; ++j) { s0 += (xv[j][0] * xv[j][0] + xv[j][1] * xv[j][1]) + (xv[j][2] * xv[j][2] + xv[j][3] * xv[j][3]); s1 += (xv[j + 4][0] * xv[j + 4][0] + xv[j + 4][1] * xv[j + 4][1]) + (xv[j + 4][2] * xv[j + 4][2] + xv[j + 4][3] * xv[j + 4][3]); }
                s0 = wave_sum(s0); s1 = wave_sum(s1);
#pragma unroll
                for (int j = 0; j < 8; ++j) { v2u w; w.x = pg8::cvt_pk_bf16(xv[j][0], xv[j][1]); w.y = pg8::cvt_pk_bf16(xv[j][2], xv[j][3]);
                    const int row = m + (j >> 2), col = 4 * (lane + 64 * (j & 3));
                    *(v2u*)(A.xb + pg8::blk_off(row, col, D)) = w; }
                if (lane < 2) { const float s = lane ? s1 : s0; A.ssq0[m + lane] = s; A.ssq1[m + lane] = 0.f; A.ssq2[m + lane] = 0.f; }
#pragma unroll
                for (int j = 0; j < 8; ++j) xv[j] = xn[j];
                m += 2 * NGW;
            }
        }
    }
}

__device__ __forceinline__ f32x2 bf2_to_f2(unsigned z) { return (f32x2){__uint_as_float(z << 16), __uint_as_float(z & 0xffff0000u)}; }
#ifndef CONV_SWAP
#define CONV_SWAP 0
#endif
template <int N, int OFF> __device__ __forceinline__ void rs_step(float (&v)[32], int lane) {
#if CONV_SWAP
    if constexpr (OFF == 32 || (OFF == 16 && CONV_SWAP == 2)) {
#pragma unroll
        for (int i = 0; i < N; ++i) {
            const unsigned a = __builtin_bit_cast(unsigned, v[i]), b = __builtin_bit_cast(unsigned, v[i + N]);
            if constexpr (OFF == 32) { const auto r = __builtin_amdgcn_permlane32_swap(a, b, false, false); v[i] = __builtin_bit_cast(float, (unsigned)r[0]) + __builtin_bit_cast(float, (unsigned)r[1]); }
            else { const auto r = __builtin_amdgcn_permlane16_swap(a, b, false, false); v[i] = __builtin_bit_cast(float, (unsigned)r[0]) + __builtin_bit_cast(float, (unsigned)r[1]); }
            if ((i & 1) == 1) __builtin_amdgcn_sched_barrier(0);
        }
        return;
    }
#endif
    const bool up = (lane & OFF) != 0;
    float t[N];
#pragma unroll
    for (int i = 0; i < N; ++i) { const float send = up ? v[i] : v[i + N]; t[i] = __shfl_xor(send, OFF); }
    __builtin_amdgcn_sched_barrier(0);
#pragma unroll
    for (int i = 0; i < N; ++i) { const float keep = up ? v[i + N] : v[i]; v[i] = keep + t[i]; }
}
template <int N2> __device__ __forceinline__ float reduce_scatter(float (&v)[32], int lane) {
    static_assert(N2 == 32, "32 values over 64 lanes");
    rs_step<16, 32>(v, lane); rs_step<8, 16>(v, lane); rs_step<4, 8>(v, lane); rs_step<2, 4>(v, lane); rs_step<1, 2>(v, lane);
    return v[0] + __shfl_xor(v[0], 1);
}
template <int BASE, int CVAR = 0  > __device__ __forceinline__ void conv_step16(const Args& A, f32x2 (&h)[32], unsigned (&zin)[16], const f32x2 (&w)[CWID], f32x2 bias, f32x2 g2, f32x2 b2,
                                                               const bf16* znext, bool have_next, bf16* orow, LAS float* red, LAS f32x2* STAT, int lane, int wid) {
    f32x2 y[16];
#pragma unroll
    for (int s0 = 0; s0 < 16; s0 += 4) {
        y[s0] = __builtin_elementwise_fma(w[0], h[(BASE + s0 + 2) & 31], bias); y[s0] = __builtin_elementwise_fma(w[1], h[(BASE + s0 + 3) & 31], y[s0]);
        y[s0 + 1] = __builtin_elementwise_fma(w[0], h[(BASE + s0 + 3) & 31], bias); y[s0 + 2] = bias; y[s0 + 3] = bias;
#pragma unroll
        for (int j = 0; j < 4; ++j) h[BASE + s0 + j] = bf2_to_f2(zin[s0 + j]);
#pragma unroll
        for (int k = 0; k < CWID; ++k)
#pragma unroll
            for (int s = s0; s < s0 + 4; ++s)
                if (!((s == s0 && k < 2) || (s == s0 + 1 && k < 1))) y[s] = __builtin_elementwise_fma(w[k], h[(BASE + s + 2 + k) & 31], y[s]);
    }
    {
        float v[32];
#pragma unroll
        for (int s = 0; s < 16; ++s) { v[2 * s] = y[s][0] + y[s][1]; v[2 * s + 1] = y[s][0] * y[s][0] + y[s][1] * y[s][1]; }
        const float r = reduce_scatter<32>(v, lane);
        if ((lane & 1) == 0) red[wid * 32 + (lane >> 1)] = r;
    }
    if (have_next) {
#pragma unroll
        for (int s = 0; s < 16; ++s) zin[s] = CA_NT ? __builtin_nontemporal_load((const unsigned*)(znext + (size_t)s * D)) : *(const unsigned*)(znext + (size_t)s * D);
    }
    __syncthreads();
    {
        float tot = 0.f;
#pragma unroll
        for (int wv = 0; wv < 8; ++wv) tot += red[wv * 32 + (lane & 31)];
        const float other = __shfl_xor(tot, 1);
        const float sm = (lane & 1) ? other : tot, sq = (lane & 1) ? tot : other;
        const float mu = sm * (1.0f / D), rs = __builtin_amdgcn_rsqf(fmaxf(sq * (1.0f / D) - mu * mu, 0.0f) + 1e-6f);
        if ((lane & 33) == 0) STAT[lane >> 1] = (f32x2){mu, rs};
    }
#pragma unroll
    for (int s = 0; s < 16; ++s) {
        const f32x2 st = STAT[s];
        f32x2 v = (y[s] - st[0]) * st[1] * g2 + b2;
        v[0] = v[0] * pg8::fast_sigmoid(v[0]); v[1] = v[1] * pg8::fast_sigmoid(v[1]);
        *(unsigned*)(orow + (size_t)s * D) = pg8::cvt_pk_bf16(v[0], v[1]);
    }
}
template <int CVAR = 0> __device__ __forceinline__ void conv_phase(const Args& A, LAS unsigned char* lds, const int wave_id, const int ch0, const int chstep, const bf16* zbase) {
    int tid_ = wave_id * 64 + pg8::fresh_lane_id(); asm volatile("" : "+v"(tid_));
    const int tid = tid_, lane = tid & 63, wid = tid >> 6, c0 = 2 * tid;
    LAS float* RED = (LAS float*)lds;
    LAS f32x2* STAT = (LAS f32x2*)(lds + 4096) + wid * 16;
    f32x2 w[CWID];
#pragma unroll
    for (int k = 0; k < CWID; ++k) w[k] = *(const f32x2*)(A.conv_w + k * D + c0);
    const f32x2 bias = *(const f32x2*)(A.conv_b + c0), g2 = *(const f32x2*)(A.ln_g + c0), b2 = *(const f32x2*)(A.ln_b + c0);
    const int nchunks = A.M / 128;
    for (int ch = ch0; ch < nchunks; ch += chstep) {
        const int t0 = ch * 128; const bool first = (t0 % SEQ) == 0;
        const bf16* zp = zbase + (size_t)t0 * D + c0;
        bf16* op = A.c + (size_t)t0 * D + c0;
        f32x2 h[32];
        unsigned zin[16];
#pragma unroll
        for (int s = 0; s < 16; ++s) zin[s] = CA_NT ? __builtin_nontemporal_load((const unsigned*)(zp + (size_t)s * D)) : *(const unsigned*)(zp + (size_t)s * D);
#pragma unroll
        for (int i = 2; i < 32; ++i) { unsigned zz = 0u; if (!first) zz = *(const unsigned*)(zp - (size_t)(32 - i) * D); h[i] = bf2_to_f2(zz); }
#pragma unroll 1
        for (int tb = 0; tb < 128; tb += 32) {
            conv_step16<0, CVAR>(A, h, zin, w, bias, g2, b2, zp + (size_t)(tb + 16) * D, true, op + (size_t)tb * D, RED, STAT, lane, wid);
            conv_step16<16, CVAR>(A, h, zin, w, bias, g2, b2, zp + (size_t)(tb + 32) * D, tb + 32 < 128, op + (size_t)(tb + 16) * D, RED + 256, STAT, lane, wid);
        }
    }
    __syncthreads();
}

constexpr int ATT_K_OFF = 0, ATT_V_OFF = 32768, ATT_TB_OFF = 65536, ATT_LS_OFF = 69632, ATT_OST_OFF = 73728;
__device__ __forceinline__ s16x4 vtr(const LAS unsigned char* p) { typedef short v4i16_t __attribute__((ext_vector_type(4))); return __builtin_bit_cast(s16x4, __builtin_amdgcn_ds_read_tr16_b64_v4i16((LAS v4i16_t*)p)); }
template <int VAR  > __device__ __forceinline__ void attn_phase(const Args& A, LAS unsigned char* lds, const int wave_id, const int u0, const int ustep, const int uend, const bf16* qbase, const bf16* kbase_g, const bf16* vbase_g, bf16* obase) {
    int tid_ = wave_id * 64 + pg8::fresh_lane_id(); asm volatile("" : "+v"(tid_));
    const int tid = tid_, lane = tid & 63, r32 = lane & 31, hi = lane >> 5; const int wid = __builtin_amdgcn_readfirstlane(tid >> 6);
    const int nunits = (A.M / 128) * HKV;
    LAS float* TB = (LAS float*)(lds + ATT_TB_OFF);
    LAS float* LS = (LAS float*)(lds + ATT_LS_OFF) + wid * 64;
    v4u kreg[4], vreg[4];
#define ATT_LOAD_KV(u_) do { const int blk_ = (u_) >> 2, hk_ = (u_) & 3, t0_ = blk_ * 128; const bool first_ = (t0_ % SEQ) == 0; \
        _Pragma("unroll") for (int i = 0; i < 4; ++i) { const int idx = tid + 512 * i, key = idx >> 3, cc = idx & 7; \
            if (!(first_ && key < 128)) { const size_t g_ = (size_t)(t0_ - 128 + key) * 256 + hk_ * 64 + cc * 8; kreg[i] = *(const v4u*)(kbase_g + g_); vreg[i] = *(const v4u*)(vbase_g + g_); } } } while (0)
    float shift; bool use_bound;
    { float gq = fabsf(A.q_norm[lane]), gk = fabsf(A.k_norm[lane]), bm = 0.f;
#pragma unroll
      for (int i = 0; i < 8; ++i) bm = fmaxf(bm, fabsf(A.rel_bias[lane + 64 * i]));
#pragma unroll
      for (int o = 1; o < 64; o <<= 1) { const float t0_ = __shfl_xor(gq, o), t1_ = __shfl_xor(gk, o), t2_ = __shfl_xor(bm, o); __builtin_amdgcn_sched_barrier(0); gq = fmaxf(gq, t0_); gk = fmaxf(gk, t1_); bm = fmaxf(bm, t2_); }
      const float bnd = (8.0f * gq * gk + bm) * pg8::LOG2E; use_bound = bnd <= 40.0f; shift = use_bound ? bnd : 0.0f; }
    int u = u0;
    bf16x8 qn[4];
#define ATT_LOAD_Q0(u_) do { const int t0_ = ((u_) >> 2) * 128, hk_ = (u_) & 3, g_ = wid >> 2, sub_ = wid & 3; const size_t qrow_ = (size_t)(t0_ + 32 * sub_ + r32) * D + (hk_ * 4 + g_) * HD; \
        _Pragma("unroll") for (int d0 = 0; d0 < 4; ++d0) qn[d0] = CA_NT ? __builtin_nontemporal_load((const bf16x8*)(qbase + qrow_ + 16 * d0 + 8 * hi)) : *(const bf16x8*)(qbase + qrow_ + 16 * d0 + 8 * hi); } while (0)
    if (u < uend) { ATT_LOAD_KV(u); ATT_LOAD_Q0(u); }
    int tb_hk = -1;
    for (; u < uend; u += ustep) {
        const int blk = u >> 2, hk = u & 3, t0 = blk * 128; const bool first = (t0 % SEQ) == 0;
#pragma unroll
        for (int i = 0; i < 4; ++i) {
            const int idx = tid + 512 * i, key = idx >> 3, cc = idx & 7;
            const bool dead = first && key < 128;
            *(LAS v4u*)(lds + ATT_K_OFF + key * 128 + ((cc ^ ((key >> 1) & 7)) << 4)) = dead ? (v4u){0u, 0u, 0u, 0u} : kreg[i];
            *(LAS v4u*)(lds + ATT_V_OFF + ((key >> 2) * 2 + (cc >> 2)) * 256 + (key & 3) * 64 + (cc & 3) * 16) = dead ? (v4u){0u, 0u, 0u, 0u} : vreg[i];
        }
        if (hk != tb_hk) {
            for (int e = tid; e < 4 * 192; e += NTHREADS) {
                const int g = e / 192, dist = e % 192 - 32;
                TB[e] = (dist >= 0 && dist < 128) ? A.rel_bias[T5B[dist] * HQ + hk * 4 + g] * pg8::LOG2E - shift : -3.0e38f;
            }
            tb_hk = hk;
        }
        __syncthreads();
        bf16x8 qf[2][4];
#pragma unroll
        for (int d0 = 0; d0 < 4; ++d0) qf[0][d0] = qn[d0];
        {   const int task = wid + 8, g = task >> 2, sub = task & 3;
            const size_t qrow = (size_t)(t0 + 32 * sub + r32) * D + (hk * 4 + g) * HD;
#pragma unroll
            for (int d0 = 0; d0 < 4; ++d0) qf[1][d0] = CA_NT ? __builtin_nontemporal_load((const bf16x8*)(qbase + qrow + 16 * d0 + 8 * hi)) : *(const bf16x8*)(qbase + qrow + 16 * d0 + 8 * hi); }
        if (u + ustep < uend) { ATT_LOAD_KV(u + ustep); ATT_LOAD_Q0(u + ustep); }
#define ATT_SBAR() __builtin_amdgcn_sched_barrier(0)
        if (VAR == 1) { asm volatile("" :: "v"(qf[0][0]), "v"(qf[0][1]), "v"(qf[0][2]), "v"(qf[0][3]), "v"(qf[1][0]), "v"(qf[1][1]), "v"(qf[1][2]), "v"(qf[1][3])); }
#ifndef ATT_PAIR
#define ATT_PAIR 0
#endif
        if (ATT_PAIR && VAR == 0 && use_bound) {
            const int sub = wid & 3, g0 = wid >> 2, hA = hk * 4 + g0;
            const LAS float* tbA = TB + g0 * 192 + 32 + r32 - 4 * hi; const LAS float* tbB = tbA + 2 * 192;
            const float sinkA = A.sinks[hA] * pg8::LOG2E - shift, sinkB = A.sinks[hA + 2] * pg8::LOG2E - shift;
            f32x16 oA0, oA1, oB0, oB1;
#pragma unroll
            for (int r = 0; r < 16; ++r) { oA0[r] = 0.f; oA1[r] = 0.f; oB0[r] = 0.f; oB1[r] = 0.f; }
            float lA = 0.f, lB = 0.f;
            bf16x8 kfr[4]; s16x4 vfr[2][4];
            const LAS unsigned char* kbase = lds + ATT_K_OFF + r32 * 128; const int kx = (r32 >> 1) & 7;
            const LAS unsigned char* vbase = lds + ATT_V_OFF + hi * 512 + ((lane & 15) >> 2) * 64 + (((lane >> 4) & 1) * 16 + (lane & 3) * 4) * 2;
#define ATT_LOADK(buf, kt_) do { _Pragma("unroll") for (int d0 = 0; d0 < 4; ++d0) kfr[d0] = *(const LAS bf16x8*)(kbase + (kt_) * 4096 + (((2 * d0 + hi) ^ kx) << 4)); } while (0)
#define ATT_LOADV(buf, kt_, s2_) do { const LAS unsigned char* vp_ = vbase + ((8 * (kt_) + 4 * (s2_)) * 2) * 256; vfr[buf][0] = vtr(vp_); vfr[buf][1] = vtr(vp_ + 2 * 512); vfr[buf][2] = vtr(vp_ + 256); vfr[buf][3] = vtr(vp_ + 256 + 2 * 512); } while (0)
#define ATT_PV(sX, oX0, oX1, lX) do { \
                _Pragma("unroll") for (int r = 0; r < 16; ++r) { sX[r] = __builtin_amdgcn_exp2f(sX[r]); lX += sX[r]; } \
                _Pragma("unroll") for (int s2 = 0; s2 < 2; ++s2) { \
                    v4u pw; pw.x = pg8::cvt_pk_bf16(sX[8 * s2 + 0], sX[8 * s2 + 1]); pw.y = pg8::cvt_pk_bf16(sX[8 * s2 + 2], sX[8 * s2 + 3]); pw.z = pg8::cvt_pk_bf16(sX[8 * s2 + 4], sX[8 * s2 + 5]); pw.w = pg8::cvt_pk_bf16(sX[8 * s2 + 6], sX[8 * s2 + 7]); \
                    const bf16x8 pa = __builtin_bit_cast(bf16x8, pw); \
                    const s16x4 a0 = vfr[s2][0], a1 = vfr[s2][1], b0 = vfr[s2][2], b1 = vfr[s2][3]; \
                    const bf16x8 v0 = (bf16x8){a0[0], a0[1], a0[2], a0[3], a1[0], a1[1], a1[2], a1[3]}; \
                    const bf16x8 v1 = (bf16x8){b0[0], b0[1], b0[2], b0[3], b1[0], b1[1], b1[2], b1[3]}; \
                    oX0 = __builtin_amdgcn_mfma_f32_32x32x16_bf16(pa, v0, oX0, 0, 0, 0); oX1 = __builtin_amdgcn_mfma_f32_32x32x16_bf16(pa, v1, oX1, 0, 0, 0); } } while (0)
            ATT_LOADK(0, sub + 4);
#pragma unroll
            for (int di = 0; di < 5; ++di) {
                const int kt = sub + 4 - di;
                f32x16 sA, sB;
#pragma unroll
                for (int r = 0; r < 16; ++r) { sA[r] = tbA[32 * di - ((r & 3) + 8 * (r >> 2))]; sB[r] = tbB[32 * di - ((r & 3) + 8 * (r >> 2))]; }
                ATT_LOADV(0, kt, 0); ATT_LOADV(1, kt, 1);
                ATT_SBAR();
#pragma unroll
                for (int d0 = 0; d0 < 4; ++d0) sA = __builtin_amdgcn_mfma_f32_32x32x16_bf16(kfr[d0], qf[0][d0], sA, 0, 0, 0);
#pragma unroll
                for (int d0 = 0; d0 < 4; ++d0) sB = __builtin_amdgcn_mfma_f32_32x32x16_bf16(kfr[d0], qf[1][d0], sB, 0, 0, 0);
                ATT_SBAR();
                if (di < 4) ATT_LOADK(0, kt - 1);
                if (first && kt < 4) {
#pragma unroll
                    for (int r = 0; r < 16; ++r) { sA[r] = -3.0e38f; sB[r] = -3.0e38f; }
                }
                ATT_PV(sA, oA0, oA1, lA);
                ATT_PV(sB, oB0, oB1, lB);
            }
#define ATT_EPI(oX0, oX1, lX, sinkX, hX) do { \
                float l_ = lX + __shfl_xor(lX, 32); l_ += __builtin_amdgcn_exp2f(sinkX); const float linv = __builtin_amdgcn_rcpf(l_); \
                unsigned* ob = (unsigned*)(obase + (size_t)(t0 + 32 * sub + 4 * hi) * D + (hX) * HD) + r32; \
                _Pragma("unroll") for (int r = 0; r < 16; ++r) { \
                    const float li0 = __builtin_bit_cast(float, __builtin_amdgcn_readlane(__builtin_bit_cast(int, linv), (r & 3) + 8 * (r >> 2))); \
                    const float li1 = __builtin_bit_cast(float, __builtin_amdgcn_readlane(__builtin_bit_cast(int, linv), (r & 3) + 8 * (r >> 2) + 4)); \
                    const float li = hi ? li1 : li0; \
                    ob[(size_t)((r & 3) + 8 * (r >> 2)) * (D / 2)] = pg8::cvt_pk_bf16(oX0[r] * li, oX1[r] * li); } } while (0)
            ATT_EPI(oA0, oA1, lA, sinkA, hA);
            ATT_EPI(oB0, oB1, lB, sinkB, hA + 2);
#undef ATT_EPI
#undef ATT_PV
#undef ATT_LOADK
#undef ATT_LOADV
        } else
#pragma unroll
        for (int ti = 0; ti < (VAR == 1 ? 0 : 2); ++ti) {
            const int task = wid + 8 * ti, g = task >> 2, sub = task & 3, h = hk * 4 + g;
            f32x16 s[5];
            const LAS float* tb = TB + g * 192 + 32 + r32 - 4 * hi;
#pragma unroll
            for (int di = 0; di < 5; ++di)
#pragma unroll
                for (int r = 0; r < 16; ++r) s[di][r] = tb[32 * di - ((r & 3) + 8 * (r >> 2))];
            float sink2 = A.sinks[h] * pg8::LOG2E - shift;
            bf16x8 kfr[2][4];
            const LAS unsigned char* kbase = lds + ATT_K_OFF + r32 * 128; const int kx = (r32 >> 1) & 7;
#define ATT_LOADK(buf, kt_) do { _Pragma("unroll") for (int d0 = 0; d0 < 4; ++d0) kfr[buf][d0] = *(const LAS bf16x8*)(kbase + (kt_) * 4096 + (((2 * d0 + hi) ^ kx) << 4)); } while (0)
            ATT_LOADK(0, sub + 4);
#pragma unroll
            for (int di = 0; di < 5; ++di) {
                const int kt = sub + 4 - di;
                if (di < 4) ATT_LOADK((di + 1) & 1, kt - 1);
                ATT_SBAR();
#pragma unroll
                for (int d0 = 0; d0 < 4; ++d0) s[di] = __builtin_amdgcn_mfma_f32_32x32x16_bf16(kfr[di & 1][d0], qf[ti][d0], s[di], 0, 0, 0);
                ATT_SBAR();
                if (first && kt < 4) {
#pragma unroll
                    for (int r = 0; r < 16; ++r) s[di][r] = -3.0e38f;
                }
            }
            if (VAR == 3) { asm volatile("" :: "v"(s[0]), "v"(s[1]), "v"(s[2]), "v"(s[3]), "v"(s[4])); continue; }
            s16x4 vfr[2][4];
            const LAS unsigned char* vbase = lds + ATT_V_OFF + hi * 512 + ((lane & 15) >> 2) * 64 + (((lane >> 4) & 1) * 16 + (lane & 3) * 4) * 2;
#define ATT_LOADV(buf, kt_, s2_) do { const LAS unsigned char* vp_ = vbase + ((8 * (kt_) + 4 * (s2_)) * 2) * 256; vfr[buf][0] = vtr(vp_); vfr[buf][1] = vtr(vp_ + 2 * 512); vfr[buf][2] = vtr(vp_ + 256); vfr[buf][3] = vtr(vp_ + 256 + 2 * 512); } while (0)
            ATT_LOADV(0, sub + 4, 0);
            if (!use_bound) {
                float mx = sink2;
#pragma unroll
                for (int di = 0; di < 5; ++di)
#pragma unroll
                    for (int r = 0; r < 16; r += 2) mx = fmaxf(mx, fmaxf(s[di][r], s[di][r + 1]));
                mx = fmaxf(mx, __shfl_xor(mx, 32));
#pragma unroll
                for (int di = 0; di < 5; ++di)
#pragma unroll
                    for (int r = 0; r < 16; ++r) s[di][r] -= mx;
                sink2 -= mx;
            }
            float l = 0.f;
#pragma unroll
            for (int di = 0; di < 5; ++di)
#pragma unroll
                for (int r = 0; r < 16; ++r) { s[di][r] = __builtin_amdgcn_exp2f(s[di][r]); l += s[di][r]; }
            f32x16 o0, o1;
#pragma unroll
            for (int r = 0; r < 16; ++r) { o0[r] = 0.f; o1[r] = 0.f; }
#pragma unroll
            for (int j = 0; j < 10; ++j) {
                const int di = j >> 1, s2 = j & 1;
                if (j < 9) ATT_LOADV((j + 1) & 1, sub + 4 - ((j + 1) >> 1), (j + 1) & 1);
                ATT_SBAR();
                v4u pw; pw.x = pg8::cvt_pk_bf16(s[di][8 * s2 + 0], s[di][8 * s2 + 1]); pw.y = pg8::cvt_pk_bf16(s[di][8 * s2 + 2], s[di][8 * s2 + 3]);
                pw.z = pg8::cvt_pk_bf16(s[di][8 * s2 + 4], s[di][8 * s2 + 5]); pw.w = pg8::cvt_pk_bf16(s[di][8 * s2 + 6], s[di][8 * s2 + 7]);
                const bf16x8 pa = __builtin_bit_cast(bf16x8, pw);
                const s16x4 a0 = vfr[j & 1][0], a1 = vfr[j & 1][1], b0 = vfr[j & 1][2], b1 = vfr[j & 1][3];
                const bf16x8 v0 = (bf16x8){a0[0], a0[1], a0[2], a0[3], a1[0], a1[1], a1[2], a1[3]};
                const bf16x8 v1 = (bf16x8){b0[0], b0[1], b0[2], b0[3], b1[0], b1[1], b1[2], b1[3]};
                o0 = __builtin_amdgcn_mfma_f32_32x32x16_bf16(pa, v0, o0, 0, 0, 0);
                o1 = __builtin_amdgcn_mfma_f32_32x32x16_bf16(pa, v1, o1, 0, 0, 0);
                ATT_SBAR();
            }
            if (VAR == 2) { asm volatile("" :: "v"(o0), "v"(o1), "v"(l)); continue; }
            l += __shfl_xor(l, 32);
            l += __builtin_amdgcn_exp2f(sink2);
            const float linv = __builtin_amdgcn_rcpf(l);
            unsigned* ob = (unsigned*)(obase + (size_t)(t0 + 32 * sub + 4 * hi) * D + h * HD) + r32;
#pragma unroll
            for (int r = 0; r < 16; ++r) {
                const float li0 = __builtin_bit_cast(float, __builtin_amdgcn_readlane(__builtin_bit_cast(int, linv), (r & 3) + 8 * (r >> 2)));
                const float li1 = __builtin_bit_cast(float, __builtin_amdgcn_readlane(__builtin_bit_cast(int, linv), (r & 3) + 8 * (r >> 2) + 4));
                const float li = hi ? li1 : li0;
                ob[(size_t)((r & 3) + 8 * (r >> 2)) * (D / 2)] = pg8::cvt_pk_bf16(o0[r] * li, o1[r] * li);
            }
        }
#undef ATT_LOADK
#undef ATT_LOADV
#undef ATT_SBAR
        __syncthreads();
    }
#undef ATT_LOAD_KV
#undef ATT_LOAD_Q0
}
typedef unsigned gu32_t;
#define XB_TMO      128
#define XB_XCNT(j)  (256  + 64 * (j))
#define XB_XSUB(j)  (1280 + 64 * (j))
#define XB_XGEN(j)  (2304 + 64 * (j))
#define XB_TOP      3328
#define XB_TOPGEN   3392
#define XCD_BAR_WORDS 3456
#ifndef XB_FLAT
#define XB_FLAT 1
#endif
#define XB_SPIN_CAP (1u << 18)

__device__ __forceinline__ unsigned xb_ld(unsigned* p)              { return __hip_atomic_load(p, __ATOMIC_RELAXED, __HIP_MEMORY_SCOPE_AGENT); }
__device__ __forceinline__ unsigned xb_add(unsigned* p, unsigned v) { return __hip_atomic_fetch_add(p, v, __ATOMIC_RELAXED, __HIP_MEMORY_SCOPE_AGENT); }
__device__ __forceinline__ unsigned xb_xcc_id() { return (unsigned)__builtin_amdgcn_s_getreg((3 << 11) | 20) & 0xFu; }
#define XB_SPIN(cond, bar) do { unsigned _sp = 0; while (cond) { __builtin_amdgcn_s_sleep(1); \
    if ((++_sp & 255u) == 0u) { if (xb_ld(&(bar)[XB_TMO])) break; if (_sp > XB_SPIN_CAP) { atomicAdd(&(bar)[XB_TMO], 1u); break; } } } } while (0)

struct XcdBarrier {
    unsigned* bar; unsigned x; int w;
    volatile LAS unsigned* st;
};

__device__ __forceinline__ XcdBarrier xcd_barrier_post(unsigned* bar, volatile LAS unsigned* st) {
    XcdBarrier b; b.bar = bar; b.x = xb_xcc_id(); b.st = st; b.w = __builtin_amdgcn_readfirstlane((int)threadIdx.x >> 6);
    if (threadIdx.x == 0) st[2] = xb_add(&bar[XB_XCNT(b.x)], 1u);
    return b;
}
__device__ __forceinline__ void xcd_barrier_complete(unsigned* bar, unsigned x, unsigned& nloc, unsigned& nx) {
    const unsigned G = gridDim.x * gridDim.y * gridDim.z;
    unsigned sum, cnt, mine, sp = 0u;
    for (;;) {
        sum = 0u; cnt = 0u; mine = 0u;
#pragma unroll
        for (unsigned j = 0; j < 16; ++j) { const unsigned c = xb_ld(&bar[XB_XCNT(j)]); sum += c; cnt += (c > 0u) ? (XB_FLAT ? (1u << j) : 1u) : 0u; mine = (j == x) ? c : mine; }
        if (sum == G) break;
        __builtin_amdgcn_s_sleep(1);
        if ((++sp & 255u) == 0u) { if (xb_ld(&bar[XB_TMO])) break; if (sp > XB_SPIN_CAP) { atomicAdd(&bar[XB_TMO], 1u); break; } }
    }
    nloc = mine > 0u ? mine : 1u; nx = cnt > 0u ? cnt : 1u;
}
__device__ __forceinline__ unsigned xcd_even_placement(unsigned* bar) {
    const unsigned G = gridDim.x * gridDim.y * gridDim.z; unsigned ok = (G % 8u == 0u) ? 1u : 0u;
#pragma unroll
    for (unsigned j = 0; j < 16; ++j) { const unsigned c = xb_ld(&bar[XB_XCNT(j)]); ok &= (c == (j < 8u ? G / 8u : 0u)) ? 1u : 0u; }
    return ok;
}

#ifndef XB_FLAT
#define XB_FLAT 1
#endif
#define XB_FLAG 3408
__device__ __forceinline__ void xcd_barrier(const XcdBarrier& b) {
    asm volatile("s_waitcnt vmcnt(0)" ::: "memory");
    __syncthreads();
    if (b.w == 0 && pg8::fresh_lane_id() == 0) {
        unsigned* bar = b.bar;
        __builtin_amdgcn_s_waitcnt(0);
        unsigned nloc = b.st[0], nx = b.st[1];
        if (nloc == 0u) { xcd_barrier_complete(bar, b.x, nloc, nx); b.st[0] = nloc; b.st[1] = nx; b.st[3] = xcd_even_placement(bar); }
        const unsigned old = xb_add(&bar[XB_XSUB(b.x)], 1u);
        const unsigned gen = old / nloc;
#if XB_FLAT
        if (old + 1u == (gen + 1u) * nloc) {
            __builtin_amdgcn_fence(__ATOMIC_RELEASE, "agent");
            asm volatile("s_waitcnt vmcnt(0)" ::: "memory");
            __hip_atomic_store(&bar[XB_FLAG + b.x], gen + 1u, __ATOMIC_RELAXED, __HIP_MEMORY_SCOPE_AGENT);
        }
        {   unsigned sp = 0u;
            for (;;) {
                unsigned pending = 0u;
#pragma unroll
                for (unsigned j = 0; j < 16; ++j) { const unsigned f = xb_ld(&bar[XB_FLAG + j]); pending |= ((int)(f - (gen + 1u)) < 0) ? (1u << j) : 0u; }
                if ((pending & nx) == 0u) break;
                __builtin_amdgcn_s_sleep(1);
                if ((++sp & 255u) == 0u) { if (xb_ld(&bar[XB_TMO])) break; if (sp > XB_SPIN_CAP) { atomicAdd(&bar[XB_TMO], 1u); break; } }
            }
        }
        __builtin_amdgcn_fence(__ATOMIC_ACQUIRE, "agent");
        asm volatile("s_waitcnt vmcnt(0)" ::: "memory");
#else
        if (old + 1u == (gen + 1u) * nloc) {
            __builtin_amdgcn_fence(__ATOMIC_RELEASE, "agent");
            asm volatile("s_waitcnt vmcnt(0)" ::: "memory");
            const unsigned og = xb_add(&bar[XB_TOP], 1u);
            const unsigned tg = og / nx;
            if (og + 1u == (tg + 1u) * nx) xb_add(&bar[XB_TOPGEN], 1u);
            else XB_SPIN(xb_ld(&bar[XB_TOPGEN]) == tg, bar);
            __builtin_amdgcn_fence(__ATOMIC_ACQUIRE, "agent");
            xb_add(&bar[XB_XGEN(b.x)], 1u);
            asm volatile("s_waitcnt vmcnt(0)" ::: "memory");
        } else {
            XB_SPIN(xb_ld(&bar[XB_XGEN(b.x)]) == gen, bar);
            __builtin_amdgcn_fence(__ATOMIC_ACQUIRE, "agent");
            asm volatile("s_waitcnt vmcnt(0)" ::: "memory");
        }
#endif
    }
    __syncthreads();
}

#define XB_LSUB(j)  (3456 + 8 * (j))
__device__ __forceinline__ void xcd_local_barrier(const XcdBarrier& b) {
    asm volatile("s_waitcnt vmcnt(0)" ::: "memory");
    __syncthreads();
    if (b.w == 0 && pg8::fresh_lane_id() == 0) {
        unsigned* bar = b.bar;
        __builtin_amdgcn_s_waitcnt(0);
        const unsigned nloc = b.st[0];
        const unsigned old = xb_add(&bar[XB_LSUB(b.x)], 1u);
        const unsigned want = (old / nloc + 1u) * nloc;
        XB_SPIN((int)(xb_ld(&bar[XB_LSUB(b.x)]) - want) < 0, bar);
        __builtin_amdgcn_fence(__ATOMIC_ACQUIRE, "agent");
        asm volatile("s_waitcnt vmcnt(0)" ::: "memory");
    }
    __syncthreads();
}
typedef pg8::EpiResid<false, true, true> EpiRes2; typedef pg8::EpiResid<false, true, false> EpiRes6; typedef pg8::EpiResid<false, false, true> EpiRes8;
#ifndef STOP_AFTER
#define STOP_AFTER 99
#endif
#ifndef H_REV
#define H_REV 0
#endif
#ifndef H_NT
#define H_NT 0
#endif
#ifndef GEMM_PF
#define GEMM_PF 0
#endif
#ifndef CONV_PROBE_VAR
#define CONV_PROBE_VAR 0
#endif
#ifndef ATTN_PROBE_VAR
#define ATTN_PROBE_VAR 0
#endif
#ifndef DUP_MASK
#define DUP_MASK 0
#endif
__global__ void __launch_bounds__(NTHREADS, 2) mega_fwd(Args A) {
    extern __shared__ __attribute__((aligned(16))) unsigned char lds_raw[];
    LAS unsigned char* lds = (LAS unsigned char*)lds_raw;
    const int tid = threadIdx.x, lane = tid & 63, wave = __builtin_amdgcn_readfirstlane(tid >> 6), G = gridDim.x;
    const int vcu = (G % 8 == 0) ? ((int)blockIdx.x % 8) * (G / 8) + (int)blockIdx.x / 8 : (int)blockIdx.x;
    const int M = A.M;
    volatile LAS unsigned* MISC = (volatile LAS unsigned*)(lds + RING_BYTES);
    if (tid < 16) MISC[tid] = 0u;
    __syncthreads();
    const XcdBarrier bar = xcd_barrier_post(A.ctl, MISC);
#ifndef XCC_PROBE
#define XCC_PROBE 0
#endif
    if (XCC_PROBE && tid == 0 && xb_xcc_id() != (blockIdx.x & 7u)) { const unsigned long long t0_ = __builtin_amdgcn_s_memrealtime(); while ((unsigned)(__builtin_amdgcn_s_memrealtime() - t0_) < 30000u) __builtin_amdgcn_s_sleep(8); }
#define GRID_SYNC() xcd_barrier(bar)
#ifndef LOCAL_CHAIN
#define LOCAL_CHAIN 1
#endif
#define SEAM_SYNC() do { if (LOCALM) xcd_local_barrier(bar); else xcd_barrier(bar); } while (0)
#ifndef GEMM_BAL
#define GEMM_BAL 0
#endif
#ifndef PROBE_PHASE
#define PROBE_PHASE -1
#endif
#ifndef CLK_PROBE
#define CLK_PROBE 0
#endif
#ifndef PROBE_BLOCK
#define PROBE_BLOCK 0
#endif
#ifndef PROBE_ALL
#define PROBE_ALL 0
#endif
#define STAMP(k) do { if (PROBE_PHASE >= 0 && blockIdx.x == PROBE_BLOCK && tid == 0) { const unsigned long long t_ = __builtin_amdgcn_s_memrealtime(); const unsigned long long c_ = CLK_PROBE ? (unsigned long long)clock64() : 0ull; if ((k) == PROBE_PHASE) { MISC[4] = (unsigned)t_; MISC[6] = (unsigned)c_; } if ((k) == (PROBE_ALL ? 10 : PROBE_PHASE + 1)) { MISC[5] = (unsigned)t_; MISC[7] = (unsigned)c_; } } } while (0)
#define GEMM_PHASE_X(ABLK, AAUX, REVX, EPI_T, AP, BP, NN, KK, ...) do { pg8::Gemm g_{AP, BP, M, NN, KK}; pg8::StaticOrder S_; S_.init(M, NN, G, cvirt, REVX); EPI_T E_{__VA_ARGS__}; \
        pg8::gemm_phase<EPI_T, pg8::StaticOrder, true, true, 1, ABLK, 0, AAUX, GEMM_PF, (GEMM_BAL != 0)>(lds, g_, S_, E_, wave); } while (0)
#define GEMM_PHASE_(ABLK, ...) GEMM_PHASE_X(ABLK, 0, 0, __VA_ARGS__)
#define GEMM_PHASE_HNT(...) GEMM_PHASE_X((BLOCKED_ACT != 0 || BLOCKED_H != 0), H_NT, H_REV, __VA_ARGS__)
#define GEMM_PHASE(...) GEMM_PHASE_(false, __VA_ARGS__)
#define GEMM_PHASE_B(...) GEMM_PHASE_((BLOCKED_ACT != 0), __VA_ARGS__)

    STAMP(0);
    p0_prologue(A, lds, vcu * NWAVES + wave, G * NWAVES, lane);
    if (DUP_MASK & 1) { __syncthreads(); p0_prologue(A, lds, vcu * NWAVES + wave, G * NWAVES, lane); }
    GRID_SYNC();
    const bool LOCALM = LOCAL_CHAIN && NB == 8 && M == M_FULL && __builtin_amdgcn_readfirstlane((int)MISC[3]) != 0;
    const int cvirt = LOCALM ? __builtin_amdgcn_readfirstlane((int)MISC[2]) * 8 + (int)bar.x : (int)blockIdx.x;
#define AL_Z (LOCALM ? A.H + (size_t)(cvirt & 7) * ((size_t)SEQ * (FF - D)) : A.z)
#define AL_Q (LOCALM ? A.H + (size_t)SEQ * D + (size_t)(cvirt & 7) * ((size_t)SEQ * (FF - D)) : A.q)
#define AL_K (LOCALM ? A.H + (size_t)2 * SEQ * D + (size_t)(cvirt & 7) * ((size_t)SEQ * (FF - 256)) : A.k)
#define AL_V (LOCALM ? A.H + (size_t)2 * SEQ * D + (size_t)SEQ * 256 + (size_t)(cvirt & 7) * ((size_t)SEQ * (FF - 256)) : A.v)
    STAMP(1);
    if (DUP_MASK & 8) GEMM_PHASE(pg8::EpiSwiglu, A.xb, A.W1i, 2 * FF, D, A.H, FF, A.ssq0);
    if (DUP_MASK & 64) GEMM_PHASE(pg8::EpiProbe<0>, A.xb, A.W1i, 2 * FF, D, A.H, FF, A.ssq0);
    if (DUP_MASK & 32768) GEMM_PHASE_X(false, 0, 3, pg8::EpiProbe<0>, A.xb, A.W1i, 2 * FF, D, A.H, FF, A.ssq0);
    if (DUP_MASK & 128) GEMM_PHASE(pg8::EpiProbe<1>, A.xb, A.W1i, 2 * FF, D, A.H, FF, A.ssq0);
    if (DUP_MASK & 2048) GEMM_PHASE(pg8::EpiProbe<2>, A.xb, A.W1i, 2 * FF, D, A.H, FF, A.ssq0);
    if (DUP_MASK & 4096) do { pg8::Gemm g_{A.xb, A.W1i, M, 2 * FF, D}; pg8::StaticOrder S_; S_.init(M, 2 * FF, G, (int)blockIdx.x); pg8::EpiProbe<0> E_{A.H, FF, A.ssq0}; pg8::gemm_phase<pg8::EpiProbe<0>, pg8::StaticOrder, true, true, 1, false, 1>(lds, g_, S_, E_, wave); } while (0);
    if (DUP_MASK & 16384) do { pg8::Gemm g_{A.xb, A.W1i, M, 2 * FF, D}; pg8::StaticOrder S_; S_.init(M, 2 * FF, G, (int)blockIdx.x); pg8::EpiProbe<0> E_{A.H, FF, A.ssq0}; pg8::gemm_phase<pg8::EpiProbe<0>, pg8::StaticOrder, true, true, 1, false, 3>(lds, g_, S_, E_, wave); } while (0);
    if (DUP_MASK & 8192) do { pg8::Gemm g_{A.xb, A.W1i, M, 2 * FF, D}; pg8::StaticOrder S_; S_.init(M, 2 * FF, G, (int)blockIdx.x); pg8::EpiProbe<0> E_{A.H, FF, A.ssq0}; pg8::gemm_phase<pg8::EpiProbe<0>, pg8::StaticOrder, true, true, 1, false, 2>(lds, g_, S_, E_, wave); } while (0);
#ifndef G1_TWICE
#define G1_TWICE 0
#endif
    GEMM_PHASE_X((BLOCKED_ACT != 0), 0, (G1_TWICE ? 2 : 0), pg8::EpiSwiglu, A.xb, A.W1i, 2 * FF, D, A.H, FF, A.ssq0);
    SEAM_SYNC();
    STAMP(2);
    if (STOP_AFTER <= 1) return;
    if (DUP_MASK & 256) GEMM_PHASE_B(pg8::EpiProbe<0>, A.H, A.W1o, D, FF, A.H, FF, A.ssq0);
    if (DUP_MASK & 512) GEMM_PHASE_B(pg8::EpiProbe<0>, A.H, A.W1o, D, FF, A.H, FF, A.ssq0);
    GEMM_PHASE_HNT(EpiRes2, A.H, A.W1o, D, FF, nullptr, A.xb, A.x1, A.xb, A.ssq1);
    SEAM_SYNC();
    STAMP(3);
    if (STOP_AFTER <= 2) return;
    GEMM_PHASE_B(pg8::EpiMix, A.xb, A.Wmx, INW, D, A.ssq1, AL_Z, AL_Q, AL_K, AL_V, A.gc, A.ga, A.q_norm, A.k_norm);
    if (DUP_MASK & 16) GEMM_PHASE_B(pg8::EpiMix, A.xb, A.Wmx, INW, D, A.ssq1, AL_Z, AL_Q, AL_K, AL_V, A.gc, A.ga, A.q_norm, A.k_norm);
    SEAM_SYNC();
    STAMP(4);
    if (STOP_AFTER <= 3) return;
    const int cv_r = cvirt >> 3, cv_x = cvirt & 7;
    const int ch0 = LOCALM ? 32 * cv_x + cv_r : (int)blockIdx.x, chstep = LOCALM ? M / 128 : G;
    const int u0 = LOCALM ? (32 * cv_x + (cv_r >> 2)) * 4 + (cv_r & 3) : (int)blockIdx.x, ustep = LOCALM ? 32 : G, uend = LOCALM ? (cv_x + 1) * 128 : (M / 128) * HKV;
    if (DUP_MASK & 2) conv_phase<CONV_PROBE_VAR>(A, lds, wave, ch0, chstep, AL_Z);
#ifndef CA_ALTERNATE
#define CA_ALTERNATE 0
#endif
    {   const bool attn_first = CA_ALTERNATE && DUP_MASK == 0 && PROBE_PHASE < 0 && (cv_r & 1);
        _Pragma("unroll 1") for (int st_ = 0; st_ < 2; ++st_) {
            if ((st_ == 1) == attn_first) { conv_phase<0>(A, lds, wave, ch0, chstep, AL_Z); STAMP(5); }
            else {
                if ((DUP_MASK & 4) && ATTN_PROBE_VAR != 0) attn_phase<ATTN_PROBE_VAR>(A, lds, wave, u0, ustep, uend, AL_Q, AL_K, AL_V, (DUP_MASK & 4) ? A.o : AL_Q);
                _Pragma("unroll 1") for (int rep_ = 0; rep_ < (((DUP_MASK & 4) && ATTN_PROBE_VAR == 0) ? 2 : 1); ++rep_) attn_phase<0>(A, lds, wave, u0, ustep, uend, AL_Q, AL_K, AL_V, (DUP_MASK & 4) ? A.o : AL_Q);
            }
        }
    }
    SEAM_SYNC();
    STAMP(6);
    if (STOP_AFTER <= 4) return;
    do { pg8::Gemm g_{A.c, A.Wcp, M, D, D, (DUP_MASK & 4) ? A.o : AL_Q, A.Wao}; pg8::StaticOrder S_; S_.init(M, D, G, cvirt); pg8::EpiMerge E_{A.gc, A.ga, AL_Z};
         pg8::gemm_phase<pg8::EpiMerge, pg8::StaticOrder, true, true, 2, false, 0, 0, GEMM_PF, (GEMM_BAL != 0)>(lds, g_, S_, E_, wave); } while (0);
    SEAM_SYNC();
    STAMP(7);
    if (STOP_AFTER <= 6) return;
#ifndef G6_REV
#define G6_REV 0
#endif
    GEMM_PHASE_X((BLOCKED_ACT != 0), 0, G6_REV, EpiRes6, AL_Z, A.Wot, D, D, nullptr, A.xb, A.x2, A.xb, A.ssq2);
    SEAM_SYNC();
    STAMP(8);
    if (STOP_AFTER <= 7) return;
    GEMM_PHASE_B(pg8::EpiSwiglu, A.xb, A.W2i, 2 * FF, D, A.H2, FF, A.ssq2);
    if (DUP_MASK & 32) GEMM_PHASE_B(pg8::EpiSwiglu, A.xb, A.W2i, 2 * FF, D, A.H2, FF, A.ssq2);
    SEAM_SYNC();
    STAMP(9);
#ifndef G8_TWICE
#define G8_TWICE 0
#endif
    GEMM_PHASE_X((BLOCKED_ACT != 0 || BLOCKED_H != 0), H_NT, (G8_TWICE ? 2 : H_REV), EpiRes8, A.H2, A.W2o, D, FF, nullptr, A.xb, A.out, nullptr, nullptr);
    if (PROBE_PHASE >= 0) { __syncthreads(); STAMP(10); if (blockIdx.x == PROBE_BLOCK) { __syncthreads(); const unsigned d_ = PROBE_ALL ? (MISC[5] - MISC[4]) : CLK_PROBE ? (unsigned)((unsigned long long)(MISC[7] - MISC[6]) * 1000ull / (MISC[5] - MISC[4])) : 8u * (MISC[5] - MISC[4]); const unsigned long long t0_ = __builtin_amdgcn_s_memrealtime(); while ((unsigned)(__builtin_amdgcn_s_memrealtime() - t0_) < d_) __builtin_amdgcn_s_sleep(8); } }
    if (DUP_MASK & 1024) { _Pragma("unroll 1") for (int i_ = 0; i_ < 8; ++i_) GRID_SYNC(); }
#undef GEMM_PHASE
#undef GEMM_PHASE_B
#undef GEMM_PHASE_
#undef GEMM_PHASE_X
#undef GEMM_PHASE_HNT
#undef GRID_SYNC
}

static size_t ws_map(Args& a, unsigned char* ws, int M, bool alias) {
    size_t off = 0;
    auto take = [&](size_t bytes) { unsigned char* p = ws + off; off += (bytes + 255) & ~(size_t)255; return p; };
    const size_t act = (size_t)M * D * 2;
#ifndef H2_OVER_GATES
#define H2_OVER_GATES 0
#endif
#ifndef WS_TOP
#define WS_TOP 1
#endif
    if (alias && WS_TOP && WS_TOP != 3) {
        a.gc = (bf16*)take(act); a.ga = (bf16*)take(act); a.c = (bf16*)take(act);
        a.W1o = (bf16*)take((size_t)D * FF * 2); a.Wmx = (bf16*)take((size_t)INW * D * 2);
        a.Wcp = (bf16*)take((size_t)D * D * 2); a.Wao = (bf16*)take((size_t)D * D * 2); a.Wot = (bf16*)take((size_t)D * D * 2);
        a.W2i = (bf16*)take((size_t)2 * FF * D * 2); a.W2o = (bf16*)take((size_t)D * FF * 2);
        a.ctl = (unsigned*)take(1u << 20);
        a.ssq0 = (float*)take((size_t)M * 4); a.ssq1 = (float*)take((size_t)M * 4); a.ssq2 = (float*)take((size_t)M * 4);
#if WS_TOP == 2
        a.H = (bf16*)take((size_t)M * FF * 2); a.H2 = a.H;
        a.W1i = (bf16*)take((size_t)2 * FF * D * 2);
        a.xb = (bf16*)take(act);
#else
        a.W1i = (bf16*)take((size_t)2 * FF * D * 2);
        a.xb = (bf16*)take(act);
        a.H = (bf16*)take((size_t)M * FF * 2); a.H2 = a.H;
#endif
        a.z = a.H; a.q = a.z + (size_t)M * D; a.k = a.q + (size_t)M * D; a.v = a.k + (size_t)M * 256;
        a.o = a.q; a.m1 = nullptr; a.mg = a.z;
#if H2_OVER_GATES
        a.H2 = a.gc;
#endif
        return off;
    }
    a.ctl = (unsigned*)take(1u << 20);
    a.ssq0 = (float*)take((size_t)M * 4); a.ssq1 = (float*)take((size_t)M * 4); a.ssq2 = (float*)take((size_t)M * 4);
    a.W1i = (bf16*)take((size_t)2 * FF * D * 2); a.W1o = (bf16*)take((size_t)D * FF * 2); a.Wmx = (bf16*)take((size_t)INW * D * 2);
    a.Wcp = (bf16*)take((size_t)D * D * 2); a.Wao = (bf16*)take((size_t)D * D * 2); a.Wot = (bf16*)take((size_t)D * D * 2);
    a.W2i = (bf16*)take((size_t)2 * FF * D * 2); a.W2o = (bf16*)take((size_t)D * FF * 2);
    a.xb = (bf16*)take(act);
    a.H = (bf16*)take((size_t)M * FF * 2); a.H2 = a.H;
    if (alias) {
        a.z = a.H; a.q = a.z + (size_t)M * D; a.k = a.q + (size_t)M * D; a.v = a.k + (size_t)M * 256;
        a.gc = (bf16*)take(act); a.ga = (bf16*)take(act); a.c = (bf16*)take(act);
        a.o = a.q; a.m1 = nullptr; a.mg = a.z;
    } else {
        a.z = (bf16*)take(act); a.q = (bf16*)take(act); a.k = (bf16*)take((size_t)M * 256 * 2); a.v = (bf16*)take((size_t)M * 256 * 2);
        a.gc = (bf16*)take(act); a.ga = (bf16*)take(act); a.c = (bf16*)take(act);
        a.o = (bf16*)take(act); a.m1 = nullptr; a.mg = (bf16*)take(act);
    }
    return off;
}
static void set_inputs(Args& a, void* const* d_in) {
    a.x = (const float*)d_in[0]; a.ffn1_norm = (const float*)d_in[1]; a.ffn1_w_in = (const float*)d_in[2]; a.ffn1_w_out = (const float*)d_in[3];
    a.mix_norm = (const float*)d_in[4]; a.w_in = (const float*)d_in[5]; a.conv_w = (const float*)d_in[6]; a.conv_b = (const float*)d_in[7];
    a.ln_g = (const float*)d_in[8]; a.ln_b = (const float*)d_in[9]; a.conv_proj = (const float*)d_in[10]; a.q_norm = (const float*)d_in[11];
    a.k_norm = (const float*)d_in[12]; a.sinks = (const float*)d_in[13]; a.rel_bias = (const float*)d_in[14]; a.attn_wo = (const float*)d_in[15];
    a.w_out = (const float*)d_in[16]; a.ffn2_norm = (const float*)d_in[17]; a.ffn2_w_in = (const float*)d_in[18]; a.ffn2_w_out = (const float*)d_in[19];
}
static int g_grid = 0;
static bool launch_mega(Args& a, hipStream_t stream) {
    if (g_grid == 0) {
        int dev = 0, cus = 0, per_cu = 0;
        if (hipGetDevice(&dev) != hipSuccess || hipDeviceGetAttribute(&cus, hipDeviceAttributeMultiprocessorCount, dev) != hipSuccess) { g_grid = -1; return false; }
        if (hipFuncSetAttribute((const void*)mega_fwd, hipFuncAttributeMaxDynamicSharedMemorySize, LDS_BYTES) != hipSuccess) { fprintf(stderr, "hipFuncSetAttribute failed\n"); g_grid = -1; return false; }
        if (hipOccupancyMaxActiveBlocksPerMultiprocessor(&per_cu, (const void*)mega_fwd, NTHREADS, LDS_BYTES) != hipSuccess || per_cu < 1) { fprintf(stderr, "occupancy query: %d blocks per CU\n", per_cu); g_grid = -1; (void)hipGetLastError(); return false; }
        g_grid = cus;
    }
    if (g_grid < 0) return false;
    void* args[] = {&a};
    const hipError_t e = hipLaunchCooperativeKernel((const void*)mega_fwd, dim3(g_grid), dim3(NTHREADS), args, LDS_BYTES, stream);
    if (e != hipSuccess) { fprintf(stderr, "cooperative launch failed: %s (grid %d)\n", hipGetErrorString(e), g_grid); return false; }
    return true;
}
#if DEBUG_ORACLE
namespace nv {
constexpr int S = SEQ, B = NB;
constexpr float EPS = 1e-6f;
__device__ __forceinline__ float sigmoidf_(float v) { return 1.f / (1.f + expf(-v)); }
__device__ __forceinline__ float siluf_(float v) { return v / (1.f + expf(-v)); }
__device__ __forceinline__ float block_sum_256(float v, float* red) {
    for (int o = 32; o > 0; o >>= 1) v += __shfl_xor(v, o);
    const int w = threadIdx.x >> 6, l = threadIdx.x & 63;
    __syncthreads(); if (l == 0) red[w] = v; __syncthreads();
    return red[0] + red[1] + red[2] + red[3];
}
__global__ void rms_rows(const float* x, const float* g, float* out) {
    __shared__ float red[4];
    const size_t r = blockIdx.x;
    const float4 v = ((const float4*)(x + r * D))[threadIdx.x];
    const float ss = block_sum_256(v.x * v.x + v.y * v.y + v.z * v.z + v.w * v.w, red);
    const float rs = rsqrtf(ss * (1.f / D) + EPS);
    const float4 gg = ((const float4*)g)[threadIdx.x];
    float4 o; o.x = v.x * rs * gg.x; o.y = v.y * rs * gg.y; o.z = v.z * rs * gg.z; o.w = v.w * rs * gg.w;
    ((float4*)(out + r * D))[threadIdx.x] = o;
}
__global__ void gemm_f32(const float* __restrict__ A, int lda, const float* __restrict__ Bm, int ldb, float* __restrict__ C, int ldc, int K) {
    __shared__ float As[16][68];
    __shared__ float Bs[16][68];
    const int tx = threadIdx.x & 15, ty = threadIdx.x >> 4;
    const int m0 = blockIdx.y * 64, n0 = blockIdx.x * 64;
    float acc[4][4] = {};
    for (int k0 = 0; k0 < K; k0 += 16) {
        {
            const int r = threadIdx.x >> 2, kq = (threadIdx.x & 3) * 4;
            const float4 a = *(const float4*)(A + (size_t)(m0 + r) * lda + k0 + kq);
            As[kq + 0][r] = a.x; As[kq + 1][r] = a.y; As[kq + 2][r] = a.z; As[kq + 3][r] = a.w;
            const int kr = threadIdx.x >> 4, c4 = (threadIdx.x & 15) * 4;
            *(float4*)&Bs[kr][c4] = *(const float4*)(Bm + (size_t)(k0 + kr) * ldb + n0 + c4);
        }
        __syncthreads();
#pragma unroll
        for (int k = 0; k < 16; ++k) {
            const float4 a = *(const float4*)&As[k][ty * 4];
            const float4 b = *(const float4*)&Bs[k][tx * 4];
            const float av[4] = {a.x, a.y, a.z, a.w}, bv[4] = {b.x, b.y, b.z, b.w};
#pragma unroll
            for (int i = 0; i < 4; ++i)
#pragma unroll
                for (int j = 0; j < 4; ++j) acc[i][j] = fmaf(av[i], bv[j], acc[i][j]);
        }
        __syncthreads();
    }
#pragma unroll
    for (int i = 0; i < 4; ++i) { float4 o; o.x = acc[i][0]; o.y = acc[i][1]; o.z = acc[i][2]; o.w = acc[i][3]; *(float4*)(C + (size_t)(m0 + ty * 4 + i) * ldc + n0 + tx * 4) = o; }
}
__global__ void swiglu_k(const float* U, float* H, int rows) {
    const size_t i = (size_t)blockIdx.x * blockDim.x + threadIdx.x;
    if (i >= (size_t)rows * FF) return;
    const size_t t = i / FF; const int j = (int)(i % FF);
    H[i] = siluf_(U[t * (2 * FF) + j]) * U[t * (2 * FF) + FF + j];
}
__global__ void resid_k(const float* xin, const float* y, float scale, float* out, size_t n) {
    const size_t i = (size_t)blockIdx.x * blockDim.x + threadIdx.x;
    if (i < n) out[i] = xin[i] + scale * y[i];
}
__global__ void glu_k(const float* P, float* z, int rows) {
    const size_t i = (size_t)blockIdx.x * blockDim.x + threadIdx.x;
    if (i >= (size_t)rows * D) return;
    const size_t t = i / D; const int c = (int)(i % D);
    z[i] = P[t * INW + c] * sigmoidf_(P[t * INW + D + c]);
}
__global__ void conv_k(const float* z, const float* w, const float* bias, float* y) {
    const size_t i = (size_t)blockIdx.x * blockDim.x + threadIdx.x;
    if (i >= (size_t)S * D) return;
    const int t = (int)(i / D), c = (int)(i % D);
    float acc = bias[c];
    for (int k = 0; k < CWID; ++k) { const int tt = t - (CWID - 1) + k; if (tt >= 0) acc = fmaf(w[k * D + c], z[(size_t)tt * D + c], acc); }
    y[i] = acc;
}
__global__ void ln_silu_k(const float* y, const float* g, const float* b, float* out) {
    __shared__ float red[4];
    const size_t r = blockIdx.x;
    const float4 v = ((const float4*)(y + r * D))[threadIdx.x];
    const float mu = block_sum_256(v.x + v.y + v.z + v.w, red) * (1.f / D);
    const float dx = v.x - mu, dy = v.y - mu, dz = v.z - mu, dw = v.w - mu;
    const float var = block_sum_256(dx * dx + dy * dy + dz * dz + dw * dw, red) * (1.f / D);
    const float rs = rsqrtf(var + EPS);
    const float4 gg = ((const float4*)g)[threadIdx.x], bb = ((const float4*)b)[threadIdx.x];
    float4 o; o.x = siluf_(dx * rs * gg.x + bb.x); o.y = siluf_(dy * rs * gg.y + bb.y); o.z = siluf_(dz * rs * gg.z + bb.z); o.w = siluf_(dw * rs * gg.w + bb.w);
    ((float4*)(out + r * D))[threadIdx.x] = o;
}
__global__ void qknorm_k(const float* P, const float* qg, const float* kg, float* qn, float* kn) {
    const int wv = (blockIdx.x * 4) + (threadIdx.x >> 6), lane = threadIdx.x & 63;
    const int t = wv / (HQ + HKV), hh = wv % (HQ + HKV);
    if (t >= S) return;
    const bool isq = hh < HQ;
    const int h = isq ? hh : hh - HQ;
    const float v = P[(size_t)t * INW + (isq ? 2 * D + h * HD : 3 * D + h * HD) + lane];
    float ss = v * v;
    for (int o = 32; o > 0; o >>= 1) ss += __shfl_xor(ss, o);
    const float rs = rsqrtf(ss * (1.f / HD) + EPS);
    if (isq) qn[(size_t)t * (HQ * HD) + h * HD + lane] = v * rs * qg[lane];
    else     kn[(size_t)t * (HKV * HD) + h * HD + lane] = v * rs * kg[lane];
}
__global__ void attn_k(const float* qn, const float* kn, const float* P, const float* sinks, const float* rel_bias, float* o) {
    const int wv = (blockIdx.x * 4) + (threadIdx.x >> 6), lane = threadIdx.x & 63;
    const int t = wv / HQ, h = wv % HQ, hk = h / (HQ / HKV);
    if (t >= S) return;
    const float* q = qn + (size_t)t * (HQ * HD) + h * HD;
    float s[2];
#pragma unroll
    for (int u = 0; u < 2; ++u) {
        const int dist = lane + 64 * u, key = t - dist;
        float acc = -3.0e38f;
        if (key >= 0) {
            const float* kr = kn + (size_t)key * (HKV * HD) + hk * HD;
            float d = 0.f;
            for (int e = 0; e < HD; ++e) d = fmaf(q[e], kr[e], d);
            acc = d * 0.125f + rel_bias[T5B[dist] * HQ + h];
        }
        s[u] = acc;
    }
    const float sink = sinks[h];
    float m = fmaxf(fmaxf(s[0], s[1]), sink);
    for (int of = 32; of > 0; of >>= 1) m = fmaxf(m, __shfl_xor(m, of));
    float p0 = (t - lane >= 0) ? expf(s[0] - m) : 0.f, p1 = (t - lane - 64 >= 0) ? expf(s[1] - m) : 0.f;
    float l = p0 + p1;
    for (int of = 32; of > 0; of >>= 1) l += __shfl_xor(l, of);
    l += expf(sink - m);
    const float inv = 1.f / l;
    float acc = 0.f;
    for (int j = 0; j < 64; ++j) {
        const float pj0 = __shfl(p0, j), pj1 = __shfl(p1, j);
        const int k0 = t - j, k1 = t - j - 64;
        if (k0 >= 0) acc = fmaf(pj0, P[(size_t)k0 * INW + 3 * D + HKV * HD + hk * HD + lane], acc);
        if (k1 >= 0) acc = fmaf(pj1, P[(size_t)k1 * INW + 3 * D + HKV * HD + hk * HD + lane], acc);
    }
    o[(size_t)t * (HQ * HD) + h * HD + lane] = acc * inv;
}
__global__ void merge_k(const float* P, const float* a, const float* b, float* mg, int rows) {
    const size_t i = (size_t)blockIdx.x * blockDim.x + threadIdx.x;
    if (i >= (size_t)rows * D) return;
    const size_t t = i / D; const int c = (int)(i % D);
    mg[i] = sigmoidf_(P[t * INW + 3584 + c]) * a[i] + sigmoidf_(P[t * INW + 4608 + c]) * b[i];
}
static void gemm(const float* A, int lda, const float* Bm, int ldb, float* C, int ldc, int M, int N, int K, hipStream_t st) {
    hipLaunchKernelGGL(gemm_f32, dim3(N / 64, M / 64), dim3(256), 0, st, A, lda, Bm, ldb, C, ldc, K);
}
__global__ void cmp_k(const void* a, int a_is_bf16, int lda, float ascale, const float* ref, int ldr, int sig, int rows, int cols, unsigned* slot, int blk) {
    const size_t i = (size_t)blockIdx.x * blockDim.x + threadIdx.x;
    float d = 0.f, r2 = 0.f;
    if (i < (size_t)rows * cols) {
        const size_t t = i / cols; const int c = (int)(i % cols);
        const size_t ai_ = blk ? (((t >> 4) * (size_t)(blk >> 5) + (c >> 5)) * 512 + (t & 15) * 32 + (c & 31)) : t * lda + c;
        float av = a_is_bf16 ? __uint_as_float((unsigned)((const unsigned short*)a)[ai_] << 16) : ((const float*)a)[ai_];
        float rv = ref[t * ldr + c]; if (sig) rv = sigmoidf_(rv);
        d = fabsf(av * ascale - rv); if (!(d == d)) d = 1e30f; r2 = rv * rv;
    }
    float d2 = d * d;
    for (int o = 32; o > 0; o >>= 1) { d = fmaxf(d, __shfl_xor(d, o)); r2 += __shfl_xor(r2, o); d2 += __shfl_xor(d2, o); }
    if ((threadIdx.x & 63) == 0) { atomicMax(slot, __float_as_uint(d)); atomicAdd((float*)(slot + 1), r2); atomicAdd((float*)(slot + 2), d2); }
}
constexpr int NCHK = 16;
struct Counts { float c[NCHK]; };
__global__ void decide_k(unsigned* slots, Counts cnt, float tol, float* code_out) {
    if (threadIdx.x != 0 || blockIdx.x != 0) return;
    float code = 0.f;
    for (int k = 0; k < NCHK; ++k) {
        if (cnt.c[k] <= 0.f) continue;
        const float md = __uint_as_float(slots[4 * k]), rr = __uint_as_float(slots[4 * k + 1]), dd = __uint_as_float(slots[4 * k + 2]);
        const float rms = sqrtf(rr / cnt.c[k]), rmsr = sqrtf(dd / fmaxf(rr, 1e-30f));
        if (!(rmsr <= tol) || !(md <= 0.5f * rms)) { code = (float)(k + 1) + (rmsr < 0.03f ? 0.f : rmsr < 0.3f ? 0.3f : 0.6f); break; }
    }
    *code_out = code;
}
__global__ void finish_k(float* out, const float* mega_out, size_t dbg_off, size_t dbg_n, size_t n, const float* code) {
    const size_t i = (size_t)blockIdx.x * blockDim.x + threadIdx.x;
    if (i >= n) return;
    const float c = *code;
    float v = out[i];
    if (c == 0.f && i >= dbg_off && i < dbg_off + dbg_n) v = mega_out[i - dbg_off];
    out[i] = v * (1.f + c);
}
}
#ifndef DBG_B
#define DBG_B 5
#endif
#ifndef DBG_TOL
#define DBG_TOL 0.01f
#endif
#endif

#ifndef MEMSET_PROBE
#define MEMSET_PROBE 0
#endif
extern "C" void kernel_launch(void* const* d_in, const int* in_sizes, int n_in, void* d_out, int out_size, void* d_ws, size_t ws_size, hipStream_t stream) {
    (void)in_sizes; (void)n_in; (void)out_size;
#if !DEBUG_ORACLE
    Args a{};
    set_inputs(a, d_in);
    a.out = (float*)d_out; a.x1 = nullptr; a.x2 = nullptr;
    {
        Args t{}; const size_t used = ws_map(t, (unsigned char*)d_ws, M_FULL, true);
        const size_t shift = (WS_TOP && ws_size > used) ? ((ws_size - used) & ~(size_t)4095) : 0;
        ws_map(a, (unsigned char*)d_ws + shift, M_FULL, true);
    }
    a.M = M_FULL;
#if (DUP_MASK & 4)
    a.o = (bf16*)d_out;
#endif
#if MEMSET_PROBE
    if (hipMemsetAsync((unsigned char*)a.ctl + 65536, 0, 4096, stream) != hipSuccess) return;
#endif
    if (hipMemsetAsync(a.ctl, 0, CTL_ZERO_BYTES, stream) != hipSuccess) return;
    launch_mega(a, stream);
#else
    using namespace nv;
    unsigned char* wsb = (unsigned char*)d_ws;
    Args a{};
    set_inputs(a, d_in);
    a.x += (size_t)DBG_B * S * D;
    size_t used = ws_map(a, wsb, S, false);
    auto takeb = [&](size_t bytes) { unsigned char* p = wsb + used; used += (bytes + 255) & ~(size_t)255; return p; };
    a.x1 = (float*)takeb((size_t)S * D * 4); a.x2 = (float*)takeb((size_t)S * D * 4); a.out = (float*)takeb((size_t)S * D * 4);
    a.H2 = (bf16*)takeb((size_t)S * FF * 2);
    a.M = S;
    unsigned* slots = (unsigned*)takeb(256); float* code = (float*)takeb(256);
    Counts hc{};
    const float* x = (const float*)d_in[0];
    float* out = (float*)d_out;
    float* xn = (float*)takeb((size_t)S * D * 4); float* U = (float*)takeb((size_t)S * INW * 4); float* Hh = (float*)takeb((size_t)S * FF * 4); float* Y = (float*)takeb((size_t)S * D * 4);
    float* z = (float*)takeb((size_t)S * D * 4); float* cy = xn; float* cv = (float*)takeb((size_t)S * D * 4); float* qn = (float*)takeb((size_t)S * D * 4);
    float* kn = (float*)takeb((size_t)S * 256 * 4); float* ao = (float*)takeb((size_t)S * D * 4); float* av = (float*)takeb((size_t)S * D * 4); float* bv = (float*)takeb((size_t)S * D * 4);
    float* mg = (float*)takeb((size_t)S * D * 4);
    if (used > ws_size) { fprintf(stderr, "debug build needs %zu bytes of workspace, have %zu\n", used, ws_size); return; }
    hipMemsetAsync(slots, 0, 256, stream);
    hipMemsetAsync(a.ctl, 0, CTL_ZERO_BYTES, stream);
    launch_mega(a, stream);
    const int EB = 256; const size_t n1 = (size_t)S * D;
    int nchk = 0;
    auto chk = [&](const void* ap, int isbf, int lda, float asc, const float* ref, int ldr, int sig, int rows, int cols, int blk = 0) {
        const size_t n = (size_t)rows * cols;
        hipLaunchKernelGGL(cmp_k, dim3((unsigned)((n + 255) / 256)), dim3(256), 0, stream, ap, isbf, lda, asc, ref, ldr, sig, rows, cols, slots + 4 * nchk, BLOCKED_ACT ? blk : 0);
        hc.c[nchk] = (float)n; ++nchk;
    };
    for (int bi = 0; bi < B; ++bi) {
        const int b = (bi == B - 1) ? DBG_B : (bi >= DBG_B ? bi + 1 : bi);
        const bool dbg = (b == DBG_B);
        const float* xbp = x + (size_t)b * S * D; float* ob = out + (size_t)b * S * D;
        hipLaunchKernelGGL(rms_rows, dim3(S), dim3(256), 0, stream, xbp, a.ffn1_norm, xn);
        gemm(xn, D, a.ffn1_w_in, 2 * FF, U, 2 * FF, S, 2 * FF, D, stream);
        hipLaunchKernelGGL(swiglu_k, dim3((unsigned)(((size_t)S * FF + EB - 1) / EB)), dim3(EB), 0, stream, U, Hh, S);
        if (dbg) chk(a.H, 1, FF, 1.f, Hh, FF, 0, S, FF, FF);
        gemm(Hh, FF, a.ffn1_w_out, D, Y, D, S, D, FF, stream);
        hipLaunchKernelGGL(resid_k, dim3((unsigned)((n1 + EB - 1) / EB)), dim3(EB), 0, stream, xbp, Y, 0.5f, ob, n1);
        if (dbg) chk(a.x1, 0, D, 1.f, ob, D, 0, S, D);
        hipLaunchKernelGGL(rms_rows, dim3(S), dim3(256), 0, stream, ob, a.mix_norm, xn);
        gemm(xn, D, a.w_in, INW, U, INW, S, INW, D, stream);
        hipLaunchKernelGGL(glu_k, dim3((unsigned)((n1 + EB - 1) / EB)), dim3(EB), 0, stream, U, z, S);
        if (dbg) chk(a.z, 1, D, 1.f, z, D, 0, S, D);
        hipLaunchKernelGGL(qknorm_k, dim3(S * (HQ + HKV) / 4), dim3(256), 0, stream, U, a.q_norm, a.k_norm, qn, kn);
        if (dbg) { chk(a.q, 1, D, 1.f / (0.125f * 1.4426950408889634f), qn, D, 0, S, D);
                   chk(a.k, 1, 256, 1.f, kn, 256, 0, S, 256);
                   chk(a.v, 1, 256, 1.f, U + 3328, INW, 0, S, 256);
                   chk(a.ga, 1, D, 1.f, U + 4608, INW, 1, S, D, D);
                   chk(a.ga, 1, D, 1.f, U + 4608, INW, 1, S, D, D); }
        hipLaunchKernelGGL(conv_k, dim3((unsigned)((n1 + EB - 1) / EB)), dim3(EB), 0, stream, z, a.conv_w, a.conv_b, cy);
        hipLaunchKernelGGL(ln_silu_k, dim3(S), dim3(256), 0, stream, cy, a.ln_g, a.ln_b, cv);
        if (dbg) chk(a.c, 1, D, 1.f, cv, D, 0, S, D);
        gemm(cv, D, a.conv_proj, D, av, D, S, D, D, stream);
        hipLaunchKernelGGL(attn_k, dim3(S * HQ / 4), dim3(256), 0, stream, qn, kn, U, a.sinks, a.rel_bias, ao);
        if (dbg) chk(a.o, 1, D, 1.f, ao, D, 0, S, D);
        gemm(ao, D, a.attn_wo, D, bv, D, S, D, D, stream);
        hipLaunchKernelGGL(merge_k, dim3((unsigned)((n1 + EB - 1) / EB)), dim3(EB), 0, stream, U, av, bv, mg, S);
        if (dbg) chk(a.mg, 1, D, 1.f, mg, D, 0, S, D, D);
        gemm(mg, D, a.w_out, D, Y, D, S, D, D, stream);
        hipLaunchKernelGGL(resid_k, dim3((unsigned)((n1 + EB - 1) / EB)), dim3(EB), 0, stream, ob, Y, 1.0f, ob, n1);
        if (dbg) chk(a.x2, 0, D, 1.f, ob, D, 0, S, D);
        hipLaunchKernelGGL(rms_rows, dim3(S), dim3(256), 0, stream, ob, a.ffn2_norm, xn);
        gemm(xn, D, a.ffn2_w_in, 2 * FF, U, 2 * FF, S, 2 * FF, D, stream);
        hipLaunchKernelGGL(swiglu_k, dim3((unsigned)(((size_t)S * FF + EB - 1) / EB)), dim3(EB), 0, stream, U, Hh, S);
        if (dbg) chk(a.H2, 1, FF, 1.f, Hh, FF, 0, S, FF, FF);
        gemm(Hh, FF, a.ffn2_w_out, D, Y, D, S, D, FF, stream);
        hipLaunchKernelGGL(resid_k, dim3((unsigned)((n1 + EB - 1) / EB)), dim3(EB), 0, stream, ob, Y, 0.5f, ob, n1);
        if (dbg) chk(a.out, 0, D, 1.f, ob, D, 0, S, D);
    }
    hipLaunchKernelGGL(decide_k, dim3(1), dim3(64), 0, stream, slots, hc, DBG_TOL, code);
    const size_t nall = (size_t)B * S * D;
    hipLaunchKernelGGL(finish_k, dim3((unsigned)((nall + 255) / 256)), dim3(256), 0, stream, out, a.out, (size_t)DBG_B * S * D, (size_t)S * D, nall, code);
#endif
}
```
